# Optimizing an MI355X kernel written in HIP

```python
import jax, jax.numpy as jnp
from jax import lax
import numpy as np

D_MODEL = 1024
BATCH = 16
SEQ = 4096
DEPTH = 4

N_A_LAYERS = DEPTH // 2
N_B_LAYERS = DEPTH - N_A_LAYERS

A_HEADS = 8
A_QK_DIM = D_MODEL // 2
A_V_DIM = D_MODEL
A_QK_HEAD = A_QK_DIM // A_HEADS
A_V_HEAD = A_V_DIM // A_HEADS
A_IN_DIM = 2 * A_QK_DIM + 2 * A_V_DIM + 2 * A_HEADS
A_CHUNK = 64
GATE_SOFTCAP = 15.0

B_HEADS = 16
B_HEAD_DIM = D_MODEL // B_HEADS
Q_BLOCK = 128
KV_OUT_DIM = 2 * D_MODEL + B_HEADS

N_EXPERTS = 16
N_GROUPS = 4
EXPERTS_PER_GROUP = N_EXPERTS // N_GROUPS
TOP_K = 2
D_EXPERT = D_MODEL // 2
MOE_BLOCK = 256

N_MOD = 6
EPS = 1e-6
F32 = jnp.float32

kernel_name = "mlstm_fox_yoco_grouped_moe_adaln"


def rmsnorm(x, g):
    xf = x.astype(F32)
    y = xf * lax.rsqrt(jnp.mean(xf * xf, axis=-1, keepdims=True) + EPS)
    return (y * g.astype(F32)).astype(x.dtype)


def modulate(h, shift, scale):
    return h * (1 + scale[:, None, :]) + shift[:, None, :]


def softcap(x, cap):
    return cap * jnp.tanh(x / cap)


def mlstm_cell(q, k, v, ig, lf):
    B, H, S, dk = q.shape
    dv = v.shape[-1]
    nc = S // A_CHUNK

    def chunks(t):
        return jnp.moveaxis(t.reshape(t.shape[:2] + (nc, A_CHUNK) + t.shape[3:]), 2, 0)

    tri = jnp.tril(jnp.ones((A_CHUNK, A_CHUNK), dtype=bool))

    def step(carry, xs):
        C, n, m = carry
        qc, kc, vc, igc, lfc = xs
        b = jnp.cumsum(lfc, axis=-1)
        d_intra = jnp.where(tri, b[..., :, None] - b[..., None, :] + igc[..., None, :], -jnp.inf)
        d_inter = b + m[..., None]
        m_t = jnp.maximum(d_inter, jnp.max(d_intra, axis=-1))
        w = jnp.exp(d_intra - m_t[..., None]) * jnp.einsum('bhtd,bhsd->bhts', qc, kc)
        a = jnp.exp(d_inter - m_t)
        num = jnp.einsum('bhts,bhsv->bhtv', w, vc) + a[..., None] * jnp.einsum('bhtd,bhdv->bhtv', qc, C)
        den = jnp.sum(w, axis=-1) + a * jnp.einsum('bhtd,bhd->bht', qc, n)
        h = num / jnp.maximum(jnp.abs(den), jnp.exp(-m_t))[..., None]
        b_last = b[..., -1]
        g = b_last[..., None] - b + igc
        m_new = jnp.maximum(b_last + m, jnp.max(g, axis=-1))
        wk = jnp.exp(g - m_new[..., None])
        decay = jnp.exp(b_last + m - m_new)
        C = decay[..., None, None] * C + jnp.einsum('bhs,bhsd,bhsv->bhdv', wk, kc, vc)
        n = decay[..., None] * n + jnp.einsum('bhs,bhsd->bhd', wk, kc)
        return (C, n, m_new), h

    init = (jnp.zeros((B, H, dk, dv), F32), jnp.zeros((B, H, dk), F32), jnp.zeros((B, H), F32))
    _, hs = lax.scan(step, init, (chunks(q), chunks(k), chunks(v), chunks(ig), chunks(lf)))
    return jnp.moveaxis(hs, 0, 2).reshape(B, H, S, dv)


def mlstm_layer(h, w_in, b_gates, mh_norm, w_out):
    B, S, _ = h.shape
    proj = jnp.einsum('bsd,de->bse', h, w_in)
    q, k, v, o, gates = jnp.split(
        proj, [A_QK_DIM, 2 * A_QK_DIM, 2 * A_QK_DIM + A_V_DIM, 2 * A_QK_DIM + 2 * A_V_DIM], axis=-1)
    gates = softcap(gates.astype(F32) + b_gates.astype(F32), GATE_SOFTCAP)
    ig = jnp.transpose(gates[..., :A_HEADS], (0, 2, 1))
    lf = jax.nn.log_sigmoid(jnp.transpose(gates[..., A_HEADS:], (0, 2, 1)))

    def heads(t, dh):
        return t.astype(F32).reshape(B, S, A_HEADS, dh).transpose(0, 2, 1, 3)

    hs = mlstm_cell(heads(q, A_QK_HEAD) * (A_QK_HEAD ** -0.5), heads(k, A_QK_HEAD), heads(v, A_V_HEAD), ig, lf)
    hs = hs * lax.rsqrt(jnp.mean(hs * hs, axis=-1, keepdims=True) + EPS)
    hs = hs.transpose(0, 2, 1, 3) * mh_norm.astype(F32).reshape(A_HEADS, A_V_HEAD)
    out = hs.reshape(B, S, A_V_DIM) * jax.nn.sigmoid(o.astype(F32))
    return jnp.einsum('bse,ed->bsd', out.astype(h.dtype), w_out)


def shared_kv(x, kv_norm, shift, scale, w_kv, b_fgate):
    B, S, _ = x.shape
    h = modulate(rmsnorm(x, kv_norm), shift, scale)
    kvf = jnp.einsum('bsd,de->bse', h, w_kv)
    k = kvf[..., :D_MODEL].reshape(B, S, B_HEADS, B_HEAD_DIM).transpose(0, 2, 1, 3)
    v = kvf[..., D_MODEL:2 * D_MODEL].reshape(B, S, B_HEADS, B_HEAD_DIM).transpose(0, 2, 1, 3)
    log_f = jax.nn.log_sigmoid(kvf[..., 2 * D_MODEL:].astype(F32) + b_fgate.astype(F32))
    fcum = jnp.cumsum(log_f, axis=1).transpose(0, 2, 1)
    return k, v, fcum


def fox_layer(h, w_q, w_o, k, v, fcum):
    B, S, _ = h.shape
    nb = S // Q_BLOCK
    q = jnp.einsum('bsd,de->bse', h, w_q).reshape(B, S, B_HEADS, B_HEAD_DIM).transpose(0, 2, 1, 3)
    q_blocks = jnp.moveaxis(q.reshape(B, B_HEADS, nb, Q_BLOCK, B_HEAD_DIM), 2, 0)
    f_blocks = jnp.moveaxis(fcum.reshape(B, B_HEADS, nb, Q_BLOCK), 2, 0)
    offs = jnp.arange(Q_BLOCK)
    scale = B_HEAD_DIM ** -0.5

    def query_block(args):
        i, qi, fi = args
        qi = qi.astype(F32) * scale
        q_pos = i * Q_BLOCK + offs

        def key_block(j, carry):
            m, l, acc = carry
            kj = lax.dynamic_slice_in_dim(k, j * Q_BLOCK, Q_BLOCK, axis=2).astype(F32)
            vj = lax.dynamic_slice_in_dim(v, j * Q_BLOCK, Q_BLOCK, axis=2).astype(F32)
            fj = lax.dynamic_slice_in_dim(fcum, j * Q_BLOCK, Q_BLOCK, axis=2)
            s = jnp.einsum('bhtd,bhsd->bhts', qi, kj) + fi[..., :, None] - fj[..., None, :]
            s = jnp.where(q_pos[:, None] >= (j * Q_BLOCK + offs)[None, :], s, -jnp.inf)
            m_new = jnp.maximum(m, jnp.max(s, axis=-1))
            p = jnp.exp(s - m_new[..., None])
            corr = jnp.exp(m - m_new)
            return (m_new, corr * l + jnp.sum(p, axis=-1),
                    corr[..., None] * acc + jnp.einsum('bhts,bhsd->bhtd', p, vj))

        init = (jnp.full((B, B_HEADS, Q_BLOCK), -jnp.inf, F32), jnp.zeros((B, B_HEADS, Q_BLOCK), F32),
                jnp.zeros((B, B_HEADS, Q_BLOCK, B_HEAD_DIM), F32))
        _, l, acc = lax.fori_loop(0, i + 1, key_block, init)
        return acc / l[..., None]

    o = lax.map(query_block, (jnp.arange(nb), q_blocks, f_blocks))
    o = jnp.moveaxis(o, 0, 2).reshape(B, B_HEADS, S, B_HEAD_DIM).transpose(0, 2, 1, 3).reshape(B, S, D_MODEL)
    return jnp.einsum('bse,ed->bsd', o.astype(h.dtype), w_o)


def moe_ffn(h, w_router, router_bias, w_gate, w_up, w_down):
    B, S, D = h.shape
    T = B * S
    A = T * TOP_K
    P = A + N_EXPERTS * MOE_BLOCK
    nblk = P // MOE_BLOCK
    ht = h.reshape(T, D)
    aff = jax.nn.sigmoid(jnp.einsum('td,de->te', ht, w_router).astype(F32))
    sel = (aff + router_bias.astype(F32)).reshape(T, N_GROUPS, EXPERTS_PER_GROUP)
    grp_score = jnp.sum(lax.top_k(sel, TOP_K)[0], axis=-1)
    grp = jnp.argmax(grp_score, axis=-1)
    in_grp = jnp.take_along_axis(sel, grp[:, None, None], axis=1)[:, 0]
    local = lax.top_k(in_grp, TOP_K)[1]
    e_idx = grp[:, None] * EXPERTS_PER_GROUP + local
    w_sel = jnp.take_along_axis(aff, e_idx, axis=1)
    gates = w_sel / jnp.sum(w_sel, axis=-1, keepdims=True)
    flat_e = e_idx.reshape(-1).astype(jnp.int32)
    flat_tok = jnp.repeat(jnp.arange(T, dtype=jnp.int32), TOP_K)
    flat_w = gates.reshape(-1)
    order = jnp.argsort(flat_e)
    sorted_e = flat_e[order]
    counts = jnp.bincount(flat_e, length=N_EXPERTS)
    padded = (counts + MOE_BLOCK - 1) // MOE_BLOCK * MOE_BLOCK
    pad_end = jnp.cumsum(padded)
    pad_start = pad_end - padded
    start = jnp.cumsum(counts) - counts
    dest = pad_start[sorted_e] + jnp.arange(A, dtype=jnp.int32) - start[sorted_e]
    buf_tok = jnp.full((P,), T, jnp.int32).at[dest].set(flat_tok[order])
    buf_w = jnp.zeros((P,), F32).at[dest].set(flat_w[order])
    blk_expert = jnp.clip(jnp.searchsorted(pad_end, jnp.arange(nblk, dtype=pad_end.dtype) * MOE_BLOCK,
                                           side='right'), 0, N_EXPERTS - 1)
    h_pad = jnp.concatenate([ht, jnp.zeros((1, D), ht.dtype)], axis=0)

    def expert_block(args):
        tok, e = args
        xb = h_pad[tok]
        return jnp.einsum('tf,fd->td', jax.nn.silu(xb @ w_gate[e]) * (xb @ w_up[e]), w_down[e])

    ys = lax.map(expert_block, (buf_tok.reshape(nblk, MOE_BLOCK), blk_expert))
    ys = ys.reshape(P, D).astype(F32) * buf_w[:, None]
    out = jax.ops.segment_sum(ys, buf_tok, num_segments=T + 1)[:T]
    return out.reshape(B, S, D).astype(h.dtype)


def setup_inputs(seed: int = 0) -> dict:
    key = jax.random.key(seed)
    ks = jax.random.split(key, 26)

    def nrm(k, shape, scale):
        return jax.random.normal(k, shape, F32) * scale

    d = D_MODEL
    ada = 0.5 * d ** -0.5
    return {
        "x": nrm(ks[0], (BATCH, SEQ, d), 1.0),
        "c": nrm(ks[1], (BATCH, d), 1.0),
        "a_w_in": nrm(ks[2], (N_A_LAYERS, d, A_IN_DIM), d ** -0.5),
        "a_b_gates": jnp.concatenate([
            nrm(ks[3], (N_A_LAYERS, A_HEADS), 0.1),
            jnp.linspace(3.0, 6.0, A_HEADS, dtype=F32)[None, :] + nrm(ks[4], (N_A_LAYERS, A_HEADS), 0.1)], axis=-1),
        "a_mh_norm": 1.0 + nrm(ks[5], (N_A_LAYERS, A_V_DIM), 0.02),
        "a_w_out": nrm(ks[6], (N_A_LAYERS, A_V_DIM, d), A_V_DIM ** -0.5),
        "kv_norm": 1.0 + nrm(ks[7], (d,), 0.02),
        "w_ada_kv": nrm(ks[8], (d, 2 * d), ada),
        "b_ada_kv": nrm(ks[9], (2 * d,), 0.01),
        "w_kv": nrm(ks[10], (d, KV_OUT_DIM), d ** -0.5),
        "b_fgate": jnp.linspace(2.0, 6.0, B_HEADS, dtype=F32) + nrm(ks[11], (B_HEADS,), 0.1),
        "b_w_q": nrm(ks[12], (N_B_LAYERS, d, d), d ** -0.5),
        "b_w_o": nrm(ks[13], (N_B_LAYERS, d, d), d ** -0.5),
        "norm_mix": 1.0 + nrm(ks[14], (DEPTH, d), 0.02),
        "norm_ffn": 1.0 + nrm(ks[15], (DEPTH, d), 0.02),
        "w_ada": nrm(ks[16], (DEPTH, d, N_MOD * d), ada),
        "b_ada": nrm(ks[17], (DEPTH, N_MOD * d), 0.01),
        "w_router": nrm(ks[18], (d, N_EXPERTS), d ** -0.5),
        "router_bias": nrm(ks[19], (N_EXPERTS,), 0.01),
        "w_gate": nrm(ks[20], (DEPTH, N_EXPERTS, d, D_EXPERT), d ** -0.5),
        "w_up": nrm(ks[21], (DEPTH, N_EXPERTS, d, D_EXPERT), d ** -0.5),
        "w_down": nrm(ks[22], (DEPTH, N_EXPERTS, D_EXPERT, d), D_EXPERT ** -0.5),
        "norm_final": 1.0 + nrm(ks[23], (d,), 0.02),
        "w_ada_final": nrm(ks[24], (d, 2 * d), ada),
        "b_ada_final": nrm(ks[25], (2 * d,), 0.01),
    }


def reference(x, c, a_w_in, a_b_gates, a_mh_norm, a_w_out, kv_norm, w_ada_kv, b_ada_kv, w_kv, b_fgate,
              b_w_q, b_w_o, norm_mix, norm_ffn, w_ada, b_ada, w_router, router_bias, w_gate, w_up, w_down,
              norm_final, w_ada_final, b_ada_final):
    c_act = jax.nn.silu(c)
    mods = jnp.einsum('bd,lde->lbe', c_act, w_ada) + b_ada[:, None, :]
    k_sh = v_sh = fcum = None
    for layer in range(DEPTH):
        sh_m, sc_m, g_m, sh_f, sc_f, g_f = jnp.split(mods[layer], N_MOD, axis=-1)
        h = modulate(rmsnorm(x, norm_mix[layer]), sh_m, sc_m)
        if layer < N_A_LAYERS:
            mix = mlstm_layer(h, a_w_in[layer], a_b_gates[layer], a_mh_norm[layer], a_w_out[layer])
        else:
            if layer == N_A_LAYERS:
                kv_mod = c_act @ w_ada_kv + b_ada_kv
                k_sh, v_sh, fcum = shared_kv(x, kv_norm, kv_mod[:, :D_MODEL], kv_mod[:, D_MODEL:], w_kv, b_fgate)
            j = layer - N_A_LAYERS
            mix = fox_layer(h, b_w_q[j], b_w_o[j], k_sh, v_sh, fcum)
        x = x + g_m[:, None, :] * mix
        h = modulate(rmsnorm(x, norm_ffn[layer]), sh_f, sc_f)
        x = x + g_f[:, None, :] * moe_ffn(h, w_router, router_bias, w_gate[layer], w_up[layer], w_down[layer])
    fin = c_act @ w_ada_final + b_ada_final
    return modulate(rmsnorm(x, norm_final), fin[:, :D_MODEL], fin[:, D_MODEL:])
```

```cpp
#include <hip/hip_runtime.h>
#include <hip/hip_bf16.h>
#include <cstdio>
#include <cstdint>
#define LAS __attribute__((address_space(3)))
#define GAS __attribute__((address_space(1)))

namespace pg8 {
typedef unsigned short bf16_t;
typedef short bf16x8 __attribute__((ext_vector_type(8)));
typedef float f32x4 __attribute__((ext_vector_type(4)));
typedef unsigned u32x4 __attribute__((ext_vector_type(4)));
typedef unsigned u32x2 __attribute__((ext_vector_type(2)));
constexpr int BM = 256, BK = 64, HALF = 128, HTB = HALF * BK * 2  , STAGE_BYTES = 8 * HTB, NXCD = 8, WGM = 8;

__host__ __device__ __forceinline__ int lds_byte(int r, int c) { const int st = (r >> 4) * 2 + (c >> 5), rr = r & 15, cc = c & 31, ob = rr * 64 + cc * 2; return st * 1024 + (ob ^ (((ob >> 9) & 1) << 5)); }
__host__ __device__ __forceinline__ void stage_rc(int b, int& R, int& C) { const int st = b / 1024, sb = b % 1024, swz = sb ^ (((sb >> 9) & 1) << 5); R = (st >> 1) * 16 + swz / 64; C = (st & 1) * 32 + (swz % 64) / 2; }
__host__ __device__ __forceinline__ int perm32(int rho) { const int n = rho >> 4, i = rho & 15; return 8 * (i >> 2) + 4 * n + (i & 3); }

struct Unit { int pm, pn, cls, lb; };

struct StaticOrder {
    int nM, nN, nwg, G, c;
    __device__ __forceinline__ void init(int nM_, int nN_, int G_, int c_) { nM = nM_; nN = nN_; nwg = nM * nN; G = G_; c = c_; }
    __device__ __forceinline__ bool next(int i, Unit& u) const {
        const long L = (long)i * G + c; if (L >= nwg) return false;
        int wgid = (int)L; { const int q = nwg / NXCD, r = nwg % NXCD, xcd = wgid % NXCD, off = wgid / NXCD; wgid = (xcd < r ? xcd * (q + 1) : r * (q + 1) + (xcd - r) * q) + off; }
        const int nig = WGM * nN, gid = wgid / nig, fm = gid * WGM, gsz = (nM - fm) < WGM ? (nM - fm) : WGM;
        u.pm = fm + ((wgid % nig) % gsz); u.pn = (wgid % nig) / gsz; u.cls = 0; u.lb = 0; return true;
    }
};

__device__ __forceinline__ unsigned cvt_pk_bf16(float lo, float hi) { unsigned r; asm volatile("v_cvt_pk_bf16_f32 %0, %1, %2" : "=v"(r) : "v"(lo), "v"(hi)); return r; }
__device__ __forceinline__ float sigmoidf_(float x) { return __builtin_amdgcn_rcpf(1.0f + __expf(-x)); }

template <class Epi, class Prob, bool ALIGN_EPI>
__device__ __forceinline__ void gemm_phase(LAS unsigned char* lds, const Prob& S, const Epi& E) {
    int tid_ = threadIdx.x; asm volatile("" : "+v"(tid_));
    const int tid = tid_, wid = __builtin_amdgcn_readfirstlane(tid >> 6), lane = tid & 63, wr = wid >> 2, wc = wid & 3, fr = lane & 15, fq = lane >> 4;
    const int K = S.K, nt = K / BK;
    int R0, C0; stage_rc(tid * 16, R0, C0);
    const int Rb0 = Epi::PERM ? ((R0 & ~31) + perm32(R0 & 31)) : R0;
    unsigned voffB[2]; voffB[0] = (unsigned)(Rb0 * S.ldb + C0) * 2u; voffB[1] = (unsigned)((Rb0 + 64) * S.ldb + C0) * 2u;
    const size_t hstepB = (size_t)HALF * S.ldb * 2;
    const unsigned ldsw = (unsigned)wid * 1024u;
    const int aoff_l = lds_byte(wr * 64 + fr, fq * 8), boff_l = lds_byte(wc * 32 + fr, fq * 8);
    const char* const Ab = S.a_base();
#define PG8_SA(b, h) (((b) * 2 + (h)) * HTB)
#define PG8_SB(b, h) ((4 + (b) * 2 + (h)) * HTB)
#define PG8_STA(bufoff, h, tt) do { _Pragma("unroll") for (int _i = 0; _i < 2; ++_i) \
        __builtin_amdgcn_global_load_lds((const unsigned*)(Ab + (size_t)aoff[h][_i] + (size_t)(tt) * (BK * 2)), (LAS unsigned*)(lds + (bufoff) + ldsw + _i * 8192), 16, 0, 0); } while (0)
#define PG8_STB(bufoff, bp, h) do { _Pragma("unroll") for (int _i = 0; _i < 2; ++_i) \
        __builtin_amdgcn_global_load_lds((const unsigned*)((bp) + (h) * hstepB + voffB[_i]), (LAS unsigned*)(lds + (bufoff) + ldsw + _i * 8192), 16, 0, 0); } while (0)
#define PG8_LDA(dst, b, h) do { _Pragma("unroll") for (int m = 0; m < 4; ++m) _Pragma("unroll") for (int k = 0; k < 2; ++k) dst[m][k] = *(const LAS bf16x8*)(lds + PG8_SA(b, h) + aoff_l + m * 2048 + k * 1024); } while (0)
#define PG8_LDB(dst, b, h) do { _Pragma("unroll") for (int n = 0; n < 2; ++n) _Pragma("unroll") for (int k = 0; k < 2; ++k) dst[n][k] = *(const LAS bf16x8*)(lds + PG8_SB(b, h) + boff_l + n * 2048 + k * 1024); } while (0)
#define PG8_MMA(ai, bj, At, Bt) do { __builtin_amdgcn_s_setprio(1); _Pragma("unroll") for (int m = 0; m < 4; ++m) _Pragma("unroll") for (int n = 0; n < 2; ++n) _Pragma("unroll") for (int k = 0; k < 2; ++k) \
        acc[ai][bj][m][n] = __builtin_amdgcn_mfma_f32_16x16x32_bf16(Bt[n][k], At[m][k], acc[ai][bj][m][n], 0, 0, 0); __builtin_amdgcn_s_setprio(0); } while (0)
#define PG8_WAIT_V(n) asm volatile("s_waitcnt vmcnt(" #n ")" ::: "memory")
#define PG8_WAIT_L(n) asm volatile("s_waitcnt lgkmcnt(" #n ")" ::: "memory")
#define PG8_BAR __builtin_amdgcn_s_barrier()
#define PG8_SCHED __builtin_amdgcn_sched_barrier(0)
    Unit cur, nxt; int ui = 0;
    if (!S.next(0, cur)) return;
    f32x4 acc[2][2][4][2];
#pragma unroll
    for (int a = 0; a < 2; ++a)
#pragma unroll
        for (int b = 0; b < 2; ++b)
#pragma unroll
            for (int m = 0; m < 4; ++m)
#pragma unroll
                for (int n = 0; n < 2; ++n) acc[a][b][m][n] = (f32x4){0.f, 0.f, 0.f, 0.f};
    bf16x8 At[4][2], B0[2][2], B1[2][2];
    unsigned aoff[2][2], aoffN[2][2];
    S.a_off(cur, R0, C0, aoff);
    { const char* bp0 = S.b_tile(cur, 0); const char* bp1 = S.b_tile(cur, 1);
      PG8_STB(PG8_SB(0, 0), bp0, 0); PG8_STB(PG8_SB(0, 1), bp0, 1); PG8_STA(PG8_SA(0, 0), 0, 0); PG8_STA(PG8_SA(0, 1), 1, 0);
      if (wr == 1) PG8_BAR;
      PG8_WAIT_V(2); PG8_BAR;
      PG8_STB(PG8_SB(1, 0), bp1, 0); PG8_STA(PG8_SA(1, 0), 0, 1); PG8_STB(PG8_SB(1, 1), bp1, 1);
      PG8_WAIT_V(6); PG8_BAR; }
    for (;;) {
        const bool has_next = S.next(ui + 1, nxt);
        for (int t = 0; t < nt; t += 2) {
            const bool last = (t == nt - 2);
            if (last) { if (has_next) S.a_off(nxt, R0, C0, aoffN); else { aoffN[0][0] = aoff[0][0]; aoffN[0][1] = aoff[0][1]; aoffN[1][0] = aoff[1][0]; aoffN[1][1] = aoff[1][1]; } }
            PG8_LDB(B0, 0, 0); PG8_LDB(B1, 0, 1); PG8_SCHED; PG8_LDA(At, 0, 0); PG8_STA(PG8_SA(1, 1), 1, t + 1);
            PG8_WAIT_V(8); PG8_WAIT_L(0); PG8_BAR; PG8_MMA(0, 0, At, B0); PG8_MMA(0, 1, At, B1); PG8_BAR; PG8_SCHED;
            const int t2 = last ? 0 : t + 2;
            const Unit& u2 = (last && has_next) ? nxt : cur;
            if (last) { aoff[0][0] = aoffN[0][0]; aoff[0][1] = aoffN[0][1]; aoff[1][0] = aoffN[1][0]; aoff[1][1] = aoffN[1][1]; }
            const char* b2 = S.b_tile(u2, t2); const char* b3 = S.b_tile(u2, t2 + 1);
            PG8_LDA(At, 0, 1); PG8_STB(PG8_SB(0, 0), b2, 0); PG8_STB(PG8_SB(0, 1), b2, 1); PG8_STA(PG8_SA(0, 0), 0, t2);
            PG8_WAIT_V(8); PG8_WAIT_L(0); PG8_BAR; PG8_MMA(1, 0, At, B0); PG8_MMA(1, 1, At, B1); PG8_BAR; PG8_SCHED;
            PG8_LDB(B0, 1, 0); PG8_LDB(B1, 1, 1); PG8_SCHED; PG8_LDA(At, 1, 0); PG8_STA(PG8_SA(0, 1), 1, t2);
            PG8_WAIT_V(8); PG8_WAIT_L(0); PG8_BAR; PG8_MMA(0, 0, At, B0); PG8_MMA(0, 1, At, B1); PG8_BAR; PG8_SCHED;
            PG8_LDA(At, 1, 1); PG8_STB(PG8_SB(1, 0), b3, 0); PG8_STB(PG8_SB(1, 1), b3, 1); PG8_STA(PG8_SA(1, 0), 0, t2 + 1);
            PG8_WAIT_V(8); PG8_WAIT_L(0); PG8_BAR; PG8_MMA(1, 0, At, B0); PG8_MMA(1, 1, At, B1); PG8_BAR; PG8_SCHED;
        }
        if constexpr (ALIGN_EPI) { if (wr == 0) PG8_BAR; }
        E(acc, cur, wr, wc, fr, fq);
        if (!has_next) break;
#pragma unroll
        for (int a = 0; a < 2; ++a)
#pragma unroll
            for (int b = 0; b < 2; ++b)
#pragma unroll
                for (int m = 0; m < 4; ++m)
#pragma unroll
                    for (int n = 0; n < 2; ++n) acc[a][b][m][n] = (f32x4){0.f, 0.f, 0.f, 0.f};
        cur = nxt; ++ui;
        if constexpr (ALIGN_EPI) { if (wr == 1) PG8_BAR; }
    }
    PG8_WAIT_V(0);
    if constexpr (!ALIGN_EPI) { if (wr == 0) PG8_BAR; }
    PG8_BAR;
#undef PG8_SA
#undef PG8_SB
#undef PG8_STA
#undef PG8_STB
#undef PG8_LDA
#undef PG8_LDB
#undef PG8_MMA
#undef PG8_WAIT_V
#undef PG8_WAIT_L
#undef PG8_BAR
#undef PG8_SCHED
}
}

#include <hip/hip_bf16.h>
#include <cmath>
namespace attn_body {
using bf16=__hip_bfloat16;
using bf16x8=__attribute__((ext_vector_type(8)))short;
using s16x4=__attribute__((ext_vector_type(4)))short;
using f32x16=__attribute__((ext_vector_type(16)))float;
using u32x4=__attribute__((ext_vector_type(4)))unsigned;
constexpr int BATCH=16,NHEAD=16,SEQ=4096,D=64,DM=NHEAD*D;
constexpr int NW=8,QBLK=32,QB=QBLK*NW,KVBLK=64,NQB=SEQ/QB;
constexpr int ATTN_PITCH=DM, ATTN_UNIT_ROWS=QB;
__device__ __forceinline__ int crow(int r,int hi){return (r&3)+8*(r>>2)+4*hi;}
#define SBAR() __builtin_amdgcn_sched_barrier(0)
__device__ __forceinline__ void cmask(f32x16&p0,f32x16&p1,int jb,int qrel,int hi){
  const float NEG=-INFINITY; int kb=64*jb+4*hi;
  #pragma unroll
  for(int r=0;r<16;++r){int kv=kb+(r&3)+8*(r>>2); if(kv>qrel)p0[r]=NEG; if(kv+32>qrel)p1[r]=NEG;}
}

constexpr int NSLOT=3, SLOTB=8192;
constexpr int LDS_K=0, LDS_V=NSLOT*SLOTB, LDS_WS=2*NSLOT*SLOTB, LDS_OST=LDS_WS+NW*64*4, LDS_BYTES=LDS_OST+NW*4096;
constexpr float C2=0.125f*1.4426950408889634f;
__device__ __forceinline__ void glds16(const void*gsrc,unsigned lds_dst){unsigned keep;
  asm volatile("s_mov_b32 %0, m0\n\ts_mov_b32 m0, %2\n\ts_nop 0\n\tglobal_load_lds_dwordx4 %1, off\n\ts_mov_b32 m0, %0":"=&s"(keep):"v"(gsrc),"s"(lds_dst):"memory");}
__device__ __forceinline__ float max3f(float a,float b,float c){float r;asm("v_max3_f32 %0, %1, %2, %3":"=v"(r):"v"(a),"v"(b),"v"(c));return r;}
__device__ __forceinline__ float max2f(float a,float b){float r;asm("v_max_f32_e32 %0, %1, %2":"=v"(r):"v"(a),"v"(b));return r;}
__device__ __forceinline__ float fadd_s(float a,float b){float r;asm("v_add_f32_e32 %0, %1, %2":"=v"(r):"v"(a),"v"(b));return r;}
__device__ __forceinline__ float fsub_s(float a,float b){float r;asm("v_sub_f32_e32 %0, %1, %2":"=v"(r):"v"(a),"v"(b));return r;}
typedef float f32x2_t __attribute__((ext_vector_type(2))); typedef __bf16 bf16x2_t __attribute__((ext_vector_type(2)));
__device__ __forceinline__ unsigned cvtpk_s(float lo,float hi){f32x2_t v={lo,hi};bf16x2_t b=__builtin_convertvector(v,bf16x2_t);return __builtin_bit_cast(unsigned,b);}
#define WAIT_BAR(N) asm volatile("s_waitcnt vmcnt(" #N ") lgkmcnt(0)\n\ts_barrier":::"memory")

__device__ __forceinline__ void qkt(f32x16&p0,f32x16&p1,const char*Kslot,const bf16x8*qr,const f32x16&c0,const f32x16&c1,int r32,int hi){
  const char*kb=Kslot+hi*1024+r32*16;
  #pragma unroll
  for(int d0=0;d0<4;++d0){
    const bf16x8 b0=*reinterpret_cast<const bf16x8*>(kb+d0*2048);
    const bf16x8 b1=*reinterpret_cast<const bf16x8*>(kb+d0*2048+512);
    if(d0==0){p0=__builtin_amdgcn_mfma_f32_32x32x16_bf16(b0,qr[0],c0,0,0,0);p1=__builtin_amdgcn_mfma_f32_32x32x16_bf16(b1,qr[0],c1,0,0,0);}
    else{p0=__builtin_amdgcn_mfma_f32_32x32x16_bf16(b0,qr[d0],p0,0,0,0);p1=__builtin_amdgcn_mfma_f32_32x32x16_bf16(b1,qr[d0],p1,0,0,0);}}
}
typedef __attribute__((address_space(3))) const char* lds_cptr;
typedef short v4i16_t __attribute__((ext_vector_type(4)));
__device__ __forceinline__ void kload8(bf16x8*kf,lds_cptr kp){
  kf[0]=*(const __attribute__((address_space(3))) bf16x8*)(kp);      kf[1]=*(const __attribute__((address_space(3))) bf16x8*)(kp+512);
  kf[2]=*(const __attribute__((address_space(3))) bf16x8*)(kp+2048); kf[3]=*(const __attribute__((address_space(3))) bf16x8*)(kp+2560);
  kf[4]=*(const __attribute__((address_space(3))) bf16x8*)(kp+4096); kf[5]=*(const __attribute__((address_space(3))) bf16x8*)(kp+4608);
  kf[6]=*(const __attribute__((address_space(3))) bf16x8*)(kp+6144); kf[7]=*(const __attribute__((address_space(3))) bf16x8*)(kp+6656);
}
__device__ __forceinline__ void kload2(bf16x8*kf,lds_cptr kp,int j){ kf[2*j]=*(const __attribute__((address_space(3))) bf16x8*)(kp+j*2048); kf[2*j+1]=*(const __attribute__((address_space(3))) bf16x8*)(kp+j*2048+512); }
__device__ __forceinline__ s16x4 vtr(lds_cptr p){ return __builtin_bit_cast(s16x4,__builtin_amdgcn_ds_read_tr16_b64_v4i16((__attribute__((address_space(3))) v4i16_t*)p)); }
__device__ __forceinline__ float rowmax(const f32x16&p0,const f32x16&p1){
  float a=max3f(p0[0],p0[1],p1[0]),b=max3f(p0[2],p0[3],p1[1]);a=max3f(a,p1[2],p1[3]);
  #pragma unroll
  for(int r=4;r<16;r+=4){a=max3f(a,p0[r],p0[r+1]);b=max3f(b,p0[r+2],p0[r+3]);a=max3f(a,p1[r],p1[r+1]);b=max3f(b,p1[r+2],p1[r+3]);}
  const float m=max2f(a,b);
  auto rr=__builtin_amdgcn_permlane32_swap(__float_as_uint(m),__float_as_uint(m),false,false);
  return max2f(__uint_as_float(rr[0]),__uint_as_float(rr[1]));
}
__device__ __forceinline__ void pv(f32x16*o,int vb,bf16x8 pa0,bf16x8 pa1,bf16x8 pa2,bf16x8 pa3){
  #pragma unroll
  for(int d0=0;d0<2;++d0){s16x4 lo[4],hi[4];
    #pragma unroll
    for(int ks=0;ks<4;++ks){
      asm volatile("ds_read_b64_tr_b16 %0,%1 offset:%c2":"=&v"(lo[ks]):"v"(vb),"i"(d0*4096+ks*1024):"memory");
      asm volatile("ds_read_b64_tr_b16 %0,%1 offset:%c2":"=&v"(hi[ks]):"v"(vb),"i"(d0*4096+ks*1024+512):"memory");}
    asm volatile("s_waitcnt lgkmcnt(0)":::"memory");SBAR();
    #define PK(k) (bf16x8){lo[k][0],lo[k][1],lo[k][2],lo[k][3],hi[k][0],hi[k][1],hi[k][2],hi[k][3]}
    o[d0]=__builtin_amdgcn_mfma_f32_32x32x16_bf16(pa0,PK(0),o[d0],0,0,0);
    o[d0]=__builtin_amdgcn_mfma_f32_32x32x16_bf16(pa1,PK(1),o[d0],0,0,0);
    o[d0]=__builtin_amdgcn_mfma_f32_32x32x16_bf16(pa2,PK(2),o[d0],0,0,0);
    o[d0]=__builtin_amdgcn_mfma_f32_32x32x16_bf16(pa3,PK(3),o[d0],0,0,0);
    #undef PK
  }
}

#ifndef ATTN_STORE16
#define ATTN_STORE16(p,v) (*(u32x4*)(p)=(v))
#endif
typedef float f32x4_t __attribute__((ext_vector_type(4)));
typedef __attribute__((address_space(3))) const float* fb_lptr;
template<int THRL> __device__ __forceinline__ void attn_unit(int b,int h,int qb,const bf16*Q,const bf16*__restrict__ K,const bf16*__restrict__ V,bf16*O,char*shm,fb_lptr fbl){
  int tid_=threadIdx.x; asm volatile("":"+v"(tid_)); const int tid=tid_,lane=tid&63,r32=lane&31,hi=lane>>5; const int wid=__builtin_amdgcn_readfirstlane(tid>>6);
  const long rowbase=(long)b*SEQ; const int q0=qb*QB;
  const bf16*Qw=Q+(rowbase+q0+wid*QBLK)*DM+h*D;
  const bf16*Kh=K+rowbase*DM+h*D,*Vh=V+rowbase*DM+h*D;
  const unsigned lds0=(unsigned)(uintptr_t)shm;
  float*wsf=(float*)(shm+LDS_WS)+wid*64;
  const bf16*ksrc=Kh+(long)lane*DM+wid*8;
  const bf16*vsrc=Vh+(long)(16*(wid&3)+(lane>>2))*DM+(wid>>2)*32+(lane&3)*8;
  const unsigned kdst=lds0+LDS_K+wid*1024, vdst=lds0+LDS_V+wid*1024;
  #define DMA_K(t,slot) glds16(ksrc+(long)(t)*KVBLK*DM,(unsigned)__builtin_amdgcn_readfirstlane(kdst+(slot)))
  #define DMA_V(t,slot) glds16(vsrc+(long)(t)*KVBLK*DM,(unsigned)__builtin_amdgcn_readfirstlane(vdst+(slot)))
  const int vb0=(int)(lds0+LDS_V)+((lane>>4)&1)*32+(lane&3)*8+(4*hi+((lane&15)>>2))*64;
  const char*Kbase=shm+LDS_K; bf16x8 kf[8];
  const lds_cptr shm3=(lds_cptr)shm; const lds_cptr kp0=shm3+LDS_K+hi*1024+r32*16; const lds_cptr vp0=shm3+LDS_V+((lane>>4)&1)*32+(lane&3)*8+(4*hi+((lane&15)>>2))*64;
  const int NT=(q0+QB)/KVBLK;
  DMA_K(0,0);DMA_V(0,0);DMA_K(1,SLOTB);
  bf16x8 qr[4];
  #pragma unroll
  for(int d0=0;d0<4;++d0)qr[d0]=*reinterpret_cast<const bf16x8*>(&Qw[(long)r32*DM+d0*16+hi*8]);
  #define FBIAS(C0,C1,t) do{ const fb_lptr fp_=fbl+64*(t)+4*hi; const float nm_=-mhat; \
    _Pragma("unroll") for(int g_=0;g_<4;++g_){ const f32x4_t a_=*(const __attribute__((address_space(3))) f32x4_t*)(fp_+8*g_); const f32x4_t b_=*(const __attribute__((address_space(3))) f32x4_t*)(fp_+32+8*g_); \
      _Pragma("unroll") for(int i_=0;i_<4;++i_){ C0[4*g_+i_]=a_[i_]+nm_; C1[4*g_+i_]=b_[i_]+nm_; } SBAR(); } }while(0)
  float mhat=0.f,l_reg=0.f;f32x16 o[2];o[0]=f32x16{};o[1]=f32x16{};
  const int qrel=wid*QBLK+r32;
  #define CMASK(P0,P1,t) do{int jb_=(t)-(NT-4); if(jb_>=0)cmask(P0,P1,jb_,qrel,hi);}while(0)
  bool resc=false;
  #define START(P0,P1) do{ const float rm=rowmax(P0,P1); resc=false; \
    { const float dl=rm; mhat=fadd_s(mhat,dl); \
      _Pragma("unroll") for(int r=0;r<16;++r){P0[r]=fsub_s(P0[r],dl);P1[r]=fsub_s(P1[r],dl);} \
      } \
    _Pragma("unroll") for(int r=0;r<16;++r)P0[r]=__builtin_amdgcn_exp2f(P0[r]); }while(0)
  #define RESC() do{ if(resc){ asm volatile("s_waitcnt lgkmcnt(0)":::"memory"); \
      _Pragma("unroll") for(int d_=0;d_<2;++d_) _Pragma("unroll") for(int r=0;r<16;++r)o[d_][r]*=wsf[crow(r,hi)]; } }while(0)
  f32x16 pA0,pA1,pB0,pB1;
  int sl_prev=0,sl_cur=0,sl_next=SLOTB;
  #define ROT() do{sl_prev=sl_cur;sl_cur=sl_next;sl_next=(sl_next==(NSLOT-1)*SLOTB)?0:sl_next+SLOTB;}while(0)
  DMA_K(2,2*SLOTB);
  WAIT_BAR(3);
  FBIAS(pA0,pA1,0); qkt(pA0,pA1,Kbase,qr,pA0,pA1,r32,hi);asm volatile("s_nop 15\n\ts_nop 7":"+v"(pA0),"+v"(pA1));CMASK(pA0,pA1,0);
  START(pA0,pA1);
  _Pragma("unroll") for(int r=0;r<16;++r)pA1[r]=__builtin_amdgcn_exp2f(pA1[r]);
  WAIT_BAR(0);
  DMA_K(3,0);DMA_V(1,SLOTB);
  ROT();
  kload8(kf,kp0+sl_cur);
  WAIT_BAR(2);
  s16x4 vlo[8],vhi[8]; u32x4 pw0,pw1,pw2,pw3;
  #define PKW(P,B) cvtpk_s(P[B],P[B+1])
  #define PAF(k) __builtin_bit_cast(bf16x8,pw##k)
  #define VFR(i) (bf16x8){vlo[i][0],vlo[i][1],vlo[i][2],vlo[i][3],vhi[i][0],vhi[i][1],vhi[i][2],vhi[i][3]}
  #define PIN(x) asm volatile("":"+v"(x))
  #define MX3(a,b,c) __builtin_fmaxf(__builtin_fmaxf((a),(b)),(c))
  #define GAPA(MF,A0,A1,A2,A3,W0,W1,PW) do{ MF; sacc+=A0; sacc+=A1; sacc+=A2; sacc+=A3; PIN(sacc); W0; W1; PIN(PW); SBAR(); }while(0)
  #define EX(v) __builtin_amdgcn_exp2f(v)
  #define GAPB(MF,X,B) do{ MF; X[B]=EX(X[B]); X[B+1]=EX(X[B+1]); X[B+2]=EX(X[B+2]); X[B+3]=EX(X[B+3]); PIN(X); SBAR(); }while(0)
  #define VRD(i) do{ vlo[i]=vtr(vp_+(((i)>>2)*4096+((i)&3)*1024)); vhi[i]=vtr(vp_+(((i)>>2)*4096+((i)&3)*1024+512)); }while(0)
  #define KRD(G,j) do{ if(G){ kload2(kf,kp0+sl_next,j); SBAR(); } }while(0)
  #define STEP(C0,C1,P0,P1,t,GK,GV,GL) do{ SBAR(); FBIAS(C0,C1,t); SBAR(); \
    const lds_cptr vp_=vp0+sl_prev; \
    VRD(0); SBAR(); float sacc=(P0[0]+P0[1]); \
    GAPA(C0=__builtin_amdgcn_mfma_f32_32x32x16_bf16(kf[0],qr[0],C0,0,0,0), P0[2],P0[3],P0[4],P0[5],     pw0[0]=PKW(P0,0), pw0[1]=PKW(P0,2), pw0); \
    VRD(4); SBAR(); GAPA(C1=__builtin_amdgcn_mfma_f32_32x32x16_bf16(kf[1],qr[0],C1,0,0,0), P0[6],P0[7],P0[8],P0[9],     pw0[2]=PKW(P0,4), pw0[3]=PKW(P0,6), pw0); \
    VRD(1); SBAR(); GAPA(C0=__builtin_amdgcn_mfma_f32_32x32x16_bf16(kf[2],qr[1],C0,0,0,0),   P0[10],P0[11],P0[12],P0[13], pw1[0]=PKW(P0,8), pw1[1]=PKW(P0,10), pw1); \
    VRD(5); SBAR(); GAPA(C1=__builtin_amdgcn_mfma_f32_32x32x16_bf16(kf[3],qr[1],C1,0,0,0),   P0[14],P0[15],P1[0],P1[1],   pw1[2]=PKW(P0,12),pw1[3]=PKW(P0,14), pw1); \
    VRD(2); SBAR(); GAPA(C0=__builtin_amdgcn_mfma_f32_32x32x16_bf16(kf[4],qr[2],C0,0,0,0),   P1[2],P1[3],P1[4],P1[5],     pw2[0]=PKW(P1,0), pw2[1]=PKW(P1,2), pw2); \
    VRD(6); SBAR(); GAPA(C1=__builtin_amdgcn_mfma_f32_32x32x16_bf16(kf[5],qr[2],C1,0,0,0),   P1[6],P1[7],P1[8],P1[9],     pw2[2]=PKW(P1,4), pw2[3]=PKW(P1,6), pw2); \
    VRD(3); SBAR(); GAPA(C0=__builtin_amdgcn_mfma_f32_32x32x16_bf16(kf[6],qr[3],C0,0,0,0),   P1[10],P1[11],P1[12],P1[13], pw3[0]=PKW(P1,8), pw3[1]=PKW(P1,10), pw3); \
    VRD(7); SBAR(); GAPA(C1=__builtin_amdgcn_mfma_f32_32x32x16_bf16(kf[7],qr[3],C1,0,0,0),   P1[14],P1[15],0.f,0.f,       pw3[2]=PKW(P1,12),pw3[3]=PKW(P1,14), pw3); \
    l_reg+=sacc; \
    if(GK){DMA_K((t)+3,sl_cur);} if(GV){DMA_V((t)+1,sl_next);} \
    CMASK(C0,C1,t); \
    { float a=MX3(C0[0],C0[1],C1[0]),b=MX3(C0[2],C0[3],C1[1]); a=MX3(a,C1[2],C1[3]); \
      _Pragma("unroll") for(int r=4;r<16;r+=4){a=MX3(a,C0[r],C0[r+1]);b=MX3(b,C0[r+2],C0[r+3]);a=MX3(a,C1[r],C1[r+1]);b=MX3(b,C1[r+2],C1[r+3]);} \
      float rm=__builtin_fmaxf(a,b); { auto rr=__builtin_amdgcn_permlane32_swap(__float_as_uint(rm),__float_as_uint(rm),false,false); rm=__builtin_fmaxf(__uint_as_float(rr[0]),__uint_as_float(rr[1])); } \
      resc=false; \
      if(__builtin_expect(__any(rm>(float)THRL),0)){ const float dl=__builtin_fmaxf(rm,0.f); mhat+=dl; \
        _Pragma("unroll") for(int r=0;r<16;++r){C0[r]-=dl;C1[r]-=dl;} \
        const float f=__builtin_amdgcn_exp2f(-dl); l_reg*=f; if(hi==0)wsf[r32]=f; resc=true; } } \
    SBAR(); \
    GAPB(o[0]=__builtin_amdgcn_mfma_f32_32x32x16_bf16(PAF(0),VFR(0),o[0],0,0,0), C0,0); \
    GAPB(o[1]=__builtin_amdgcn_mfma_f32_32x32x16_bf16(PAF(0),VFR(4),o[1],0,0,0), C0,4); \
    KRD(GL,0); GAPB(o[0]=__builtin_amdgcn_mfma_f32_32x32x16_bf16(PAF(1),VFR(1),o[0],0,0,0), C0,8); \
    KRD(GL,1); GAPB(o[1]=__builtin_amdgcn_mfma_f32_32x32x16_bf16(PAF(1),VFR(5),o[1],0,0,0), C0,12); \
    KRD(GL,2); GAPB(o[0]=__builtin_amdgcn_mfma_f32_32x32x16_bf16(PAF(2),VFR(2),o[0],0,0,0), C1,0); \
    KRD(GL,3); GAPB(o[1]=__builtin_amdgcn_mfma_f32_32x32x16_bf16(PAF(2),VFR(6),o[1],0,0,0), C1,4); \
    GAPB(o[0]=__builtin_amdgcn_mfma_f32_32x32x16_bf16(PAF(3),VFR(3),o[0],0,0,0), C1,8); \
    GAPB(o[1]=__builtin_amdgcn_mfma_f32_32x32x16_bf16(PAF(3),VFR(7),o[1],0,0,0), C1,12); \
    }while(0)
  int t=1;
  #undef CMASK
  #define CMASK(P0,P1,t) do{}while(0)
  for(;t+5<NT;t+=2){
    STEP(pB0,pB1,pA0,pA1,t,true,true,true);     WAIT_BAR(2); RESC(); ROT();
    STEP(pA0,pA1,pB0,pB1,t+1,true,true,true);   WAIT_BAR(2); RESC(); ROT();
  }
  #undef CMASK
  #define CMASK(P0,P1,t) do{int jb_=(t)-(NT-4); if(jb_>=0)cmask(P0,P1,jb_,qrel,hi);}while(0)
  #define ENDW(tt) do{ if((tt)+3<NT){WAIT_BAR(2);} else if((tt)+2<NT){WAIT_BAR(1);} else {WAIT_BAR(0);} }while(0)
  for(;t+1<NT;t+=2){
    STEP(pB0,pB1,pA0,pA1,t,(t+3<NT),(t+1<NT),(t+1<NT));       ENDW(t);   RESC(); ROT();
    STEP(pA0,pA1,pB0,pB1,t+1,(t+4<NT),(t+2<NT),(t+2<NT));     ENDW(t+1); RESC(); ROT();
  }
  STEP(pB0,pB1,pA0,pA1,NT-1,false,false,false); RESC();
  { float sacc=pB0[0]+pB0[1]; _Pragma("unroll") for(int r=2;r<16;++r)sacc+=pB0[r]; _Pragma("unroll") for(int r=0;r<16;++r)sacc+=pB1[r]; l_reg+=sacc;
    pw0=(u32x4){PKW(pB0,0),PKW(pB0,2),PKW(pB0,4),PKW(pB0,6)};pw1=(u32x4){PKW(pB0,8),PKW(pB0,10),PKW(pB0,12),PKW(pB0,14)};pw2=(u32x4){PKW(pB1,0),PKW(pB1,2),PKW(pB1,4),PKW(pB1,6)};pw3=(u32x4){PKW(pB1,8),PKW(pB1,10),PKW(pB1,12),PKW(pB1,14)};
    SBAR(); pv(o,vb0+sl_cur,PAF(0),PAF(1),PAF(2),PAF(3)); }
  #undef PKW
  #undef PAF
  #undef VFR
  #undef PIN
  #undef MX3
  #undef GAPA
  #undef GAPB
  #undef EX
  #undef VRD
  #undef KRD
  #undef STEP
  #undef ENDW
  {auto rr=__builtin_amdgcn_permlane32_swap(__float_as_uint(l_reg),__float_as_uint(l_reg),false,false);l_reg=__uint_as_float(rr[0])+__uint_as_float(rr[1]);}
  if(hi==0)wsf[32+r32]=l_reg;asm volatile("s_waitcnt lgkmcnt(0)":::"memory");
  float rli[16];
  #pragma unroll
  for(int r=0;r<16;++r)rli[r]=__builtin_amdgcn_rcpf(wsf[32+crow(r,hi)]);
  bf16*Ow=O+(rowbase+q0+wid*QBLK)*DM+h*D;
  { bf16*stg=(bf16*)(shm+LDS_OST)+wid*2048;
    #pragma unroll
    for(int r=0;r<16;++r){const int orow=crow(r,hi);
      #pragma unroll
      for(int d0=0;d0<2;++d0)stg[orow*64+d0*32+r32]=__float2bfloat16(o[d0][r]*rli[r]);}
    asm volatile("s_waitcnt lgkmcnt(0)":::"memory");
    #pragma unroll
    for(int i=0;i<4;++i){const int row=i*8+(lane>>3),ch=lane&7; const u32x4 v=*(const u32x4*)(stg+row*64+ch*8); ATTN_STORE16(Ow+(long)row*DM+ch*8,v);} }
  asm volatile("s_waitcnt lgkmcnt(0)\n\ts_barrier":::"memory");
  #undef DMA_K
  #undef DMA_V
  #undef CMASK
  #undef START
  #undef RESC
  #undef FBIAS
  #undef ROT
}
constexpr int ATTN_LDS_BYTES=LDS_BYTES;
struct AttnTensors { const bf16* Q; const bf16* K; const bf16* V; bf16* O; const float* FB; };
constexpr int FB_OFF=86016;
template<int THRL=8> __device__ __forceinline__ void attn_phase(char*lds,const AttnTensors&T,int vcu,int G){
  const fb_lptr fbl=(fb_lptr)(lds+FB_OFF);
  for(int bh=vcu;bh<BATCH*NHEAD;bh+=G){
    { __attribute__((address_space(3))) float* fw=(__attribute__((address_space(3))) float*)(lds+FB_OFF);
      int ti_=threadIdx.x; asm volatile("":"+v"(ti_)); for(int i=ti_;i<SEQ;i+=512)fw[i]=T.FB[(size_t)bh*SEQ+i]; }
    asm volatile("s_waitcnt vmcnt(0) lgkmcnt(0)\n\ts_barrier":::"memory");
    for(int qb=NQB-1;qb>=0;--qb) attn_unit<THRL>(bh/NHEAD,bh%NHEAD,qb,T.Q,T.K,T.V,T.O,lds,fbl);
  }
}
#undef SBAR
#undef WAIT_BAR
}

constexpr int DM = 1024, NB = 16, SEQ = 4096, NT = NB * SEQ;
constexpr int DEPTH = 4, NAL = 2;
constexpr int A_IN = 3088, A_PROJ = 3072;
constexpr int KV_OUT = 2064;
constexpr int NE = 16, DE = 512, NCLS = 24, CLS_CAP = NT;
constexpr float EPS = 1e-6f;
constexpr int NWAVES = 8;
constexpr int MAX_RB = NT / 256 + NCLS;

constexpr size_t MiB = 1u << 20;
constexpr size_t WS_CTL = 0, CTL_ZERO_BYTES = 1 * MiB;
constexpr size_t WS_MODS = 1 * MiB;
constexpr size_t WS_KVMOD = WS_MODS + (size_t)DEPTH * NB * 6144 * 4;
constexpr size_t WS_FIN = WS_KVMOD + (size_t)NB * 2048 * 4;
constexpr size_t WS_WTS = 3 * MiB;
constexpr size_t WS_G16 = 4 * MiB;
constexpr size_t WS_FB = 8 * MiB;
constexpr size_t WS_PERM = 12 * MiB;
constexpr size_t WS_WIN = 18 * MiB, WS_WOUT = 30 * MiB, WS_WKV = 34 * MiB, WS_WQ = 38 * MiB, WS_WO = 42 * MiB;
constexpr size_t WS_BT1 = 46 * MiB;
constexpr size_t WS_BT2 = 174 * MiB;
constexpr size_t WS_HB = 238 * MiB;
constexpr size_t WS_BIG = 366 * MiB;
constexpr size_t WS_ACT = 750 * MiB;
constexpr size_t WS_END = 890 * MiB;
static_assert(WS_FIN + (size_t)NB * 2048 * 4 <= WS_WTS && WS_ACT + (size_t)MAX_RB * 256 * 1024 * 2 <= WS_END, "d_ws map");
constexpr int CW_BAR = 4096;
constexpr int CW_CNT = 16384;
constexpr int RING_OFF = 0, RING_BYTES = 131072;
constexpr int LDSCTL_OFF = RING_BYTES, MISC_OFF = LDSCTL_OFF + 320;
constexpr int TAB_OFF = MISC_OFF + 128;
constexpr int LDS_BYTES = 147456;
static_assert(TAB_OFF + 256 <= LDS_BYTES, "LDS map");

typedef unsigned short bf16;
typedef unsigned v4u __attribute__((ext_vector_type(4)));
typedef unsigned v2u __attribute__((ext_vector_type(2)));
typedef float f32x4 __attribute__((ext_vector_type(4)));
typedef short bf16x8 __attribute__((ext_vector_type(8)));
typedef GAS unsigned gu32;
#define RLX_AGENT __ATOMIC_RELAXED, __HIP_MEMORY_SCOPE_AGENT
#define LDS_WAIT() asm volatile("s_waitcnt lgkmcnt(0)" ::: "memory")
__device__ __forceinline__ unsigned f2bf(float f) { unsigned u = __builtin_bit_cast(unsigned, f); return (u + 0x7fffu + ((u >> 16) & 1u)) >> 16; }
__device__ __forceinline__ unsigned pk2(float lo, float hi) { return f2bf(lo) | (f2bf(hi) << 16); }
__device__ __forceinline__ float bf2f(unsigned b) { return __builtin_bit_cast(float, (b & 0xffffu) << 16); }

#define XB_TMO      128
#define XB_XCNT(j)  (256  + 64 * (j))
#define XB_XSUB(j)  (1280 + 64 * (j))
#define XB_XGEN(j)  (2304 + 64 * (j))
#define XB_TOP      3328
#define XB_TOPGEN   3392
#define XCD_BAR_WORDS 3456
#define XB_SPIN_CAP (1u << 22)

__device__ __forceinline__ unsigned xb_ld(unsigned* p)              { return __hip_atomic_load(p, __ATOMIC_RELAXED, __HIP_MEMORY_SCOPE_AGENT); }
__device__ __forceinline__ unsigned xb_add(unsigned* p, unsigned v) { return __hip_atomic_fetch_add(p, v, __ATOMIC_RELAXED, __HIP_MEMORY_SCOPE_AGENT); }
__device__ __forceinline__ unsigned xb_xcc_id() { return (unsigned)__builtin_amdgcn_s_getreg((3 << 11) | 20) & 0xFu; }
#define XB_SPIN(cond, bar) do { unsigned _sp = 0; while (cond) { __builtin_amdgcn_s_sleep(1); \
    if ((++_sp & 255u) == 0u) { if (xb_ld(&(bar)[XB_TMO])) break; if (_sp > XB_SPIN_CAP) { atomicAdd(&(bar)[XB_TMO], 1u); break; } } } } while (0)

struct XcdBarrier { unsigned* bar; unsigned x; volatile LAS unsigned* st; };

__device__ __forceinline__ XcdBarrier xcd_barrier_post(unsigned* bar, volatile LAS unsigned* st) {
    XcdBarrier b; b.bar = bar; b.x = xb_xcc_id(); b.st = st;
    if (threadIdx.x == 0) (void)xb_add(&bar[XB_XCNT(b.x)], 1u);
    return b;
}
__device__ __forceinline__ void xcd_barrier_complete(unsigned* bar, unsigned x, unsigned& nloc, unsigned& nx) {
    const unsigned G = gridDim.x * gridDim.y * gridDim.z;
    unsigned sum, cnt, mine, sp = 0u;
    for (;;) {
        sum = 0u; cnt = 0u; mine = 0u;
#pragma unroll
        for (unsigned j = 0; j < 16; ++j) { const unsigned c = xb_ld(&bar[XB_XCNT(j)]); sum += c; cnt += (c > 0u) ? 1u : 0u; mine = (j == x) ? c : mine; }
        if (sum == G) break;
        __builtin_amdgcn_s_sleep(1);
        if ((++sp & 255u) == 0u) { if (xb_ld(&bar[XB_TMO])) break; if (sp > XB_SPIN_CAP) { atomicAdd(&bar[XB_TMO], 1u); break; } }
    }
    nloc = mine > 0u ? mine : 1u; nx = cnt > 0u ? cnt : 1u;
}
__device__ __forceinline__ void xcd_barrier(const XcdBarrier& b) {
    asm volatile("s_waitcnt vmcnt(0)" ::: "memory");
    __syncthreads();
    if (threadIdx.x == 0) {
        unsigned* bar = b.bar; unsigned bx = b.x; asm volatile("" : "+s"(bar), "+s"(bx));
        __builtin_amdgcn_s_waitcnt(0);
        unsigned nloc = b.st[0], nx = b.st[1];
        if (nloc == 0u) { xcd_barrier_complete(bar, bx, nloc, nx); b.st[0] = nloc; b.st[1] = nx; }
        const unsigned old = xb_add(&bar[XB_XSUB(bx)], 1u);
        const unsigned gen = old / nloc;
        if (old + 1u == (gen + 1u) * nloc) {
            __builtin_amdgcn_fence(__ATOMIC_RELEASE, "agent");
            asm volatile("s_waitcnt vmcnt(0)" ::: "memory");
            const unsigned og = xb_add(&bar[XB_TOP], 1u);
            const unsigned tg = og / nx;
            if (og + 1u == (tg + 1u) * nx) xb_add(&bar[XB_TOPGEN], 1u);
            else XB_SPIN(xb_ld(&bar[XB_TOPGEN]) == tg, bar);
            __builtin_amdgcn_fence(__ATOMIC_ACQUIRE, "agent");
            xb_add(&bar[XB_XGEN(bx)], 1u);
            asm volatile("s_waitcnt vmcnt(0)" ::: "memory");
        } else {
            XB_SPIN(xb_ld(&bar[XB_XGEN(bx)]) == gen, bar);
            __builtin_amdgcn_fence(__ATOMIC_ACQUIRE, "agent");
            asm volatile("s_waitcnt vmcnt(0)" ::: "memory");
        }
    }
    __syncthreads();
}

struct Args { const float* in[25]; float* out; unsigned char* ws; int ph_lo, ph_hi; };
enum { I_X = 0, I_C, I_AWIN, I_ABG, I_AMH, I_AWOUT, I_KVNORM, I_WADAKV, I_BADAKV, I_WKV, I_BFG, I_BWQ, I_BWO, I_NMIX, I_NFFN, I_WADA, I_BADA, I_WR, I_RB, I_WG, I_WU, I_WD, I_NFIN, I_WADAF, I_BADAF };

struct Frame {
    LAS unsigned char* lds;
    volatile LAS unsigned* MISC;
    gu32* ctl;
    int tid, lane, wave;
    int vcu, G;
};

__device__ __forceinline__ float wave_sum(float v) {
#pragma unroll
    for (int o = 1; o < 64; o <<= 1) v += __shfl_xor(v, o);
    return v;
}

__device__ __forceinline__ void p0_transpose_blk(const float* W, int ldw, int k0, int n0, bf16* WT, int ldt, int drow0, LAS float* scr, int lane) {
#pragma unroll 8
    for (int i = 0; i < 32; ++i) { const int kk = 2 * i + (lane >> 5); scr[kk * 33 + (lane & 31)] = W[(size_t)(k0 + kk) * ldw + n0 + (lane & 31)]; }
    LDS_WAIT(); asm volatile("" ::: "memory");
    const int c = lane & 7;
#pragma unroll
    for (int j = 0; j < 4; ++j) { const int n = (lane >> 3) + 8 * j; const LAS float* s = scr + (8 * c) * 33 + n;
        v4u o; o.x = pk2(s[0 * 33], s[1 * 33]); o.y = pk2(s[2 * 33], s[3 * 33]); o.z = pk2(s[4 * 33], s[5 * 33]); o.w = pk2(s[6 * 33], s[7 * 33]);
        *(GAS v4u*)(WT + (size_t)(drow0 + n) * ldt + k0 + 8 * c) = o; }
    LDS_WAIT(); asm volatile("" ::: "memory");
}
__device__ __forceinline__ void p0_prologue(Frame& F, const Args& a) {
    unsigned char* ws = a.ws;
    {
        LAS float* cact = (LAS float*)(F.lds);
        LAS float* red = (LAS float*)(F.lds + 65536);
        const float* c = a.in[I_C];
        for (int i = F.tid; i < NB * DM; i += 512) { const int b = i >> 10, d = i & 1023; const float v = c[i]; cact[d * 16 + b] = v / (1.0f + __expf(-v)); }
        __syncthreads();
        for (int blk = blockIdx.x; blk < 224; blk += F.G) {
            const float* W; const float* bias; float* out; int ldw, e0, ostride;
            if (blk < 192) { const int l = blk / 48; e0 = (blk % 48) * 128; W = a.in[I_WADA] + (size_t)l * DM * 6144; ldw = 6144; bias = a.in[I_BADA] + l * 6144; out = (float*)(ws + WS_MODS) + (size_t)l * NB * 6144; ostride = 6144; }
            else if (blk < 208) { e0 = (blk - 192) * 128; W = a.in[I_WADAKV]; ldw = 2048; bias = a.in[I_BADAKV]; out = (float*)(ws + WS_KVMOD); ostride = 2048; }
            else { e0 = (blk - 208) * 128; W = a.in[I_WADAF]; ldw = 2048; bias = a.in[I_BADAF]; out = (float*)(ws + WS_FIN); ostride = 2048; }
            const int col = F.tid & 127, ks = F.tid >> 7;
            float acc[16];
#pragma unroll
            for (int b = 0; b < 16; ++b) acc[b] = 0.f;
            const float* wp = W + (size_t)(ks * 256) * ldw + e0 + col;
#pragma unroll 4
            for (int d = 0; d < 256; ++d) { const float w = wp[(size_t)d * ldw]; const LAS f32x4* cp = (const LAS f32x4*)(cact + (ks * 256 + d) * 16);
#pragma unroll
                for (int q = 0; q < 4; ++q) { const f32x4 cv = cp[q]; acc[4 * q + 0] += w * cv[0]; acc[4 * q + 1] += w * cv[1]; acc[4 * q + 2] += w * cv[2]; acc[4 * q + 3] += w * cv[3]; } }
#pragma unroll
            for (int b = 0; b < 16; ++b) red[(ks * 128 + col) * 16 + b] = acc[b];
            __syncthreads();
            for (int i = F.tid; i < 128 * 16; i += 512) { const int cc = i & 127, b = i >> 7;
                const float s = red[(0 * 128 + cc) * 16 + b] + red[(1 * 128 + cc) * 16 + b] + red[(2 * 128 + cc) * 16 + b] + red[(3 * 128 + cc) * 16 + b];
                out[(size_t)b * ostride + e0 + cc] = s + bias[e0 + cc]; }
            __syncthreads();
        }
    }
    __syncthreads();
    {
        LAS float* scr = (LAS float*)(F.lds + F.wave * 16384);
        const int gw = F.vcu * NWAVES + F.wave, NGW = F.G * NWAVES;
        constexpr int I_IN = 16 * 96, I_SQ = 16 * 32, I_KV = 16 * 64, I_GU = 16 * 16, I_DN = 8 * 32;
        constexpr int N_IN = 2 * I_IN, N_OUT = 2 * I_SQ, N_KV = I_KV, N_Q = 2 * I_SQ, N_O = 2 * I_SQ, N_G = 64 * I_GU, N_U = 64 * I_GU, N_D = 64 * I_DN;
        constexpr int NITEMS = N_IN + N_OUT + N_KV + N_Q + N_O + N_G + N_U + N_D;
        for (int it = gw; it < NITEMS; it += NGW) {
            int r = it;
            if (r < N_IN) { const int l = r / I_IN, q = r % I_IN, kb = q / 96, nb = q % 96;
                p0_transpose_blk(a.in[I_AWIN] + (size_t)l * DM * A_IN, A_IN, 64 * kb, 32 * nb, (bf16*)(ws + WS_WIN) + (size_t)l * A_PROJ * DM, DM, 32 * nb, scr, F.lane); continue; } r -= N_IN;
            if (r < N_OUT) { const int l = r / I_SQ, q = r % I_SQ, kb = q / 32, nb = q % 32;
                p0_transpose_blk(a.in[I_AWOUT] + (size_t)l * DM * DM, DM, 64 * kb, 32 * nb, (bf16*)(ws + WS_WOUT) + (size_t)l * DM * DM, DM, 32 * nb, scr, F.lane); continue; } r -= N_OUT;
            if (r < N_KV) { const int kb = r / 64, nb = r % 64;
                p0_transpose_blk(a.in[I_WKV], KV_OUT, 64 * kb, 32 * nb, (bf16*)(ws + WS_WKV), DM, 32 * nb, scr, F.lane); continue; } r -= N_KV;
            if (r < N_Q) { const int l = r / I_SQ, q = r % I_SQ, kb = q / 32, nb = q % 32;
                p0_transpose_blk(a.in[I_BWQ] + (size_t)l * DM * DM, DM, 64 * kb, 32 * nb, (bf16*)(ws + WS_WQ) + (size_t)l * DM * DM, DM, 32 * nb, scr, F.lane); continue; } r -= N_Q;
            if (r < N_O) { const int l = r / I_SQ, q = r % I_SQ, kb = q / 32, nb = q % 32;
                p0_transpose_blk(a.in[I_BWO] + (size_t)l * DM * DM, DM, 64 * kb, 32 * nb, (bf16*)(ws + WS_WO) + (size_t)l * DM * DM, DM, 32 * nb, scr, F.lane); continue; } r -= N_O;
            if (r < N_G + N_U) { const int up = r >= N_G; if (up) r -= N_G; const int le = r / I_GU, q = r % I_GU, kb = q / 16, nb = q % 16; const int n0 = 32 * nb;
                const float* W = a.in[up ? I_WU : I_WG] + (size_t)le * DM * DE;
                p0_transpose_blk(W, DE, 64 * kb, n0, (bf16*)(ws + WS_BT1) + (size_t)le * 1024 * DM, DM, (n0 >> 7) * 256 + up * 128 + (n0 & 127), scr, F.lane); continue; } r -= N_G + N_U;
            { const int le = r / I_DN, q = r % I_DN, kb = q / 32, nb = q % 32;
                p0_transpose_blk(a.in[I_WD] + (size_t)le * DE * DM, DM, 64 * kb, 32 * nb, (bf16*)(ws + WS_BT2) + (size_t)le * DM * DE, DE, 32 * nb, scr, F.lane); }
        }
    }
}

__device__ __forceinline__ float log_sigmoidf_(float x) { return fminf(x, 0.f) - log1pf(__expf(-fabsf(x))); }
template <bool ROUTER>
__device__ __forceinline__ void norm_phase(Frame& F, const float* x, const float* gamma, const float* shift, const float* scale, int mstride, bf16* out,
                                           int mode, const float* W16, int ldw, const float* bias16, float* G16, float2* wts, int* perm, gu32* gcnt) {
    LAS float* wT = (LAS float*)(F.lds);
    LAS int* hist = (LAS int*)(F.lds + 65536);
    LAS int* sbase = hist + 32;
    LAS int* tinfo = hist + 64;
    int tid_ = threadIdx.x; asm volatile("" : "+v"(tid_)); const int tid = tid_, lane = tid & 63, wave = __builtin_amdgcn_readfirstlane(tid >> 6);
    if (mode != 0) { for (int i = tid; i < DM * 16; i += 512) { const int d = i >> 4, e = i & 15; wT[e * DM + d] = W16[(size_t)d * ldw + e]; } }
    if (tid < 32) hist[tid] = 0;
    __syncthreads();
    for (int chunk = blockIdx.x; chunk < NT / 256; chunk += F.G) {
        const int b = chunk >> 4;
        f32x4 ga[4], sb[4];
#pragma unroll
        for (int j = 0; j < 4; ++j) { const int col = 4 * lane + 256 * j; const f32x4 g = *(const f32x4*)(gamma + col), sc = *(const f32x4*)(scale + (size_t)b * mstride + col); sb[j] = *(const f32x4*)(shift + (size_t)b * mstride + col);
            ga[j] = g * (sc + 1.0f); }
#pragma clang loop unroll(disable)
        for (int i = 0; i < 32; ++i) {
            const int row = chunk * 256 + wave * 32 + i;
            const GAS f32x4* xr = (const GAS f32x4*)(x + (size_t)row * DM) + lane;
            f32x4 v[4]; float s = 0.f;
#pragma unroll
            for (int j = 0; j < 4; ++j) { v[j] = xr[64 * j]; s += (v[j].x * v[j].x + v[j].y * v[j].y) + (v[j].z * v[j].z + v[j].w * v[j].w); }
            const float r = 1.0f / sqrtf(wave_sum(s) * (1.0f / DM) + EPS);
            GAS v2u* o8 = (GAS v2u*)(out + (size_t)row * DM) + lane;
#pragma unroll
            for (int j = 0; j < 4; ++j) { v[j] = v[j] * r * ga[j] + sb[j]; v2u w; w.x = pk2(v[j].x, v[j].y); w.y = pk2(v[j].z, v[j].w); o8[64 * j] = w; }
            if (mode == 0) continue;
            float p[16];
#pragma unroll
            for (int e = 0; e < 16; ++e) { float a = 0.f;
#pragma unroll
                for (int j = 0; j < 4; ++j) { const f32x4 w = *(const LAS f32x4*)(wT + e * DM + 4 * lane + 256 * j); a += (v[j].x * w.x + v[j].y * w.y) + (v[j].z * w.z + v[j].w * w.w); }
                p[e] = a; }
#pragma unroll
            for (int k = 0; k < 8; ++k) { const bool hi = lane & 32; const float mine = hi ? p[k + 8] : p[k], send = hi ? p[k] : p[k + 8]; p[k] = mine + __shfl_xor(send, 32); }
#pragma unroll
            for (int k = 0; k < 4; ++k) { const bool hi = lane & 16; const float mine = hi ? p[k + 4] : p[k], send = hi ? p[k] : p[k + 4]; p[k] = mine + __shfl_xor(send, 16); }
#pragma unroll
            for (int k = 0; k < 2; ++k) { const bool hi = lane & 8; const float mine = hi ? p[k + 2] : p[k], send = hi ? p[k] : p[k + 2]; p[k] = mine + __shfl_xor(send, 8); }
            { const bool hi = lane & 4; const float mine = hi ? p[1] : p[0], send = hi ? p[0] : p[1]; p[0] = mine + __shfl_xor(send, 4); }
            p[0] += __shfl_xor(p[0], 2); p[0] += __shfl_xor(p[0], 1);
            const int e = (lane >> 2) & 15;
            if (!ROUTER) {
              if (mode == 1) {
                float g = p[0] + bias16[e]; g = 15.0f * tanhf(g * (1.0f / 15.0f));
                if (e >= 8) g = log_sigmoidf_(g);
                if ((lane & 3) == 0) G16[(size_t)row * 16 + e] = g;
              } else {
                const float g = log_sigmoidf_(p[0] + bias16[e]);
                if ((lane & 3) == 0) G16[(size_t)row * 16 + e] = g;
              }
            } else {
                float aff[16], sel[16];
#pragma unroll
                for (int q = 0; q < 16; ++q) { const float lg = __shfl(p[0], 4 * q); aff[q] = 1.0f / (1.0f + __expf(-lg)); sel[q] = aff[q] + bias16[q]; }
                float gs[4];
#pragma unroll
                for (int g = 0; g < 4; ++g) { const float s0 = sel[4 * g], s1 = sel[4 * g + 1], s2 = sel[4 * g + 2], s3 = sel[4 * g + 3];
                    const float a = fmaxf(s0, s1), bb = fminf(s0, s1), c = fmaxf(s2, s3), d = fminf(s2, s3);
                    gs[g] = fmaxf(a, c) + fmaxf(fminf(a, c), fmaxf(bb, d)); }
                int grp = 0; float best = gs[0];
#pragma unroll
                for (int g = 1; g < 4; ++g) if (gs[g] > best) { best = gs[g]; grp = g; }
                float sg[4], ag[4];
#pragma unroll
                for (int q = 0; q < 4; ++q) { sg[q] = grp == 0 ? sel[q] : grp == 1 ? sel[4 + q] : grp == 2 ? sel[8 + q] : sel[12 + q]; ag[q] = grp == 0 ? aff[q] : grp == 1 ? aff[4 + q] : grp == 2 ? aff[8 + q] : aff[12 + q]; }
                int i1 = 0; float b1 = sg[0];
#pragma unroll
                for (int q = 1; q < 4; ++q) if (sg[q] > b1) { b1 = sg[q]; i1 = q; }
                int i2 = -1; float b2 = 0.f;
#pragma unroll
                for (int q = 0; q < 4; ++q) if (q != i1 && (i2 < 0 || sg[q] > b2)) { b2 = sg[q]; i2 = q; }
                const int ea = i1 < i2 ? i1 : i2, eb = i1 < i2 ? i2 : i1;
                const float wa = ea == 0 ? ag[0] : ea == 1 ? ag[1] : ag[2], wb = eb == 1 ? ag[1] : eb == 2 ? ag[2] : ag[3];
                const float inv = 1.0f / (wa + wb);
                const int pid = ea == 0 ? eb - 1 : ea == 1 ? eb + 1 : 5;
                const int cls = grp * 6 + pid;
                if (lane == 0) { wts[row] = make_float2(wa * inv, wb * inv); const int rk = __hip_atomic_fetch_add(&hist[cls], 1, __ATOMIC_RELAXED, __HIP_MEMORY_SCOPE_WORKGROUP); tinfo[wave * 32 + i] = cls | (rk << 8); }
            }
        }
        if (ROUTER) {
            __syncthreads();
            if (tid < NCLS) { const int n = hist[tid]; sbase[tid] = n ? (int)__hip_atomic_fetch_add(gcnt + tid, (unsigned)n, RLX_AGENT) : 0; }
            __syncthreads();
            if (tid < 256) { const int ti = tinfo[tid], cls = ti & 255, rk = ti >> 8; perm[(size_t)cls * CLS_CAP + sbase[cls] + rk] = chunk * 256 + tid; }
            __syncthreads();
            if (tid < 32) hist[tid] = 0;
            __syncthreads();
        }
    }
    __syncthreads();
}
__device__ __forceinline__ void final_norm_phase(Frame& F, float* x, const float* gamma, const float* shift, const float* scale, int mstride) {
    int tid_ = threadIdx.x; asm volatile("" : "+v"(tid_)); const int lane = tid_ & 63, wave = __builtin_amdgcn_readfirstlane(tid_ >> 6);
    for (int chunk = blockIdx.x; chunk < NT / 256; chunk += F.G) {
        const int b = chunk >> 4;
        f32x4 ga[4], sb[4];
#pragma unroll
        for (int j = 0; j < 4; ++j) { const int col = 4 * lane + 256 * j; const f32x4 g = *(const f32x4*)(gamma + col), sc = *(const f32x4*)(scale + (size_t)b * mstride + col); sb[j] = *(const f32x4*)(shift + (size_t)b * mstride + col);
            ga[j] = g * (sc + 1.0f); }
#pragma clang loop unroll(disable)
        for (int i = 0; i < 32; ++i) {
            const int row = chunk * 256 + wave * 32 + i;
            GAS f32x4* xr = (GAS f32x4*)(x + (size_t)row * DM) + lane;
            f32x4 v[4]; float s = 0.f;
#pragma unroll
            for (int j = 0; j < 4; ++j) { v[j] = xr[64 * j]; s += (v[j].x * v[j].x + v[j].y * v[j].y) + (v[j].z * v[j].z + v[j].w * v[j].w); }
            const float r = 1.0f / sqrtf(wave_sum(s) * (1.0f / DM) + EPS);
#pragma unroll
            for (int j = 0; j < 4; ++j) xr[64 * j] = v[j] * r * ga[j] + sb[j];
        }
    }
}

__device__ __forceinline__ void fcum_phase(Frame& F, const float* logf, float* FB) {
    LAS float* wtot = (LAS float*)(F.lds);
    int tid_ = threadIdx.x; asm volatile("" : "+v"(tid_)); const int tid = tid_, lane = tid & 63, wave = __builtin_amdgcn_readfirstlane(tid >> 6);
    for (int chain = blockIdx.x; chain < NB * 16; chain += F.G) {
        const int b = chain >> 4, hh = chain & 15;
        float v[8]; float run = 0.f;
#pragma unroll
        for (int j = 0; j < 8; ++j) { run += logf[((size_t)b * SEQ + tid * 8 + j) * 16 + hh]; v[j] = run; }
        float inc = run;
#pragma unroll
        for (int o = 1; o < 64; o <<= 1) { const float t = __shfl_up(inc, o); if (lane >= o) inc += t; }
        if (lane == 63) wtot[wave] = inc;
        __syncthreads();
        float base = inc - run;
        for (int w = 0; w < wave; ++w) base += wtot[w];
#pragma unroll
        for (int j = 0; j < 8; ++j) FB[(size_t)chain * SEQ + tid * 8 + j] = -(base + v[j]) * 1.4426950408889634f;
        __syncthreads();
    }
}

__device__ __forceinline__ float wave_scan_add(float v, int lane) {
#pragma unroll
    for (int o = 1; o < 64; o <<= 1) { const float t = __shfl_up(v, o); if (lane >= o) v += t; }
    return v;
}
__device__ __forceinline__ float wave_scan_max(float v, int lane) {
#pragma unroll
    for (int o = 1; o < 64; o <<= 1) { const float t = __shfl_up(v, o); if (lane >= o) v = fmaxf(v, t); }
    return v;
}
__device__ __forceinline__ void cell_phase(Frame& F, const bf16* PROJ, const float* G16, const float* mhn, bf16* HS) {
    constexpr int PST = 72;
    LAS bf16* sQ = (LAS bf16*)(F.lds);
    LAS bf16* sK = sQ + 64 * PST;
    LAS bf16* sKT = sK + 64 * PST;
    LAS bf16* sW = sKT + 64 * PST;
    LAS bf16* sVT = sW + 64 * PST;
    LAS bf16* sCT = sVT + 128 * PST;
    LAS float* fz = (LAS float*)(sCT + 128 * PST);
    LAS float* sU = fz, *sM = fz + 64, *sA = fz + 128, *sEm = fz + 192, *sWk = fz + 256, *sInv = fz + 320, *sN = fz + 384, *sScal = fz + 448, *sSS = fz + 512;
    int tid_ = threadIdx.x; asm volatile("" : "+v"(tid_));
    const int tid = tid_, lane = tid & 63, w = __builtin_amdgcn_readfirstlane(tid >> 6), fr = lane & 15, fq = lane >> 4;
    for (int chain = blockIdx.x; chain < NB * 8; chain += F.G) {
        const int b = chain >> 3, hh = chain & 7;
        f32x4 accC[4];
#pragma unroll
        for (int ni = 0; ni < 4; ++ni) accC[ni] = (f32x4){0.f, 0.f, 0.f, 0.f};
        for (int i = tid; i < 128 * PST; i += 512) sCT[i] = 0;
        if (tid < 64) sN[tid] = 0.f;
        float m_prev = 0.f;
        __syncthreads();
        for (int c = 0; c < SEQ / 64; ++c) {
            const size_t t0 = (size_t)b * SEQ + 64 * c;
            const int row = tid >> 3, seg = tid & 7;
            const bf16* pr = PROJ + (t0 + row) * A_PROJ + hh * 64 + seg * 8;
            const v4u qv = *(const GAS v4u*)pr, kv = *(const GAS v4u*)(pr + 512);
            const bf16* pv = PROJ + (t0 + row) * A_PROJ + 1024 + hh * 128 + seg * 8;
            const v4u v0 = *(const GAS v4u*)pv, v1 = *(const GAS v4u*)(pv + 64);
            float ig = 0.f, lf = 0.f;
            if (tid < 64) { ig = G16[(t0 + tid) * 16 + hh]; lf = G16[(t0 + tid) * 16 + 8 + hh]; }
            *(LAS v4u*)(sQ + row * PST + seg * 8) = qv;
            *(LAS v4u*)(sK + row * PST + seg * 8) = kv;
#pragma unroll
            for (int j = 0; j < 4; ++j) { sVT[(seg * 8 + 2 * j) * PST + row] = (bf16)(v0[j] & 0xffffu); sVT[(seg * 8 + 2 * j + 1) * PST + row] = (bf16)(v0[j] >> 16);
                sVT[(64 + seg * 8 + 2 * j) * PST + row] = (bf16)(v1[j] & 0xffffu); sVT[(64 + seg * 8 + 2 * j + 1) * PST + row] = (bf16)(v1[j] >> 16); }
            if (w == 0) {
                const float bc = wave_scan_add(lf, lane), u = ig - bc, pm = wave_scan_max(u, lane), M = fmaxf(m_prev, pm);
                const float M63 = __shfl(M, 63), bl = __shfl(bc, 63);
                sU[lane] = u; sM[lane] = M; sA[lane] = __expf(m_prev - M); sEm[lane] = __expf(-(bc + M)); sWk[lane] = __expf(u - M63);
                if (lane == 0) { sScal[0] = __expf(m_prev - M63); sScal[1] = bl + M63; }
            }
            __syncthreads();
            { const float wk = sWk[row];
#pragma unroll
              for (int j = 0; j < 4; ++j) { sKT[(seg * 8 + 2 * j) * PST + row] = (bf16)f2bf(bf2f(kv[j] & 0xffffu) * wk); sKT[(seg * 8 + 2 * j + 1) * PST + row] = (bf16)f2bf(bf2f(kv[j] >> 16) * wk); } }
            { const int mi = w >> 1;
#pragma unroll
              for (int nn = 0; nn < 2; ++nn) { const int ni = (w & 1) * 2 + nn; f32x4 acc = (f32x4){0.f, 0.f, 0.f, 0.f};
#pragma unroll
                for (int ks = 0; ks < 2; ++ks) { const bf16x8 av = *(const LAS bf16x8*)(sQ + (16 * mi + fr) * PST + 32 * ks + 8 * fq), bv = *(const LAS bf16x8*)(sK + (16 * ni + fr) * PST + 32 * ks + 8 * fq);
                    acc = __builtin_amdgcn_mfma_f32_16x16x32_bf16(av, bv, acc, 0, 0, 0); }
                const int s = 16 * ni + fr; const float us = sU[s];
#pragma unroll
                for (int i = 0; i < 4; ++i) { const int t = 16 * mi + 4 * fq + i; const float wv = (s <= t) ? __expf(us - sM[t]) * acc[i] : 0.f; sW[t * PST + s] = (bf16)f2bf(wv); } } }
            __syncthreads();
            { const int t = tid >> 3, part = tid & 7; float d1 = 0.f, qn = 0.f;
#pragma unroll
              for (int j = 0; j < 8; ++j) { d1 += bf2f(sW[t * PST + part * 8 + j]); qn += bf2f(sQ[t * PST + part * 8 + j]) * sN[part * 8 + j]; }
              d1 += __shfl_xor(d1, 1); d1 += __shfl_xor(d1, 2); d1 += __shfl_xor(d1, 4); qn += __shfl_xor(qn, 1); qn += __shfl_xor(qn, 2); qn += __shfl_xor(qn, 4);
              const float den = d1 + sA[t] * qn; if (part == 0) sInv[t] = 1.0f / fmaxf(fabsf(den), sEm[t]); }
            f32x4 acc[4];
#pragma unroll
            for (int mi = 0; mi < 4; ++mi) acc[mi] = (f32x4){0.f, 0.f, 0.f, 0.f};
#pragma unroll
            for (int ks = 0; ks < 2; ++ks) { const bf16x8 bq = *(const LAS bf16x8*)(sCT + (16 * w + fr) * PST + 32 * ks + 8 * fq);
#pragma unroll
                for (int mi = 0; mi < 4; ++mi) { const bf16x8 av = *(const LAS bf16x8*)(sQ + (16 * mi + fr) * PST + 32 * ks + 8 * fq); acc[mi] = __builtin_amdgcn_mfma_f32_16x16x32_bf16(av, bq, acc[mi], 0, 0, 0); } }
#pragma unroll
            for (int mi = 0; mi < 4; ++mi)
#pragma unroll
                for (int i = 0; i < 4; ++i) acc[mi][i] *= sA[16 * mi + 4 * fq + i];
#pragma unroll
            for (int ks = 0; ks < 2; ++ks) { const bf16x8 bv = *(const LAS bf16x8*)(sVT + (16 * w + fr) * PST + 32 * ks + 8 * fq);
#pragma unroll
                for (int mi = 0; mi < 4; ++mi) { const bf16x8 av = *(const LAS bf16x8*)(sW + (16 * mi + fr) * PST + 32 * ks + 8 * fq); acc[mi] = __builtin_amdgcn_mfma_f32_16x16x32_bf16(av, bv, acc[mi], 0, 0, 0); } }
            __syncthreads();
#pragma unroll
            for (int mi = 0; mi < 4; ++mi)
#pragma unroll
                for (int i = 0; i < 4; ++i) { const int t = 16 * mi + 4 * fq + i; const float hv = acc[mi][i] * sInv[t]; acc[mi][i] = hv; float sq = hv * hv;
                    sq += __shfl_xor(sq, 1); sq += __shfl_xor(sq, 2); sq += __shfl_xor(sq, 4); sq += __shfl_xor(sq, 8); if (fr == 0) sSS[w * 64 + t] = sq; }
            __syncthreads();
            { const int col = hh * 128 + 16 * w + fr; const float mh = mhn[col];
#pragma unroll
              for (int mi = 0; mi < 4; ++mi)
#pragma unroll
                for (int i = 0; i < 4; ++i) { const int t = 16 * mi + 4 * fq + i; float tot = 0.f;
#pragma unroll
                    for (int ww = 0; ww < 8; ++ww) tot += sSS[ww * 64 + t];
                    const float rn = 1.0f / sqrtf(tot * (1.0f / 128.0f) + EPS);
                    const float og = bf2f(PROJ[(t0 + t) * A_PROJ + 2048 + col]);
                    HS[(t0 + t) * DM + col] = (bf16)f2bf(acc[mi][i] * rn * mh * og); } }
            { const float decay = sScal[0];
#pragma unroll
              for (int ni = 0; ni < 4; ++ni) accC[ni] = accC[ni] * decay;
#pragma unroll
              for (int ks = 0; ks < 2; ++ks) { const bf16x8 av = *(const LAS bf16x8*)(sVT + (16 * w + fr) * PST + 32 * ks + 8 * fq);
#pragma unroll
                for (int ni = 0; ni < 4; ++ni) { const bf16x8 bv = *(const LAS bf16x8*)(sKT + (16 * ni + fr) * PST + 32 * ks + 8 * fq); accC[ni] = __builtin_amdgcn_mfma_f32_16x16x32_bf16(av, bv, accC[ni], 0, 0, 0); } }
#pragma unroll
              for (int ni = 0; ni < 4; ++ni)
#pragma unroll
                for (int i = 0; i < 4; ++i) sCT[(16 * w + 4 * fq + i) * PST + 16 * ni + fr] = (bf16)f2bf(accC[ni][i]);
              const int d = tid >> 3, part = tid & 7; float sk = 0.f;
#pragma unroll
              for (int j = 0; j < 8; ++j) sk += bf2f(sKT[d * PST + part * 8 + j]);
              sk += __shfl_xor(sk, 1); sk += __shfl_xor(sk, 2); sk += __shfl_xor(sk, 4);
              if (part == 0) sN[d] = decay * sN[d] + sk;
              m_prev = sScal[1]; }
            __syncthreads();
        }
    }
}

struct DenseProb {
    const bf16* A; int lda; const bf16* Bt; int ldb; int K; pg8::StaticOrder S;
    __device__ __forceinline__ bool next(int i, pg8::Unit& u) const { return S.next(i, u); }
    __device__ __forceinline__ const char* a_base() const { return (const char*)A; }
    __device__ __forceinline__ void a_off(const pg8::Unit& u, int R0, int C0, unsigned (&o)[2][2]) const {
#pragma unroll
        for (int h = 0; h < 2; ++h)
#pragma unroll
            for (int i = 0; i < 2; ++i) o[h][i] = (unsigned)((u.pm * 256 + h * 128 + R0 + 64 * i) * lda + C0) * 2u; }
    __device__ __forceinline__ const char* b_tile(const pg8::Unit& u, int tt) const { return (const char*)Bt + (size_t)u.pn * 256 * ldb * 2 + (size_t)tt * 128; }
};
struct ClassTab { const LAS int* blkstart; const LAS int* ncls; };
__device__ __forceinline__ void class_of(const ClassTab& T, pg8::Unit& u) { int c = 0; while (c < NCLS - 1 && u.pm >= T.blkstart[c + 1]) ++c; u.cls = c; u.lb = u.pm - T.blkstart[c]; }
__device__ __forceinline__ void pair_of(int cls, int& ea, int& eb) { const int g = cls / 6, p = cls % 6; const int a = p < 3 ? 0 : p < 5 ? 1 : 2, b = p < 3 ? p + 1 : p < 5 ? p - 1 : 3; ea = g * 4 + a; eb = g * 4 + b; }
struct Moe1Prob {
    const bf16* A; int ldb; int K; const bf16* Bt1l; const int* perm; ClassTab T; pg8::StaticOrder S;
    __device__ __forceinline__ bool next(int i, pg8::Unit& u) const { if (!S.next(i, u)) return false; class_of(T, u); return true; }
    __device__ __forceinline__ const char* a_base() const { return (const char*)A; }
    __device__ __forceinline__ void a_off(const pg8::Unit& u, int R0, int C0, unsigned (&o)[2][2]) const {
        const int n = T.ncls[u.cls];
#pragma unroll
        for (int h = 0; h < 2; ++h)
#pragma unroll
            for (int i = 0; i < 2; ++i) { int pos = u.lb * 256 + h * 128 + R0 + 64 * i; pos = pos < n ? pos : n - 1; const int tok = perm[(size_t)u.cls * CLS_CAP + pos]; o[h][i] = (unsigned)(tok * DM + C0) * 2u; } }
    __device__ __forceinline__ const char* b_tile(const pg8::Unit& u, int tt) const { int ea, eb; pair_of(u.cls, ea, eb); const int e = u.pn < 4 ? ea : eb;
        return (const char*)Bt1l + ((size_t)e * 1024 + (size_t)(u.pn & 3) * 256) * DM * 2 + (size_t)tt * 128; }
};
struct Moe2Prob {
    const bf16* A; int ldb; int K; const bf16* Bt2l; ClassTab T; pg8::StaticOrder S;
    __device__ __forceinline__ bool next(int i, pg8::Unit& u) const { if (!S.next(i, u)) return false; class_of(T, u); return true; }
    __device__ __forceinline__ const char* a_base() const { return (const char*)A; }
    __device__ __forceinline__ void a_off(const pg8::Unit& u, int R0, int C0, unsigned (&o)[2][2]) const {
#pragma unroll
        for (int h = 0; h < 2; ++h)
#pragma unroll
            for (int i = 0; i < 2; ++i) o[h][i] = (unsigned)((u.pm * 256 + h * 128 + R0 + 64 * i) * DM + C0) * 2u; }
    __device__ __forceinline__ const char* b_tile(const pg8::Unit& u, int tt) const { int ea, eb; pair_of(u.cls, ea, eb); const int e = tt < 8 ? ea : eb;
        return (const char*)Bt2l + ((size_t)e * 1024 + (size_t)u.pn * 256) * DE * 2 + (size_t)(tt & 7) * 128; }
};

struct EpiProj {
    static constexpr bool PERM = true;
    bf16* O; int ldc; int split_cols; size_t split_stride; int nscale; float scale; int sig_from;
    __device__ __forceinline__ void operator()(const pg8::f32x4 (&acc)[2][2][4][2], const pg8::Unit& u, int wr, int wc, int fr, int fq) const {
        const int row0 = u.pm * 256 + wr * 64 + fr; int colt = u.pn * 256; bf16* base = O;
        if (split_cols) { const int t = colt / split_cols; base += (size_t)t * split_stride; colt -= t * split_cols; }
        const float sc = u.pn < nscale ? scale : 1.0f; const bool sg = u.pn >= sig_from;
        const int col0 = colt + wc * 32 + 8 * fq;
#pragma unroll
        for (int ai = 0; ai < 2; ++ai)
#pragma unroll
            for (int m = 0; m < 4; ++m) { bf16* rowp = base + (size_t)(row0 + ai * 128 + m * 16) * ldc + col0;
#pragma unroll
                for (int bj = 0; bj < 2; ++bj) { pg8::f32x4 v0 = acc[ai][bj][m][0] * sc, v1 = acc[ai][bj][m][1] * sc;
                    if (sg) {
#pragma unroll
                        for (int j = 0; j < 4; ++j) { v0[j] = pg8::sigmoidf_(v0[j]); v1[j] = pg8::sigmoidf_(v1[j]); } }
                    pg8::u32x4 w; w.x = pg8::cvt_pk_bf16(v0[0], v0[1]); w.y = pg8::cvt_pk_bf16(v0[2], v0[3]); w.z = pg8::cvt_pk_bf16(v1[0], v1[1]); w.w = pg8::cvt_pk_bf16(v1[2], v1[3]);
                    *(pg8::u32x4*)(rowp + bj * 128) = w; } }
    }
};
struct EpiRes {
    static constexpr bool PERM = false;
    const float* base; float* out; const float* gate; int gstride;
    __device__ __forceinline__ void operator()(const pg8::f32x4 (&acc)[2][2][4][2], const pg8::Unit& u, int wr, int wc, int fr, int fq) const {
        const int row0 = u.pm * 256 + wr * 64 + fr, col0 = u.pn * 256 + wc * 32 + 4 * fq;
        const float* gp = gate + (size_t)(u.pm >> 4) * gstride + col0;
        pg8::f32x4 gv[2][2];
#pragma unroll
        for (int bj = 0; bj < 2; ++bj)
#pragma unroll
            for (int n = 0; n < 2; ++n) gv[bj][n] = *(const pg8::f32x4*)(gp + bj * 128 + n * 16);
#pragma unroll
        for (int ai = 0; ai < 2; ++ai)
#pragma unroll
            for (int m = 0; m < 4; ++m) { const size_t off = (size_t)(row0 + ai * 128 + m * 16) * DM + col0;
#pragma unroll
                for (int bj = 0; bj < 2; ++bj)
#pragma unroll
                    for (int n = 0; n < 2; ++n) { const pg8::f32x4 bs = *(const pg8::f32x4*)(base + off + bj * 128 + n * 16); *(pg8::f32x4*)(out + off + bj * 128 + n * 16) = bs + gv[bj][n] * acc[ai][bj][m][n]; } }
    }
};
struct EpiResScatter {
    static constexpr bool PERM = false;
    float* x; const float* gate; int gstride; const int* perm; ClassTab T;
    __device__ __forceinline__ void operator()(const pg8::f32x4 (&acc)[2][2][4][2], const pg8::Unit& u, int wr, int wc, int fr, int fq) const {
        const int n = T.ncls[u.cls]; const int col0 = u.pn * 256 + wc * 32 + 4 * fq;
#pragma unroll
        for (int ai = 0; ai < 2; ++ai)
#pragma unroll
            for (int m = 0; m < 4; ++m) { const int pos = u.lb * 256 + ai * 128 + wr * 64 + m * 16 + fr;
                if (pos < n) { const int tok = perm[(size_t)u.cls * CLS_CAP + pos]; const size_t off = (size_t)tok * DM + col0; const float* gp = gate + (size_t)(tok >> 12) * gstride + col0;
#pragma unroll
                    for (int bj = 0; bj < 2; ++bj)
#pragma unroll
                        for (int nn = 0; nn < 2; ++nn) { const pg8::f32x4 gv = *(const pg8::f32x4*)(gp + bj * 128 + nn * 16); const pg8::f32x4 bs = *(const pg8::f32x4*)(x + off + bj * 128 + nn * 16);
                            *(pg8::f32x4*)(x + off + bj * 128 + nn * 16) = bs + gv * acc[ai][bj][m][nn]; } } }
    }
};
struct EpiAct {
    static constexpr bool PERM = true;
    bf16* act; const int* perm; const float2* wts; ClassTab T;
    __device__ __forceinline__ void operator()(const pg8::f32x4 (&acc)[2][2][4][2], const pg8::Unit& u, int wr, int wc, int fr, int fq) const {
        const int n = T.ncls[u.cls]; const int second = u.pn >> 2; const int col0 = second * 512 + (u.pn & 3) * 128 + wc * 32 + 8 * fq;
#pragma unroll
        for (int ai = 0; ai < 2; ++ai)
#pragma unroll
            for (int m = 0; m < 4; ++m) { const int lr = ai * 128 + wr * 64 + m * 16 + fr; int pos = u.lb * 256 + lr; pos = pos < n ? pos : n - 1;
                const int tok = perm[(size_t)u.cls * CLS_CAP + pos]; const float2 w2 = wts[tok]; const float wt = second ? w2.y : w2.x;
                pg8::f32x4 g0 = acc[ai][0][m][0], g1 = acc[ai][0][m][1]; const pg8::f32x4 u0 = acc[ai][1][m][0], u1 = acc[ai][1][m][1];
#pragma unroll
                for (int j = 0; j < 4; ++j) { g0[j] = g0[j] * pg8::sigmoidf_(g0[j]) * u0[j] * wt; g1[j] = g1[j] * pg8::sigmoidf_(g1[j]) * u1[j] * wt; }
                pg8::u32x4 w; w.x = pg8::cvt_pk_bf16(g0[0], g0[1]); w.y = pg8::cvt_pk_bf16(g0[2], g0[3]); w.z = pg8::cvt_pk_bf16(g1[0], g1[1]); w.w = pg8::cvt_pk_bf16(g1[2], g1[3]);
                *(pg8::u32x4*)(act + (size_t)(u.pm * 256 + lr) * DM + col0) = w; }
    }
};
__device__ __forceinline__ void build_class_tab(Frame& F, gu32* gcnt) {
    LAS int* blkstart = (LAS int*)(F.lds + TAB_OFF); LAS int* ncls = blkstart + 32;
    if (F.tid == 0) { int run = 0; for (int c = 0; c < NCLS; ++c) { const int n = (int)__hip_atomic_load(gcnt + c, RLX_AGENT); ncls[c] = n; blkstart[c] = run; run += (n + 255) >> 8; } blkstart[NCLS] = run; }
    __syncthreads();
}

__global__ void __launch_bounds__(NWAVES * 64, 2) mk_fwd(Args args) {
    extern __shared__ __attribute__((aligned(16))) unsigned char lds[];
    Frame F;
    F.lds = (LAS unsigned char*)lds;
    F.MISC = (volatile LAS unsigned*)(F.lds + MISC_OFF);
    F.tid = threadIdx.x; F.lane = F.tid & 63; F.wave = __builtin_amdgcn_readfirstlane(F.tid >> 6);
    F.G = gridDim.x; { const int bx = blockIdx.x; F.vcu = (F.G % 8 == 0) ? (bx % 8) * (F.G / 8) + bx / 8 : bx; }
    unsigned char* ws = args.ws;
    F.ctl = (gu32*)(ws + WS_CTL);
    for (int u = F.tid; u < (LDS_BYTES - LDSCTL_OFF) / 4; u += NWAVES * 64) ((LAS unsigned*)(F.lds + LDSCTL_OFF))[u] = 0u;
    __syncthreads();
    const int lo = args.ph_lo, hi = args.ph_hi;
    const bool multi = (hi - lo) > 1;
    XcdBarrier bar; bar.bar = (unsigned*)(F.ctl + CW_BAR); bar.x = 0; bar.st = nullptr;
    if (multi) bar = xcd_barrier_post((unsigned*)(F.ctl + CW_BAR), F.MISC + 8);
    int ph = 0;
#define PH_BEGIN(run) const bool run = (lo <= ph && ph < hi); ++ph;
#define PH_END(run) do { if (run && ph < hi) xcd_barrier(bar); } while (0)

    float* const X = args.out;

    { PH_BEGIN(run) if (run) {
#ifndef DIS_P0
 p0_prologue(F, args);
#endif
 } PH_END(run); }

    for (int step = 0; step < 5; ++step) {
        unsigned char* ws = args.ws; asm volatile("" : "+s"(ws));
        float* const MODS = (float*)(ws + WS_MODS);
        bf16* const HB = (bf16*)(ws + WS_HB);
        bf16* const BIG = (bf16*)(ws + WS_BIG);
        bf16* const ACT = (bf16*)(ws + WS_ACT);
        float* const G16 = (float*)(ws + WS_G16);
        float* const FB = (float*)(ws + WS_FB);
        float2* const WTS = (float2*)(ws + WS_WTS);
        int* const PERM = (int*)(ws + WS_PERM);
        bf16* const Kb = BIG; bf16* const Vb = BIG + (size_t)NT * DM; bf16* const Qb = BIG + (size_t)2 * NT * DM;
        const int kind = step < 2 ? 0 : step == 2 ? 1 : 2;
        const int L = step < 2 ? step : step == 2 ? 2 : step - 1;
        const float* xin = (L == 0) ? args.in[I_X] : X;
        const float* mods = MODS + (size_t)L * NB * 6144;
        { PH_BEGIN(run) if (run) {
#ifndef DIS_NORM1
            const float* gam = kind == 1 ? args.in[I_KVNORM] : args.in[I_NMIX] + L * DM;
            const float* shf = kind == 1 ? (const float*)(ws + WS_KVMOD) : mods; const float* scl = shf + 1024; const int mstr = kind == 1 ? 2048 : 6144;
            const int nmode = kind == 0 ? 1 : kind == 1 ? 2 : 0;
            const float* w16 = kind == 0 ? args.in[I_AWIN] + (size_t)L * DM * A_IN + A_PROJ : args.in[I_WKV] + 2048; const int ldw16 = kind == 0 ? A_IN : KV_OUT;
            const float* b16 = kind == 0 ? args.in[I_ABG] + L * 16 : args.in[I_BFG];
            norm_phase<false>(F, xin, gam, shf, scl, mstr, HB, nmode, w16, ldw16, b16, G16, nullptr, nullptr, nullptr);
#endif
          } PH_END(run); }
        { PH_BEGIN(run) if (run) {
#ifndef DIS_PROJ
            if (kind == 1) fcum_phase(F, G16, FB);
            DenseProb P; P.A = HB; P.lda = DM; P.ldb = DM; P.K = DM;
            EpiProj E; E.split_cols = 0; E.split_stride = 0; E.nscale = 0; E.scale = 1.f; E.sig_from = 1 << 30;
            if (kind == 0) { P.Bt = (const bf16*)(ws + WS_WIN) + (size_t)L * A_PROJ * DM; P.S.init(NT / 256, A_PROJ / 256, F.G, (int)blockIdx.x); E.O = BIG; E.ldc = A_PROJ; E.nscale = 2; E.scale = 0.125f; E.sig_from = 8; }
            else if (kind == 1) { P.Bt = (const bf16*)(ws + WS_WKV); P.S.init(NT / 256, 8, F.G, (int)blockIdx.x); E.O = Kb; E.ldc = DM; E.split_cols = 1024; E.split_stride = (size_t)NT * DM; }
            else { P.Bt = (const bf16*)(ws + WS_WQ) + (size_t)(L - 2) * DM * DM; P.S.init(NT / 256, 4, F.G, (int)blockIdx.x); E.O = Qb; E.ldc = DM; E.nscale = 4; E.scale = attn_body::C2; }
            pg8::gemm_phase<EpiProj, DenseProb, true>(F.lds + RING_OFF, P, E);
#endif
          } PH_END(run); }
        if (kind == 1) continue;
        { PH_BEGIN(run) if (run) {
#ifndef DIS_CELL
            if (kind == 0) cell_phase(F, BIG, G16, args.in[I_AMH] + L * DM, HB);
#endif
#ifndef DIS_ATTN
            if (kind == 2) { const attn_body::AttnTensors AT{(const attn_body::bf16*)Qb, (const attn_body::bf16*)Kb, (const attn_body::bf16*)Vb, (attn_body::bf16*)Qb, FB};
                   attn_body::attn_phase<8>((char*)lds + RING_OFF, AT, F.vcu, F.G); }
#endif
          } PH_END(run); }
        { PH_BEGIN(run) if (run) {
#ifndef DIS_OUT
            DenseProb P; P.A = kind == 0 ? HB : Qb; P.lda = DM; P.ldb = DM; P.K = DM;
            P.Bt = kind == 0 ? (const bf16*)(ws + WS_WOUT) + (size_t)L * DM * DM : (const bf16*)(ws + WS_WO) + (size_t)(L - 2) * DM * DM;
            P.S.init(NT / 256, 4, F.G, (int)blockIdx.x);
            EpiRes E; E.base = xin; E.out = X; E.gate = mods + 2048; E.gstride = 6144;
            pg8::gemm_phase<EpiRes, DenseProb, true>(F.lds + RING_OFF, P, E);
#endif
          } PH_END(run); }
        gu32* const gcnt = (gu32*)(ws + WS_CTL) + CW_CNT + L * 32;
        { PH_BEGIN(run) if (run) {
#ifndef DIS_NORM2
            norm_phase<true>(F, X, args.in[I_NFFN] + L * DM, mods + 3072, mods + 4096, 6144, HB, 3, args.in[I_WR], 16, args.in[I_RB], nullptr, WTS, PERM, gcnt);
#endif
          } PH_END(run); }
        const ClassTab CT{(const LAS int*)(F.lds + TAB_OFF), (const LAS int*)(F.lds + TAB_OFF) + 32};
        { PH_BEGIN(run) if (run) {
#ifndef DIS_MOE1
            build_class_tab(F, gcnt);
            Moe1Prob P; P.A = HB; P.ldb = DM; P.K = DM; P.Bt1l = (const bf16*)(ws + WS_BT1) + (size_t)L * 16 * 1024 * DM; P.perm = PERM; P.T = CT;
            P.S.init(CT.blkstart[NCLS], 8, F.G, (int)blockIdx.x);
            EpiAct E; E.act = ACT; E.perm = PERM; E.wts = WTS; E.T = CT;
            pg8::gemm_phase<EpiAct, Moe1Prob, true>(F.lds + RING_OFF, P, E);
#endif
          } PH_END(run); }
        { PH_BEGIN(run) if (run) {
#ifndef DIS_MOE2
            build_class_tab(F, gcnt);
            Moe2Prob P; P.A = ACT; P.ldb = DE; P.K = DM; P.Bt2l = (const bf16*)(ws + WS_BT2) + (size_t)L * 16 * DM * DE; P.T = CT;
            P.S.init(CT.blkstart[NCLS], 4, F.G, (int)blockIdx.x);
            EpiResScatter E; E.x = X; E.gate = mods + 5120; E.gstride = 6144; E.perm = PERM; E.T = CT;
            pg8::gemm_phase<EpiResScatter, Moe2Prob, true>(F.lds + RING_OFF, P, E);
#endif
          } PH_END(run); }
    }
    { PH_BEGIN(run) if (run) {
#ifndef DIS_FINAL
 final_norm_phase(F, X, args.in[I_NFIN], (const float*)(args.ws + WS_FIN), (const float*)(args.ws + WS_FIN) + 1024, 2048);
#endif
 } }
#undef PH_BEGIN
#undef PH_END
}
constexpr int N_PHASES = 1 + 2 * 7 + 2 + 2 * 7 + 1;

#ifndef MK_SPLIT
#define MK_SPLIT 1
#endif
extern "C" void kernel_launch(void* const* d_in, const int* in_sizes, int n_in, void* d_out, int out_size, void* d_ws, size_t ws_size, hipStream_t stream) {
    static int grid = 0;
    if (grid == 0) {
        if (n_in != 25 || in_sizes[0] != NT * DM || out_size != NT * DM || ws_size < WS_END) { fprintf(stderr, "kernel_launch: unexpected shapes (n_in %d, in0 %d, out %d, ws %zu); nothing launched\n", n_in, n_in > 0 ? in_sizes[0] : -1, out_size, ws_size); grid = -1; return; }
        int dev = 0, cus = 0, per_cu = 0;
        if (hipGetDevice(&dev) != hipSuccess || hipDeviceGetAttribute(&cus, hipDeviceAttributeMultiprocessorCount, dev) != hipSuccess) { grid = -1; return; }
        if (hipFuncSetAttribute((const void*)mk_fwd, hipFuncAttributeMaxDynamicSharedMemorySize, LDS_BYTES) != hipSuccess) { fprintf(stderr, "kernel_launch: hipFuncSetAttribute failed\n"); grid = -1; return; }
        if (hipOccupancyMaxActiveBlocksPerMultiprocessor(&per_cu, (const void*)mk_fwd, NWAVES * 64, LDS_BYTES) != hipSuccess || per_cu < 1) { fprintf(stderr, "kernel_launch: occupancy query reports %d workgroups per CU\n", per_cu); }
        (void)hipGetLastError();
        grid = cus;
    }
    if (grid < 0) return;
    if (hipMemsetAsync((char*)d_ws + WS_CTL, 0, CTL_ZERO_BYTES, stream) != hipSuccess) return;
    Args a{};
    for (int i = 0; i < 25; ++i) a.in[i] = (const float*)d_in[i];
    a.out = (float*)d_out; a.ws = (unsigned char*)d_ws;
#if MK_SPLIT
    for (int p = 0; p < N_PHASES; ++p) { a.ph_lo = p; a.ph_hi = p + 1; hipLaunchKernelGGL(mk_fwd, dim3(grid), dim3(NWAVES * 64), LDS_BYTES, stream, a); }
#else
    a.ph_lo = 0; a.ph_hi = N_PHASES;
    hipLaunchKernelGGL(mk_fwd, dim3(grid), dim3(NWAVES * 64), LDS_BYTES, stream, a);
#endif
}
```

```cpp
#include <hip/hip_runtime.h>
#include <hip/hip_bf16.h>
#include <cstdio>
#include <cstdint>
#define LAS __attribute__((address_space(3)))
#define GAS __attribute__((address_space(1)))

namespace pg8 {
typedef unsigned short bf16_t;
typedef short bf16x8 __attribute__((ext_vector_type(8)));
typedef float f32x4 __attribute__((ext_vector_type(4)));
typedef unsigned u32x4 __attribute__((ext_vector_type(4)));
typedef unsigned u32x2 __attribute__((ext_vector_type(2)));
constexpr int BM = 256, BK = 64, HALF = 128, HTB = HALF * BK * 2  , STAGE_BYTES = 8 * HTB, NXCD = 8, WGM = 8;

__host__ __device__ __forceinline__ int lds_byte(int r, int c) { const int st = (r >> 4) * 2 + (c >> 5), rr = r & 15, cc = c & 31, ob = rr * 64 + cc * 2; return st * 1024 + (ob ^ (((ob >> 9) & 1) << 5)); }
__host__ __device__ __forceinline__ void stage_rc(int b, int& R, int& C) { const int st = b / 1024, sb = b % 1024, swz = sb ^ (((sb >> 9) & 1) << 5); R = (st >> 1) * 16 + swz / 64; C = (st & 1) * 32 + (swz % 64) / 2; }
__host__ __device__ __forceinline__ int perm32(int rho) { const int n = rho >> 4, i = rho & 15; return 8 * (i >> 2) + 4 * n + (i & 3); }

struct Unit { int pm, pn, cls, lb; };

struct StaticOrder {
    int nM, nN, nwg, G, c;
    __device__ __forceinline__ void init(int nM_, int nN_, int G_, int c_) { nM = nM_; nN = nN_; nwg = nM * nN; G = G_; c = c_; }
    __device__ __forceinline__ bool next(int i, Unit& u) const {
        const long L = (long)i * G + c; if (L >= nwg) return false;
        int wgid = (int)L; { const int q = nwg / NXCD, r = nwg % NXCD, xcd = wgid % NXCD, off = wgid / NXCD; wgid = (xcd < r ? xcd * (q + 1) : r * (q + 1) + (xcd - r) * q) + off; }
        const int nig = WGM * nN, gid = wgid / nig, fm = gid * WGM, gsz = (nM - fm) < WGM ? (nM - fm) : WGM;
        u.pm = fm + ((wgid % nig) % gsz); u.pn = (wgid % nig) / gsz; u.cls = 0; u.lb = 0; return true;
    }
};

__device__ __forceinline__ unsigned cvt_pk_bf16(float lo, float hi) { unsigned r; asm volatile("v_cvt_pk_bf16_f32 %0, %1, %2" : "=v"(r) : "v"(lo), "v"(hi)); return r; }
__device__ __forceinline__ float sigmoidf_(float x) { return __builtin_amdgcn_rcpf(1.0f + __expf(-x)); }

template <class Epi, class Prob, bool ALIGN_EPI>
__device__ __forceinline__ void gemm_phase(LAS unsigned char* lds, const Prob& S, const Epi& E) {
    int tid_ = threadIdx.x; asm volatile("" : "+v"(tid_));
    const int tid = tid_, wid = __builtin_amdgcn_readfirstlane(tid >> 6), lane = tid & 63, wr = wid >> 2, wc = wid & 3, fr = lane & 15, fq = lane >> 4;
    const int K = S.K, nt = K / BK;
    int R0, C0; stage_rc(tid * 16, R0, C0);
    const int Rb0 = Epi::PERM ? ((R0 & ~31) + perm32(R0 & 31)) : R0;
    unsigned voffB[2]; voffB[0] = (unsigned)(Rb0 * S.ldb + C0) * 2u; voffB[1] = (unsigned)((Rb0 + 64) * S.ldb + C0) * 2u;
    const size_t hstepB = (size_t)HALF * S.ldb * 2;
    const unsigned ldsw = (unsigned)wid * 1024u;
    const int aoff_l = lds_byte(wr * 64 + fr, fq * 8), boff_l = lds_byte(wc * 32 + fr, fq * 8);
    const char* const Ab = S.a_base();
#define PG8_SA(b, h) (((b) * 2 + (h)) * HTB)
#define PG8_SB(b, h) ((4 + (b) * 2 + (h)) * HTB)
#define PG8_STA(bufoff, h, tt) do { _Pragma("unroll") for (int _i = 0; _i < 2; ++_i) \
        __builtin_amdgcn_global_load_lds((const unsigned*)(Ab + (size_t)aoff[h][_i] + (size_t)(tt) * (BK * 2)), (LAS unsigned*)(lds + (bufoff) + ldsw + _i * 8192), 16, 0, 0); } while (0)
#define PG8_STB(bufoff, bp, h) do { _Pragma("unroll") for (int _i = 0; _i < 2; ++_i) \
        __builtin_amdgcn_global_load_lds((const unsigned*)((bp) + (h) * hstepB + voffB[_i]), (LAS unsigned*)(lds + (bufoff) + ldsw + _i * 8192), 16, 0, 0); } while (0)
#define PG8_LDA(dst, b, h) do { _Pragma("unroll") for (int m = 0; m < 4; ++m) _Pragma("unroll") for (int k = 0; k < 2; ++k) dst[m][k] = *(const LAS bf16x8*)(lds + PG8_SA(b, h) + aoff_l + m * 2048 + k * 1024); } while (0)
#define PG8_LDB(dst, b, h) do { _Pragma("unroll") for (int n = 0; n < 2; ++n) _Pragma("unroll") for (int k = 0; k < 2; ++k) dst[n][k] = *(const LAS bf16x8*)(lds + PG8_SB(b, h) + boff_l + n * 2048 + k * 1024); } while (0)
#define PG8_MMA(ai, bj, At, Bt) do { __builtin_amdgcn_s_setprio(1); _Pragma("unroll") for (int m = 0; m < 4; ++m) _Pragma("unroll") for (int n = 0; n < 2; ++n) _Pragma("unroll") for (int k = 0; k < 2; ++k) \
        acc[ai][bj][m][n] = __builtin_amdgcn_mfma_f32_16x16x32_bf16(Bt[n][k], At[m][k], acc[ai][bj][m][n], 0, 0, 0); __builtin_amdgcn_s_setprio(0); } while (0)
#define PG8_WAIT_V(n) asm volatile("s_waitcnt vmcnt(" #n ")" ::: "memory")
#define PG8_WAIT_L(n) asm volatile("s_waitcnt lgkmcnt(" #n ")" ::: "memory")
#define PG8_BAR __builtin_amdgcn_s_barrier()
#define PG8_SCHED __builtin_amdgcn_sched_barrier(0)
    Unit cur, nxt; int ui = 0;
    if (!S.next(0, cur)) return;
    f32x4 acc[2][2][4][2];
#pragma unroll
    for (int a = 0; a < 2; ++a)
#pragma unroll
        for (int b = 0; b < 2; ++b)
#pragma unroll
            for (int m = 0; m < 4; ++m)
#pragma unroll
                for (int n = 0; n < 2; ++n) acc[a][b][m][n] = (f32x4){0.f, 0.f, 0.f, 0.f};
    bf16x8 At[4][2], B0[2][2], B1[2][2];
    unsigned aoff[2][2], aoffN[2][2];
    S.a_off(cur, R0, C0, aoff);
    { const char* bp0 = S.b_tile(cur, 0); const char* bp1 = S.b_tile(cur, 1);
      PG8_STB(PG8_SB(0, 0), bp0, 0); PG8_STB(PG8_SB(0, 1), bp0, 1); PG8_STA(PG8_SA(0, 0), 0, 0); PG8_STA(PG8_SA(0, 1), 1, 0);
      if (wr == 1) PG8_BAR;
      PG8_WAIT_V(2); PG8_BAR;
      PG8_STB(PG8_SB(1, 0), bp1, 0); PG8_STA(PG8_SA(1, 0), 0, 1); PG8_STB(PG8_SB(1, 1), bp1, 1);
      PG8_WAIT_V(6); PG8_BAR; }
    for (;;) {
        const bool has_next = S.next(ui + 1, nxt);
        for (int t = 0; t < nt; t += 2) {
            const bool last = (t == nt - 2);
            if (last) { if (has_next) S.a_off(nxt, R0, C0, aoffN); else { aoffN[0][0] = aoff[0][0]; aoffN[0][1] = aoff[0][1]; aoffN[1][0] = aoff[1][0]; aoffN[1][1] = aoff[1][1]; } }
            PG8_LDB(B0, 0, 0); PG8_LDB(B1, 0, 1); PG8_SCHED; PG8_LDA(At, 0, 0); PG8_STA(PG8_SA(1, 1), 1, t + 1);
            PG8_WAIT_V(8); PG8_WAIT_L(0); PG8_BAR; PG8_MMA(0, 0, At, B0); PG8_MMA(0, 1, At, B1); PG8_BAR; PG8_SCHED;
            const int t2 = last ? 0 : t + 2;
            const Unit& u2 = (last && has_next) ? nxt : cur;
            if (last) { aoff[0][0] = aoffN[0][0]; aoff[0][1] = aoffN[0][1]; aoff[1][0] = aoffN[1][0]; aoff[1][1] = aoffN[1][1]; }
            const char* b2 = S.b_tile(u2, t2); const char* b3 = S.b_tile(u2, t2 + 1);
            PG8_LDA(At, 0, 1); PG8_STB(PG8_SB(0, 0), b2, 0); PG8_STB(PG8_SB(0, 1), b2, 1); PG8_STA(PG8_SA(0, 0), 0, t2);
            PG8_WAIT_V(8); PG8_WAIT_L(0); PG8_BAR; PG8_MMA(1, 0, At, B0); PG8_MMA(1, 1, At, B1); PG8_BAR; PG8_SCHED;
            PG8_LDB(B0, 1, 0); PG8_LDB(B1, 1, 1); PG8_SCHED; PG8_LDA(At, 1, 0); PG8_STA(PG8_SA(0, 1), 1, t2);
            PG8_WAIT_V(8); PG8_WAIT_L(0); PG8_BAR; PG8_MMA(0, 0, At, B0); PG8_MMA(0, 1, At, B1); PG8_BAR; PG8_SCHED;
            PG8_LDA(At, 1, 1); PG8_STB(PG8_SB(1, 0), b3, 0); PG8_STB(PG8_SB(1, 1), b3, 1); PG8_STA(PG8_SA(1, 0), 0, t2 + 1);
            PG8_WAIT_V(8); PG8_WAIT_L(0); PG8_BAR; PG8_MMA(1, 0, At, B0); PG8_MMA(1, 1, At, B1); PG8_BAR; PG8_SCHED;
        }
        if constexpr (ALIGN_EPI) { if (wr == 0) PG8_BAR; }
        E(acc, cur, wr, wc, fr, fq);
        if (!has_next) break;
#pragma unroll
        for (int a = 0; a < 2; ++a)
#pragma unroll
            for (int b = 0; b < 2; ++b)
#pragma unroll
                for (int m = 0; m < 4; ++m)
#pragma unroll
                    for (int n = 0; n < 2; ++n) acc[a][b][m][n] = (f32x4){0.f, 0.f, 0.f, 0.f};
        cur = nxt; ++ui;
        if constexpr (ALIGN_EPI) { if (wr == 1) PG8_BAR; }
    }
    PG8_WAIT_V(0);
    if constexpr (!ALIGN_EPI) { if (wr == 0) PG8_BAR; }
    PG8_BAR;
#undef PG8_SA
#undef PG8_SB
#undef PG8_STA
#undef PG8_STB
#undef PG8_LDA
#undef PG8_LDB
#undef PG8_MMA
#undef PG8_WAIT_V
#undef PG8_WAIT_L
#undef PG8_BAR
#undef PG8_SCHED
}
}

#include <hip/hip_bf16.h>
#include <cmath>
namespace attn_body {
using bf16=__hip_bfloat16;
using bf16x8=__attribute__((ext_vector_type(8)))short;
using s16x4=__attribute__((ext_vector_type(4)))short;
using f32x16=__attribute__((ext_vector_type(16)))float;
using u32x4=__attribute__((ext_vector_type(4)))unsigned;
constexpr int BATCH=16,NHEAD=16,SEQ=4096,D=64,DM=NHEAD*D;
constexpr int NW=8,QBLK=32,QB=QBLK*NW,KVBLK=64,NQB=SEQ/QB;
constexpr int ATTN_PITCH=DM, ATTN_UNIT_ROWS=QB;
__device__ __forceinline__ int crow(int r,int hi){return (r&3)+8*(r>>2)+4*hi;}
#define SBAR() __builtin_amdgcn_sched_barrier(0)
__device__ __forceinline__ void cmask(f32x16&p0,f32x16&p1,int jb,int qrel,int hi){
  const float NEG=-INFINITY; int kb=64*jb+4*hi;
  #pragma unroll
  for(int r=0;r<16;++r){int kv=kb+(r&3)+8*(r>>2); if(kv>qrel)p0[r]=NEG; if(kv+32>qrel)p1[r]=NEG;}
}

constexpr int NSLOT=3, SLOTB=8192;
constexpr int LDS_K=0, LDS_V=NSLOT*SLOTB, LDS_WS=2*NSLOT*SLOTB, LDS_OST=LDS_WS+NW*64*4, LDS_BYTES=LDS_OST+NW*4096;
constexpr float C2=0.125f*1.4426950408889634f;
__device__ __forceinline__ void glds16(const void*gsrc,unsigned lds_dst){unsigned keep;
  asm volatile("s_mov_b32 %0, m0\n\ts_mov_b32 m0, %2\n\ts_nop 0\n\tglobal_load_lds_dwordx4 %1, off\n\ts_mov_b32 m0, %0":"=&s"(keep):"v"(gsrc),"s"(lds_dst):"memory");}
__device__ __forceinline__ float max3f(float a,float b,float c){float r;asm("v_max3_f32 %0, %1, %2, %3":"=v"(r):"v"(a),"v"(b),"v"(c));return r;}
__device__ __forceinline__ float max2f(float a,float b){float r;asm("v_max_f32_e32 %0, %1, %2":"=v"(r):"v"(a),"v"(b));return r;}
__device__ __forceinline__ float fadd_s(float a,float b){float r;asm("v_add_f32_e32 %0, %1, %2":"=v"(r):"v"(a),"v"(b));return r;}
__device__ __forceinline__ float fsub_s(float a,float b){float r;asm("v_sub_f32_e32 %0, %1, %2":"=v"(r):"v"(a),"v"(b));return r;}
typedef float f32x2_t __attribute__((ext_vector_type(2))); typedef __bf16 bf16x2_t __attribute__((ext_vector_type(2)));
__device__ __forceinline__ unsigned cvtpk_s(float lo,float hi){f32x2_t v={lo,hi};bf16x2_t b=__builtin_convertvector(v,bf16x2_t);return __builtin_bit_cast(unsigned,b);}
#define WAIT_BAR(N) asm volatile("s_waitcnt vmcnt(" #N ") lgkmcnt(0)\n\ts_barrier":::"memory")

__device__ __forceinline__ void qkt(f32x16&p0,f32x16&p1,const char*Kslot,const bf16x8*qr,const f32x16&c0,const f32x16&c1,int r32,int hi){
  const char*kb=Kslot+hi*1024+r32*16;
  #pragma unroll
  for(int d0=0;d0<4;++d0){
    const bf16x8 b0=*reinterpret_cast<const bf16x8*>(kb+d0*2048);
    const bf16x8 b1=*reinterpret_cast<const bf16x8*>(kb+d0*2048+512);
    if(d0==0){p0=__builtin_amdgcn_mfma_f32_32x32x16_bf16(b0,qr[0],c0,0,0,0);p1=__builtin_amdgcn_mfma_f32_32x32x16_bf16(b1,qr[0],c1,0,0,0);}
    else{p0=__builtin_amdgcn_mfma_f32_32x32x16_bf16(b0,qr[d0],p0,0,0,0);p1=__builtin_amdgcn_mfma_f32_32x32x16_bf16(b1,qr[d0],p1,0,0,0);}}
}
typedef __attribute__((address_space(3))) const char* lds_cptr;
typedef short v4i16_t __attribute__((ext_vector_type(4)));
__device__ __forceinline__ void kload8(bf16x8*kf,lds_cptr kp){
  kf[0]=*(const __attribute__((address_space(3))) bf16x8*)(kp);      kf[1]=*(const __attribute__((address_space(3))) bf16x8*)(kp+512);
  kf[2]=*(const __attribute__((address_space(3))) bf16x8*)(kp+2048); kf[3]=*(const __attribute__((address_space(3))) bf16x8*)(kp+2560);
  kf[4]=*(const __attribute__((address_space(3))) bf16x8*)(kp+4096); kf[5]=*(const __attribute__((address_space(3))) bf16x8*)(kp+4608);
  kf[6]=*(const __attribute__((address_space(3))) bf16x8*)(kp+6144); kf[7]=*(const __attribute__((address_space(3))) bf16x8*)(kp+6656);
}
__device__ __forceinline__ void kload2(bf16x8*kf,lds_cptr kp,int j){ kf[2*j]=*(const __attribute__((address_space(3))) bf16x8*)(kp+j*2048); kf[2*j+1]=*(const __attribute__((address_space(3))) bf16x8*)(kp+j*2048+512); }
__device__ __forceinline__ s16x4 vtr(lds_cptr p){ return __builtin_bit_cast(s16x4,__builtin_amdgcn_ds_read_tr16_b64_v4i16((__attribute__((address_space(3))) v4i16_t*)p)); }
__device__ __forceinline__ float rowmax(const f32x16&p0,const f32x16&p1){
  float a=max3f(p0[0],p0[1],p1[0]),b=max3f(p0[2],p0[3],p1[1]);a=max3f(a,p1[2],p1[3]);
  #pragma unroll
  for(int r=4;r<16;r+=4){a=max3f(a,p0[r],p0[r+1]);b=max3f(b,p0[r+2],p0[r+3]);a=max3f(a,p1[r],p1[r+1]);b=max3f(b,p1[r+2],p1[r+3]);}
  const float m=max2f(a,b);
  auto rr=__builtin_amdgcn_permlane32_swap(__float_as_uint(m),__float_as_uint(m),false,false);
  return max2f(__uint_as_float(rr[0]),__uint_as_float(rr[1]));
}
__device__ __forceinline__ void pv(f32x16*o,int vb,bf16x8 pa0,bf16x8 pa1,bf16x8 pa2,bf16x8 pa3){
  #pragma unroll
  for(int d0=0;d0<2;++d0){s16x4 lo[4],hi[4];
    #pragma unroll
    for(int ks=0;ks<4;++ks){
      asm volatile("ds_read_b64_tr_b16 %0,%1 offset:%c2":"=&v"(lo[ks]):"v"(vb),"i"(d0*4096+ks*1024):"memory");
      asm volatile("ds_read_b64_tr_b16 %0,%1 offset:%c2":"=&v"(hi[ks]):"v"(vb),"i"(d0*4096+ks*1024+512):"memory");}
    asm volatile("s_waitcnt lgkmcnt(0)":::"memory");SBAR();
    #define PK(k) (bf16x8){lo[k][0],lo[k][1],lo[k][2],lo[k][3],hi[k][0],hi[k][1],hi[k][2],hi[k][3]}
    o[d0]=__builtin_amdgcn_mfma_f32_32x32x16_bf16(pa0,PK(0),o[d0],0,0,0);
    o[d0]=__builtin_amdgcn_mfma_f32_32x32x16_bf16(pa1,PK(1),o[d0],0,0,0);
    o[d0]=__builtin_amdgcn_mfma_f32_32x32x16_bf16(pa2,PK(2),o[d0],0,0,0);
    o[d0]=__builtin_amdgcn_mfma_f32_32x32x16_bf16(pa3,PK(3),o[d0],0,0,0);
    #undef PK
  }
}

#ifndef ATTN_STORE16
#define ATTN_STORE16(p,v) (*(u32x4*)(p)=(v))
#endif
typedef float f32x4_t __attribute__((ext_vector_type(4)));
typedef __attribute__((address_space(3))) const float* fb_lptr;
template<int THRL> __device__ __forceinline__ void attn_unit(int b,int h,int qb,const bf16*Q,const bf16*__restrict__ K,const bf16*__restrict__ V,bf16*O,char*shm,fb_lptr fbl){
  int tid_=threadIdx.x; asm volatile("":"+v"(tid_)); const int tid=tid_,lane=tid&63,r32=lane&31,hi=lane>>5; const int wid=__builtin_amdgcn_readfirstlane(tid>>6);
  const long rowbase=(long)b*SEQ; const int q0=qb*QB;
  const bf16*Qw=Q+(rowbase+q0+wid*QBLK)*DM+h*D;
  const bf16*Kh=K+rowbase*DM+h*D,*Vh=V+rowbase*DM+h*D;
  const unsigned lds0=(unsigned)(uintptr_t)shm;
  float*wsf=(float*)(shm+LDS_WS)+wid*64;
  const bf16*ksrc=Kh+(long)lane*DM+wid*8;
  const bf16*vsrc=Vh+(long)(16*(wid&3)+(lane>>2))*DM+(wid>>2)*32+(lane&3)*8;
  const unsigned kdst=lds0+LDS_K+wid*1024, vdst=lds0+LDS_V+wid*1024;
  #define DMA_K(t,slot) glds16(ksrc+(long)(t)*KVBLK*DM,(unsigned)__builtin_amdgcn_readfirstlane(kdst+(slot)))
  #define DMA_V(t,slot) glds16(vsrc+(long)(t)*KVBLK*DM,(unsigned)__builtin_amdgcn_readfirstlane(vdst+(slot)))
  const int vb0=(int)(lds0+LDS_V)+((lane>>4)&1)*32+(lane&3)*8+(4*hi+((lane&15)>>2))*64;
  const char*Kbase=shm+LDS_K; bf16x8 kf[8];
  const lds_cptr shm3=(lds_cptr)shm; const lds_cptr kp0=shm3+LDS_K+hi*1024+r32*16; const lds_cptr vp0=shm3+LDS_V+((lane>>4)&1)*32+(lane&3)*8+(4*hi+((lane&15)>>2))*64;
  const int NT=(q0+QB)/KVBLK;
  DMA_K(0,0);DMA_V(0,0);DMA_K(1,SLOTB);
  bf16x8 qr[4];
  #pragma unroll
  for(int d0=0;d0<4;++d0)qr[d0]=*reinterpret_cast<const bf16x8*>(&Qw[(long)r32*DM+d0*16+hi*8]);
  #define FBIAS(C0,C1,t) do{ const fb_lptr fp_=fbl+64*(t)+4*hi; const float nm_=-mhat; \
    _Pragma("unroll") for(int g_=0;g_<4;++g_){ const f32x4_t a_=*(const __attribute__((address_space(3))) f32x4_t*)(fp_+8*g_); const f32x4_t b_=*(const __attribute__((address_space(3))) f32x4_t*)(fp_+32+8*g_); \
      _Pragma("unroll") for(int i_=0;i_<4;++i_){ C0[4*g_+i_]=a_[i_]+nm_; C1[4*g_+i_]=b_[i_]+nm_; } SBAR(); } }while(0)
  float mhat=0.f,l_reg=0.f;f32x16 o[2];o[0]=f32x16{};o[1]=f32x16{};
  const int qrel=wid*QBLK+r32;
  #define CMASK(P0,P1,t) do{int jb_=(t)-(NT-4); if(jb_>=0)cmask(P0,P1,jb_,qrel,hi);}while(0)
  bool resc=false;
  #define START(P0,P1) do{ const float rm=rowmax(P0,P1); resc=false; \
    { const float dl=rm; mhat=fadd_s(mhat,dl); \
      _Pragma("unroll") for(int r=0;r<16;++r){P0[r]=fsub_s(P0[r],dl);P1[r]=fsub_s(P1[r],dl);} \
      } \
    _Pragma("unroll") for(int r=0;r<16;++r)P0[r]=__builtin_amdgcn_exp2f(P0[r]); }while(0)
  #define RESC() do{ if(resc){ asm volatile("s_waitcnt lgkmcnt(0)":::"memory"); \
      _Pragma("unroll") for(int d_=0;d_<2;++d_) _Pragma("unroll") for(int r=0;r<16;++r)o[d_][r]*=wsf[crow(r,hi)]; } }while(0)
  f32x16 pA0,pA1,pB0,pB1;
  int sl_prev=0,sl_cur=0,sl_next=SLOTB;
  #define ROT() do{sl_prev=sl_cur;sl_cur=sl_next;sl_next=(sl_next==(NSLOT-1)*SLOTB)?0:sl_next+SLOTB;}while(0)
  DMA_K(2,2*SLOTB);
  WAIT_BAR(3);
  FBIAS(pA0,pA1,0); qkt(pA0,pA1,Kbase,qr,pA0,pA1,r32,hi);asm volatile("s_nop 15\n\ts_nop 7":"+v"(pA0),"+v"(pA1));CMASK(pA0,pA1,0);
  START(pA0,pA1);
  _Pragma("unroll") for(int r=0;r<16;++r)pA1[r]=__builtin_amdgcn_exp2f(pA1[r]);
  WAIT_BAR(0);
  DMA_K(3,0);DMA_V(1,SLOTB);
  ROT();
  kload8(kf,kp0+sl_cur);
  WAIT_BAR(2);
  s16x4 vlo[8],vhi[8]; u32x4 pw0,pw1,pw2,pw3;
  #define PKW(P,B) cvtpk_s(P[B],P[B+1])
  #define PAF(k) __builtin_bit_cast(bf16x8,pw##k)
  #define VFR(i) (bf16x8){vlo[i][0],vlo[i][1],vlo[i][2],vlo[i][3],vhi[i][0],vhi[i][1],vhi[i][2],vhi[i][3]}
  #define PIN(x) asm volatile("":"+v"(x))
  #define MX3(a,b,c) __builtin_fmaxf(__builtin_fmaxf((a),(b)),(c))
  #define GAPA(MF,A0,A1,A2,A3,W0,W1,PW) do{ MF; sacc+=A0; sacc+=A1; sacc+=A2; sacc+=A3; PIN(sacc); W0; W1; PIN(PW); SBAR(); }while(0)
  #define EX(v) __builtin_amdgcn_exp2f(v)
  #define GAPB(MF,X,B) do{ MF; X[B]=EX(X[B]); X[B+1]=EX(X[B+1]); X[B+2]=EX(X[B+2]); X[B+3]=EX(X[B+3]); PIN(X); SBAR(); }while(0)
  #define VRD(i) do{ vlo[i]=vtr(vp_+(((i)>>2)*4096+((i)&3)*1024)); vhi[i]=vtr(vp_+(((i)>>2)*4096+((i)&3)*1024+512)); }while(0)
  #define KRD(G,j) do{ if(G){ kload2(kf,kp0+sl_next,j); SBAR(); } }while(0)
  #define STEP(C0,C1,P0,P1,t,GK,GV,GL) do{ SBAR(); FBIAS(C0,C1,t); SBAR(); \
    const lds_cptr vp_=vp0+sl_prev; \
    VRD(0); SBAR(); float sacc=(P0[0]+P0[1]); \
    GAPA(C0=__builtin_amdgcn_mfma_f32_32x32x16_bf16(kf[0],qr[0],C0,0,0,0), P0[2],P0[3],P0[4],P0[5],     pw0[0]=PKW(P0,0), pw0[1]=PKW(P0,2), pw0); \
    VRD(4); SBAR(); GAPA(C1=__builtin_amdgcn_mfma_f32_32x32x16_bf16(kf[1],qr[0],C1,0,0,0), P0[6],P0[7],P0[8],P0[9],     pw0[2]=PKW(P0,4), pw0[3]=PKW(P0,6), pw0); \
    VRD(1); SBAR(); GAPA(C0=__builtin_amdgcn_mfma_f32_32x32x16_bf16(kf[2],qr[1],C0,0,0,0),   P0[10],P0[11],P0[12],P0[13], pw1[0]=PKW(P0,8), pw1[1]=PKW(P0,10), pw1); \
    VRD(5); SBAR(); GAPA(C1=__builtin_amdgcn_mfma_f32_32x32x16_bf16(kf[3],qr[1],C1,0,0,0),   P0[14],P0[15],P1[0],P1[1],   pw1[2]=PKW(P0,12),pw1[3]=PKW(P0,14), pw1); \
    VRD(2); SBAR(); GAPA(C0=__builtin_amdgcn_mfma_f32_32x32x16_bf16(kf[4],qr[2],C0,0,0,0),   P1[2],P1[3],P1[4],P1[5],     pw2[0]=PKW(P1,0), pw2[1]=PKW(P1,2), pw2); \
    VRD(6); SBAR(); GAPA(C1=__builtin_amdgcn_mfma_f32_32x32x16_bf16(kf[5],qr[2],C1,0,0,0),   P1[6],P1[7],P1[8],P1[9],     pw2[2]=PKW(P1,4), pw2[3]=PKW(P1,6), pw2); \
    VRD(3); SBAR(); GAPA(C0=__builtin_amdgcn_mfma_f32_32x32x16_bf16(kf[6],qr[3],C0,0,0,0),   P1[10],P1[11],P1[12],P1[13], pw3[0]=PKW(P1,8), pw3[1]=PKW(P1,10), pw3); \
    VRD(7); SBAR(); GAPA(C1=__builtin_amdgcn_mfma_f32_32x32x16_bf16(kf[7],qr[3],C1,0,0,0),   P1[14],P1[15],0.f,0.f,       pw3[2]=PKW(P1,12),pw3[3]=PKW(P1,14), pw3); \
    l_reg+=sacc; \
    if(GK){DMA_K((t)+3,sl_cur);} if(GV){DMA_V((t)+1,sl_next);} \
    CMASK(C0,C1,t); \
    { float a=MX3(C0[0],C0[1],C1[0]),b=MX3(C0[2],C0[3],C1[1]); a=MX3(a,C1[2],C1[3]); \
      _Pragma("unroll") for(int r=4;r<16;r+=4){a=MX3(a,C0[r],C0[r+1]);b=MX3(b,C0[r+2],C0[r+3]);a=MX3(a,C1[r],C1[r+1]);b=MX3(b,C1[r+2],C1[r+3]);} \
      float rm=__builtin_fmaxf(a,b); { auto rr=__builtin_amdgcn_permlane32_swap(__float_as_uint(rm),__float_as_uint(rm),false,false); rm=__builtin_fmaxf(__uint_as_float(rr[0]),__uint_as_float(rr[1])); } \
      resc=false; \
      if(__builtin_expect(__any(rm>(float)THRL),0)){ const float dl=__builtin_fmaxf(rm,0.f); mhat+=dl; \
        _Pragma("unroll") for(int r=0;r<16;++r){C0[r]-=dl;C1[r]-=dl;} \
        const float f=__builtin_amdgcn_exp2f(-dl); l_reg*=f; if(hi==0)wsf[r32]=f; resc=true; } } \
    SBAR(); \
    GAPB(o[0]=__builtin_amdgcn_mfma_f32_32x32x16_bf16(PAF(0),VFR(0),o[0],0,0,0), C0,0); \
    GAPB(o[1]=__builtin_amdgcn_mfma_f32_32x32x16_bf16(PAF(0),VFR(4),o[1],0,0,0), C0,4); \
    KRD(GL,0); GAPB(o[0]=__builtin_amdgcn_mfma_f32_32x32x16_bf16(PAF(1),VFR(1),o[0],0,0,0), C0,8); \
    KRD(GL,1); GAPB(o[1]=__builtin_amdgcn_mfma_f32_32x32x16_bf16(PAF(1),VFR(5),o[1],0,0,0), C0,12); \
    KRD(GL,2); GAPB(o[0]=__builtin_amdgcn_mfma_f32_32x32x16_bf16(PAF(2),VFR(2),o[0],0,0,0), C1,0); \
    KRD(GL,3); GAPB(o[1]=__builtin_amdgcn_mfma_f32_32x32x16_bf16(PAF(2),VFR(6),o[1],0,0,0), C1,4); \
    GAPB(o[0]=__builtin_amdgcn_mfma_f32_32x32x16_bf16(PAF(3),VFR(3),o[0],0,0,0), C1,8); \
    GAPB(o[1]=__builtin_amdgcn_mfma_f32_32x32x16_bf16(PAF(3),VFR(7),o[1],0,0,0), C1,12); \
    }while(0)
  int t=1;
  #undef CMASK
  #define CMASK(P0,P1,t) do{}while(0)
  for(;t+5<NT;t+=2){
    STEP(pB0,pB1,pA0,pA1,t,true,true,true);     WAIT_BAR(2); RESC(); ROT();
    STEP(pA0,pA1,pB0,pB1,t+1,true,true,true);   WAIT_BAR(2); RESC(); ROT();
  }
  #undef CMASK
  #define CMASK(P0,P1,t) do{int jb_=(t)-(NT-4); if(jb_>=0)cmask(P0,P1,jb_,qrel,hi);}while(0)
  #define ENDW(tt) do{ if((tt)+3<NT){WAIT_BAR(2);} else if((tt)+2<NT){WAIT_BAR(1);} else {WAIT_BAR(0);} }while(0)
  for(;t+1<NT;t+=2){
    STEP(pB0,pB1,pA0,pA1,t,(t+3<NT),(t+1<NT),(t+1<NT));       ENDW(t);   RESC(); ROT();
    STEP(pA0,pA1,pB0,pB1,t+1,(t+4<NT),(t+2<NT),(t+2<NT));     ENDW(t+1); RESC(); ROT();
  }
  STEP(pB0,pB1,pA0,pA1,NT-1,false,false,false); RESC();
  { float sacc=pB0[0]+pB0[1]; _Pragma("unroll") for(int r=2;r<16;++r)sacc+=pB0[r]; _Pragma("unroll") for(int r=0;r<16;++r)sacc+=pB1[r]; l_reg+=sacc;
    pw0=(u32x4){PKW(pB0,0),PKW(pB0,2),PKW(pB0,4),PKW(pB0,6)};pw1=(u32x4){PKW(pB0,8),PKW(pB0,10),PKW(pB0,12),PKW(pB0,14)};pw2=(u32x4){PKW(pB1,0),PKW(pB1,2),PKW(pB1,4),PKW(pB1,6)};pw3=(u32x4){PKW(pB1,8),PKW(pB1,10),PKW(pB1,12),PKW(pB1,14)};
    SBAR(); pv(o,vb0+sl_cur,PAF(0),PAF(1),PAF(2),PAF(3)); }
  #undef PKW
  #undef PAF
  #undef VFR
  #undef PIN
  #undef MX3
  #undef GAPA
  #undef GAPB
  #undef EX
  #undef VRD
  #undef KRD
  #undef STEP
  #undef ENDW
  {auto rr=__builtin_amdgcn_permlane32_swap(__float_as_uint(l_reg),__float_as_uint(l_reg),false,false);l_reg=__uint_as_float(rr[0])+__uint_as_float(rr[1]);}
  if(hi==0)wsf[32+r32]=l_reg;asm volatile("s_waitcnt lgkmcnt(0)":::"memory");
  float rli[16];
  #pragma unroll
  for(int r=0;r<16;++r)rli[r]=__builtin_amdgcn_rcpf(wsf[32+crow(r,hi)]);
  bf16*Ow=O+(rowbase+q0+wid*QBLK)*DM+h*D;
  { bf16*stg=(bf16*)(shm+LDS_OST)+wid*2048;
    #pragma unroll
    for(int r=0;r<16;++r){const int orow=crow(r,hi);
      #pragma unroll
      for(int d0=0;d0<2;++d0)stg[orow*64+d0*32+r32]=__float2bfloat16(o[d0][r]*rli[r]);}
    asm volatile("s_waitcnt lgkmcnt(0)":::"memory");
    #pragma unroll
    for(int i=0;i<4;++i){const int row=i*8+(lane>>3),ch=lane&7; const u32x4 v=*(const u32x4*)(stg+row*64+ch*8); ATTN_STORE16(Ow+(long)row*DM+ch*8,v);} }
  asm volatile("s_waitcnt lgkmcnt(0)\n\ts_barrier":::"memory");
  #undef DMA_K
  #undef DMA_V
  #undef CMASK
  #undef START
  #undef RESC
  #undef FBIAS
  #undef ROT
}
constexpr int ATTN_LDS_BYTES=LDS_BYTES;
struct AttnTensors { const bf16* Q; const bf16* K; const bf16* V; bf16* O; const float* FB; };
constexpr int FB_OFF=86016;
template<int THRL=8> __device__ __forceinline__ void attn_phase(char*lds,const AttnTensors&T,int vcu,int G){
  const fb_lptr fbl=(fb_lptr)(lds+FB_OFF);
  for(int bh=vcu;bh<BATCH*NHEAD;bh+=G){
    { __attribute__((address_space(3))) float* fw=(__attribute__((address_space(3))) float*)(lds+FB_OFF);
      int ti_=threadIdx.x; asm volatile("":"+v"(ti_)); for(int i=ti_;i<SEQ;i+=512)fw[i]=T.FB[(size_t)bh*SEQ+i]; }
    asm volatile("s_waitcnt vmcnt(0) lgkmcnt(0)\n\ts_barrier":::"memory");
    for(int qb=NQB-1;qb>=0;--qb) attn_unit<THRL>(bh/NHEAD,bh%NHEAD,qb,T.Q,T.K,T.V,T.O,lds,fbl);
  }
}
#undef SBAR
#undef WAIT_BAR
}

constexpr int DM = 1024, NB = 16, SEQ = 4096, NT = NB * SEQ;
constexpr int DEPTH = 4, NAL = 2;
constexpr int A_IN = 3088, A_PROJ = 3072;
constexpr int KV_OUT = 2064;
constexpr int NE = 16, DE = 512, NCLS = 24, CLS_CAP = NT;
constexpr float EPS = 1e-6f;
constexpr int NWAVES = 8;
constexpr int MAX_RB = NT / 256 + NCLS;

constexpr size_t MiB = 1u << 20;
constexpr size_t WS_CTL = 0, CTL_ZERO_BYTES = 1 * MiB;
constexpr size_t WS_MODS = 1 * MiB;
constexpr size_t WS_KVMOD = WS_MODS + (size_t)DEPTH * NB * 6144 * 4;
constexpr size_t WS_FIN = WS_KVMOD + (size_t)NB * 2048 * 4;
constexpr size_t WS_WTS = 3 * MiB;
constexpr size_t WS_G16 = 4 * MiB;
constexpr size_t WS_FB = 8 * MiB;
constexpr size_t WS_PERM = 12 * MiB;
constexpr size_t WS_WIN = 18 * MiB, WS_WOUT = 30 * MiB, WS_WKV = 34 * MiB, WS_WQ = 38 * MiB, WS_WO = 42 * MiB;
constexpr size_t WS_BT1 = 46 * MiB;
constexpr size_t WS_BT2 = 174 * MiB;
constexpr size_t WS_HB = 238 * MiB;
constexpr size_t WS_BIG = 366 * MiB;
constexpr size_t WS_ACT = 750 * MiB;
constexpr size_t WS_END = 890 * MiB;
static_assert(WS_FIN + (size_t)NB * 2048 * 4 <= WS_WTS && WS_ACT + (size_t)MAX_RB * 256 * 1024 * 2 <= WS_END, "d_ws map");
constexpr int CW_BAR = 4096;
constexpr int CW_CNT = 16384;
constexpr int RING_OFF = 0, RING_BYTES = 131072;
constexpr int LDSCTL_OFF = RING_BYTES, MISC_OFF = LDSCTL_OFF + 320;
constexpr int TAB_OFF = MISC_OFF + 128;
constexpr int LDS_BYTES = 147456;
static_assert(TAB_OFF + 256 <= LDS_BYTES, "LDS map");

typedef unsigned short bf16;
typedef unsigned v4u __attribute__((ext_vector_type(4)));
typedef unsigned v2u __attribute__((ext_vector_type(2)));
typedef float f32x4 __attribute__((ext_vector_type(4)));
typedef short bf16x8 __attribute__((ext_vector_type(8)));
typedef GAS unsigned gu32;
#define RLX_AGENT __ATOMIC_RELAXED, __HIP_MEMORY_SCOPE_AGENT
#define LDS_WAIT() asm volatile("s_waitcnt lgkmcnt(0)" ::: "memory")
__device__ __forceinline__ unsigned f2bf(float f) { unsigned u = __builtin_bit_cast(unsigned, f); return (u + 0x7fffu + ((u >> 16) & 1u)) >> 16; }
__device__ __forceinline__ unsigned pk2(float lo, float hi) { return f2bf(lo) | (f2bf(hi) << 16); }
__device__ __forceinline__ float bf2f(unsigned b) { return __builtin_bit_cast(float, (b & 0xffffu) << 16); }

#define XB_TMO      128
#define XB_XCNT(j)  (256  + 64 * (j))
#define XB_XSUB(j)  (1280 + 64 * (j))
#define XB_XGEN(j)  (2304 + 64 * (j))
#define XB_TOP      3328
#define XB_TOPGEN   3392
#define XCD_BAR_WORDS 3456
#define XB_SPIN_CAP (1u << 22)

__device__ __forceinline__ unsigned xb_ld(unsigned* p)              { return __hip_atomic_load(p, __ATOMIC_RELAXED, __HIP_MEMORY_SCOPE_AGENT); }
__device__ __forceinline__ unsigned xb_add(unsigned* p, unsigned v) { return __hip_atomic_fetch_add(p, v, __ATOMIC_RELAXED, __HIP_MEMORY_SCOPE_AGENT); }
__device__ __forceinline__ unsigned xb_xcc_id() { return (unsigned)__builtin_amdgcn_s_getreg((3 << 11) | 20) & 0xFu; }
#define XB_SPIN(cond, bar) do { unsigned _sp = 0; while (cond) { __builtin_amdgcn_s_sleep(1); \
    if ((++_sp & 255u) == 0u) { if (xb_ld(&(bar)[XB_TMO])) break; if (_sp > XB_SPIN_CAP) { atomicAdd(&(bar)[XB_TMO], 1u); break; } } } } while (0)

struct XcdBarrier { unsigned* bar; unsigned x; volatile LAS unsigned* st; };

__device__ __forceinline__ XcdBarrier xcd_barrier_post(unsigned* bar, volatile LAS unsigned* st) {
    XcdBarrier b; b.bar = bar; b.x = xb_xcc_id(); b.st = st;
    if (threadIdx.x == 0) (void)xb_add(&bar[XB_XCNT(b.x)], 1u);
    return b;
}
__device__ __forceinline__ void xcd_barrier_complete(unsigned* bar, unsigned x, unsigned& nloc, unsigned& nx) {
    const unsigned G = gridDim.x * gridDim.y * gridDim.z;
    unsigned sum, cnt, mine, sp = 0u;
    for (;;) {
        sum = 0u; cnt = 0u; mine = 0u;
#pragma unroll
        for (unsigned j = 0; j < 16; ++j) { const unsigned c = xb_ld(&bar[XB_XCNT(j)]); sum += c; cnt += (c > 0u) ? 1u : 0u; mine = (j == x) ? c : mine; }
        if (sum == G) break;
        __builtin_amdgcn_s_sleep(1);
        if ((++sp & 255u) == 0u) { if (xb_ld(&bar[XB_TMO])) break; if (sp > XB_SPIN_CAP) { atomicAdd(&bar[XB_TMO], 1u); break; } }
    }
    nloc = mine > 0u ? mine : 1u; nx = cnt > 0u ? cnt : 1u;
}
__device__ __forceinline__ void xcd_barrier(const XcdBarrier& b) {
    asm volatile("s_waitcnt vmcnt(0)" ::: "memory");
    __syncthreads();
    if (threadIdx.x == 0) {
        unsigned* bar = b.bar; unsigned bx = b.x; asm volatile("" : "+s"(bar), "+s"(bx));
        __builtin_amdgcn_s_waitcnt(0);
        unsigned nloc = b.st[0], nx = b.st[1];
        if (nloc == 0u) { xcd_barrier_complete(bar, bx, nloc, nx); b.st[0] = nloc; b.st[1] = nx; }
        const unsigned old = xb_add(&bar[XB_XSUB(bx)], 1u);
        const unsigned gen = old / nloc;
        if (old + 1u == (gen + 1u) * nloc) {
            __builtin_amdgcn_fence(__ATOMIC_RELEASE, "agent");
            asm volatile("s_waitcnt vmcnt(0)" ::: "memory");
            const unsigned og = xb_add(&bar[XB_TOP], 1u);
            const unsigned tg = og / nx;
            if (og + 1u == (tg + 1u) * nx) xb_add(&bar[XB_TOPGEN], 1u);
            else XB_SPIN(xb_ld(&bar[XB_TOPGEN]) == tg, bar);
            __builtin_amdgcn_fence(__ATOMIC_ACQUIRE, "agent");
            xb_add(&bar[XB_XGEN(bx)], 1u);
            asm volatile("s_waitcnt vmcnt(0)" ::: "memory");
        } else {
            XB_SPIN(xb_ld(&bar[XB_XGEN(bx)]) == gen, bar);
            __builtin_amdgcn_fence(__ATOMIC_ACQUIRE, "agent");
            asm volatile("s_waitcnt vmcnt(0)" ::: "memory");
        }
    }
    __syncthreads();
}

struct Args { const float* in[25]; float* out; unsigned char* ws; int ph_lo, ph_hi; };
enum { I_X = 0, I_C, I_AWIN, I_ABG, I_AMH, I_AWOUT, I_KVNORM, I_WADAKV, I_BADAKV, I_WKV, I_BFG, I_BWQ, I_BWO, I_NMIX, I_NFFN, I_WADA, I_BADA, I_WR, I_RB, I_WG, I_WU, I_WD, I_NFIN, I_WADAF, I_BADAF };

struct Frame {
    LAS unsigned char* lds;
    volatile LAS unsigned* MISC;
    gu32* ctl;
    int tid, lane, wave;
    int vcu, G;
};

__device__ __forceinline__ float wave_sum(float v) {
#pragma unroll
    for (int o = 1; o < 64; o <<= 1) v += __shfl_xor(v, o);
    return v;
}

__device__ __forceinline__ void p0_transpose_blk(const float* W, int ldw, int k0, int n0, bf16* WT, int ldt, int drow0, LAS float* scr, int lane) {
#pragma unroll 8
    for (int i = 0; i < 32; ++i) { const int kk = 2 * i + (lane >> 5); scr[kk * 33 + (lane & 31)] = W[(size_t)(k0 + kk) * ldw + n0 + (lane & 31)]; }
    LDS_WAIT(); asm volatile("" ::: "memory");
    const int c = lane & 7;
#pragma unroll
    for (int j = 0; j < 4; ++j) { const int n = (lane >> 3) + 8 * j; const LAS float* s = scr + (8 * c) * 33 + n;
        v4u o; o.x = pk2(s[0 * 33], s[1 * 33]); o.y = pk2(s[2 * 33], s[3 * 33]); o.z = pk2(s[4 * 33], s[5 * 33]); o.w = pk2(s[6 * 33], s[7 * 33]);
        *(GAS v4u*)(WT + (size_t)(drow0 + n) * ldt + k0 + 8 * c) = o; }
    LDS_WAIT(); asm volatile("" ::: "memory");
}
__device__ __forceinline__ void p0_prologue(Frame& F, const Args& a) {
    unsigned char* ws = a.ws;
    {
        LAS float* cact = (LAS float*)(F.lds);
        LAS float* red = (LAS float*)(F.lds + 65536);
        const float* c = a.in[I_C];
        for (int i = F.tid; i < NB * DM; i += 512) { const int b = i >> 10, d = i & 1023; const float v = c[i]; cact[d * 16 + b] = v / (1.0f + __expf(-v)); }
        __syncthreads();
        for (int blk = blockIdx.x; blk < 224; blk += F.G) {
            const float* W; const float* bias; float* out; int ldw, e0, ostride;
            if (blk < 192) { const int l = blk / 48; e0 = (blk % 48) * 128; W = a.in[I_WADA] + (size_t)l * DM * 6144; ldw = 6144; bias = a.in[I_BADA] + l * 6144; out = (float*)(ws + WS_MODS) + (size_t)l * NB * 6144; ostride = 6144; }
            else if (blk < 208) { e0 = (blk - 192) * 128; W = a.in[I_WADAKV]; ldw = 2048; bias = a.in[I_BADAKV]; out = (float*)(ws + WS_KVMOD); ostride = 2048; }
            else { e0 = (blk - 208) * 128; W = a.in[I_WADAF]; ldw = 2048; bias = a.in[I_BADAF]; out = (float*)(ws + WS_FIN); ostride = 2048; }
            const int col = F.tid & 127, ks = F.tid >> 7;
            float acc[16];
#pragma unroll
            for (int b = 0; b < 16; ++b) acc[b] = 0.f;
            const float* wp = W + (size_t)(ks * 256) * ldw + e0 + col;
#pragma unroll 4
            for (int d = 0; d < 256; ++d) { const float w = wp[(size_t)d * ldw]; const LAS f32x4* cp = (const LAS f32x4*)(cact + (ks * 256 + d) * 16);
#pragma unroll
                for (int q = 0; q < 4; ++q) { const f32x4 cv = cp[q]; acc[4 * q + 0] += w * cv[0]; acc[4 * q + 1] += w * cv[1]; acc[4 * q + 2] += w * cv[2]; acc[4 * q + 3] += w * cv[3]; } }
#pragma unroll
            for (int b = 0; b < 16; ++b) red[(ks * 128 + col) * 16 + b] = acc[b];
            __syncthreads();
            for (int i = F.tid; i < 128 * 16; i += 512) { const int cc = i & 127, b = i >> 7;
                const float s = red[(0 * 128 + cc) * 16 + b] + red[(1 * 128 + cc) * 16 + b] + red[(2 * 128 + cc) * 16 + b] + red[(3 * 128 + cc) * 16 + b];
                out[(size_t)b * ostride + e0 + cc] = s + bias[e0 + cc]; }
            __syncthreads();
        }
    }
    __syncthreads();
    {
        LAS float* scr = (LAS float*)(F.lds + F.wave * 16384);
        const int gw = F.vcu * NWAVES + F.wave, NGW = F.G * NWAVES;
        constexpr int I_IN = 16 * 96, I_SQ = 16 * 32, I_KV = 16 * 64, I_GU = 16 * 16, I_DN = 8 * 32;
        constexpr int N_IN = 2 * I_IN, N_OUT = 2 * I_SQ, N_KV = I_KV, N_Q = 2 * I_SQ, N_O = 2 * I_SQ, N_G = 64 * I_GU, N_U = 64 * I_GU, N_D = 64 * I_DN;
        constexpr int NITEMS = N_IN + N_OUT + N_KV + N_Q + N_O + N_G + N_U + N_D;
        for (int it = gw; it < NITEMS; it += NGW) {
            int r = it;
            if (r < N_IN) { const int l = r / I_IN, q = r % I_IN, kb = q / 96, nb = q % 96;
                p0_transpose_blk(a.in[I_AWIN] + (size_t)l * DM * A_IN, A_IN, 64 * kb, 32 * nb, (bf16*)(ws + WS_WIN) + (size_t)l * A_PROJ * DM, DM, 32 * nb, scr, F.lane); continue; } r -= N_IN;
            if (r < N_OUT) { const int l = r / I_SQ, q = r % I_SQ, kb = q / 32, nb = q % 32;
                p0_transpose_blk(a.in[I_AWOUT] + (size_t)l * DM * DM, DM, 64 * kb, 32 * nb, (bf16*)(ws + WS_WOUT) + (size_t)l * DM * DM, DM, 32 * nb, scr, F.lane); continue; } r -= N_OUT;
            if (r < N_KV) { const int kb = r / 64, nb = r % 64;
                p0_transpose_blk(a.in[I_WKV], KV_OUT, 64 * kb, 32 * nb, (bf16*)(ws + WS_WKV), DM, 32 * nb, scr, F.lane); continue; } r -= N_KV;
            if (r < N_Q) { const int l = r / I_SQ, q = r % I_SQ, kb = q / 32, nb = q % 32;
                p0_transpose_blk(a.in[I_BWQ] + (size_t)l * DM * DM, DM, 64 * kb, 32 * nb, (bf16*)(ws + WS_WQ) + (size_t)l * DM * DM, DM, 32 * nb, scr, F.lane); continue; } r -= N_Q;
            if (r < N_O) { const int l = r / I_SQ, q = r % I_SQ, kb = q / 32, nb = q % 32;
                p0_transpose_blk(a.in[I_BWO] + (size_t)l * DM * DM, DM, 64 * kb, 32 * nb, (bf16*)(ws + WS_WO) + (size_t)l * DM * DM, DM, 32 * nb, scr, F.lane); continue; } r -= N_O;
            if (r < N_G + N_U) { const int up = r >= N_G; if (up) r -= N_G; const int le = r / I_GU, q = r % I_GU, kb = q / 16, nb = q % 16; const int n0 = 32 * nb;
                const float* W = a.in[up ? I_WU : I_WG] + (size_t)le * DM * DE;
                p0_transpose_blk(W, DE, 64 * kb, n0, (bf16*)(ws + WS_BT1) + (size_t)le * 1024 * DM, DM, (n0 >> 7) * 256 + up * 128 + (n0 & 127), scr, F.lane); continue; } r -= N_G + N_U;
            { const int le = r / I_DN, q = r % I_DN, kb = q / 32, nb = q % 32;
                p0_transpose_blk(a.in[I_WD] + (size_t)le * DE * DM, DM, 64 * kb, 32 * nb, (bf16*)(ws + WS_BT2) + (size_t)le * DM * DE, DE, 32 * nb, scr, F.lane); }
        }
    }
}

__device__ __forceinline__ float log_sigmoidf_(float x) { return fminf(x, 0.f) - log1pf(__expf(-fabsf(x))); }
template <bool ROUTER>
__device__ __forceinline__ void norm_phase(Frame& F, const float* x, const float* gamma, const float* shift, const float* scale, int mstride, bf16* out,
                                           int mode, const float* W16, int ldw, const float* bias16, float* G16, float2* wts, int* perm, gu32* gcnt) {
    LAS float* wT = (LAS float*)(F.lds);
    LAS int* hist = (LAS int*)(F.lds + 65536);
    LAS int* sbase = hist + 32;
    LAS int* tinfo = hist + 64;
    int tid_ = threadIdx.x; asm volatile("" : "+v"(tid_)); const int tid = tid_, lane = tid & 63, wave = __builtin_amdgcn_readfirstlane(tid >> 6);
    if (mode != 0) { for (int i = tid; i < DM * 16; i += 512) { const int d = i >> 4, e = i & 15; wT[e * DM + d] = W16[(size_t)d * ldw + e]; } }
    if (tid < 32) hist[tid] = 0;
    __syncthreads();
    for (int chunk = blockIdx.x; chunk < NT / 256; chunk += F.G) {
        const int b = chunk >> 4;
        f32x4 ga[4], sb[4];
#pragma unroll
        for (int j = 0; j < 4; ++j) { const int col = 4 * lane + 256 * j; const f32x4 g = *(const f32x4*)(gamma + col), sc = *(const f32x4*)(scale + (size_t)b * mstride + col); sb[j] = *(const f32x4*)(shift + (size_t)b * mstride + col);
            ga[j] = g * (sc + 1.0f); }
#pragma clang loop unroll(disable)
        for (int i = 0; i < 32; ++i) {
            const int row = chunk * 256 + wave * 32 + i;
            const GAS f32x4* xr = (const GAS f32x4*)(x + (size_t)row * DM) + lane;
            f32x4 v[4]; float s = 0.f;
#pragma unroll
            for (int j = 0; j < 4; ++j) { v[j] = xr[64 * j]; s += (v[j].x * v[j].x + v[j].y * v[j].y) + (v[j].z * v[j].z + v[j].w * v[j].w); }
            const float r = 1.0f / sqrtf(wave_sum(s) * (1.0f / DM) + EPS);
            GAS v2u* o8 = (GAS v2u*)(out + (size_t)row * DM) + lane;
#pragma unroll
            for (int j = 0; j < 4; ++j) { v[j] = v[j] * r * ga[j] + sb[j]; v2u w; w.x = pk2(v[j].x, v[j].y); w.y = pk2(v[j].z, v[j].w); o8[64 * j] = w; }
            if (mode == 0) continue;
            float p[16];
#pragma unroll
            for (int e = 0; e < 16; ++e) { float a = 0.f;
#pragma unroll
                for (int j = 0; j < 4; ++j) { const f32x4 w = *(const LAS f32x4*)(wT + e * DM + 4 * lane + 256 * j); a += (v[j].x * w.x + v[j].y * w.y) + (v[j].z * w.z + v[j].w * w.w); }
                p[e] = a; }
#pragma unroll
            for (int k = 0; k < 8; ++k) { const bool hi = lane & 32; const float mine = hi ? p[k + 8] : p[k], send = hi ? p[k] : p[k + 8]; p[k] = mine + __shfl_xor(send, 32); }
#pragma unroll
            for (int k = 0; k < 4; ++k) { const bool hi = lane & 16; const float mine = hi ? p[k + 4] : p[k], send = hi ? p[k] : p[k + 4]; p[k] = mine + __shfl_xor(send, 16); }
#pragma unroll
            for (int k = 0; k < 2; ++k) { const bool hi = lane & 8; const float mine = hi ? p[k + 2] : p[k], send = hi ? p[k] : p[k + 2]; p[k] = mine + __shfl_xor(send, 8); }
            { const bool hi = lane & 4; const float mine = hi ? p[1] : p[0], send = hi ? p[0] : p[1]; p[0] = mine + __shfl_xor(send, 4); }
            p[0] += __shfl_xor(p[0], 2); p[0] += __shfl_xor(p[0], 1);
            const int e = (lane >> 2) & 15;
            if (!ROUTER) {
              if (mode == 1) {
                float g = p[0] + bias16[e]; g = 15.0f * tanhf(g * (1.0f / 15.0f));
                if (e >= 8) g = log_sigmoidf_(g);
                if ((lane & 3) == 0) G16[(size_t)row * 16 + e] = g;
              } else {
                const float g = log_sigmoidf_(p[0] + bias16[e]);
                if ((lane & 3) == 0) G16[(size_t)row * 16 + e] = g;
              }
            } else {
                float aff[16], sel[16];
#pragma unroll
                for (int q = 0; q < 16; ++q) { const float lg = __shfl(p[0], 4 * q); aff[q] = 1.0f / (1.0f + __expf(-lg)); sel[q] = aff[q] + bias16[q]; }
                float gs[4];
#pragma unroll
                for (int g = 0; g < 4; ++g) { const float s0 = sel[4 * g], s1 = sel[4 * g + 1], s2 = sel[4 * g + 2], s3 = sel[4 * g + 3];
                    const float a = fmaxf(s0, s1), bb = fminf(s0, s1), c = fmaxf(s2, s3), d = fminf(s2, s3);
                    gs[g] = fmaxf(a, c) + fmaxf(fminf(a, c), fmaxf(bb, d)); }
                int grp = 0; float best = gs[0];
#pragma unroll
                for (int g = 1; g < 4; ++g) if (gs[g] > best) { best = gs[g]; grp = g; }
                float sg[4], ag[4];
#pragma unroll
                for (int q = 0; q < 4; ++q) { sg[q] = grp == 0 ? sel[q] : grp == 1 ? sel[4 + q] : grp == 2 ? sel[8 + q] : sel[12 + q]; ag[q] = grp == 0 ? aff[q] : grp == 1 ? aff[4 + q] : grp == 2 ? aff[8 + q] : aff[12 + q]; }
                int i1 = 0; float b1 = sg[0];
#pragma unroll
                for (int q = 1; q < 4; ++q) if (sg[q] > b1) { b1 = sg[q]; i1 = q; }
                int i2 = -1; float b2 = 0.f;
#pragma unroll
                for (int q = 0; q < 4; ++q) if (q != i1 && (i2 < 0 || sg[q] > b2)) { b2 = sg[q]; i2 = q; }
                const int ea = i1 < i2 ? i1 : i2, eb = i1 < i2 ? i2 : i1;
                const float wa = ea == 0 ? ag[0] : ea == 1 ? ag[1] : ag[2], wb = eb == 1 ? ag[1] : eb == 2 ? ag[2] : ag[3];
                const float inv = 1.0f / (wa + wb);
                const int pid = ea == 0 ? eb - 1 : ea == 1 ? eb + 1 : 5;
                const int cls = grp * 6 + pid;
                if (lane == 0) { wts[row] = make_float2(wa * inv, wb * inv); const int rk = __hip_atomic_fetch_add(&hist[cls], 1, __ATOMIC_RELAXED, __HIP_MEMORY_SCOPE_WORKGROUP); tinfo[wave * 32 + i] = cls | (rk << 8); }
            }
        }
        if (ROUTER) {
            __syncthreads();
            if (tid < NCLS) { const int n = hist[tid]; sbase[tid] = n ? (int)__hip_atomic_fetch_add(gcnt + tid, (unsigned)n, RLX_AGENT) : 0; }
            __syncthreads();
            if (tid < 256) { const int ti = tinfo[tid], cls = ti & 255, rk = ti >> 8; perm[(size_t)cls * CLS_CAP + sbase[cls] + rk] = chunk * 256 + tid; }
            __syncthreads();
            if (tid < 32) hist[tid] = 0;
            __syncthreads();
        }
    }
    __syncthreads();
}
__device__ __forceinline__ void final_norm_phase(Frame& F, float* x, const float* gamma, const float* shift, const float* scale, int mstride) {
    int tid_ = threadIdx.x; asm volatile("" : "+v"(tid_)); const int lane = tid_ & 63, wave = __builtin_amdgcn_readfirstlane(tid_ >> 6);
    for (int chunk = blockIdx.x; chunk < NT / 256; chunk += F.G) {
        const int b = chunk >> 4;
        f32x4 ga[4], sb[4];
#pragma unroll
        for (int j = 0; j < 4; ++j) { const int col = 4 * lane + 256 * j; const f32x4 g = *(const f32x4*)(gamma + col), sc = *(const f32x4*)(scale + (size_t)b * mstride + col); sb[j] = *(const f32x4*)(shift + (size_t)b * mstride + col);
            ga[j] = g * (sc + 1.0f); }
#pragma clang loop unroll(disable)
        for (int i = 0; i < 32; ++i) {
            const int row = chunk * 256 + wave * 32 + i;
            GAS f32x4* xr = (GAS f32x4*)(x + (size_t)row * DM) + lane;
            f32x4 v[4]; float s = 0.f;
#pragma unroll
            for (int j = 0; j < 4; ++j) { v[j] = xr[64 * j]; s += (v[j].x * v[j].x + v[j].y * v[j].y) + (v[j].z * v[j].z + v[j].w * v[j].w); }
            const float r = 1.0f / sqrtf(wave_sum(s) * (1.0f / DM) + EPS);
#pragma unroll
            for (int j = 0; j < 4; ++j) xr[64 * j] = v[j] * r * ga[j] + sb[j];
        }
    }
}

__device__ __forceinline__ void fcum_phase(Frame& F, const float* logf, float* FB) {
    LAS float* wtot = (LAS float*)(F.lds);
    int tid_ = threadIdx.x; asm volatile("" : "+v"(tid_)); const int tid = tid_, lane = tid & 63, wave = __builtin_amdgcn_readfirstlane(tid >> 6);
    for (int chain = blockIdx.x; chain < NB * 16; chain += F.G) {
        const int b = chain >> 4, hh = chain & 15;
        float v[8]; float run = 0.f;
#pragma unroll
        for (int j = 0; j < 8; ++j) { run += logf[((size_t)b * SEQ + tid * 8 + j) * 16 + hh]; v[j] = run; }
        float inc = run;
#pragma unroll
        for (int o = 1; o < 64; o <<= 1) { const float t = __shfl_up(inc, o); if (lane >= o) inc += t; }
        if (lane == 63) wtot[wave] = inc;
        __syncthreads();
        float base = inc - run;
        for (int w = 0; w < wave; ++w) base += wtot[w];
#pragma unroll
        for (int j = 0; j < 8; ++j) FB[(size_t)chain * SEQ + tid * 8 + j] = -(base + v[j]) * 1.4426950408889634f;
        __syncthreads();
    }
}

__device__ __forceinline__ float wave_scan_add(float v, int lane) {
#pragma unroll
    for (int o = 1; o < 64; o <<= 1) { const float t = __shfl_up(v, o); if (lane >= o) v += t; }
    return v;
}
__device__ __forceinline__ float wave_scan_max(float v, int lane) {
#pragma unroll
    for (int o = 1; o < 64; o <<= 1) { const float t = __shfl_up(v, o); if (lane >= o) v = fmaxf(v, t); }
    return v;
}
__device__ __forceinline__ void cell_phase(Frame& F, const bf16* PROJ, const float* G16, const float* mhn, bf16* HS) {
    constexpr int PST = 72;
    LAS bf16* sQ = (LAS bf16*)(F.lds);
    LAS bf16* sK = sQ + 64 * PST;
    LAS bf16* sKT = sK + 64 * PST;
    LAS bf16* sW = sKT + 64 * PST;
    LAS bf16* sVT = sW + 64 * PST;
    LAS bf16* sCT = sVT + 128 * PST;
    LAS float* fz = (LAS float*)(sCT + 128 * PST);
    LAS float* sU = fz, *sM = fz + 64, *sA = fz + 128, *sEm = fz + 192, *sWk = fz + 256, *sInv = fz + 320, *sN = fz + 384, *sScal = fz + 448, *sSS = fz + 512;
    int tid_ = threadIdx.x; asm volatile("" : "+v"(tid_));
    const int tid = tid_, lane = tid & 63, w = __builtin_amdgcn_readfirstlane(tid >> 6), fr = lane & 15, fq = lane >> 4;
    for (int chain = blockIdx.x; chain < NB * 8; chain += F.G) {
        const int b = chain >> 3, hh = chain & 7;
        f32x4 accC[4];
#pragma unroll
        for (int ni = 0; ni < 4; ++ni) accC[ni] = (f32x4){0.f, 0.f, 0.f, 0.f};
        for (int i = tid; i < 128 * PST; i += 512) sCT[i] = 0;
        if (tid < 64) sN[tid] = 0.f;
        float m_prev = 0.f;
        __syncthreads();
        for (int c = 0; c < SEQ / 64; ++c) {
            const size_t t0 = (size_t)b * SEQ + 64 * c;
            const int row = tid >> 3, seg = tid & 7;
            const bf16* pr = PROJ + (t0 + row) * A_PROJ + hh * 64 + seg * 8;
            const v4u qv = *(const GAS v4u*)pr, kv = *(const GAS v4u*)(pr + 512);
            const bf16* pv = PROJ + (t0 + row) * A_PROJ + 1024 + hh * 128 + seg * 8;
            const v4u v0 = *(const GAS v4u*)pv, v1 = *(const GAS v4u*)(pv + 64);
            float ig = 0.f, lf = 0.f;
            if (tid < 64) { ig = G16[(t0 + tid) * 16 + hh]; lf = G16[(t0 + tid) * 16 + 8 + hh]; }
            *(LAS v4u*)(sQ + row * PST + seg * 8) = qv;
            *(LAS v4u*)(sK + row * PST + seg * 8) = kv;
#pragma unroll
            for (int j = 0; j < 4; ++j) { sVT[(seg * 8 + 2 * j) * PST + row] = (bf16)(v0[j] & 0xffffu); sVT[(seg * 8 + 2 * j + 1) * PST + row] = (bf16)(v0[j] >> 16);
                sVT[(64 + seg * 8 + 2 * j) * PST + row] = (bf16)(v1[j] & 0xffffu); sVT[(64 + seg * 8 + 2 * j + 1) * PST + row] = (bf16)(v1[j] >> 16); }
            if (w == 0) {
                const float bc = wave_scan_add(lf, lane), u = ig - bc, pm = wave_scan_max(u, lane), M = fmaxf(m_prev, pm);
                const float M63 = __shfl(M, 63), bl = __shfl(bc, 63);
                sU[lane] = u; sM[lane] = M; sA[lane] = __expf(m_prev - M); sEm[lane] = __expf(-(bc + M)); sWk[lane] = __expf(u - M63);
                if (lane == 0) { sScal[0] = __expf(m_prev - M63); sScal[1] = bl + M63; }
            }
            __syncthreads();
            { const float wk = sWk[row];
#pragma unroll
              for (int j = 0; j < 4; ++j) { sKT[(seg * 8 + 2 * j) * PST + row] = (bf16)f2bf(bf2f(kv[j] & 0xffffu) * wk); sKT[(seg * 8 + 2 * j + 1) * PST + row] = (bf16)f2bf(bf2f(kv[j] >> 16) * wk); } }
            { const int mi = w >> 1;
#pragma unroll
              for (int nn = 0; nn < 2; ++nn) { const int ni = (w & 1) * 2 + nn; f32x4 acc = (f32x4){0.f, 0.f, 0.f, 0.f};
#pragma unroll
                for (int ks = 0; ks < 2; ++ks) { const bf16x8 av = *(const LAS bf16x8*)(sQ + (16 * mi + fr) * PST + 32 * ks + 8 * fq), bv = *(const LAS bf16x8*)(sK + (16 * ni + fr) * PST + 32 * ks + 8 * fq);
                    acc = __builtin_amdgcn_mfma_f32_16x16x32_bf16(av, bv, acc, 0, 0, 0); }
                const int s = 16 * ni + fr; const float us = sU[s];
#pragma unroll
                for (int i = 0; i < 4; ++i) { const int t = 16 * mi + 4 * fq + i; const float wv = (s <= t) ? __expf(us - sM[t]) * acc[i] : 0.f; sW[t * PST + s] = (bf16)f2bf(wv); } } }
            __syncthreads();
            { const int t = tid >> 3, part = tid & 7; float d1 = 0.f, qn = 0.f;
#pragma unroll
              for (int j = 0; j < 8; ++j) { d1 += bf2f(sW[t * PST + part * 8 + j]); qn += bf2f(sQ[t * PST + part * 8 + j]) * sN[part * 8 + j]; }
              d1 += __shfl_xor(d1, 1); d1 += __shfl_xor(d1, 2); d1 += __shfl_xor(d1, 4); qn += __shfl_xor(qn, 1); qn += __shfl_xor(qn, 2); qn += __shfl_xor(qn, 4);
              const float den = d1 + sA[t] * qn; if (part == 0) sInv[t] = 1.0f / fmaxf(fabsf(den), sEm[t]); }
            f32x4 acc[4];
#pragma unroll
            for (int mi = 0; mi < 4; ++mi) acc[mi] = (f32x4){0.f, 0.f, 0.f, 0.f};
#pragma unroll
            for (int ks = 0; ks < 2; ++ks) { const bf16x8 bq = *(const LAS bf16x8*)(sCT + (16 * w + fr) * PST + 32 * ks + 8 * fq);
#pragma unroll
                for (int mi = 0; mi < 4; ++mi) { const bf16x8 av = *(const LAS bf16x8*)(sQ + (16 * mi + fr) * PST + 32 * ks + 8 * fq); acc[mi] = __builtin_amdgcn_mfma_f32_16x16x32_bf16(av, bq, acc[mi], 0, 0, 0); } }
#pragma unroll
            for (int mi = 0; mi < 4; ++mi)
#pragma unroll
                for (int i = 0; i < 4; ++i) acc[mi][i] *= sA[16 * mi + 4 * fq + i];
#pragma unroll
            for (int ks = 0; ks < 2; ++ks) { const bf16x8 bv = *(const LAS bf16x8*)(sVT + (16 * w + fr) * PST + 32 * ks + 8 * fq);
#pragma unroll
                for (int mi = 0; mi < 4; ++mi) { const bf16x8 av = *(const LAS bf16x8*)(sW + (16 * mi + fr) * PST + 32 * ks + 8 * fq); acc[mi] = __builtin_amdgcn_mfma_f32_16x16x32_bf16(av, bv, acc[mi], 0, 0, 0); } }
            __syncthreads();
#pragma unroll
            for (int mi = 0; mi < 4; ++mi)
#pragma unroll
                for (int i = 0; i < 4; ++i) { const int t = 16 * mi + 4 * fq + i; const float hv = acc[mi][i] * sInv[t]; acc[mi][i] = hv; float sq = hv * hv;
                    sq += __shfl_xor(sq, 1); sq += __shfl_xor(sq, 2); sq += __shfl_xor(sq, 4); sq += __shfl_xor(sq, 8); if (fr == 0) sSS[w * 64 + t] = sq; }
            __syncthreads();
            { const int col = hh * 128 + 16 * w + fr; const float mh = mhn[col];
#pragma unroll
              for (int mi = 0; mi < 4; ++mi)
#pragma unroll
                for (int i = 0; i < 4; ++i) { const int t = 16 * mi + 4 * fq + i; float tot = 0.f;
#pragma unroll
                    for (int ww = 0; ww < 8; ++ww) tot += sSS[ww * 64 + t];
                    const float rn = 1.0f / sqrtf(tot * (1.0f / 128.0f) + EPS);
                    const float og = bf2f(PROJ[(t0 + t) * A_PROJ + 2048 + col]);
                    HS[(t0 + t) * DM + col] = (bf16)f2bf(acc[mi][i] * rn * mh * og); } }
            { const float decay = sScal[0];
#pragma unroll
              for (int ni = 0; ni < 4; ++ni) accC[ni] = accC[ni] * decay;
#pragma unroll
              for (int ks = 0; ks < 2; ++ks) { const bf16x8 av = *(const LAS bf16x8*)(sVT + (16 * w + fr) * PST + 32 * ks + 8 * fq);
#pragma unroll
                for (int ni = 0; ni < 4; ++ni) { const bf16x8 bv = *(const LAS bf16x8*)(sKT + (16 * ni + fr) * PST + 32 * ks + 8 * fq); accC[ni] = __builtin_amdgcn_mfma_f32_16x16x32_bf16(av, bv, accC[ni], 0, 0, 0); } }
#pragma unroll
              for (int ni = 0; ni < 4; ++ni)
#pragma unroll
                for (int i = 0; i < 4; ++i) sCT[(16 * w + 4 * fq + i) * PST + 16 * ni + fr] = (bf16)f2bf(accC[ni][i]);
              const int d = tid >> 3, part = tid & 7; float sk = 0.f;
#pragma unroll
              for (int j = 0; j < 8; ++j) sk += bf2f(sKT[d * PST + part * 8 + j]);
              sk += __shfl_xor(sk, 1); sk += __shfl_xor(sk, 2); sk += __shfl_xor(sk, 4);
              if (part == 0) sN[d] = decay * sN[d] + sk;
              m_prev = sScal[1]; }
            __syncthreads();
        }
    }
}

struct DenseProb {
    const bf16* A; int lda; const bf16* Bt; int ldb; int K; pg8::StaticOrder S;
    __device__ __forceinline__ bool next(int i, pg8::Unit& u) const { return S.next(i, u); }
    __device__ __forceinline__ const char* a_base() const { return (const char*)A; }
    __device__ __forceinline__ void a_off(const pg8::Unit& u, int R0, int C0, unsigned (&o)[2][2]) const {
#pragma unroll
        for (int h = 0; h < 2; ++h)
#pragma unroll
            for (int i = 0; i < 2; ++i) o[h][i] = (unsigned)((u.pm * 256 + h * 128 + R0 + 64 * i) * lda + C0) * 2u; }
    __device__ __forceinline__ const char* b_tile(const pg8::Unit& u, int tt) const { return (const char*)Bt + (size_t)u.pn * 256 * ldb * 2 + (size_t)tt * 128; }
};
struct ClassTab { const LAS int* blkstart; const LAS int* ncls; };
__device__ __forceinline__ void class_of(const ClassTab& T, pg8::Unit& u) { int c = 0; while (c < NCLS - 1 && u.pm >= T.blkstart[c + 1]) ++c; u.cls = c; u.lb = u.pm - T.blkstart[c]; }
__device__ __forceinline__ void pair_of(int cls, int& ea, int& eb) { const int g = cls / 6, p = cls % 6; const int a = p < 3 ? 0 : p < 5 ? 1 : 2, b = p < 3 ? p + 1 : p < 5 ? p - 1 : 3; ea = g * 4 + a; eb = g * 4 + b; }
struct Moe1Prob {
    const bf16* A; int ldb; int K; const bf16* Bt1l; const int* perm; ClassTab T; pg8::StaticOrder S;
    __device__ __forceinline__ bool next(int i, pg8::Unit& u) const { if (!S.next(i, u)) return false; class_of(T, u); return true; }
    __device__ __forceinline__ const char* a_base() const { return (const char*)A; }
    __device__ __forceinline__ void a_off(const pg8::Unit& u, int R0, int C0, unsigned (&o)[2][2]) const {
        const int n = T.ncls[u.cls];
#pragma unroll
        for (int h = 0; h < 2; ++h)
#pragma unroll
            for (int i = 0; i < 2; ++i) { int pos = u.lb * 256 + h * 128 + R0 + 64 * i; pos = pos < n ? pos : n - 1; const int tok = perm[(size_t)u.cls * CLS_CAP + pos]; o[h][i] = (unsigned)(tok * DM + C0) * 2u; } }
    __device__ __forceinline__ const char* b_tile(const pg8::Unit& u, int tt) const { int ea, eb; pair_of(u.cls, ea, eb); const int e = u.pn < 4 ? ea : eb;
        return (const char*)Bt1l + ((size_t)e * 1024 + (size_t)(u.pn & 3) * 256) * DM * 2 + (size_t)tt * 128; }
};
struct Moe2Prob {
    const bf16* A; int ldb; int K; const bf16* Bt2l; ClassTab T; pg8::StaticOrder S;
    __device__ __forceinline__ bool next(int i, pg8::Unit& u) const { if (!S.next(i, u)) return false; class_of(T, u); return true; }
    __device__ __forceinline__ const char* a_base() const { return (const char*)A; }
    __device__ __forceinline__ void a_off(const pg8::Unit& u, int R0, int C0, unsigned (&o)[2][2]) const {
#pragma unroll
        for (int h = 0; h < 2; ++h)
#pragma unroll
            for (int i = 0; i < 2; ++i) o[h][i] = (unsigned)((u.pm * 256 + h * 128 + R0 + 64 * i) * DM + C0) * 2u; }
    __device__ __forceinline__ const char* b_tile(const pg8::Unit& u, int tt) const { int ea, eb; pair_of(u.cls, ea, eb); const int e = tt < 8 ? ea : eb;
        return (const char*)Bt2l + ((size_t)e * 1024 + (size_t)u.pn * 256) * DE * 2 + (size_t)(tt & 7) * 128; }
};

struct EpiProj {
    static constexpr bool PERM = true;
    bf16* O; int ldc; int split_cols; size_t split_stride; int nscale; float scale; int sig_from;
    __device__ __forceinline__ void operator()(const pg8::f32x4 (&acc)[2][2][4][2], const pg8::Unit& u, int wr, int wc, int fr, int fq) const {
        const int row0 = u.pm * 256 + wr * 64 + fr; int colt = u.pn * 256; bf16* base = O;
        if (split_cols) { const int t = colt / split_cols; base += (size_t)t * split_stride; colt -= t * split_cols; }
        const float sc = u.pn < nscale ? scale : 1.0f; const bool sg = u.pn >= sig_from;
        const int col0 = colt + wc * 32 + 8 * fq;
#pragma unroll
        for (int ai = 0; ai < 2; ++ai)
#pragma unroll
            for (int m = 0; m < 4; ++m) { bf16* rowp = base + (size_t)(row0 + ai * 128 + m * 16) * ldc + col0;
#pragma unroll
                for (int bj = 0; bj < 2; ++bj) { pg8::f32x4 v0 = acc[ai][bj][m][0] * sc, v1 = acc[ai][bj][m][1] * sc;
                    if (sg) {
#pragma unroll
                        for (int j = 0; j < 4; ++j) { v0[j] = pg8::sigmoidf_(v0[j]); v1[j] = pg8::sigmoidf_(v1[j]); } }
                    pg8::u32x4 w; w.x = pg8::cvt_pk_bf16(v0[0], v0[1]); w.y = pg8::cvt_pk_bf16(v0[2], v0[3]); w.z = pg8::cvt_pk_bf16(v1[0], v1[1]); w.w = pg8::cvt_pk_bf16(v1[2], v1[3]);
                    *(pg8::u32x4*)(rowp + bj * 128) = w; } }
    }
};
struct EpiRes {
    static constexpr bool PERM = false;
    const float* base; float* out; const float* gate; int gstride;
    __device__ __forceinline__ void operator()(const pg8::f32x4 (&acc)[2][2][4][2], const pg8::Unit& u, int wr, int wc, int fr, int fq) const {
        const int row0 = u.pm * 256 + wr * 64 + fr, col0 = u.pn * 256 + wc * 32 + 4 * fq;
        const float* gp = gate + (size_t)(u.pm >> 4) * gstride + col0;
        pg8::f32x4 gv[2][2];
#pragma unroll
        for (int bj = 0; bj < 2; ++bj)
#pragma unroll
            for (int n = 0; n < 2; ++n) gv[bj][n] = *(const pg8::f32x4*)(gp + bj * 128 + n * 16);
#pragma unroll
        for (int ai = 0; ai < 2; ++ai)
#pragma unroll
            for (int m = 0; m < 4; ++m) { const size_t off = (size_t)(row0 + ai * 128 + m * 16) * DM + col0;
#pragma unroll
                for (int bj = 0; bj < 2; ++bj)
#pragma unroll
                    for (int n = 0; n < 2; ++n) { const pg8::f32x4 bs = *(const pg8::f32x4*)(base + off + bj * 128 + n * 16); *(pg8::f32x4*)(out + off + bj * 128 + n * 16) = bs + gv[bj][n] * acc[ai][bj][m][n]; } }
    }
};
struct EpiResScatter {
    static constexpr bool PERM = false;
    float* x; const float* gate; int gstride; const int* perm; ClassTab T;
    __device__ __forceinline__ void operator()(const pg8::f32x4 (&acc)[2][2][4][2], const pg8::Unit& u, int wr, int wc, int fr, int fq) const {
        const int n = T.ncls[u.cls]; const int col0 = u.pn * 256 + wc * 32 + 4 * fq;
#pragma unroll
        for (int ai = 0; ai < 2; ++ai)
#pragma unroll
            for (int m = 0; m < 4; ++m) { const int pos = u.lb * 256 + ai * 128 + wr * 64 + m * 16 + fr;
                if (pos < n) { const int tok = perm[(size_t)u.cls * CLS_CAP + pos]; const size_t off = (size_t)tok * DM + col0; const float* gp = gate + (size_t)(tok >> 12) * gstride + col0;
#pragma unroll
                    for (int bj = 0; bj < 2; ++bj)
#pragma unroll
                        for (int nn = 0; nn < 2; ++nn) { const pg8::f32x4 gv = *(const pg8::f32x4*)(gp + bj * 128 + nn * 16); const pg8::f32x4 bs = *(const pg8::f32x4*)(x + off + bj * 128 + nn * 16);
                            *(pg8::f32x4*)(x + off + bj * 128 + nn * 16) = bs + gv * acc[ai][bj][m][nn]; } } }
    }
};
struct EpiAct {
    static constexpr bool PERM = true;
    bf16* act; const int* perm; const float2* wts; ClassTab T;
    __device__ __forceinline__ void operator()(const pg8::f32x4 (&acc)[2][2][4][2], const pg8::Unit& u, int wr, int wc, int fr, int fq) const {
        const int n = T.ncls[u.cls]; const int second = u.pn >> 2; const int col0 = second * 512 + (u.pn & 3) * 128 + wc * 32 + 8 * fq;
#pragma unroll
        for (int ai = 0; ai < 2; ++ai)
#pragma unroll
            for (int m = 0; m < 4; ++m) { const int lr = ai * 128 + wr * 64 + m * 16 + fr; int pos = u.lb * 256 + lr; pos = pos < n ? pos : n - 1;
                const int tok = perm[(size_t)u.cls * CLS_CAP + pos]; const float2 w2 = wts[tok]; const float wt = second ? w2.y : w2.x;
                pg8::f32x4 g0 = acc[ai][0][m][0], g1 = acc[ai][0][m][1]; const pg8::f32x4 u0 = acc[ai][1][m][0], u1 = acc[ai][1][m][1];
#pragma unroll
                for (int j = 0; j < 4; ++j) { g0[j] = g0[j] * pg8::sigmoidf_(g0[j]) * u0[j] * wt; g1[j] = g1[j] * pg8::sigmoidf_(g1[j]) * u1[j] * wt; }
                pg8::u32x4 w; w.x = pg8::cvt_pk_bf16(g0[0], g0[1]); w.y = pg8::cvt_pk_bf16(g0[2], g0[3]); w.z = pg8::cvt_pk_bf16(g1[0], g1[1]); w.w = pg8::cvt_pk_bf16(g1[2], g1[3]);
                *(pg8::u32x4*)(act + (size_t)(u.pm * 256 + lr) * DM + col0) = w; }
    }
};
__device__ __forceinline__ void build_class_tab(Frame& F, gu32* gcnt) {
    LAS int* blkstart = (LAS int*)(F.lds + TAB_OFF); LAS int* ncls = blkstart + 32;
    if (F.tid == 0) { int run = 0; for (int c = 0; c < NCLS; ++c) { const int n = (int)__hip_atomic_load(gcnt + c, RLX_AGENT); ncls[c] = n; blkstart[c] = run; run += (n + 255) >> 8; } blkstart[NCLS] = run; }
    __syncthreads();
}

__global__ void __launch_bounds__(NWAVES * 64, 2) mk_fwd(Args args) {
    extern __shared__ __attribute__((aligned(16))) unsigned char lds[];
    Frame F;
    F.lds = (LAS unsigned char*)lds;
    F.MISC = (volatile LAS unsigned*)(F.lds + MISC_OFF);
    F.tid = threadIdx.x; F.lane = F.tid & 63; F.wave = __builtin_amdgcn_readfirstlane(F.tid >> 6);
    F.G = gridDim.x; { const int bx = blockIdx.x; F.vcu = (F.G % 8 == 0) ? (bx % 8) * (F.G / 8) + bx / 8 : bx; }
    unsigned char* ws = args.ws;
    F.ctl = (gu32*)(ws + WS_CTL);
    for (int u = F.tid; u < (LDS_BYTES - LDSCTL_OFF) / 4; u += NWAVES * 64) ((LAS unsigned*)(F.lds + LDSCTL_OFF))[u] = 0u;
    __syncthreads();
    const int lo = args.ph_lo, hi = args.ph_hi;
    const bool multi = (hi - lo) > 1;
    XcdBarrier bar; bar.bar = (unsigned*)(F.ctl + CW_BAR); bar.x = 0; bar.st = nullptr;
    if (multi) bar = xcd_barrier_post((unsigned*)(F.ctl + CW_BAR), F.MISC + 8);
    int ph = 0;
#define PH_BEGIN(run) const bool run = (lo <= ph && ph < hi); ++ph;
#define PH_END(run) do { if (run && ph < hi) xcd_barrier(bar); } while (0)

    float* const X = args.out;

    { PH_BEGIN(run) if (run) {
#ifndef DIS_P0
 p0_prologue(F, args);
#endif
 } PH_END(run); }

    for (int step = 0; step < 5; ++step) {
        unsigned char* ws = args.ws; asm volatile("" : "+s"(ws));
        float* const MODS = (float*)(ws + WS_MODS);
        bf16* const HB = (bf16*)(ws + WS_HB);
        bf16* const BIG = (bf16*)(ws + WS_BIG);
        bf16* const ACT = (bf16*)(ws + WS_ACT);
        float* const G16 = (float*)(ws + WS_G16);
        float* const FB = (float*)(ws + WS_FB);
        float2* const WTS = (float2*)(ws + WS_WTS);
        int* const PERM = (int*)(ws + WS_PERM);
        bf16* const Kb = BIG; bf16* const Vb = BIG + (size_t)NT * DM; bf16* const Qb = BIG + (size_t)2 * NT * DM;
        const int kind = step < 2 ? 0 : step == 2 ? 1 : 2;
        const int L = step < 2 ? step : step == 2 ? 2 : step - 1;
        const float* xin = (L == 0) ? args.in[I_X] : X;
        const float* mods = MODS + (size_t)L * NB * 6144;
        { PH_BEGIN(run) if (run) {
#ifndef DIS_NORM1
            const float* gam = kind == 1 ? args.in[I_KVNORM] : args.in[I_NMIX] + L * DM;
            const float* shf = kind == 1 ? (const float*)(ws + WS_KVMOD) : mods; const float* scl = shf + 1024; const int mstr = kind == 1 ? 2048 : 6144;
            const int nmode = kind == 0 ? 1 : kind == 1 ? 2 : 0;
            const float* w16 = kind == 0 ? args.in[I_AWIN] + (size_t)L * DM * A_IN + A_PROJ : args.in[I_WKV] + 2048; const int ldw16 = kind == 0 ? A_IN : KV_OUT;
            const float* b16 = kind == 0 ? args.in[I_ABG] + L * 16 : args.in[I_BFG];
            norm_phase<false>(F, xin, gam, shf, scl, mstr, HB, nmode, w16, ldw16, b16, G16, nullptr, nullptr, nullptr);
#endif
          } PH_END(run); }
        { PH_BEGIN(run) if (run) {
#ifndef DIS_PROJ
            if (kind == 1) fcum_phase(F, G16, FB);
            DenseProb P; P.A = HB; P.lda = DM; P.ldb = DM; P.K = DM;
            EpiProj E; E.split_cols = 0; E.split_stride = 0; E.nscale = 0; E.scale = 1.f; E.sig_from = 1 << 30;
            if (kind == 0) { P.Bt = (const bf16*)(ws + WS_WIN) + (size_t)L * A_PROJ * DM; P.S.init(NT / 256, A_PROJ / 256, F.G, (int)blockIdx.x); E.O = BIG; E.ldc = A_PROJ; E.nscale = 2; E.scale = 0.125f; E.sig_from = 8; }
            else if (kind == 1) { P.Bt = (const bf16*)(ws + WS_WKV); P.S.init(NT / 256, 8, F.G, (int)blockIdx.x); E.O = Kb; E.ldc = DM; E.split_cols = 1024; E.split_stride = (size_t)NT * DM; }
            else { P.Bt = (const bf16*)(ws + WS_WQ) + (size_t)(L - 2) * DM * DM; P.S.init(NT / 256, 4, F.G, (int)blockIdx.x); E.O = Qb; E.ldc = DM; E.nscale = 4; E.scale = attn_body::C2; }
            pg8::gemm_phase<EpiProj, DenseProb, true>(F.lds + RING_OFF, P, E);
#endif
          } PH_END(run); }
        if (kind == 1) continue;
        { PH_BEGIN(run) if (run) {
#ifndef DIS_CELL
            if (kind == 0) cell_phase(F, BIG, G16, args.in[I_AMH] + L * DM, HB);
#endif
#ifndef DIS_ATTN
            if (kind == 2) { const attn_body::AttnTensors AT{(const attn_body::bf16*)Qb, (const attn_body::bf16*)Kb, (const attn_body::bf16*)Vb, (attn_body::bf16*)Qb, FB};
                   attn_body::attn_phase<8>((char*)lds + RING_OFF, AT, F.vcu, F.G); }
#endif
          } PH_END(run); }
        { PH_BEGIN(run) if (run) {
#ifndef DIS_OUT
            DenseProb P; P.A = kind == 0 ? HB : Qb; P.lda = DM; P.ldb = DM; P.K = DM;
            P.Bt = kind == 0 ? (const bf16*)(ws + WS_WOUT) + (size_t)L * DM * DM : (const bf16*)(ws + WS_WO) + (size_t)(L - 2) * DM * DM;
            P.S.init(NT / 256, 4, F.G, (int)blockIdx.x);
            EpiRes E; E.base = xin; E.out = X; E.gate = mods + 2048; E.gstride = 6144;
            pg8::gemm_phase<EpiRes, DenseProb, true>(F.lds + RING_OFF, P, E);
#endif
          } PH_END(run); }
        gu32* const gcnt = (gu32*)(ws + WS_CTL) + CW_CNT + L * 32;
        { PH_BEGIN(run) if (run) {
#ifndef DIS_NORM2
            norm_phase<true>(F, X, args.in[I_NFFN] + L * DM, mods + 3072, mods + 4096, 6144, HB, 3, args.in[I_WR], 16, args.in[I_RB], nullptr, WTS, PERM, gcnt);
#endif
          } PH_END(run); }
        const ClassTab CT{(const LAS int*)(F.lds + TAB_OFF), (const LAS int*)(F.lds + TAB_OFF) + 32};
        { PH_BEGIN(run) if (run) {
#ifndef DIS_MOE1
            build_class_tab(F, gcnt);
            Moe1Prob P; P.A = HB; P.ldb = DM; P.K = DM; P.Bt1l = (const bf16*)(ws + WS_BT1) + (size_t)L * 16 * 1024 * DM; P.perm = PERM; P.T = CT;
            P.S.init(CT.blkstart[NCLS], 8, F.G, (int)blockIdx.x);
            EpiAct E; E.act = ACT; E.perm = PERM; E.wts = WTS; E.T = CT;
            pg8::gemm_phase<EpiAct, Moe1Prob, true>(F.lds + RING_OFF, P, E);
#endif
          } PH_END(run); }
        { PH_BEGIN(run) if (run) {
#ifndef DIS_MOE2
            build_class_tab(F, gcnt);
            Moe2Prob P; P.A = ACT; P.ldb = DE; P.K = DM; P.Bt2l = (const bf16*)(ws + WS_BT2) + (size_t)L * 16 * DM * DE; P.T = CT;
            P.S.init(CT.blkstart[NCLS], 4, F.G, (int)blockIdx.x);
            EpiResScatter E; E.x = X; E.gate = mods + 5120; E.gstride = 6144; E.perm = PERM; E.T = CT;
            pg8::gemm_phase<EpiResScatter, Moe2Prob, true>(F.lds + RING_OFF, P, E);
#endif
          } PH_END(run); }
    }
    { PH_BEGIN(run) if (run) {
#ifndef DIS_FINAL
 final_norm_phase(F, X, args.in[I_NFIN], (const float*)(args.ws + WS_FIN), (const float*)(args.ws + WS_FIN) + 1024, 2048);
#endif
 } }
#undef PH_BEGIN
#undef PH_END
}
constexpr int N_PHASES = 1 + 2 * 7 + 2 + 2 * 7 + 1;

#ifndef MK_SPLIT
#define MK_SPLIT 0
#endif
extern "C" void kernel_launch(void* const* d_in, const int* in_sizes, int n_in, void* d_out, int out_size, void* d_ws, size_t ws_size, hipStream_t stream) {
    static int grid = 0;
    if (grid == 0) {
        if (n_in != 25 || in_sizes[0] != NT * DM || out_size != NT * DM || ws_size < WS_END) { fprintf(stderr, "kernel_launch: unexpected shapes (n_in %d, in0 %d, out %d, ws %zu); nothing launched\n", n_in, n_in > 0 ? in_sizes[0] : -1, out_size, ws_size); grid = -1; return; }
        int dev = 0, cus = 0, per_cu = 0;
        if (hipGetDevice(&dev) != hipSuccess || hipDeviceGetAttribute(&cus, hipDeviceAttributeMultiprocessorCount, dev) != hipSuccess) { grid = -1; return; }
        if (hipFuncSetAttribute((const void*)mk_fwd, hipFuncAttributeMaxDynamicSharedMemorySize, LDS_BYTES) != hipSuccess) { fprintf(stderr, "kernel_launch: hipFuncSetAttribute failed\n"); grid = -1; return; }
        if (hipOccupancyMaxActiveBlocksPerMultiprocessor(&per_cu, (const void*)mk_fwd, NWAVES * 64, LDS_BYTES) != hipSuccess || per_cu < 1) { fprintf(stderr, "kernel_launch: occupancy query reports %d workgroups per CU\n", per_cu); }
        (void)hipGetLastError();
        grid = cus;
    }
    if (grid < 0) return;
    if (hipMemsetAsync((char*)d_ws + WS_CTL, 0, CTL_ZERO_BYTES, stream) != hipSuccess) return;
    Args a{};
    for (int i = 0; i < 25; ++i) a.in[i] = (const float*)d_in[i];
    a.out = (float*)d_out; a.ws = (unsigned char*)d_ws;
#if MK_SPLIT
    for (int p = 0; p < N_PHASES; ++p) { a.ph_lo = p; a.ph_hi = p + 1; hipLaunchKernelGGL(mk_fwd, dim3(grid), dim3(NWAVES * 64), LDS_BYTES, stream, a); }
#else
    a.ph_lo = 0; a.ph_hi = N_PHASES;
    hipLaunchKernelGGL(mk_fwd, dim3(grid), dim3(NWAVES * 64), LDS_BYTES, stream, a);
#endif
}
```

```cpp
#include <hip/hip_runtime.h>
#include <hip/hip_bf16.h>
#include <cstdio>
#include <cstdint>
#define LAS __attribute__((address_space(3)))
#define GAS __attribute__((address_space(1)))

namespace pg8 {
typedef unsigned short bf16_t;
typedef short bf16x8 __attribute__((ext_vector_type(8)));
typedef float f32x4 __attribute__((ext_vector_type(4)));
typedef unsigned u32x4 __attribute__((ext_vector_type(4)));
typedef unsigned u32x2 __attribute__((ext_vector_type(2)));
constexpr int BM = 256, BK = 64, HALF = 128, HTB = HALF * BK * 2  , STAGE_BYTES = 8 * HTB, NXCD = 8, WGM = 8;

__host__ __device__ __forceinline__ int lds_byte(int r, int c) { const int st = (r >> 4) * 2 + (c >> 5), rr = r & 15, cc = c & 31, ob = rr * 64 + cc * 2; return st * 1024 + (ob ^ (((ob >> 9) & 1) << 5)); }
__host__ __device__ __forceinline__ void stage_rc(int b, int& R, int& C) { const int st = b / 1024, sb = b % 1024, swz = sb ^ (((sb >> 9) & 1) << 5); R = (st >> 1) * 16 + swz / 64; C = (st & 1) * 32 + (swz % 64) / 2; }
__host__ __device__ __forceinline__ int perm32(int rho) { const int n = rho >> 4, i = rho & 15; return 8 * (i >> 2) + 4 * n + (i & 3); }

struct Unit { int pm, pn, cls, lb; };

struct StaticOrder {
    int nM, nN, nwg, G, c;
    __device__ __forceinline__ void init(int nM_, int nN_, int G_, int c_) { nM = nM_; nN = nN_; nwg = nM * nN; G = G_; c = c_; }
    __device__ __forceinline__ bool next(int i, Unit& u) const {
        const long L = (long)i * G + c; if (L >= nwg) return false;
        int wgid = (int)L; { const int q = nwg / NXCD, r = nwg % NXCD, xcd = wgid % NXCD, off = wgid / NXCD; wgid = (xcd < r ? xcd * (q + 1) : r * (q + 1) + (xcd - r) * q) + off; }
        const int nig = WGM * nN, gid = wgid / nig, fm = gid * WGM, gsz = (nM - fm) < WGM ? (nM - fm) : WGM;
        u.pm = fm + ((wgid % nig) % gsz); u.pn = (wgid % nig) / gsz; u.cls = 0; u.lb = 0; return true;
    }
};

__device__ __forceinline__ unsigned cvt_pk_bf16(float lo, float hi) { unsigned r; asm volatile("v_cvt_pk_bf16_f32 %0, %1, %2" : "=v"(r) : "v"(lo), "v"(hi)); return r; }
__device__ __forceinline__ float sigmoidf_(float x) { return __builtin_amdgcn_rcpf(1.0f + __expf(-x)); }

template <class Epi, class Prob, bool ALIGN_EPI>
__device__ __forceinline__ void gemm_phase(LAS unsigned char* lds, const Prob& S, const Epi& E) {
    int tid_ = threadIdx.x; asm volatile("" : "+v"(tid_));
    const int tid = tid_, wid = __builtin_amdgcn_readfirstlane(tid >> 6), lane = tid & 63, wr = wid >> 2, wc = wid & 3, fr = lane & 15, fq = lane >> 4;
    const int K = S.K, nt = K / BK;
    int R0, C0; stage_rc(tid * 16, R0, C0);
    const int Rb0 = Epi::PERM ? ((R0 & ~31) + perm32(R0 & 31)) : R0;
    unsigned voffB[2]; voffB[0] = (unsigned)(Rb0 * S.ldb + C0) * 2u; voffB[1] = (unsigned)((Rb0 + 64) * S.ldb + C0) * 2u;
    const size_t hstepB = (size_t)HALF * S.ldb * 2;
    const unsigned ldsw = (unsigned)wid * 1024u;
    const int aoff_l = lds_byte(wr * 64 + fr, fq * 8), boff_l = lds_byte(wc * 32 + fr, fq * 8);
    const char* const Ab = S.a_base();
#define PG8_SA(b, h) (((b) * 2 + (h)) * HTB)
#define PG8_SB(b, h) ((4 + (b) * 2 + (h)) * HTB)
#define PG8_STA(bufoff, h, tt) do { _Pragma("unroll") for (int _i = 0; _i < 2; ++_i) \
        __builtin_amdgcn_global_load_lds((const unsigned*)(Ab + (size_t)aoff[h][_i] + (size_t)(tt) * (BK * 2)), (LAS unsigned*)(lds + (bufoff) + ldsw + _i * 8192), 16, 0, 0); } while (0)
#define PG8_STB(bufoff, bp, h) do { _Pragma("unroll") for (int _i = 0; _i < 2; ++_i) \
        __builtin_amdgcn_global_load_lds((const unsigned*)((bp) + (h) * hstepB + voffB[_i]), (LAS unsigned*)(lds + (bufoff) + ldsw + _i * 8192), 16, 0, 0); } while (0)
#define PG8_LDA(dst, b, h) do { _Pragma("unroll") for (int m = 0; m < 4; ++m) _Pragma("unroll") for (int k = 0; k < 2; ++k) dst[m][k] = *(const LAS bf16x8*)(lds + PG8_SA(b, h) + aoff_l + m * 2048 + k * 1024); } while (0)
#define PG8_LDB(dst, b, h) do { _Pragma("unroll") for (int n = 0; n < 2; ++n) _Pragma("unroll") for (int k = 0; k < 2; ++k) dst[n][k] = *(const LAS bf16x8*)(lds + PG8_SB(b, h) + boff_l + n * 2048 + k * 1024); } while (0)
#define PG8_MMA(ai, bj, At, Bt) do { __builtin_amdgcn_s_setprio(1); _Pragma("unroll") for (int m = 0; m < 4; ++m) _Pragma("unroll") for (int n = 0; n < 2; ++n) _Pragma("unroll") for (int k = 0; k < 2; ++k) \
        acc[ai][bj][m][n] = __builtin_amdgcn_mfma_f32_16x16x32_bf16(Bt[n][k], At[m][k], acc[ai][bj][m][n], 0, 0, 0); __builtin_amdgcn_s_setprio(0); } while (0)
#define PG8_WAIT_V(n) asm volatile("s_waitcnt vmcnt(" #n ")" ::: "memory")
#define PG8_WAIT_L(n) asm volatile("s_waitcnt lgkmcnt(" #n ")" ::: "memory")
#define PG8_BAR __builtin_amdgcn_s_barrier()
#define PG8_SCHED __builtin_amdgcn_sched_barrier(0)
    Unit cur, nxt; int ui = 0;
    if (!S.next(0, cur)) return;
    f32x4 acc[2][2][4][2];
#pragma unroll
    for (int a = 0; a < 2; ++a)
#pragma unroll
        for (int b = 0; b < 2; ++b)
#pragma unroll
            for (int m = 0; m < 4; ++m)
#pragma unroll
                for (int n = 0; n < 2; ++n) acc[a][b][m][n] = (f32x4){0.f, 0.f, 0.f, 0.f};
    bf16x8 At[4][2], B0[2][2], B1[2][2];
    unsigned aoff[2][2], aoffN[2][2];
    S.a_off(cur, R0, C0, aoff);
    { const char* bp0 = S.b_tile(cur, 0); const char* bp1 = S.b_tile(cur, 1);
      PG8_STB(PG8_SB(0, 0), bp0, 0); PG8_STB(PG8_SB(0, 1), bp0, 1); PG8_STA(PG8_SA(0, 0), 0, 0); PG8_STA(PG8_SA(0, 1), 1, 0);
      if (wr == 1) PG8_BAR;
      PG8_WAIT_V(2); PG8_BAR;
      PG8_STB(PG8_SB(1, 0), bp1, 0); PG8_STA(PG8_SA(1, 0), 0, 1); PG8_STB(PG8_SB(1, 1), bp1, 1);
      PG8_WAIT_V(6); PG8_BAR; }
    for (;;) {
        const bool has_next = S.next(ui + 1, nxt);
        for (int t = 0; t < nt; t += 2) {
            const bool last = (t == nt - 2);
            if (last) { if (has_next) S.a_off(nxt, R0, C0, aoffN); else { aoffN[0][0] = aoff[0][0]; aoffN[0][1] = aoff[0][1]; aoffN[1][0] = aoff[1][0]; aoffN[1][1] = aoff[1][1]; } }
            PG8_LDB(B0, 0, 0); PG8_LDB(B1, 0, 1); PG8_SCHED; PG8_LDA(At, 0, 0); PG8_STA(PG8_SA(1, 1), 1, t + 1);
            PG8_WAIT_V(8); PG8_WAIT_L(0); PG8_BAR; PG8_MMA(0, 0, At, B0); PG8_MMA(0, 1, At, B1); PG8_BAR; PG8_SCHED;
            const int t2 = last ? 0 : t + 2;
            const Unit& u2 = (last && has_next) ? nxt : cur;
            if (last) { aoff[0][0] = aoffN[0][0]; aoff[0][1] = aoffN[0][1]; aoff[1][0] = aoffN[1][0]; aoff[1][1] = aoffN[1][1]; }
            const char* b2 = S.b_tile(u2, t2); const char* b3 = S.b_tile(u2, t2 + 1);
            PG8_LDA(At, 0, 1); PG8_STB(PG8_SB(0, 0), b2, 0); PG8_STB(PG8_SB(0, 1), b2, 1); PG8_STA(PG8_SA(0, 0), 0, t2);
            PG8_WAIT_V(8); PG8_WAIT_L(0); PG8_BAR; PG8_MMA(1, 0, At, B0); PG8_MMA(1, 1, At, B1); PG8_BAR; PG8_SCHED;
            PG8_LDB(B0, 1, 0); PG8_LDB(B1, 1, 1); PG8_SCHED; PG8_LDA(At, 1, 0); PG8_STA(PG8_SA(0, 1), 1, t2);
            PG8_WAIT_V(8); PG8_WAIT_L(0); PG8_BAR; PG8_MMA(0, 0, At, B0); PG8_MMA(0, 1, At, B1); PG8_BAR; PG8_SCHED;
            PG8_LDA(At, 1, 1); PG8_STB(PG8_SB(1, 0), b3, 0); PG8_STB(PG8_SB(1, 1), b3, 1); PG8_STA(PG8_SA(1, 0), 0, t2 + 1);
            PG8_WAIT_V(8); PG8_WAIT_L(0); PG8_BAR; PG8_MMA(1, 0, At, B0); PG8_MMA(1, 1, At, B1); PG8_BAR; PG8_SCHED;
        }
        if constexpr (ALIGN_EPI) { if (wr == 0) PG8_BAR; }
        E(acc, cur, wr, wc, fr, fq);
        if (!has_next) break;
#pragma unroll
        for (int a = 0; a < 2; ++a)
#pragma unroll
            for (int b = 0; b < 2; ++b)
#pragma unroll
                for (int m = 0; m < 4; ++m)
#pragma unroll
                    for (int n = 0; n < 2; ++n) acc[a][b][m][n] = (f32x4){0.f, 0.f, 0.f, 0.f};
        cur = nxt; ++ui;
        if constexpr (ALIGN_EPI) { if (wr == 1) PG8_BAR; }
    }
    PG8_WAIT_V(0);
    if constexpr (!ALIGN_EPI) { if (wr == 0) PG8_BAR; }
    PG8_BAR;
#undef PG8_SA
#undef PG8_SB
#undef PG8_STA
#undef PG8_STB
#undef PG8_LDA
#undef PG8_LDB
#undef PG8_MMA
#undef PG8_WAIT_V
#undef PG8_WAIT_L
#undef PG8_BAR
#undef PG8_SCHED
}
}

#include <hip/hip_bf16.h>
#include <cmath>
namespace attn_body {
using bf16=__hip_bfloat16;
using bf16x8=__attribute__((ext_vector_type(8)))short;
using s16x4=__attribute__((ext_vector_type(4)))short;
using f32x16=__attribute__((ext_vector_type(16)))float;
using u32x4=__attribute__((ext_vector_type(4)))unsigned;
constexpr int BATCH=16,NHEAD=16,SEQ=4096,D=64,DM=NHEAD*D;
constexpr int NW=8,QBLK=32,QB=QBLK*NW,KVBLK=64,NQB=SEQ/QB;
constexpr int ATTN_PITCH=DM, ATTN_UNIT_ROWS=QB;
__device__ __forceinline__ int crow(int r,int hi){return (r&3)+8*(r>>2)+4*hi;}
#define SBAR() __builtin_amdgcn_sched_barrier(0)
__device__ __forceinline__ void cmask(f32x16&p0,f32x16&p1,int jb,int qrel,int hi){
  const float NEG=-INFINITY; int kb=64*jb+4*hi;
  #pragma unroll
  for(int r=0;r<16;++r){int kv=kb+(r&3)+8*(r>>2); if(kv>qrel)p0[r]=NEG; if(kv+32>qrel)p1[r]=NEG;}
}

constexpr int NSLOT=3, SLOTB=8192;
constexpr int LDS_K=0, LDS_V=NSLOT*SLOTB, LDS_WS=2*NSLOT*SLOTB, LDS_OST=LDS_WS+NW*64*4, LDS_BYTES=LDS_OST+NW*4096;
constexpr float C2=0.125f*1.4426950408889634f;
__device__ __forceinline__ void glds16(const void*gsrc,unsigned lds_dst){unsigned keep;
  asm volatile("s_mov_b32 %0, m0\n\ts_mov_b32 m0, %2\n\ts_nop 0\n\tglobal_load_lds_dwordx4 %1, off\n\ts_mov_b32 m0, %0":"=&s"(keep):"v"(gsrc),"s"(lds_dst):"memory");}
__device__ __forceinline__ float max3f(float a,float b,float c){float r;asm("v_max3_f32 %0, %1, %2, %3":"=v"(r):"v"(a),"v"(b),"v"(c));return r;}
__device__ __forceinline__ float max2f(float a,float b){float r;asm("v_max_f32_e32 %0, %1, %2":"=v"(r):"v"(a),"v"(b));return r;}
__device__ __forceinline__ float fadd_s(float a,float b){float r;asm("v_add_f32_e32 %0, %1, %2":"=v"(r):"v"(a),"v"(b));return r;}
__device__ __forceinline__ float fsub_s(float a,float b){float r;asm("v_sub_f32_e32 %0, %1, %2":"=v"(r):"v"(a),"v"(b));return r;}
typedef float f32x2_t __attribute__((ext_vector_type(2))); typedef __bf16 bf16x2_t __attribute__((ext_vector_type(2)));
__device__ __forceinline__ unsigned cvtpk_s(float lo,float hi){f32x2_t v={lo,hi};bf16x2_t b=__builtin_convertvector(v,bf16x2_t);return __builtin_bit_cast(unsigned,b);}
#define WAIT_BAR(N) asm volatile("s_waitcnt vmcnt(" #N ") lgkmcnt(0)\n\ts_barrier":::"memory")

__device__ __forceinline__ void qkt(f32x16&p0,f32x16&p1,const char*Kslot,const bf16x8*qr,const f32x16&c0,const f32x16&c1,int r32,int hi){
  const char*kb=Kslot+hi*1024+r32*16;
  #pragma unroll
  for(int d0=0;d0<4;++d0){
    const bf16x8 b0=*reinterpret_cast<const bf16x8*>(kb+d0*2048);
    const bf16x8 b1=*reinterpret_cast<const bf16x8*>(kb+d0*2048+512);
    if(d0==0){p0=__builtin_amdgcn_mfma_f32_32x32x16_bf16(b0,qr[0],c0,0,0,0);p1=__builtin_amdgcn_mfma_f32_32x32x16_bf16(b1,qr[0],c1,0,0,0);}
    else{p0=__builtin_amdgcn_mfma_f32_32x32x16_bf16(b0,qr[d0],p0,0,0,0);p1=__builtin_amdgcn_mfma_f32_32x32x16_bf16(b1,qr[d0],p1,0,0,0);}}
}
typedef __attribute__((address_space(3))) const char* lds_cptr;
typedef short v4i16_t __attribute__((ext_vector_type(4)));
__device__ __forceinline__ void kload8(bf16x8*kf,lds_cptr kp){
  kf[0]=*(const __attribute__((address_space(3))) bf16x8*)(kp);      kf[1]=*(const __attribute__((address_space(3))) bf16x8*)(kp+512);
  kf[2]=*(const __attribute__((address_space(3))) bf16x8*)(kp+2048); kf[3]=*(const __attribute__((address_space(3))) bf16x8*)(kp+2560);
  kf[4]=*(const __attribute__((address_space(3))) bf16x8*)(kp+4096); kf[5]=*(const __attribute__((address_space(3))) bf16x8*)(kp+4608);
  kf[6]=*(const __attribute__((address_space(3))) bf16x8*)(kp+6144); kf[7]=*(const __attribute__((address_space(3))) bf16x8*)(kp+6656);
}
__device__ __forceinline__ void kload2(bf16x8*kf,lds_cptr kp,int j){ kf[2*j]=*(const __attribute__((address_space(3))) bf16x8*)(kp+j*2048); kf[2*j+1]=*(const __attribute__((address_space(3))) bf16x8*)(kp+j*2048+512); }
__device__ __forceinline__ s16x4 vtr(lds_cptr p){ return __builtin_bit_cast(s16x4,__builtin_amdgcn_ds_read_tr16_b64_v4i16((__attribute__((address_space(3))) v4i16_t*)p)); }
__device__ __forceinline__ float rowmax(const f32x16&p0,const f32x16&p1){
  float a=max3f(p0[0],p0[1],p1[0]),b=max3f(p0[2],p0[3],p1[1]);a=max3f(a,p1[2],p1[3]);
  #pragma unroll
  for(int r=4;r<16;r+=4){a=max3f(a,p0[r],p0[r+1]);b=max3f(b,p0[r+2],p0[r+3]);a=max3f(a,p1[r],p1[r+1]);b=max3f(b,p1[r+2],p1[r+3]);}
  const float m=max2f(a,b);
  auto rr=__builtin_amdgcn_permlane32_swap(__float_as_uint(m),__float_as_uint(m),false,false);
  return max2f(__uint_as_float(rr[0]),__uint_as_float(rr[1]));
}
__device__ __forceinline__ void pv(f32x16*o,int vb,bf16x8 pa0,bf16x8 pa1,bf16x8 pa2,bf16x8 pa3){
  #pragma unroll
  for(int d0=0;d0<2;++d0){s16x4 lo[4],hi[4];
    #pragma unroll
    for(int ks=0;ks<4;++ks){
      asm volatile("ds_read_b64_tr_b16 %0,%1 offset:%c2":"=&v"(lo[ks]):"v"(vb),"i"(d0*4096+ks*1024):"memory");
      asm volatile("ds_read_b64_tr_b16 %0,%1 offset:%c2":"=&v"(hi[ks]):"v"(vb),"i"(d0*4096+ks*1024+512):"memory");}
    asm volatile("s_waitcnt lgkmcnt(0)":::"memory");SBAR();
    #define PK(k) (bf16x8){lo[k][0],lo[k][1],lo[k][2],lo[k][3],hi[k][0],hi[k][1],hi[k][2],hi[k][3]}
    o[d0]=__builtin_amdgcn_mfma_f32_32x32x16_bf16(pa0,PK(0),o[d0],0,0,0);
    o[d0]=__builtin_amdgcn_mfma_f32_32x32x16_bf16(pa1,PK(1),o[d0],0,0,0);
    o[d0]=__builtin_amdgcn_mfma_f32_32x32x16_bf16(pa2,PK(2),o[d0],0,0,0);
    o[d0]=__builtin_amdgcn_mfma_f32_32x32x16_bf16(pa3,PK(3),o[d0],0,0,0);
    #undef PK
  }
}

#ifndef ATTN_STORE16
#define ATTN_STORE16(p,v) (*(u32x4*)(p)=(v))
#endif
typedef float f32x4_t __attribute__((ext_vector_type(4)));
typedef __attribute__((address_space(3))) const float* fb_lptr;
template<int THRL> __device__ __forceinline__ void attn_unit(int b,int h,int qb,const bf16*Q,const bf16*__restrict__ K,const bf16*__restrict__ V,bf16*O,char*shm,fb_lptr fbl){
  int tid_=threadIdx.x; asm volatile("":"+v"(tid_)); const int tid=tid_,lane=tid&63,r32=lane&31,hi=lane>>5; const int wid=__builtin_amdgcn_readfirstlane(tid>>6);
  const long rowbase=(long)b*SEQ; const int q0=qb*QB;
  const bf16*Qw=Q+(rowbase+q0+wid*QBLK)*DM+h*D;
  const bf16*Kh=K+rowbase*DM+h*D,*Vh=V+rowbase*DM+h*D;
  const unsigned lds0=(unsigned)(uintptr_t)shm;
  float*wsf=(float*)(shm+LDS_WS)+wid*64;
  const bf16*ksrc=Kh+(long)lane*DM+wid*8;
  const bf16*vsrc=Vh+(long)(16*(wid&3)+(lane>>2))*DM+(wid>>2)*32+(lane&3)*8;
  const unsigned kdst=lds0+LDS_K+wid*1024, vdst=lds0+LDS_V+wid*1024;
  #define DMA_K(t,slot) glds16(ksrc+(long)(t)*KVBLK*DM,(unsigned)__builtin_amdgcn_readfirstlane(kdst+(slot)))
  #define DMA_V(t,slot) glds16(vsrc+(long)(t)*KVBLK*DM,(unsigned)__builtin_amdgcn_readfirstlane(vdst+(slot)))
  const int vb0=(int)(lds0+LDS_V)+((lane>>4)&1)*32+(lane&3)*8+(4*hi+((lane&15)>>2))*64;
  const char*Kbase=shm+LDS_K; bf16x8 kf[8];
  const lds_cptr shm3=(lds_cptr)shm; const lds_cptr kp0=shm3+LDS_K+hi*1024+r32*16; const lds_cptr vp0=shm3+LDS_V+((lane>>4)&1)*32+(lane&3)*8+(4*hi+((lane&15)>>2))*64;
  const int NT=(q0+QB)/KVBLK;
  DMA_K(0,0);DMA_V(0,0);DMA_K(1,SLOTB);
  bf16x8 qr[4];
  #pragma unroll
  for(int d0=0;d0<4;++d0)qr[d0]=*reinterpret_cast<const bf16x8*>(&Qw[(long)r32*DM+d0*16+hi*8]);
  #define FBIAS(C0,C1,t) do{ const fb_lptr fp_=fbl+64*(t)+4*hi; const float nm_=-mhat; \
    _Pragma("unroll") for(int g_=0;g_<4;++g_){ const f32x4_t a_=*(const __attribute__((address_space(3))) f32x4_t*)(fp_+8*g_); const f32x4_t b_=*(const __attribute__((address_space(3))) f32x4_t*)(fp_+32+8*g_); \
      _Pragma("unroll") for(int i_=0;i_<4;++i_){ C0[4*g_+i_]=a_[i_]+nm_; C1[4*g_+i_]=b_[i_]+nm_; } SBAR(); } }while(0)
  float mhat=0.f,l_reg=0.f;f32x16 o[2];o[0]=f32x16{};o[1]=f32x16{};
  const int qrel=wid*QBLK+r32;
  #define CMASK(P0,P1,t) do{int jb_=(t)-(NT-4); if(jb_>=0)cmask(P0,P1,jb_,qrel,hi);}while(0)
  bool resc=false;
  #define START(P0,P1) do{ const float rm=rowmax(P0,P1); resc=false; \
    { const float dl=rm; mhat=fadd_s(mhat,dl); \
      _Pragma("unroll") for(int r=0;r<16;++r){P0[r]=fsub_s(P0[r],dl);P1[r]=fsub_s(P1[r],dl);} \
      } \
    _Pragma("unroll") for(int r=0;r<16;++r)P0[r]=__builtin_amdgcn_exp2f(P0[r]); }while(0)
  #define RESC() do{ if(resc){ asm volatile("s_waitcnt lgkmcnt(0)":::"memory"); \
      _Pragma("unroll") for(int d_=0;d_<2;++d_) _Pragma("unroll") for(int r=0;r<16;++r)o[d_][r]*=wsf[crow(r,hi)]; } }while(0)
  f32x16 pA0,pA1,pB0,pB1;
  int sl_prev=0,sl_cur=0,sl_next=SLOTB;
  #define ROT() do{sl_prev=sl_cur;sl_cur=sl_next;sl_next=(sl_next==(NSLOT-1)*SLOTB)?0:sl_next+SLOTB;}while(0)
  DMA_K(2,2*SLOTB);
  WAIT_BAR(3);
  FBIAS(pA0,pA1,0); qkt(pA0,pA1,Kbase,qr,pA0,pA1,r32,hi);asm volatile("s_nop 15\n\ts_nop 7":"+v"(pA0),"+v"(pA1));CMASK(pA0,pA1,0);
  START(pA0,pA1);
  _Pragma("unroll") for(int r=0;r<16;++r)pA1[r]=__builtin_amdgcn_exp2f(pA1[r]);
  WAIT_BAR(0);
  DMA_K(3,0);DMA_V(1,SLOTB);
  ROT();
  kload8(kf,kp0+sl_cur);
  WAIT_BAR(2);
  s16x4 vlo[8],vhi[8]; u32x4 pw0,pw1,pw2,pw3;
  #define PKW(P,B) cvtpk_s(P[B],P[B+1])
  #define PAF(k) __builtin_bit_cast(bf16x8,pw##k)
  #define VFR(i) (bf16x8){vlo[i][0],vlo[i][1],vlo[i][2],vlo[i][3],vhi[i][0],vhi[i][1],vhi[i][2],vhi[i][3]}
  #define PIN(x) asm volatile("":"+v"(x))
  #define MX3(a,b,c) __builtin_fmaxf(__builtin_fmaxf((a),(b)),(c))
  #define GAPA(MF,A0,A1,A2,A3,W0,W1,PW) do{ MF; sacc+=A0; sacc+=A1; sacc+=A2; sacc+=A3; PIN(sacc); W0; W1; PIN(PW); SBAR(); }while(0)
  #define EX(v) __builtin_amdgcn_exp2f(v)
  #define GAPB(MF,X,B) do{ MF; X[B]=EX(X[B]); X[B+1]=EX(X[B+1]); X[B+2]=EX(X[B+2]); X[B+3]=EX(X[B+3]); PIN(X); SBAR(); }while(0)
  #define VRD(i) do{ vlo[i]=vtr(vp_+(((i)>>2)*4096+((i)&3)*1024)); vhi[i]=vtr(vp_+(((i)>>2)*4096+((i)&3)*1024+512)); }while(0)
  #define KRD(G,j) do{ if(G){ kload2(kf,kp0+sl_next,j); SBAR(); } }while(0)
  #define STEP(C0,C1,P0,P1,t,GK,GV,GL) do{ SBAR(); FBIAS(C0,C1,t); SBAR(); \
    const lds_cptr vp_=vp0+sl_prev; \
    VRD(0); SBAR(); float sacc=(P0[0]+P0[1]); \
    GAPA(C0=__builtin_amdgcn_mfma_f32_32x32x16_bf16(kf[0],qr[0],C0,0,0,0), P0[2],P0[3],P0[4],P0[5],     pw0[0]=PKW(P0,0), pw0[1]=PKW(P0,2), pw0); \
    VRD(4); SBAR(); GAPA(C1=__builtin_amdgcn_mfma_f32_32x32x16_bf16(kf[1],qr[0],C1,0,0,0), P0[6],P0[7],P0[8],P0[9],     pw0[2]=PKW(P0,4), pw0[3]=PKW(P0,6), pw0); \
    VRD(1); SBAR(); GAPA(C0=__builtin_amdgcn_mfma_f32_32x32x16_bf16(kf[2],qr[1],C0,0,0,0),   P0[10],P0[11],P0[12],P0[13], pw1[0]=PKW(P0,8), pw1[1]=PKW(P0,10), pw1); \
    VRD(5); SBAR(); GAPA(C1=__builtin_amdgcn_mfma_f32_32x32x16_bf16(kf[3],qr[1],C1,0,0,0),   P0[14],P0[15],P1[0],P1[1],   pw1[2]=PKW(P0,12),pw1[3]=PKW(P0,14), pw1); \
    VRD(2); SBAR(); GAPA(C0=__builtin_amdgcn_mfma_f32_32x32x16_bf16(kf[4],qr[2],C0,0,0,0),   P1[2],P1[3],P1[4],P1[5],     pw2[0]=PKW(P1,0), pw2[1]=PKW(P1,2), pw2); \
    VRD(6); SBAR(); GAPA(C1=__builtin_amdgcn_mfma_f32_32x32x16_bf16(kf[5],qr[2],C1,0,0,0),   P1[6],P1[7],P1[8],P1[9],     pw2[2]=PKW(P1,4), pw2[3]=PKW(P1,6), pw2); \
    VRD(3); SBAR(); GAPA(C0=__builtin_amdgcn_mfma_f32_32x32x16_bf16(kf[6],qr[3],C0,0,0,0),   P1[10],P1[11],P1[12],P1[13], pw3[0]=PKW(P1,8), pw3[1]=PKW(P1,10), pw3); \
    VRD(7); SBAR(); GAPA(C1=__builtin_amdgcn_mfma_f32_32x32x16_bf16(kf[7],qr[3],C1,0,0,0),   P1[14],P1[15],0.f,0.f,       pw3[2]=PKW(P1,12),pw3[3]=PKW(P1,14), pw3); \
    l_reg+=sacc; \
    if(GK){DMA_K((t)+3,sl_cur);} if(GV){DMA_V((t)+1,sl_next);} \
    CMASK(C0,C1,t); \
    { float a=MX3(C0[0],C0[1],C1[0]),b=MX3(C0[2],C0[3],C1[1]); a=MX3(a,C1[2],C1[3]); \
      _Pragma("unroll") for(int r=4;r<16;r+=4){a=MX3(a,C0[r],C0[r+1]);b=MX3(b,C0[r+2],C0[r+3]);a=MX3(a,C1[r],C1[r+1]);b=MX3(b,C1[r+2],C1[r+3]);} \
      float rm=__builtin_fmaxf(a,b); { auto rr=__builtin_amdgcn_permlane32_swap(__float_as_uint(rm),__float_as_uint(rm),false,false); rm=__builtin_fmaxf(__uint_as_float(rr[0]),__uint_as_float(rr[1])); } \
      resc=false; \
      if(__builtin_expect(__any(rm>(float)THRL),0)){ const float dl=__builtin_fmaxf(rm,0.f); mhat+=dl; \
        _Pragma("unroll") for(int r=0;r<16;++r){C0[r]-=dl;C1[r]-=dl;} \
        const float f=__builtin_amdgcn_exp2f(-dl); l_reg*=f; if(hi==0)wsf[r32]=f; resc=true; } } \
    SBAR(); \
    GAPB(o[0]=__builtin_amdgcn_mfma_f32_32x32x16_bf16(PAF(0),VFR(0),o[0],0,0,0), C0,0); \
    GAPB(o[1]=__builtin_amdgcn_mfma_f32_32x32x16_bf16(PAF(0),VFR(4),o[1],0,0,0), C0,4); \
    KRD(GL,0); GAPB(o[0]=__builtin_amdgcn_mfma_f32_32x32x16_bf16(PAF(1),VFR(1),o[0],0,0,0), C0,8); \
    KRD(GL,1); GAPB(o[1]=__builtin_amdgcn_mfma_f32_32x32x16_bf16(PAF(1),VFR(5),o[1],0,0,0), C0,12); \
    KRD(GL,2); GAPB(o[0]=__builtin_amdgcn_mfma_f32_32x32x16_bf16(PAF(2),VFR(2),o[0],0,0,0), C1,0); \
    KRD(GL,3); GAPB(o[1]=__builtin_amdgcn_mfma_f32_32x32x16_bf16(PAF(2),VFR(6),o[1],0,0,0), C1,4); \
    GAPB(o[0]=__builtin_amdgcn_mfma_f32_32x32x16_bf16(PAF(3),VFR(3),o[0],0,0,0), C1,8); \
    GAPB(o[1]=__builtin_amdgcn_mfma_f32_32x32x16_bf16(PAF(3),VFR(7),o[1],0,0,0), C1,12); \
    }while(0)
  int t=1;
  #undef CMASK
  #define CMASK(P0,P1,t) do{}while(0)
  for(;t+5<NT;t+=2){
    STEP(pB0,pB1,pA0,pA1,t,true,true,true);     WAIT_BAR(2); RESC(); ROT();
    STEP(pA0,pA1,pB0,pB1,t+1,true,true,true);   WAIT_BAR(2); RESC(); ROT();
  }
  #undef CMASK
  #define CMASK(P0,P1,t) do{int jb_=(t)-(NT-4); if(jb_>=0)cmask(P0,P1,jb_,qrel,hi);}while(0)
  #define ENDW(tt) do{ if((tt)+3<NT){WAIT_BAR(2);} else if((tt)+2<NT){WAIT_BAR(1);} else {WAIT_BAR(0);} }while(0)
  for(;t+1<NT;t+=2){
    STEP(pB0,pB1,pA0,pA1,t,(t+3<NT),(t+1<NT),(t+1<NT));       ENDW(t);   RESC(); ROT();
    STEP(pA0,pA1,pB0,pB1,t+1,(t+4<NT),(t+2<NT),(t+2<NT));     ENDW(t+1); RESC(); ROT();
  }
  STEP(pB0,pB1,pA0,pA1,NT-1,false,false,false); RESC();
  { float sacc=pB0[0]+pB0[1]; _Pragma("unroll") for(int r=2;r<16;++r)sacc+=pB0[r]; _Pragma("unroll") for(int r=0;r<16;++r)sacc+=pB1[r]; l_reg+=sacc;
    pw0=(u32x4){PKW(pB0,0),PKW(pB0,2),PKW(pB0,4),PKW(pB0,6)};pw1=(u32x4){PKW(pB0,8),PKW(pB0,10),PKW(pB0,12),PKW(pB0,14)};pw2=(u32x4){PKW(pB1,0),PKW(pB1,2),PKW(pB1,4),PKW(pB1,6)};pw3=(u32x4){PKW(pB1,8),PKW(pB1,10),PKW(pB1,12),PKW(pB1,14)};
    SBAR(); pv(o,vb0+sl_cur,PAF(0),PAF(1),PAF(2),PAF(3)); }
  #undef PKW
  #undef PAF
  #undef VFR
  #undef PIN
  #undef MX3
  #undef GAPA
  #undef GAPB
  #undef EX
  #undef VRD
  #undef KRD
  #undef STEP
  #undef ENDW
  {auto rr=__builtin_amdgcn_permlane32_swap(__float_as_uint(l_reg),__float_as_uint(l_reg),false,false);l_reg=__uint_as_float(rr[0])+__uint_as_float(rr[1]);}
  if(hi==0)wsf[32+r32]=l_reg;asm volatile("s_waitcnt lgkmcnt(0)":::"memory");
  float rli[16];
  #pragma unroll
  for(int r=0;r<16;++r)rli[r]=__builtin_amdgcn_rcpf(wsf[32+crow(r,hi)]);
  bf16*Ow=O+(rowbase+q0+wid*QBLK)*DM+h*D;
  { bf16*stg=(bf16*)(shm+LDS_OST)+wid*2048;
    #pragma unroll
    for(int r=0;r<16;++r){const int orow=crow(r,hi);
      #pragma unroll
      for(int d0=0;d0<2;++d0)stg[orow*64+d0*32+r32]=__float2bfloat16(o[d0][r]*rli[r]);}
    asm volatile("s_waitcnt lgkmcnt(0)":::"memory");
    #pragma unroll
    for(int i=0;i<4;++i){const int row=i*8+(lane>>3),ch=lane&7; const u32x4 v=*(const u32x4*)(stg+row*64+ch*8); ATTN_STORE16(Ow+(long)row*DM+ch*8,v);} }
  asm volatile("s_waitcnt lgkmcnt(0)\n\ts_barrier":::"memory");
  #undef DMA_K
  #undef DMA_V
  #undef CMASK
  #undef START
  #undef RESC
  #undef FBIAS
  #undef ROT
}
constexpr int ATTN_LDS_BYTES=LDS_BYTES;
struct AttnTensors { const bf16* Q; const bf16* K; const bf16* V; bf16* O; const float* FB; };
constexpr int FB_OFF=86016;
template<int THRL=8> __device__ __forceinline__ void attn_phase(char*lds,const AttnTensors&T,int vcu,int G){
  const fb_lptr fbl=(fb_lptr)(lds+FB_OFF);
  for(int bh=vcu;bh<BATCH*NHEAD;bh+=G){
    { __attribute__((address_space(3))) float* fw=(__attribute__((address_space(3))) float*)(lds+FB_OFF);
      int ti_=threadIdx.x; asm volatile("":"+v"(ti_)); for(int i=ti_;i<SEQ;i+=512)fw[i]=T.FB[(size_t)bh*SEQ+i]; }
    asm volatile("s_waitcnt vmcnt(0) lgkmcnt(0)\n\ts_barrier":::"memory");
    for(int qb=NQB-1;qb>=0;--qb) attn_unit<THRL>(bh/NHEAD,bh%NHEAD,qb,T.Q,T.K,T.V,T.O,lds,fbl);
  }
}
#undef SBAR
#undef WAIT_BAR
}

constexpr int DM = 1024, NB = 16, SEQ = 4096, NT = NB * SEQ;
constexpr int DEPTH = 4, NAL = 2;
constexpr int A_IN = 3088, A_PROJ = 3072;
constexpr int KV_OUT = 2064;
constexpr int NE = 16, DE = 512, NCLS = 24, CLS_CAP = NT;
constexpr float EPS = 1e-6f;
constexpr int NWAVES = 8;
constexpr int MAX_RB = NT / 256 + NCLS;

constexpr size_t MiB = 1u << 20;
constexpr size_t WS_CTL = 0, CTL_ZERO_BYTES = 1 * MiB;
constexpr size_t WS_MODS = 1 * MiB;
constexpr size_t WS_KVMOD = WS_MODS + (size_t)DEPTH * NB * 6144 * 4;
constexpr size_t WS_FIN = WS_KVMOD + (size_t)NB * 2048 * 4;
constexpr size_t WS_WTS = 3 * MiB;
constexpr size_t WS_G16 = 4 * MiB;
constexpr size_t WS_FB = 8 * MiB;
constexpr size_t WS_PERM = 12 * MiB;
constexpr size_t WS_WIN = 18 * MiB, WS_WOUT = 30 * MiB, WS_WKV = 34 * MiB, WS_WQ = 38 * MiB, WS_WO = 42 * MiB;
constexpr size_t WS_BT1 = 46 * MiB;
constexpr size_t WS_BT2 = 174 * MiB;
constexpr size_t WS_HB = 238 * MiB;
constexpr size_t WS_BIG = 366 * MiB;
constexpr size_t WS_ACT = 750 * MiB;
constexpr size_t WS_END = 890 * MiB;
static_assert(WS_FIN + (size_t)NB * 2048 * 4 <= WS_WTS && WS_ACT + (size_t)MAX_RB * 256 * 1024 * 2 <= WS_END, "d_ws map");
constexpr int CW_BAR = 4096;
constexpr int CW_CNT = 16384;
constexpr int RING_OFF = 0, RING_BYTES = 131072;
constexpr int LDSCTL_OFF = RING_BYTES, MISC_OFF = LDSCTL_OFF + 320;
constexpr int TAB_OFF = MISC_OFF + 128;
constexpr int LDS_BYTES = 147456;
static_assert(TAB_OFF + 256 <= LDS_BYTES, "LDS map");

typedef unsigned short bf16;
typedef unsigned v4u __attribute__((ext_vector_type(4)));
typedef unsigned v2u __attribute__((ext_vector_type(2)));
typedef float f32x4 __attribute__((ext_vector_type(4)));
typedef short bf16x8 __attribute__((ext_vector_type(8)));
typedef GAS unsigned gu32;
#define RLX_AGENT __ATOMIC_RELAXED, __HIP_MEMORY_SCOPE_AGENT
#define LDS_WAIT() asm volatile("s_waitcnt lgkmcnt(0)" ::: "memory")
__device__ __forceinline__ unsigned f2bf(float f) { unsigned u = __builtin_bit_cast(unsigned, f); return (u + 0x7fffu + ((u >> 16) & 1u)) >> 16; }
__device__ __forceinline__ unsigned pk2(float lo, float hi) { return f2bf(lo) | (f2bf(hi) << 16); }
__device__ __forceinline__ float bf2f(unsigned b) { return __builtin_bit_cast(float, (b & 0xffffu) << 16); }

#define XB_TMO      128
#define XB_XCNT(j)  (256  + 64 * (j))
#define XB_XSUB(j)  (1280 + 64 * (j))
#define XB_XGEN(j)  (2304 + 64 * (j))
#define XB_TOP      3328
#define XB_TOPGEN   3392
#define XCD_BAR_WORDS 3456
#define XB_SPIN_CAP (1u << 22)

__device__ __forceinline__ unsigned xb_ld(unsigned* p)              { return __hip_atomic_load(p, __ATOMIC_RELAXED, __HIP_MEMORY_SCOPE_AGENT); }
__device__ __forceinline__ unsigned xb_add(unsigned* p, unsigned v) { return __hip_atomic_fetch_add(p, v, __ATOMIC_RELAXED, __HIP_MEMORY_SCOPE_AGENT); }
__device__ __forceinline__ unsigned xb_xcc_id() { return (unsigned)__builtin_amdgcn_s_getreg((3 << 11) | 20) & 0xFu; }
#define XB_SPIN(cond, bar) do { unsigned _sp = 0; while (cond) { __builtin_amdgcn_s_sleep(1); \
    if ((++_sp & 255u) == 0u) { if (xb_ld(&(bar)[XB_TMO])) break; if (_sp > XB_SPIN_CAP) { atomicAdd(&(bar)[XB_TMO], 1u); break; } } } } while (0)

struct XcdBarrier { unsigned* bar; unsigned x; volatile LAS unsigned* st; };

__device__ __forceinline__ XcdBarrier xcd_barrier_post(unsigned* bar, volatile LAS unsigned* st) {
    XcdBarrier b; b.bar = bar; b.x = xb_xcc_id(); b.st = st;
    if (threadIdx.x == 0) (void)xb_add(&bar[XB_XCNT(b.x)], 1u);
    return b;
}
__device__ __forceinline__ void xcd_barrier_complete(unsigned* bar, unsigned x, unsigned& nloc, unsigned& nx) {
    const unsigned G = gridDim.x * gridDim.y * gridDim.z;
    unsigned sum, cnt, mine, sp = 0u;
    for (;;) {
        sum = 0u; cnt = 0u; mine = 0u;
#pragma unroll
        for (unsigned j = 0; j < 16; ++j) { const unsigned c = xb_ld(&bar[XB_XCNT(j)]); sum += c; cnt += (c > 0u) ? 1u : 0u; mine = (j == x) ? c : mine; }
        if (sum == G) break;
        __builtin_amdgcn_s_sleep(1);
        if ((++sp & 255u) == 0u) { if (xb_ld(&bar[XB_TMO])) break; if (sp > XB_SPIN_CAP) { atomicAdd(&bar[XB_TMO], 1u); break; } }
    }
    nloc = mine > 0u ? mine : 1u; nx = cnt > 0u ? cnt : 1u;
}
__device__ __forceinline__ void xcd_barrier(const XcdBarrier& b) {
    asm volatile("s_waitcnt vmcnt(0)" ::: "memory");
    __syncthreads();
    if (threadIdx.x == 0) {
        unsigned* bar = b.bar; unsigned bx = b.x; asm volatile("" : "+s"(bar), "+s"(bx));
        __builtin_amdgcn_s_waitcnt(0);
        unsigned nloc = b.st[0], nx = b.st[1];
        if (nloc == 0u) { xcd_barrier_complete(bar, bx, nloc, nx); b.st[0] = nloc; b.st[1] = nx; }
        const unsigned old = xb_add(&bar[XB_XSUB(bx)], 1u);
        const unsigned gen = old / nloc;
        if (old + 1u == (gen + 1u) * nloc) {
            __builtin_amdgcn_fence(__ATOMIC_RELEASE, "agent");
            asm volatile("s_waitcnt vmcnt(0)" ::: "memory");
            const unsigned og = xb_add(&bar[XB_TOP], 1u);
            const unsigned tg = og / nx;
            if (og + 1u == (tg + 1u) * nx) xb_add(&bar[XB_TOPGEN], 1u);
            else XB_SPIN(xb_ld(&bar[XB_TOPGEN]) == tg, bar);
            __builtin_amdgcn_fence(__ATOMIC_ACQUIRE, "agent");
            xb_add(&bar[XB_XGEN(bx)], 1u);
            asm volatile("s_waitcnt vmcnt(0)" ::: "memory");
        } else {
            XB_SPIN(xb_ld(&bar[XB_XGEN(bx)]) == gen, bar);
            __builtin_amdgcn_fence(__ATOMIC_ACQUIRE, "agent");
            asm volatile("s_waitcnt vmcnt(0)" ::: "memory");
        }
    }
    __syncthreads();
}

struct Args { const float* in[25]; float* out; unsigned char* ws; int ph_lo, ph_hi; };
enum { I_X = 0, I_C, I_AWIN, I_ABG, I_AMH, I_AWOUT, I_KVNORM, I_WADAKV, I_BADAKV, I_WKV, I_BFG, I_BWQ, I_BWO, I_NMIX, I_NFFN, I_WADA, I_BADA, I_WR, I_RB, I_WG, I_WU, I_WD, I_NFIN, I_WADAF, I_BADAF };

struct Frame {
    LAS unsigned char* lds;
    volatile LAS unsigned* MISC;
    gu32* ctl;
    int tid, lane, wave;
    int vcu, G;
};

__device__ __forceinline__ float wave_sum(float v) {
#pragma unroll
    for (int o = 1; o < 64; o <<= 1) v += __shfl_xor(v, o);
    return v;
}

__device__ __forceinline__ void p0_transpose_blk(const float* W, int ldw, int k0, int n0, bf16* WT, int ldt, int drow0, LAS float* scr, int lane) {
#pragma unroll 8
    for (int i = 0; i < 32; ++i) { const int kk = 2 * i + (lane >> 5); scr[kk * 33 + (lane & 31)] = W[(size_t)(k0 + kk) * ldw + n0 + (lane & 31)]; }
    LDS_WAIT(); asm volatile("" ::: "memory");
    const int c = lane & 7;
#pragma unroll
    for (int j = 0; j < 4; ++j) { const int n = (lane >> 3) + 8 * j; const LAS float* s = scr + (8 * c) * 33 + n;
        v4u o; o.x = pk2(s[0 * 33], s[1 * 33]); o.y = pk2(s[2 * 33], s[3 * 33]); o.z = pk2(s[4 * 33], s[5 * 33]); o.w = pk2(s[6 * 33], s[7 * 33]);
        *(GAS v4u*)(WT + (size_t)(drow0 + n) * ldt + k0 + 8 * c) = o; }
    LDS_WAIT(); asm volatile("" ::: "memory");
}
__device__ __forceinline__ void p0_prologue(Frame& F, const Args& a) {
    unsigned char* ws = a.ws;
    {
        LAS float* cact = (LAS float*)(F.lds);
        LAS float* red = (LAS float*)(F.lds + 65536);
        const float* c = a.in[I_C];
        for (int i = F.tid; i < NB * DM; i += 512) { const int b = i >> 10, d = i & 1023; const float v = c[i]; cact[d * 16 + b] = v / (1.0f + __expf(-v)); }
        __syncthreads();
        for (int blk = blockIdx.x; blk < 224; blk += F.G) {
            const float* W; const float* bias; float* out; int ldw, e0, ostride;
            if (blk < 192) { const int l = blk / 48; e0 = (blk % 48) * 128; W = a.in[I_WADA] + (size_t)l * DM * 6144; ldw = 6144; bias = a.in[I_BADA] + l * 6144; out = (float*)(ws + WS_MODS) + (size_t)l * NB * 6144; ostride = 6144; }
            else if (blk < 208) { e0 = (blk - 192) * 128; W = a.in[I_WADAKV]; ldw = 2048; bias = a.in[I_BADAKV]; out = (float*)(ws + WS_KVMOD); ostride = 2048; }
            else { e0 = (blk - 208) * 128; W = a.in[I_WADAF]; ldw = 2048; bias = a.in[I_BADAF]; out = (float*)(ws + WS_FIN); ostride = 2048; }
            const int col = F.tid & 127, ks = F.tid >> 7;
            float acc[16];
#pragma unroll
            for (int b = 0; b < 16; ++b) acc[b] = 0.f;
            const float* wp = W + (size_t)(ks * 256) * ldw + e0 + col;
#pragma unroll 4
            for (int d = 0; d < 256; ++d) { const float w = wp[(size_t)d * ldw]; const LAS f32x4* cp = (const LAS f32x4*)(cact + (ks * 256 + d) * 16);
#pragma unroll
                for (int q = 0; q < 4; ++q) { const f32x4 cv = cp[q]; acc[4 * q + 0] += w * cv[0]; acc[4 * q + 1] += w * cv[1]; acc[4 * q + 2] += w * cv[2]; acc[4 * q + 3] += w * cv[3]; } }
#pragma unroll
            for (int b = 0; b < 16; ++b) red[(ks * 128 + col) * 16 + b] = acc[b];
            __syncthreads();
            for (int i = F.tid; i < 128 * 16; i += 512) { const int cc = i & 127, b = i >> 7;
                const float s = red[(0 * 128 + cc) * 16 + b] + red[(1 * 128 + cc) * 16 + b] + red[(2 * 128 + cc) * 16 + b] + red[(3 * 128 + cc) * 16 + b];
                out[(size_t)b * ostride + e0 + cc] = s + bias[e0 + cc]; }
            __syncthreads();
        }
    }
    __syncthreads();
    {
        LAS float* scr = (LAS float*)(F.lds + F.wave * 16384);
        const int gw = F.vcu * NWAVES + F.wave, NGW = F.G * NWAVES;
        constexpr int I_IN = 16 * 96, I_SQ = 16 * 32, I_KV = 16 * 64, I_GU = 16 * 16, I_DN = 8 * 32;
        constexpr int N_IN = 2 * I_IN, N_OUT = 2 * I_SQ, N_KV = I_KV, N_Q = 2 * I_SQ, N_O = 2 * I_SQ, N_G = 64 * I_GU, N_U = 64 * I_GU, N_D = 64 * I_DN;
        constexpr int NITEMS = N_IN + N_OUT + N_KV + N_Q + N_O + N_G + N_U + N_D;
        for (int it = gw; it < NITEMS; it += NGW) {
            int r = it;
            if (r < N_IN) { const int l = r / I_IN, q = r % I_IN, kb = q / 96, nb = q % 96;
                p0_transpose_blk(a.in[I_AWIN] + (size_t)l * DM * A_IN, A_IN, 64 * kb, 32 * nb, (bf16*)(ws + WS_WIN) + (size_t)l * A_PROJ * DM, DM, 32 * nb, scr, F.lane); continue; } r -= N_IN;
            if (r < N_OUT) { const int l = r / I_SQ, q = r % I_SQ, kb = q / 32, nb = q % 32;
                p0_transpose_blk(a.in[I_AWOUT] + (size_t)l * DM * DM, DM, 64 * kb, 32 * nb, (bf16*)(ws + WS_WOUT) + (size_t)l * DM * DM, DM, 32 * nb, scr, F.lane); continue; } r -= N_OUT;
            if (r < N_KV) { const int kb = r / 64, nb = r % 64;
                p0_transpose_blk(a.in[I_WKV], KV_OUT, 64 * kb, 32 * nb, (bf16*)(ws + WS_WKV), DM, 32 * nb, scr, F.lane); continue; } r -= N_KV;
            if (r < N_Q) { const int l = r / I_SQ, q = r % I_SQ, kb = q / 32, nb = q % 32;
                p0_transpose_blk(a.in[I_BWQ] + (size_t)l * DM * DM, DM, 64 * kb, 32 * nb, (bf16*)(ws + WS_WQ) + (size_t)l * DM * DM, DM, 32 * nb, scr, F.lane); continue; } r -= N_Q;
            if (r < N_O) { const int l = r / I_SQ, q = r % I_SQ, kb = q / 32, nb = q % 32;
                p0_transpose_blk(a.in[I_BWO] + (size_t)l * DM * DM, DM, 64 * kb, 32 * nb, (bf16*)(ws + WS_WO) + (size_t)l * DM * DM, DM, 32 * nb, scr, F.lane); continue; } r -= N_O;
            if (r < N_G + N_U) { const int up = r >= N_G; if (up) r -= N_G; const int le = r / I_GU, q = r % I_GU, kb = q / 16, nb = q % 16; const int n0 = 32 * nb;
                const float* W = a.in[up ? I_WU : I_WG] + (size_t)le * DM * DE;
                p0_transpose_blk(W, DE, 64 * kb, n0, (bf16*)(ws + WS_BT1) + (size_t)le * 1024 * DM, DM, (n0 >> 7) * 256 + up * 128 + (n0 & 127), scr, F.lane); continue; } r -= N_G + N_U;
            { const int le = r / I_DN, q = r % I_DN, kb = q / 32, nb = q % 32;
                p0_transpose_blk(a.in[I_WD] + (size_t)le * DE * DM, DM, 64 * kb, 32 * nb, (bf16*)(ws + WS_BT2) + (size_t)le * DM * DE, DE, 32 * nb, scr, F.lane); }
        }
    }
}

__device__ __forceinline__ float log_sigmoidf_(float x) { return fminf(x, 0.f) - log1pf(__expf(-fabsf(x))); }
template <bool ROUTER>
__device__ __forceinline__ void norm_phase(Frame& F, const float* x, const float* gamma, const float* shift, const float* scale, int mstride, bf16* out,
                                           int mode, const float* W16, int ldw, const float* bias16, float* G16, float2* wts, int* perm, gu32* gcnt) {
    LAS float* wT = (LAS float*)(F.lds);
    LAS int* hist = (LAS int*)(F.lds + 65536);
    LAS int* sbase = hist + 32;
    LAS int* tinfo = hist + 64;
    int tid_ = threadIdx.x; asm volatile("" : "+v"(tid_)); const int tid = tid_, lane = tid & 63, wave = __builtin_amdgcn_readfirstlane(tid >> 6);
    if (mode != 0) { for (int i = tid; i < DM * 16; i += 512) { const int d = i >> 4, e = i & 15; wT[e * DM + d] = W16[(size_t)d * ldw + e]; } }
    if (tid < 32) hist[tid] = 0;
    __syncthreads();
    for (int chunk = blockIdx.x; chunk < NT / 256; chunk += F.G) {
        const int b = chunk >> 4;
        f32x4 ga[4], sb[4];
#pragma unroll
        for (int j = 0; j < 4; ++j) { const int col = 4 * lane + 256 * j; const f32x4 g = *(const f32x4*)(gamma + col), sc = *(const f32x4*)(scale + (size_t)b * mstride + col); sb[j] = *(const f32x4*)(shift + (size_t)b * mstride + col);
            ga[j] = g * (sc + 1.0f); }
#pragma clang loop unroll(disable)
        for (int i = 0; i < 32; ++i) {
            const int row = chunk * 256 + wave * 32 + i;
            const GAS f32x4* xr = (const GAS f32x4*)(x + (size_t)row * DM) + lane;
            f32x4 v[4]; float s = 0.f;
#pragma unroll
            for (int j = 0; j < 4; ++j) { v[j] = xr[64 * j]; s += (v[j].x * v[j].x + v[j].y * v[j].y) + (v[j].z * v[j].z + v[j].w * v[j].w); }
            const float r = 1.0f / sqrtf(wave_sum(s) * (1.0f / DM) + EPS);
            GAS v2u* o8 = (GAS v2u*)(out + (size_t)row * DM) + lane;
#pragma unroll
            for (int j = 0; j < 4; ++j) { v[j] = v[j] * r * ga[j] + sb[j]; v2u w; w.x = pk2(v[j].x, v[j].y); w.y = pk2(v[j].z, v[j].w); o8[64 * j] = w; }
            if (mode == 0) continue;
            float p[16];
#pragma unroll
            for (int e = 0; e < 16; ++e) { float a = 0.f;
#pragma unroll
                for (int j = 0; j < 4; ++j) { const f32x4 w = *(const LAS f32x4*)(wT + e * DM + 4 * lane + 256 * j); a += (v[j].x * w.x + v[j].y * w.y) + (v[j].z * w.z + v[j].w * w.w); }
                p[e] = a; }
#pragma unroll
            for (int k = 0; k < 8; ++k) { const bool hi = lane & 32; const float mine = hi ? p[k + 8] : p[k], send = hi ? p[k] : p[k + 8]; p[k] = mine + __shfl_xor(send, 32); }
#pragma unroll
            for (int k = 0; k < 4; ++k) { const bool hi = lane & 16; const float mine = hi ? p[k + 4] : p[k], send = hi ? p[k] : p[k + 4]; p[k] = mine + __shfl_xor(send, 16); }
#pragma unroll
            for (int k = 0; k < 2; ++k) { const bool hi = lane & 8; const float mine = hi ? p[k + 2] : p[k], send = hi ? p[k] : p[k + 2]; p[k] = mine + __shfl_xor(send, 8); }
            { const bool hi = lane & 4; const float mine = hi ? p[1] : p[0], send = hi ? p[0] : p[1]; p[0] = mine + __shfl_xor(send, 4); }
            p[0] += __shfl_xor(p[0], 2); p[0] += __shfl_xor(p[0], 1);
            const int e = (lane >> 2) & 15;
            if (!ROUTER) {
              if (mode == 1) {
                float g = p[0] + bias16[e]; g = 15.0f * tanhf(g * (1.0f / 15.0f));
                if (e >= 8) g = log_sigmoidf_(g);
                if ((lane & 3) == 0) G16[(size_t)row * 16 + e] = g;
              } else {
                const float g = log_sigmoidf_(p[0] + bias16[e]);
                if ((lane & 3) == 0) G16[(size_t)row * 16 + e] = g;
              }
            } else {
                float aff[16], sel[16];
#pragma unroll
                for (int q = 0; q < 16; ++q) { const float lg = __shfl(p[0], 4 * q); aff[q] = 1.0f / (1.0f + __expf(-lg)); sel[q] = aff[q] + bias16[q]; }
                float gs[4];
#pragma unroll
                for (int g = 0; g < 4; ++g) { const float s0 = sel[4 * g], s1 = sel[4 * g + 1], s2 = sel[4 * g + 2], s3 = sel[4 * g + 3];
                    const float a = fmaxf(s0, s1), bb = fminf(s0, s1), c = fmaxf(s2, s3), d = fminf(s2, s3);
                    gs[g] = fmaxf(a, c) + fmaxf(fminf(a, c), fmaxf(bb, d)); }
                int grp = 0; float best = gs[0];
#pragma unroll
                for (int g = 1; g < 4; ++g) if (gs[g] > best) { best = gs[g]; grp = g; }
                float sg[4], ag[4];
#pragma unroll
                for (int q = 0; q < 4; ++q) { sg[q] = grp == 0 ? sel[q] : grp == 1 ? sel[4 + q] : grp == 2 ? sel[8 + q] : sel[12 + q]; ag[q] = grp == 0 ? aff[q] : grp == 1 ? aff[4 + q] : grp == 2 ? aff[8 + q] : aff[12 + q]; }
                int i1 = 0; float b1 = sg[0];
#pragma unroll
                for (int q = 1; q < 4; ++q) if (sg[q] > b1) { b1 = sg[q]; i1 = q; }
                int i2 = -1; float b2 = 0.f;
#pragma unroll
                for (int q = 0; q < 4; ++q) if (q != i1 && (i2 < 0 || sg[q] > b2)) { b2 = sg[q]; i2 = q; }
                const int ea = i1 < i2 ? i1 : i2, eb = i1 < i2 ? i2 : i1;
                const float wa = ea == 0 ? ag[0] : ea == 1 ? ag[1] : ag[2], wb = eb == 1 ? ag[1] : eb == 2 ? ag[2] : ag[3];
                const float inv = 1.0f / (wa + wb);
                const int pid = ea == 0 ? eb - 1 : ea == 1 ? eb + 1 : 5;
                const int cls = grp * 6 + pid;
                if (lane == 0) { wts[row] = make_float2(wa * inv, wb * inv); const int rk = __hip_atomic_fetch_add(&hist[cls], 1, __ATOMIC_RELAXED, __HIP_MEMORY_SCOPE_WORKGROUP); tinfo[wave * 32 + i] = cls | (rk << 8); }
            }
        }
        if (ROUTER) {
            __syncthreads();
            if (tid < NCLS) { const int n = hist[tid]; sbase[tid] = n ? (int)__hip_atomic_fetch_add(gcnt + tid, (unsigned)n, RLX_AGENT) : 0; }
            __syncthreads();
            if (tid < 256) { const int ti = tinfo[tid], cls = ti & 255, rk = ti >> 8; perm[(size_t)cls * CLS_CAP + sbase[cls] + rk] = chunk * 256 + tid; }
            __syncthreads();
            if (tid < 32) hist[tid] = 0;
            __syncthreads();
        }
    }
    __syncthreads();
}
__device__ __forceinline__ void final_norm_phase(Frame& F, float* x, const float* gamma, const float* shift, const float* scale, int mstride) {
    int tid_ = threadIdx.x; asm volatile("" : "+v"(tid_)); const int lane = tid_ & 63, wave = __builtin_amdgcn_readfirstlane(tid_ >> 6);
    for (int chunk = blockIdx.x; chunk < NT / 256; chunk += F.G) {
        const int b = chunk >> 4;
        f32x4 ga[4], sb[4];
#pragma unroll
        for (int j = 0; j < 4; ++j) { const int col = 4 * lane + 256 * j; const f32x4 g = *(const f32x4*)(gamma + col), sc = *(const f32x4*)(scale + (size_t)b * mstride + col); sb[j] = *(const f32x4*)(shift + (size_t)b * mstride + col);
            ga[j] = g * (sc + 1.0f); }
#pragma clang loop unroll(disable)
        for (int i = 0; i < 32; ++i) {
            const int row = chunk * 256 + wave * 32 + i;
            GAS f32x4* xr = (GAS f32x4*)(x + (size_t)row * DM) + lane;
            f32x4 v[4]; float s = 0.f;
#pragma unroll
            for (int j = 0; j < 4; ++j) { v[j] = xr[64 * j]; s += (v[j].x * v[j].x + v[j].y * v[j].y) + (v[j].z * v[j].z + v[j].w * v[j].w); }
            const float r = 1.0f / sqrtf(wave_sum(s) * (1.0f / DM) + EPS);
#pragma unroll
            for (int j = 0; j < 4; ++j) xr[64 * j] = v[j] * r * ga[j] + sb[j];
        }
    }
}

__device__ __forceinline__ void fcum_phase(Frame& F, const float* logf, float* FB) {
    LAS float* wtot = (LAS float*)(F.lds);
    int tid_ = threadIdx.x; asm volatile("" : "+v"(tid_)); const int tid = tid_, lane = tid & 63, wave = __builtin_amdgcn_readfirstlane(tid >> 6);
    for (int chain = blockIdx.x; chain < NB * 16; chain += F.G) {
        const int b = chain >> 4, hh = chain & 15;
        float v[8]; float run = 0.f;
#pragma unroll
        for (int j = 0; j < 8; ++j) { run += logf[((size_t)b * SEQ + tid * 8 + j) * 16 + hh]; v[j] = run; }
        float inc = run;
#pragma unroll
        for (int o = 1; o < 64; o <<= 1) { const float t = __shfl_up(inc, o); if (lane >= o) inc += t; }
        if (lane == 63) wtot[wave] = inc;
        __syncthreads();
        float base = inc - run;
        for (int w = 0; w < wave; ++w) base += wtot[w];
#pragma unroll
        for (int j = 0; j < 8; ++j) FB[(size_t)chain * SEQ + tid * 8 + j] = -(base + v[j]) * 1.4426950408889634f;
        __syncthreads();
    }
}

__device__ __forceinline__ float wave_scan_add(float v, int lane) {
#pragma unroll
    for (int o = 1; o < 64; o <<= 1) { const float t = __shfl_up(v, o); if (lane >= o) v += t; }
    return v;
}
__device__ __forceinline__ float wave_scan_max(float v, int lane) {
#pragma unroll
    for (int o = 1; o < 64; o <<= 1) { const float t = __shfl_up(v, o); if (lane >= o) v = fmaxf(v, t); }
    return v;
}
__device__ __forceinline__ void cell_phase(Frame& F, const bf16* PROJ, const float* G16, const float* mhn, bf16* HS) {
    constexpr int PST = 72;
    LAS bf16* sQ = (LAS bf16*)(F.lds);
    LAS bf16* sK = sQ + 64 * PST;
    LAS bf16* sKT = sK + 64 * PST;
    LAS bf16* sW = sKT + 64 * PST;
    LAS bf16* sVT = sW + 64 * PST;
    LAS bf16* sCT = sVT + 128 * PST;
    LAS float* fz = (LAS float*)(sCT + 128 * PST);
    LAS float* sU = fz, *sM = fz + 64, *sA = fz + 128, *sEm = fz + 192, *sWk = fz + 256, *sInv = fz + 320, *sN = fz + 384, *sScal = fz + 448, *sSS = fz + 512;
    int tid_ = threadIdx.x; asm volatile("" : "+v"(tid_));
    const int tid = tid_, lane = tid & 63, w = __builtin_amdgcn_readfirstlane(tid >> 6), fr = lane & 15, fq = lane >> 4;
    for (int chain = blockIdx.x; chain < NB * 8; chain += F.G) {
        const int b = chain >> 3, hh = chain & 7;
        f32x4 accC[4];
#pragma unroll
        for (int ni = 0; ni < 4; ++ni) accC[ni] = (f32x4){0.f, 0.f, 0.f, 0.f};
        for (int i = tid; i < 128 * PST; i += 512) sCT[i] = 0;
        if (tid < 64) sN[tid] = 0.f;
        float m_prev = 0.f;
        __syncthreads();
        for (int c = 0; c < SEQ / 64; ++c) {
            const size_t t0 = (size_t)b * SEQ + 64 * c;
            const int row = tid >> 3, seg = tid & 7;
            const bf16* pr = PROJ + (t0 + row) * A_PROJ + hh * 64 + seg * 8;
            const v4u qv = *(const GAS v4u*)pr, kv = *(const GAS v4u*)(pr + 512);
            const bf16* pv = PROJ + (t0 + row) * A_PROJ + 1024 + hh * 128 + seg * 8;
            const v4u v0 = *(const GAS v4u*)pv, v1 = *(const GAS v4u*)(pv + 64);
            float ig = 0.f, lf = 0.f;
            if (tid < 64) { ig = G16[(t0 + tid) * 16 + hh]; lf = G16[(t0 + tid) * 16 + 8 + hh]; }
            *(LAS v4u*)(sQ + row * PST + seg * 8) = qv;
            *(LAS v4u*)(sK + row * PST + seg * 8) = kv;
#pragma unroll
            for (int j = 0; j < 4; ++j) { sVT[(seg * 8 + 2 * j) * PST + row] = (bf16)(v0[j] & 0xffffu); sVT[(seg * 8 + 2 * j + 1) * PST + row] = (bf16)(v0[j] >> 16);
                sVT[(64 + seg * 8 + 2 * j) * PST + row] = (bf16)(v1[j] & 0xffffu); sVT[(64 + seg * 8 + 2 * j + 1) * PST + row] = (bf16)(v1[j] >> 16); }
            if (w == 0) {
                const float bc = wave_scan_add(lf, lane), u = ig - bc, pm = wave_scan_max(u, lane), M = fmaxf(m_prev, pm);
                const float M63 = __shfl(M, 63), bl = __shfl(bc, 63);
                sU[lane] = u; sM[lane] = M; sA[lane] = __expf(m_prev - M); sEm[lane] = __expf(-(bc + M)); sWk[lane] = __expf(u - M63);
                if (lane == 0) { sScal[0] = __expf(m_prev - M63); sScal[1] = bl + M63; }
            }
            __syncthreads();
            { const float wk = sWk[row];
#pragma unroll
              for (int j = 0; j < 4; ++j) { sKT[(seg * 8 + 2 * j) * PST + row] = (bf16)f2bf(bf2f(kv[j] & 0xffffu) * wk); sKT[(seg * 8 + 2 * j + 1) * PST + row] = (bf16)f2bf(bf2f(kv[j] >> 16) * wk); } }
            { const int mi = w >> 1;
#pragma unroll
              for (int nn = 0; nn < 2; ++nn) { const int ni = (w & 1) * 2 + nn; f32x4 acc = (f32x4){0.f, 0.f, 0.f, 0.f};
#pragma unroll
                for (int ks = 0; ks < 2; ++ks) { const bf16x8 av = *(const LAS bf16x8*)(sQ + (16 * mi + fr) * PST + 32 * ks + 8 * fq), bv = *(const LAS bf16x8*)(sK + (16 * ni + fr) * PST + 32 * ks + 8 * fq);
                    acc = __builtin_amdgcn_mfma_f32_16x16x32_bf16(av, bv, acc, 0, 0, 0); }
                const int s = 16 * ni + fr; const float us = sU[s];
#pragma unroll
                for (int i = 0; i < 4; ++i) { const int t = 16 * mi + 4 * fq + i; const float wv = (s <= t) ? __expf(us - sM[t]) * acc[i] : 0.f; sW[t * PST + s] = (bf16)f2bf(wv); } } }
            __syncthreads();
            { const int t = tid >> 3, part = tid & 7; float d1 = 0.f, qn = 0.f;
#pragma unroll
              for (int j = 0; j < 8; ++j) { d1 += bf2f(sW[t * PST + part * 8 + j]); qn += bf2f(sQ[t * PST + part * 8 + j]) * sN[part * 8 + j]; }
              d1 += __shfl_xor(d1, 1); d1 += __shfl_xor(d1, 2); d1 += __shfl_xor(d1, 4); qn += __shfl_xor(qn, 1); qn += __shfl_xor(qn, 2); qn += __shfl_xor(qn, 4);
              const float den = d1 + sA[t] * qn; if (part == 0) sInv[t] = 1.0f / fmaxf(fabsf(den), sEm[t]); }
            f32x4 acc[4];
#pragma unroll
            for (int mi = 0; mi < 4; ++mi) acc[mi] = (f32x4){0.f, 0.f, 0.f, 0.f};
#pragma unroll
            for (int ks = 0; ks < 2; ++ks) { const bf16x8 bq = *(const LAS bf16x8*)(sCT + (16 * w + fr) * PST + 32 * ks + 8 * fq);
#pragma unroll
                for (int mi = 0; mi < 4; ++mi) { const bf16x8 av = *(const LAS bf16x8*)(sQ + (16 * mi + fr) * PST + 32 * ks + 8 * fq); acc[mi] = __builtin_amdgcn_mfma_f32_16x16x32_bf16(av, bq, acc[mi], 0, 0, 0); } }
#pragma unroll
            for (int mi = 0; mi < 4; ++mi)
#pragma unroll
                for (int i = 0; i < 4; ++i) acc[mi][i] *= sA[16 * mi + 4 * fq + i];
#pragma unroll
            for (int ks = 0; ks < 2; ++ks) { const bf16x8 bv = *(const LAS bf16x8*)(sVT + (16 * w + fr) * PST + 32 * ks + 8 * fq);
#pragma unroll
                for (int mi = 0; mi < 4; ++mi) { const bf16x8 av = *(const LAS bf16x8*)(sW + (16 * mi + fr) * PST + 32 * ks + 8 * fq); acc[mi] = __builtin_amdgcn_mfma_f32_16x16x32_bf16(av, bv, acc[mi], 0, 0, 0); } }
            __syncthreads();
#pragma unroll
            for (int mi = 0; mi < 4; ++mi)
#pragma unroll
                for (int i = 0; i < 4; ++i) { const int t = 16 * mi + 4 * fq + i; const float hv = acc[mi][i] * sInv[t]; acc[mi][i] = hv; float sq = hv * hv;
                    sq += __shfl_xor(sq, 1); sq += __shfl_xor(sq, 2); sq += __shfl_xor(sq, 4); sq += __shfl_xor(sq, 8); if (fr == 0) sSS[w * 64 + t] = sq; }
            __syncthreads();
            { const int col = hh * 128 + 16 * w + fr; const float mh = mhn[col];
#pragma unroll
              for (int mi = 0; mi < 4; ++mi)
#pragma unroll
                for (int i = 0; i < 4; ++i) { const int t = 16 * mi + 4 * fq + i; float tot = 0.f;
#pragma unroll
                    for (int ww = 0; ww < 8; ++ww) tot += sSS[ww * 64 + t];
                    const float rn = 1.0f / sqrtf(tot * (1.0f / 128.0f) + EPS);
                    const float og = bf2f(PROJ[(t0 + t) * A_PROJ + 2048 + col]);
                    HS[(t0 + t) * DM + col] = (bf16)f2bf(acc[mi][i] * rn * mh * og); } }
            { const float decay = sScal[0];
#pragma unroll
              for (int ni = 0; ni < 4; ++ni) accC[ni] = accC[ni] * decay;
#pragma unroll
              for (int ks = 0; ks < 2; ++ks) { const bf16x8 av = *(const LAS bf16x8*)(sVT + (16 * w + fr) * PST + 32 * ks + 8 * fq);
#pragma unroll
                for (int ni = 0; ni < 4; ++ni) { const bf16x8 bv = *(const LAS bf16x8*)(sKT + (16 * ni + fr) * PST + 32 * ks + 8 * fq); accC[ni] = __builtin_amdgcn_mfma_f32_16x16x32_bf16(av, bv, accC[ni], 0, 0, 0); } }
#pragma unroll
              for (int ni = 0; ni < 4; ++ni)
#pragma unroll
                for (int i = 0; i < 4; ++i) sCT[(16 * w + 4 * fq + i) * PST + 16 * ni + fr] = (bf16)f2bf(accC[ni][i]);
              const int d = tid >> 3, part = tid & 7; float sk = 0.f;
#pragma unroll
              for (int j = 0; j < 8; ++j) sk += bf2f(sKT[d * PST + part * 8 + j]);
              sk += __shfl_xor(sk, 1); sk += __shfl_xor(sk, 2); sk += __shfl_xor(sk, 4);
              if (part == 0) sN[d] = decay * sN[d] + sk;
              m_prev = sScal[1]; }
            __syncthreads();
        }
    }
}

__device__ __forceinline__ void cellA_phase(Frame& F, const bf16* PROJ, const float* G16, bf16* CTS, float* NS, float* MS) {
    constexpr int PST = 72;
    LAS bf16* sKT0 = (LAS bf16*)(F.lds);
    LAS bf16* sVT0 = sKT0 + 2 * 64 * PST;
    int tid_ = threadIdx.x; asm volatile("" : "+v"(tid_));
    const int tid = tid_, lane = tid & 63, w = __builtin_amdgcn_readfirstlane(tid >> 6), fr = lane & 15, fq = lane >> 4;
    const int vt = w & 3, dh = w >> 2, row = tid >> 3, seg = tid & 7;
    bf16x8 ones;
#pragma unroll
    for (int j = 0; j < 8; ++j) ones[j] = (short)0x3F80;
    for (int chain = blockIdx.x; chain < NB * 16; chain += F.G) {
        const int bh = chain >> 1, vh = chain & 1, b = bh >> 3, hh = bh & 7;
        f32x4 accC[2], accN[2];
#pragma unroll
        for (int ni = 0; ni < 2; ++ni) { accC[ni] = (f32x4){0.f, 0.f, 0.f, 0.f}; accN[ni] = (f32x4){0.f, 0.f, 0.f, 0.f}; }
        float m_prev = 0.f;
        const bf16* pk = PROJ + ((size_t)b * SEQ + row) * A_PROJ + 512 + hh * 64 + seg * 8;
        const bf16* pv = PROJ + ((size_t)b * SEQ + row) * A_PROJ + 1024 + hh * 128 + vh * 64 + seg * 8;
        const float* pg = G16 + ((size_t)b * SEQ + lane) * 16 + hh;
        v4u kv = *(const GAS v4u*)pk, vv = *(const GAS v4u*)pv; float ig = ((const GAS float*)pg)[0], lf = ((const GAS float*)pg)[8];
        for (int c = 0; c < SEQ / 64; ++c) {
            LAS bf16* sKT = sKT0 + (c & 1) * 64 * PST; LAS bf16* sVT = sVT0 + (c & 1) * 64 * PST;
            const float bc = wave_scan_add(lf, lane), u = ig - bc, pm = wave_scan_max(u, lane);
            const float M63 = fmaxf(m_prev, __shfl(pm, 63)), wk = __expf(u - M63), decay = __expf(m_prev - M63), m_new = __shfl(bc, 63) + M63;
            { bf16* cs = CTS + ((size_t)(bh * 64 + c) * 128 + vh * 64 + 16 * vt + 4 * fq) * 64 + 32 * dh + fr;
#pragma unroll
              for (int ni = 0; ni < 2; ++ni)
#pragma unroll
                for (int i = 0; i < 4; ++i) ((GAS bf16*)cs)[i * 64 + 16 * ni] = (bf16)f2bf(accC[ni][i]);
              if (vh == 0 && vt == 0 && fq == 0) { ((GAS float*)NS)[(size_t)(bh * 64 + c) * 64 + 32 * dh + fr] = accN[0][0]; ((GAS float*)NS)[(size_t)(bh * 64 + c) * 64 + 32 * dh + 16 + fr] = accN[1][0]; }
              if (vh == 0 && tid == 0) ((GAS float*)MS)[bh * 64 + c] = m_prev; }
            { const float wkr = __shfl(wk, row);
#pragma unroll
              for (int j = 0; j < 4; ++j) { sKT[(seg * 8 + 2 * j) * PST + row] = (bf16)f2bf(bf2f(kv[j] & 0xffffu) * wkr); sKT[(seg * 8 + 2 * j + 1) * PST + row] = (bf16)f2bf(bf2f(kv[j] >> 16) * wkr);
                  sVT[(seg * 8 + 2 * j) * PST + row] = (bf16)(vv[j] & 0xffffu); sVT[(seg * 8 + 2 * j + 1) * PST + row] = (bf16)(vv[j] >> 16); } }
            if (c + 1 < SEQ / 64) { pk += (size_t)64 * A_PROJ; pv += (size_t)64 * A_PROJ; pg += 64 * 16; kv = *(const GAS v4u*)pk; vv = *(const GAS v4u*)pv; ig = ((const GAS float*)pg)[0]; lf = ((const GAS float*)pg)[8]; }
            __syncthreads();
#pragma unroll
            for (int ni = 0; ni < 2; ++ni) { accC[ni] = accC[ni] * decay; accN[ni] = accN[ni] * decay; }
#pragma unroll
            for (int ks = 0; ks < 2; ++ks) { const bf16x8 av = *(const LAS bf16x8*)(sVT + (16 * vt + fr) * PST + 32 * ks + 8 * fq);
#pragma unroll
                for (int ni = 0; ni < 2; ++ni) { const bf16x8 bv = *(const LAS bf16x8*)(sKT + (32 * dh + 16 * ni + fr) * PST + 32 * ks + 8 * fq);
                    accC[ni] = __builtin_amdgcn_mfma_f32_16x16x32_bf16(av, bv, accC[ni], 0, 0, 0); accN[ni] = __builtin_amdgcn_mfma_f32_16x16x32_bf16(ones, bv, accN[ni], 0, 0, 0); } }
            m_prev = m_new;
        }
        __syncthreads();
    }
}
__device__ __forceinline__ void cellB_phase(Frame& F, const bf16* PROJ, const float* G16, const float* mhn, const bf16* CTS, const float* NS, const float* MS, bf16* HS) {
    constexpr int PST = 72, HP = 132;
    LAS bf16* sW0 = (LAS bf16*)(F.lds);
    LAS bf16* sVT0 = sW0 + 2 * 64 * PST;
    LAS float* sH = (LAS float*)(sVT0 + 2 * 128 * PST);
    LAS f32x4* sT40 = (LAS f32x4*)(sH + 64 * HP);
    LAS float* sD0 = (LAS float*)(sT40 + 2 * 64);
    LAS float* sSS = sD0 + 2 * 2 * 64;
    int tid_ = threadIdx.x; asm volatile("" : "+v"(tid_));
    const int tid = tid_, lane = tid & 63, w = __builtin_amdgcn_readfirstlane(tid >> 6), fr = lane & 15, fq = lane >> 4;
    const int mi = w >> 1, row = tid >> 3, seg = tid & 7;
    int par = 0;
    for (int rb = blockIdx.x; rb < NT / 64; rb += F.G) {
        const int b = rb >> 6, c = rb & 63; const size_t t0 = (size_t)rb * 64;
#pragma clang loop unroll(disable)
        for (int hh = 0; hh < 8; ++hh, par ^= 1) {
            const int bh = b * 8 + hh;
            LAS bf16* sW = sW0 + par * 64 * PST; LAS bf16* sVT = sVT0 + par * 128 * PST; LAS f32x4* sT4 = sT40 + par * 64; LAS float* sD = sD0 + par * 128;
            bf16x8 qf[4][2], kf[2][2], ctf[2];
#pragma unroll
            for (int m2 = 0; m2 < 4; ++m2)
#pragma unroll
                for (int ks = 0; ks < 2; ++ks) qf[m2][ks] = *(const GAS bf16x8*)(PROJ + (t0 + 16 * m2 + fr) * A_PROJ + hh * 64 + 32 * ks + 8 * fq);
#pragma unroll
            for (int nn = 0; nn < 2; ++nn)
#pragma unroll
                for (int ks = 0; ks < 2; ++ks) kf[nn][ks] = *(const GAS bf16x8*)(PROJ + (t0 + 16 * ((w & 1) * 2 + nn) + fr) * A_PROJ + 512 + hh * 64 + 32 * ks + 8 * fq);
            const bf16* pv = PROJ + (t0 + row) * A_PROJ + 1024 + hh * 128 + seg * 8;
            const v4u v0 = *(const GAS v4u*)pv, v1 = *(const GAS v4u*)(pv + 64);
            const bf16* po = PROJ + (t0 + row) * A_PROJ + 2048 + hh * 128 + seg * 16;
            const v4u og0 = *(const GAS v4u*)po, og1 = *(const GAS v4u*)(po + 8);
            const float ig = ((const GAS float*)G16)[(t0 + lane) * 16 + hh], lf = ((const GAS float*)G16)[(t0 + lane) * 16 + 8 + hh];
            const float m_c = ((const GAS float*)MS)[bh * 64 + c];
            const float* np = NS + (size_t)(bh * 64 + c) * 64;
            f32x4 nv[2][2];
#pragma unroll
            for (int ks = 0; ks < 2; ++ks) { nv[ks][0] = *(const GAS f32x4*)(np + 32 * ks + 8 * fq); nv[ks][1] = *(const GAS f32x4*)(np + 32 * ks + 8 * fq + 4); }
#pragma unroll
            for (int ks = 0; ks < 2; ++ks) ctf[ks] = *(const GAS bf16x8*)(CTS + ((size_t)(bh * 64 + c) * 128 + 16 * w + fr) * 64 + 32 * ks + 8 * fq);
            const float bc = wave_scan_add(lf, lane), u = ig - bc, pm = wave_scan_max(u, lane), M = fmaxf(m_c, pm), av = __expf(m_c - M), em = __expf(-(bc + M));
#pragma unroll
            for (int j = 0; j < 4; ++j) { sVT[(seg * 8 + 2 * j) * PST + row] = (bf16)(v0[j] & 0xffffu); sVT[(seg * 8 + 2 * j + 1) * PST + row] = (bf16)(v0[j] >> 16);
                sVT[(64 + seg * 8 + 2 * j) * PST + row] = (bf16)(v1[j] & 0xffffu); sVT[(64 + seg * 8 + 2 * j + 1) * PST + row] = (bf16)(v1[j] >> 16); }
            { float Mt[4];
#pragma unroll
              for (int i = 0; i < 4; ++i) Mt[i] = __shfl(M, 16 * mi + 4 * fq + i);
              float rs[4] = {0.f, 0.f, 0.f, 0.f};
#pragma unroll
              for (int nn = 0; nn < 2; ++nn) { const int ni = (w & 1) * 2 + nn; f32x4 acc = (f32x4){0.f, 0.f, 0.f, 0.f};
#pragma unroll
                for (int ks = 0; ks < 2; ++ks) { const bf16x8 qa = mi == 0 ? qf[0][ks] : mi == 1 ? qf[1][ks] : mi == 2 ? qf[2][ks] : qf[3][ks]; acc = __builtin_amdgcn_mfma_f32_16x16x32_bf16(qa, kf[nn][ks], acc, 0, 0, 0); }
                const int s = 16 * ni + fr; const float us = __shfl(u, s);
#pragma unroll
                for (int i = 0; i < 4; ++i) { const int t = 16 * mi + 4 * fq + i; const float wv = (s <= t) ? __expf(us - Mt[i]) * acc[i] : 0.f; const unsigned wb = f2bf(wv); sW[t * PST + s] = (bf16)wb; rs[i] += bf2f(wb); } }
#pragma unroll
              for (int i = 0; i < 4; ++i) { float r = rs[i]; r += __shfl_xor(r, 1); r += __shfl_xor(r, 2); r += __shfl_xor(r, 4); r += __shfl_xor(r, 8); if (fr == 0) sD[(w & 1) * 64 + 16 * mi + 4 * fq + i] = r; } }
#pragma unroll
            for (int m2 = 0; m2 < 4; ++m2) if (w == m2) { float qn = 0.f;
#pragma unroll
                for (int ks = 0; ks < 2; ++ks) { const bf16x8 q8 = qf[m2][ks];
#pragma unroll
                    for (int j = 0; j < 8; ++j) qn += bf2f((unsigned)(unsigned short)q8[j]) * nv[ks][j >> 2][j & 3]; }
                qn += __shfl_xor(qn, 16); qn += __shfl_xor(qn, 32);
                const float at = __shfl(av, 16 * m2 + fr), et = __shfl(em, 16 * m2 + fr);
                if (fq == 0) sT4[16 * m2 + fr] = (f32x4){at, et, qn, 0.f}; }
            __syncthreads();
            f32x4 acc[4];
#pragma unroll
            for (int m2 = 0; m2 < 4; ++m2) acc[m2] = (f32x4){0.f, 0.f, 0.f, 0.f};
#pragma unroll
            for (int ks = 0; ks < 2; ++ks)
#pragma unroll
                for (int m2 = 0; m2 < 4; ++m2) acc[m2] = __builtin_amdgcn_mfma_f32_16x16x32_bf16(qf[m2][ks], ctf[ks], acc[m2], 0, 0, 0);
            float inv[4][4];
#pragma unroll
            for (int m2 = 0; m2 < 4; ++m2)
#pragma unroll
                for (int i = 0; i < 4; ++i) { const int t = 16 * m2 + 4 * fq + i; const f32x4 T4 = sT4[t]; acc[m2][i] *= T4[0];
                    const float den = sD[t] + sD[64 + t] + T4[0] * T4[2]; inv[m2][i] = 1.0f / fmaxf(fabsf(den), T4[1]); }
#pragma unroll
            for (int ks = 0; ks < 2; ++ks) { const bf16x8 bv = *(const LAS bf16x8*)(sVT + (16 * w + fr) * PST + 32 * ks + 8 * fq);
#pragma unroll
                for (int m2 = 0; m2 < 4; ++m2) { const bf16x8 a8 = *(const LAS bf16x8*)(sW + (16 * m2 + fr) * PST + 32 * ks + 8 * fq); acc[m2] = __builtin_amdgcn_mfma_f32_16x16x32_bf16(a8, bv, acc[m2], 0, 0, 0); } }
#pragma unroll
            for (int m2 = 0; m2 < 4; ++m2)
#pragma unroll
                for (int i = 0; i < 4; ++i) { const int t = 16 * m2 + 4 * fq + i; const float hv = acc[m2][i] * inv[m2][i]; sH[t * HP + 16 * w + fr] = hv; float sq = hv * hv;
                    sq += __shfl_xor(sq, 1); sq += __shfl_xor(sq, 2); sq += __shfl_xor(sq, 4); sq += __shfl_xor(sq, 8); if (fr == 0) sSS[w * 64 + t] = sq; }
            __syncthreads();
            { float tot = 0.f;
#pragma unroll
              for (int ww = 0; ww < 8; ++ww) tot += sSS[ww * 64 + row];
              const float rn = 1.0f / sqrtf(tot * (1.0f / 128.0f) + EPS);
              const float* mp = mhn + hh * 128 + seg * 16; v4u o0, o1;
#pragma unroll
              for (int q = 0; q < 4; ++q) { const f32x4 hv = *(const LAS f32x4*)(sH + row * HP + seg * 16 + 4 * q); const f32x4 mh = *(const GAS f32x4*)(mp + 4 * q);
                  const unsigned g01 = q < 2 ? og0[2 * q] : og1[2 * q - 4], g23 = q < 2 ? og0[2 * q + 1] : og1[2 * q - 3];
                  const float r0 = hv[0] * rn * mh[0] * bf2f(g01 & 0xffffu), r1 = hv[1] * rn * mh[1] * bf2f(g01 >> 16), r2 = hv[2] * rn * mh[2] * bf2f(g23 & 0xffffu), r3 = hv[3] * rn * mh[3] * bf2f(g23 >> 16);
                  if (q < 2) { o0[2 * q] = pk2(r0, r1); o0[2 * q + 1] = pk2(r2, r3); } else { o1[2 * q - 4] = pk2(r0, r1); o1[2 * q - 3] = pk2(r2, r3); } }
              bf16* ho = HS + (t0 + row) * DM + hh * 128 + seg * 16;
              *(GAS v4u*)ho = o0; *(GAS v4u*)(ho + 8) = o1; }
        }
    }
    __syncthreads();
}

struct DenseProb {
    const bf16* A; int lda; const bf16* Bt; int ldb; int K; pg8::StaticOrder S;
    __device__ __forceinline__ bool next(int i, pg8::Unit& u) const { return S.next(i, u); }
    __device__ __forceinline__ const char* a_base() const { return (const char*)A; }
    __device__ __forceinline__ void a_off(const pg8::Unit& u, int R0, int C0, unsigned (&o)[2][2]) const {
#pragma unroll
        for (int h = 0; h < 2; ++h)
#pragma unroll
            for (int i = 0; i < 2; ++i) o[h][i] = (unsigned)((u.pm * 256 + h * 128 + R0 + 64 * i) * lda + C0) * 2u; }
    __device__ __forceinline__ const char* b_tile(const pg8::Unit& u, int tt) const { return (const char*)Bt + (size_t)u.pn * 256 * ldb * 2 + (size_t)tt * 128; }
};
struct ClassTab { const LAS int* blkstart; const LAS int* ncls; };
__device__ __forceinline__ void class_of(const ClassTab& T, pg8::Unit& u) { int c = 0; while (c < NCLS - 1 && u.pm >= T.blkstart[c + 1]) ++c; u.cls = c; u.lb = u.pm - T.blkstart[c]; }
__device__ __forceinline__ void pair_of(int cls, int& ea, int& eb) { const int g = cls / 6, p = cls % 6; const int a = p < 3 ? 0 : p < 5 ? 1 : 2, b = p < 3 ? p + 1 : p < 5 ? p - 1 : 3; ea = g * 4 + a; eb = g * 4 + b; }
struct Moe1Prob {
    const bf16* A; int ldb; int K; const bf16* Bt1l; const int* perm; ClassTab T; pg8::StaticOrder S;
    __device__ __forceinline__ bool next(int i, pg8::Unit& u) const { if (!S.next(i, u)) return false; class_of(T, u); return true; }
    __device__ __forceinline__ const char* a_base() const { return (const char*)A; }
    __device__ __forceinline__ void a_off(const pg8::Unit& u, int R0, int C0, unsigned (&o)[2][2]) const {
        const int n = T.ncls[u.cls];
#pragma unroll
        for (int h = 0; h < 2; ++h)
#pragma unroll
            for (int i = 0; i < 2; ++i) { int pos = u.lb * 256 + h * 128 + R0 + 64 * i; pos = pos < n ? pos : n - 1; const int tok = perm[(size_t)u.cls * CLS_CAP + pos]; o[h][i] = (unsigned)(tok * DM + C0) * 2u; } }
    __device__ __forceinline__ const char* b_tile(const pg8::Unit& u, int tt) const { int ea, eb; pair_of(u.cls, ea, eb); const int e = u.pn < 4 ? ea : eb;
        return (const char*)Bt1l + ((size_t)e * 1024 + (size_t)(u.pn & 3) * 256) * DM * 2 + (size_t)tt * 128; }
};
struct Moe2Prob {
    const bf16* A; int ldb; int K; const bf16* Bt2l; ClassTab T; pg8::StaticOrder S;
    __device__ __forceinline__ bool next(int i, pg8::Unit& u) const { if (!S.next(i, u)) return false; class_of(T, u); return true; }
    __device__ __forceinline__ const char* a_base() const { return (const char*)A; }
    __device__ __forceinline__ void a_off(const pg8::Unit& u, int R0, int C0, unsigned (&o)[2][2]) const {
#pragma unroll
        for (int h = 0; h < 2; ++h)
#pragma unroll
            for (int i = 0; i < 2; ++i) o[h][i] = (unsigned)((u.pm * 256 + h * 128 + R0 + 64 * i) * DM + C0) * 2u; }
    __device__ __forceinline__ const char* b_tile(const pg8::Unit& u, int tt) const { int ea, eb; pair_of(u.cls, ea, eb); const int e = tt < 8 ? ea : eb;
        return (const char*)Bt2l + ((size_t)e * 1024 + (size_t)u.pn * 256) * DE * 2 + (size_t)(tt & 7) * 128; }
};

struct EpiProj {
    static constexpr bool PERM = true;
    bf16* O; int ldc; int split_cols; size_t split_stride; int nscale; float scale; int sig_from;
    __device__ __forceinline__ void operator()(const pg8::f32x4 (&acc)[2][2][4][2], const pg8::Unit& u, int wr, int wc, int fr, int fq) const {
        const int row0 = u.pm * 256 + wr * 64 + fr; int colt = u.pn * 256; bf16* base = O;
        if (split_cols) { const int t = colt / split_cols; base += (size_t)t * split_stride; colt -= t * split_cols; }
        const float sc = u.pn < nscale ? scale : 1.0f; const bool sg = u.pn >= sig_from;
        const int col0 = colt + wc * 32 + 8 * fq;
#pragma unroll
        for (int ai = 0; ai < 2; ++ai)
#pragma unroll
            for (int m = 0; m < 4; ++m) { bf16* rowp = base + (size_t)(row0 + ai * 128 + m * 16) * ldc + col0;
#pragma unroll
                for (int bj = 0; bj < 2; ++bj) { pg8::f32x4 v0 = acc[ai][bj][m][0] * sc, v1 = acc[ai][bj][m][1] * sc;
                    if (sg) {
#pragma unroll
                        for (int j = 0; j < 4; ++j) { v0[j] = pg8::sigmoidf_(v0[j]); v1[j] = pg8::sigmoidf_(v1[j]); } }
                    pg8::u32x4 w; w.x = pg8::cvt_pk_bf16(v0[0], v0[1]); w.y = pg8::cvt_pk_bf16(v0[2], v0[3]); w.z = pg8::cvt_pk_bf16(v1[0], v1[1]); w.w = pg8::cvt_pk_bf16(v1[2], v1[3]);
                    *(pg8::u32x4*)(rowp + bj * 128) = w; } }
    }
};
struct EpiRes {
    static constexpr bool PERM = false;
    const float* base; float* out; const float* gate; int gstride;
    __device__ __forceinline__ void operator()(const pg8::f32x4 (&acc)[2][2][4][2], const pg8::Unit& u, int wr, int wc, int fr, int fq) const {
        const int row0 = u.pm * 256 + wr * 64 + fr, col0 = u.pn * 256 + wc * 32 + 4 * fq;
        const float* gp = gate + (size_t)(u.pm >> 4) * gstride + col0;
        pg8::f32x4 gv[2][2];
#pragma unroll
        for (int bj = 0; bj < 2; ++bj)
#pragma unroll
            for (int n = 0; n < 2; ++n) gv[bj][n] = *(const pg8::f32x4*)(gp + bj * 128 + n * 16);
#pragma unroll
        for (int ai = 0; ai < 2; ++ai)
#pragma unroll
            for (int m = 0; m < 4; ++m) { const size_t off = (size_t)(row0 + ai * 128 + m * 16) * DM + col0;
#pragma unroll
                for (int bj = 0; bj < 2; ++bj)
#pragma unroll
                    for (int n = 0; n < 2; ++n) { const pg8::f32x4 bs = *(const pg8::f32x4*)(base + off + bj * 128 + n * 16); *(pg8::f32x4*)(out + off + bj * 128 + n * 16) = bs + gv[bj][n] * acc[ai][bj][m][n]; } }
    }
};
struct EpiResScatter {
    static constexpr bool PERM = false;
    float* x; const float* gate; int gstride; const int* perm; ClassTab T;
    __device__ __forceinline__ void operator()(const pg8::f32x4 (&acc)[2][2][4][2], const pg8::Unit& u, int wr, int wc, int fr, int fq) const {
        const int n = T.ncls[u.cls]; const int col0 = u.pn * 256 + wc * 32 + 4 * fq;
#pragma unroll
        for (int ai = 0; ai < 2; ++ai)
#pragma unroll
            for (int m = 0; m < 4; ++m) { const int pos = u.lb * 256 + ai * 128 + wr * 64 + m * 16 + fr;
                if (pos < n) { const int tok = perm[(size_t)u.cls * CLS_CAP + pos]; const size_t off = (size_t)tok * DM + col0; const float* gp = gate + (size_t)(tok >> 12) * gstride + col0;
#pragma unroll
                    for (int bj = 0; bj < 2; ++bj)
#pragma unroll
                        for (int nn = 0; nn < 2; ++nn) { const pg8::f32x4 gv = *(const pg8::f32x4*)(gp + bj * 128 + nn * 16); const pg8::f32x4 bs = *(const pg8::f32x4*)(x + off + bj * 128 + nn * 16);
                            *(pg8::f32x4*)(x + off + bj * 128 + nn * 16) = bs + gv * acc[ai][bj][m][nn]; } } }
    }
};
struct EpiAct {
    static constexpr bool PERM = true;
    bf16* act; const int* perm; const float2* wts; ClassTab T;
    __device__ __forceinline__ void operator()(const pg8::f32x4 (&acc)[2][2][4][2], const pg8::Unit& u, int wr, int wc, int fr, int fq) const {
        const int n = T.ncls[u.cls]; const int second = u.pn >> 2; const int col0 = second * 512 + (u.pn & 3) * 128 + wc * 32 + 8 * fq;
#pragma unroll
        for (int ai = 0; ai < 2; ++ai)
#pragma unroll
            for (int m = 0; m < 4; ++m) { const int lr = ai * 128 + wr * 64 + m * 16 + fr; int pos = u.lb * 256 + lr; pos = pos < n ? pos : n - 1;
                const int tok = perm[(size_t)u.cls * CLS_CAP + pos]; const float2 w2 = wts[tok]; const float wt = second ? w2.y : w2.x;
                pg8::f32x4 g0 = acc[ai][0][m][0], g1 = acc[ai][0][m][1]; const pg8::f32x4 u0 = acc[ai][1][m][0], u1 = acc[ai][1][m][1];
#pragma unroll
                for (int j = 0; j < 4; ++j) { g0[j] = g0[j] * pg8::sigmoidf_(g0[j]) * u0[j] * wt; g1[j] = g1[j] * pg8::sigmoidf_(g1[j]) * u1[j] * wt; }
                pg8::u32x4 w; w.x = pg8::cvt_pk_bf16(g0[0], g0[1]); w.y = pg8::cvt_pk_bf16(g0[2], g0[3]); w.z = pg8::cvt_pk_bf16(g1[0], g1[1]); w.w = pg8::cvt_pk_bf16(g1[2], g1[3]);
                *(pg8::u32x4*)(act + (size_t)(u.pm * 256 + lr) * DM + col0) = w; }
    }
};
__device__ __forceinline__ void build_class_tab(Frame& F, gu32* gcnt) {
    LAS int* blkstart = (LAS int*)(F.lds + TAB_OFF); LAS int* ncls = blkstart + 32;
    if (F.tid == 0) { int run = 0; for (int c = 0; c < NCLS; ++c) { const int n = (int)__hip_atomic_load(gcnt + c, RLX_AGENT); ncls[c] = n; blkstart[c] = run; run += (n + 255) >> 8; } blkstart[NCLS] = run; }
    __syncthreads();
}

__global__ void __launch_bounds__(NWAVES * 64, 2) mk_fwd(Args args) {
    extern __shared__ __attribute__((aligned(16))) unsigned char lds[];
    Frame F;
    F.lds = (LAS unsigned char*)lds;
    F.MISC = (volatile LAS unsigned*)(F.lds + MISC_OFF);
    F.tid = threadIdx.x; F.lane = F.tid & 63; F.wave = __builtin_amdgcn_readfirstlane(F.tid >> 6);
    F.G = gridDim.x; { const int bx = blockIdx.x; F.vcu = (F.G % 8 == 0) ? (bx % 8) * (F.G / 8) + bx / 8 : bx; }
    unsigned char* ws = args.ws;
    F.ctl = (gu32*)(ws + WS_CTL);
    for (int u = F.tid; u < (LDS_BYTES - LDSCTL_OFF) / 4; u += NWAVES * 64) ((LAS unsigned*)(F.lds + LDSCTL_OFF))[u] = 0u;
    __syncthreads();
    const int lo = args.ph_lo, hi = args.ph_hi;
    const bool multi = (hi - lo) > 1;
    XcdBarrier bar; bar.bar = (unsigned*)(F.ctl + CW_BAR); bar.x = 0; bar.st = nullptr;
    if (multi) bar = xcd_barrier_post((unsigned*)(F.ctl + CW_BAR), F.MISC + 8);
    int ph = 0;
#define REPEAT(N) _Pragma("clang loop unroll(disable)") for (int rep_ = 0; rep_ < (N); ++rep_)
#ifndef REP_NORM1
#define REP_NORM1 1
#endif
#ifndef REP_PROJ
#define REP_PROJ 1
#endif
#ifndef REP_CELL
#define REP_CELL 1
#endif
#ifndef REP_CELLB
#define REP_CELLB 1
#endif
#ifndef REP_ATTN
#define REP_ATTN 1
#endif
#ifndef REP_MOE1
#define REP_MOE1 1
#endif
#ifndef REP_NORM2N
#define REP_NORM2N 0
#endif
#define PH_BEGIN(run) const bool run = (lo <= ph && ph < hi); ++ph;
#define PH_END(run) do { if (run && ph < hi) xcd_barrier(bar); } while (0)

    float* const X = args.out;

    { PH_BEGIN(run) if (run) {
#ifndef DIS_P0
 p0_prologue(F, args);
#endif
 } PH_END(run); }

    for (int step = 0; step < 5; ++step) {
        unsigned char* ws = args.ws; asm volatile("" : "+s"(ws));
        float* const MODS = (float*)(ws + WS_MODS);
        bf16* const HB = (bf16*)(ws + WS_HB);
        bf16* const BIG = (bf16*)(ws + WS_BIG);
        bf16* const ACT = (bf16*)(ws + WS_ACT);
        float* const G16 = (float*)(ws + WS_G16);
        float* const FB = (float*)(ws + WS_FB);
        float2* const WTS = (float2*)(ws + WS_WTS);
        int* const PERM = (int*)(ws + WS_PERM);
        bf16* const Kb = BIG; bf16* const Vb = BIG + (size_t)NT * DM; bf16* const Qb = BIG + (size_t)2 * NT * DM;
        const int kind = step < 2 ? 0 : step == 2 ? 1 : 2;
        const int L = step < 2 ? step : step == 2 ? 2 : step - 1;
        const float* xin = (L == 0) ? args.in[I_X] : X;
        const float* mods = MODS + (size_t)L * NB * 6144;
        { PH_BEGIN(run) if (run) {
#ifndef DIS_NORM1
            const float* gam = kind == 1 ? args.in[I_KVNORM] : args.in[I_NMIX] + L * DM;
            const float* shf = kind == 1 ? (const float*)(ws + WS_KVMOD) : mods; const float* scl = shf + 1024; const int mstr = kind == 1 ? 2048 : 6144;
            const int nmode = kind == 0 ? 1 : kind == 1 ? 2 : 0;
            const float* w16 = kind == 0 ? args.in[I_AWIN] + (size_t)L * DM * A_IN + A_PROJ : args.in[I_WKV] + 2048; const int ldw16 = kind == 0 ? A_IN : KV_OUT;
            const float* b16 = kind == 0 ? args.in[I_ABG] + L * 16 : args.in[I_BFG];
            REPEAT(REP_NORM1) norm_phase<false>(F, xin, gam, shf, scl, mstr, HB, nmode, w16, ldw16, b16, G16, nullptr, nullptr, nullptr);
#endif
          } PH_END(run); }
        { PH_BEGIN(run) if (run) {
#ifndef DIS_PROJ
            if (kind == 1) fcum_phase(F, G16, FB);
            DenseProb P; P.A = HB; P.lda = DM; P.ldb = DM; P.K = DM;
            EpiProj E; E.split_cols = 0; E.split_stride = 0; E.nscale = 0; E.scale = 1.f; E.sig_from = 1 << 30;
            if (kind == 0) { P.Bt = (const bf16*)(ws + WS_WIN) + (size_t)L * A_PROJ * DM; P.S.init(NT / 256, A_PROJ / 256, F.G, (int)blockIdx.x); E.O = BIG; E.ldc = A_PROJ; E.nscale = 2; E.scale = 0.125f; E.sig_from = 8; }
            else if (kind == 1) { P.Bt = (const bf16*)(ws + WS_WKV); P.S.init(NT / 256, 8, F.G, (int)blockIdx.x); E.O = Kb; E.ldc = DM; E.split_cols = 1024; E.split_stride = (size_t)NT * DM; }
            else { P.Bt = (const bf16*)(ws + WS_WQ) + (size_t)(L - 2) * DM * DM; P.S.init(NT / 256, 4, F.G, (int)blockIdx.x); E.O = Qb; E.ldc = DM; E.nscale = 4; E.scale = attn_body::C2; }
            REPEAT(REP_PROJ) pg8::gemm_phase<EpiProj, DenseProb, true>(F.lds + RING_OFF, P, E);
#endif
          } PH_END(run); }
        if (kind == 1) continue;
        bf16* const CTS = ACT; float* const NS = (float*)(ws + WS_ACT + (size_t)128 * MiB); float* const MS = NS + (size_t)NB * 8 * 64 * 64;
        if (kind == 0) { PH_BEGIN(run) if (run) {
#ifndef DIS_CELL
            REPEAT(REP_CELL) cellA_phase(F, BIG, G16, CTS, NS, MS);
#endif
          } PH_END(run); }
        { PH_BEGIN(run) if (run) {
#ifndef DIS_CELL
            if (kind == 0) REPEAT(REP_CELLB) cellB_phase(F, BIG, G16, args.in[I_AMH] + L * DM, CTS, NS, MS, HB);
#endif
#ifndef DIS_ATTN
            if (kind == 2) REPEAT(REP_ATTN) { const attn_body::AttnTensors AT{(const attn_body::bf16*)Qb, (const attn_body::bf16*)Kb, (const attn_body::bf16*)Vb, (attn_body::bf16*)(rep_ + 1 < REP_ATTN ? ACT : Qb), FB};
                   attn_body::attn_phase<8>((char*)lds + RING_OFF, AT, F.vcu, F.G); }
#endif
          } PH_END(run); }
        { PH_BEGIN(run) if (run) {
#ifndef DIS_OUT
            DenseProb P; P.A = kind == 0 ? HB : Qb; P.lda = DM; P.ldb = DM; P.K = DM;
            P.Bt = kind == 0 ? (const bf16*)(ws + WS_WOUT) + (size_t)L * DM * DM : (const bf16*)(ws + WS_WO) + (size_t)(L - 2) * DM * DM;
            P.S.init(NT / 256, 4, F.G, (int)blockIdx.x);
            EpiRes E; E.base = xin; E.out = X; E.gate = mods + 2048; E.gstride = 6144;
            pg8::gemm_phase<EpiRes, DenseProb, true>(F.lds + RING_OFF, P, E);
#endif
          } PH_END(run); }
        gu32* const gcnt = (gu32*)(ws + WS_CTL) + CW_CNT + L * 32;
        { PH_BEGIN(run) if (run) {
#ifndef DIS_NORM2
            REPEAT(REP_NORM2N) norm_phase<false>(F, X, args.in[I_NFFN] + L * DM, mods + 3072, mods + 4096, 6144, ACT, 0, nullptr, 0, nullptr, nullptr, nullptr, nullptr, nullptr);
            norm_phase<true>(F, X, args.in[I_NFFN] + L * DM, mods + 3072, mods + 4096, 6144, HB, 3, args.in[I_WR], 16, args.in[I_RB], nullptr, WTS, PERM, gcnt);
#endif
          } PH_END(run); }
        const ClassTab CT{(const LAS int*)(F.lds + TAB_OFF), (const LAS int*)(F.lds + TAB_OFF) + 32};
        { PH_BEGIN(run) if (run) {
#ifndef DIS_MOE1
            build_class_tab(F, gcnt);
            Moe1Prob P; P.A = HB; P.ldb = DM; P.K = DM; P.Bt1l = (const bf16*)(ws + WS_BT1) + (size_t)L * 16 * 1024 * DM; P.perm = PERM; P.T = CT;
            P.S.init(CT.blkstart[NCLS], 8, F.G, (int)blockIdx.x);
            EpiAct E; E.act = ACT; E.perm = PERM; E.wts = WTS; E.T = CT;
            REPEAT(REP_MOE1) pg8::gemm_phase<EpiAct, Moe1Prob, true>(F.lds + RING_OFF, P, E);
#endif
          } PH_END(run); }
        { PH_BEGIN(run) if (run) {
#ifndef DIS_MOE2
            build_class_tab(F, gcnt);
            Moe2Prob P; P.A = ACT; P.ldb = DE; P.K = DM; P.Bt2l = (const bf16*)(ws + WS_BT2) + (size_t)L * 16 * DM * DE; P.T = CT;
            P.S.init(CT.blkstart[NCLS], 4, F.G, (int)blockIdx.x);
            EpiResScatter E; E.x = X; E.gate = mods + 5120; E.gstride = 6144; E.perm = PERM; E.T = CT;
            pg8::gemm_phase<EpiResScatter, Moe2Prob, true>(F.lds + RING_OFF, P, E);
#endif
          } PH_END(run); }
    }
    { PH_BEGIN(run) if (run) {
#ifndef DIS_FINAL
 final_norm_phase(F, X, args.in[I_NFIN], (const float*)(args.ws + WS_FIN), (const float*)(args.ws + WS_FIN) + 1024, 2048);
#endif
 } }
#undef PH_BEGIN
#undef PH_END
}
constexpr int N_PHASES = 1 + 2 * 8 + 2 + 2 * 7 + 1;

#ifndef MK_SPLIT
#define MK_SPLIT 0
#endif
extern "C" void kernel_launch(void* const* d_in, const int* in_sizes, int n_in, void* d_out, int out_size, void* d_ws, size_t ws_size, hipStream_t stream) {
    static int grid = 0;
    if (grid == 0) {
        if (n_in != 25 || in_sizes[0] != NT * DM || out_size != NT * DM || ws_size < WS_END) { fprintf(stderr, "kernel_launch: unexpected shapes (n_in %d, in0 %d, out %d, ws %zu); nothing launched\n", n_in, n_in > 0 ? in_sizes[0] : -1, out_size, ws_size); grid = -1; return; }
        int dev = 0, cus = 0, per_cu = 0;
        if (hipGetDevice(&dev) != hipSuccess || hipDeviceGetAttribute(&cus, hipDeviceAttributeMultiprocessorCount, dev) != hipSuccess) { grid = -1; return; }
        if (hipFuncSetAttribute((const void*)mk_fwd, hipFuncAttributeMaxDynamicSharedMemorySize, LDS_BYTES) != hipSuccess) { fprintf(stderr, "kernel_launch: hipFuncSetAttribute failed\n"); grid = -1; return; }
        if (hipOccupancyMaxActiveBlocksPerMultiprocessor(&per_cu, (const void*)mk_fwd, NWAVES * 64, LDS_BYTES) != hipSuccess || per_cu < 1) { fprintf(stderr, "kernel_launch: occupancy query reports %d workgroups per CU\n", per_cu); }
        (void)hipGetLastError();
        grid = cus;
    }
    if (grid < 0) return;
    if (hipMemsetAsync((char*)d_ws + WS_CTL, 0, CTL_ZERO_BYTES, stream) != hipSuccess) return;
    Args a{};
    for (int i = 0; i < 25; ++i) a.in[i] = (const float*)d_in[i];
    a.out = (float*)d_out; a.ws = (unsigned char*)d_ws;
#if MK_SPLIT
    for (int p = 0; p < N_PHASES; ++p) { a.ph_lo = p; a.ph_hi = p + 1; hipLaunchKernelGGL(mk_fwd, dim3(grid), dim3(NWAVES * 64), LDS_BYTES, stream, a); }
#else
    a.ph_lo = 0; a.ph_hi = N_PHASES;
    hipLaunchKernelGGL(mk_fwd, dim3(grid), dim3(NWAVES * 64), LDS_BYTES, stream, a);
#endif
}
```

```cpp
#include <hip/hip_runtime.h>
#include <hip/hip_bf16.h>
#include <cstdio>
#include <cstdint>
#ifndef PG8_WGM
#define PG8_WGM 8
#endif
#ifndef OUT_F8
#define OUT_F8 true
#endif
#define LAS __attribute__((address_space(3)))
#define GAS __attribute__((address_space(1)))
__device__ __forceinline__ int hw_tid_(int wave0) { unsigned z = 0u; asm volatile("" : "+s"(z)); return wave0 * 64 + (int)__builtin_amdgcn_mbcnt_hi(~0u, __builtin_amdgcn_mbcnt_lo(~0u, z)); }
#define HW_TID(wave0) hw_tid_(wave0)

namespace pg8 {
typedef unsigned short bf16_t;
typedef short bf16x8 __attribute__((ext_vector_type(8)));
typedef float f32x4 __attribute__((ext_vector_type(4)));
typedef unsigned u32x4 __attribute__((ext_vector_type(4)));
typedef unsigned u32x2 __attribute__((ext_vector_type(2)));
constexpr int BM = 256, BK = 64, HALF = 128, HTB = HALF * BK * 2  , STAGE_BYTES = 8 * HTB, NXCD = 8, WGM = PG8_WGM;

__host__ __device__ __forceinline__ int lds_byte(int r, int c) { const int st = (r >> 4) * 2 + (c >> 5), rr = r & 15, cc = c & 31, ob = rr * 64 + cc * 2; return st * 1024 + (ob ^ (((ob >> 9) & 1) << 5)); }
__host__ __device__ __forceinline__ void stage_rc(int b, int& R, int& C) { const int st = b / 1024, sb = b % 1024, swz = sb ^ (((sb >> 9) & 1) << 5); R = (st >> 1) * 16 + swz / 64; C = (st & 1) * 32 + (swz % 64) / 2; }
__host__ __device__ __forceinline__ int perm32(int rho) { const int n = rho >> 4, i = rho & 15; return 8 * (i >> 2) + 4 * n + (i & 3); }

struct Unit { int pm, pn, cls, lb, hf, r0; };

struct StaticOrder {
    int nM, nN, nwg, G, c;
    __device__ __forceinline__ void init(int nM_, int nN_, int G_, int c_) { nM = nM_; nN = nN_; nwg = nM * nN; G = G_; c = c_; }
    __device__ __forceinline__ bool next(int i, Unit& u) const { return next_L((long)i * G + c, u); }
    __device__ __forceinline__ bool next_L(long L, Unit& u) const {
        if (L >= nwg) return false;
        int wgid = (int)L; { const int q = nwg / NXCD, r = nwg % NXCD, xcd = wgid % NXCD, off = wgid / NXCD; wgid = (xcd < r ? xcd * (q + 1) : r * (q + 1) + (xcd - r) * q) + off; }
        const int nig = WGM * nN, gid = wgid / nig, fm = gid * WGM, gsz = (nM - fm) < WGM ? (nM - fm) : WGM;
        u.pm = fm + ((wgid % nig) % gsz); u.pn = (wgid % nig) / gsz; u.cls = 0; u.lb = 0; u.hf = 0; u.r0 = 0; return true;
    }
};

__device__ __forceinline__ unsigned cvt_pk_bf16(float lo, float hi) { unsigned r; asm volatile("v_cvt_pk_bf16_f32 %0, %1, %2" : "=v"(r) : "v"(lo), "v"(hi)); return r; }
__device__ __forceinline__ float sigmoidf_(float x) { return __builtin_amdgcn_rcpf(1.0f + __expf(-x)); }
typedef int v4i_t __attribute__((ext_vector_type(4)));
typedef int v8i_t __attribute__((ext_vector_type(8)));
__device__ __forceinline__ v8i_t cat8(bf16x8 lo, bf16x8 hi) { const v4i_t a = __builtin_bit_cast(v4i_t, lo), b = __builtin_bit_cast(v4i_t, hi); return __builtin_shufflevector(a, b, 0, 1, 2, 3, 4, 5, 6, 7); }

template <class Epi, class Prob, bool ALIGN_EPI, bool F8 = false, bool HALFN = false>
__device__ __forceinline__ void gemm_phase(LAS unsigned char* lds, const int wave0, const Prob& S, const Epi& E) {
    int tid_ = HW_TID(wave0); asm volatile("" : "+v"(tid_));
    const int tid = tid_, wid = __builtin_amdgcn_readfirstlane(tid >> 6), lane = tid & 63, wr = wid >> 2, wc = wid & 3, fr = lane & 15, fq = lane >> 4;
    constexpr int ESZ = F8 ? 1 : 2;
    const int K = S.K, nt = K / (F8 ? 2 * BK : BK);
    int R0, C0; stage_rc(tid * 16, R0, C0);
    const int Rb0 = Epi::PERM ? ((R0 & ~31) + perm32(R0 & 31)) : R0;
    unsigned voffB[2]; voffB[0] = (unsigned)(Rb0 * S.ldb) * ESZ + (unsigned)C0 * 2u; voffB[1] = (unsigned)((Rb0 + 64) * S.ldb) * ESZ + (unsigned)C0 * 2u;
    const size_t hstepB = (size_t)HALF * S.ldb * ESZ;
    const unsigned ldsw = (unsigned)wid * 1024u;
    const int aoff_l = lds_byte(wr * 64 + fr, F8 ? fq * 16 : fq * 8), boff_l = lds_byte(wc * 32 + fr, F8 ? fq * 16 : fq * 8);
    const int aoff_h = F8 ? lds_byte(wr * 64 + fr, fq * 16 + 8) : aoff_l + 1024, boff_h = F8 ? lds_byte(wc * 32 + fr, fq * 16 + 8) : boff_l + 1024;
    const int sc_w = S.scale_w, sc_a = S.scale_a;
    const char* const Ab = S.a_base();
#define PG8_SA(b, h) (((b) * 2 + (h)) * HTB)
#define PG8_SB(b, h) ((4 + (b) * 2 + (h)) * HTB)
#define PG8_STA(bufoff, h, tt) do { _Pragma("unroll") for (int _i = 0; _i < 2; ++_i) \
        __builtin_amdgcn_global_load_lds((const unsigned*)(Ab + (size_t)aoff[h][_i] + (size_t)(tt) * (BK * 2)), (LAS unsigned*)(lds + (bufoff) + ldsw + _i * 8192), 16, 0, 0); } while (0)
#define PG8_STB(bufoff, bp, h) do { _Pragma("unroll") for (int _i = 0; _i < 2; ++_i) \
        __builtin_amdgcn_global_load_lds((const unsigned*)((bp) + (h) * hstepB + voffB[_i]), (LAS unsigned*)(lds + (bufoff) + ldsw + _i * 8192), 16, 0, 0); } while (0)
#define PG8_LDA(dst, b, h) do { _Pragma("unroll") for (int m = 0; m < 4; ++m) _Pragma("unroll") for (int k = 0; k < 2; ++k) dst[m][k] = *(const LAS bf16x8*)(lds + PG8_SA(b, h) + (k ? aoff_h : aoff_l) + m * 2048); } while (0)
#define PG8_LDB(dst, b, h) do { _Pragma("unroll") for (int n = 0; n < 2; ++n) _Pragma("unroll") for (int k = 0; k < 2; ++k) dst[n][k] = *(const LAS bf16x8*)(lds + PG8_SB(b, h) + (k ? boff_h : boff_l) + n * 2048); } while (0)
#define PG8_MMA(ai, bj, At, Bt) do { __builtin_amdgcn_s_setprio(1); _Pragma("unroll") for (int m = 0; m < 4; ++m) _Pragma("unroll") for (int n = 0; n < 2; ++n) { \
        if constexpr (F8) acc[ai][bj][m][n] = __builtin_amdgcn_mfma_scale_f32_16x16x128_f8f6f4(cat8(Bt[n][0], Bt[n][1]), cat8(At[m][0], At[m][1]), acc[ai][bj][m][n], 0, 0, 0, sc_w, 0, sc_a); \
        else { _Pragma("unroll") for (int k = 0; k < 2; ++k) acc[ai][bj][m][n] = __builtin_amdgcn_mfma_f32_16x16x32_bf16(Bt[n][k], At[m][k], acc[ai][bj][m][n], 0, 0, 0); } } __builtin_amdgcn_s_setprio(0); } while (0)
#define PG8_WAIT_V(n) asm volatile("s_waitcnt vmcnt(" #n ")" ::: "memory")
#define PG8_WAIT_L(n) asm volatile("s_waitcnt lgkmcnt(" #n ")" ::: "memory")
#define PG8_BAR __builtin_amdgcn_s_barrier()
#define PG8_SCHED __builtin_amdgcn_sched_barrier(0)
    Unit cur, nxt; int ui = 0;
    if (!S.next(0, cur)) return;
    f32x4 acc[2][2][4][2];
#pragma unroll
    for (int a = 0; a < 2; ++a)
#pragma unroll
        for (int b = 0; b < 2; ++b)
#pragma unroll
            for (int m = 0; m < 4; ++m)
#pragma unroll
                for (int n = 0; n < 2; ++n) acc[a][b][m][n] = (f32x4){0.f, 0.f, 0.f, 0.f};
    bf16x8 At[4][2], B0[2][2], B1[2][2];
    unsigned aoff[2][2], aoffN[2][2];
    S.a_off(cur, R0, C0, aoff);
    { const char* bp0 = S.b_tile(cur, 0); const char* bp1 = S.b_tile(cur, 1);
      PG8_STB(PG8_SB(0, 0), bp0, 0); PG8_STB(PG8_SB(0, 1), bp0, 1); PG8_STA(PG8_SA(0, 0), 0, 0); PG8_STA(PG8_SA(0, 1), 1, 0);
      if (wr == 1) PG8_BAR;
      PG8_WAIT_V(2); PG8_BAR;
      PG8_STB(PG8_SB(1, 0), bp1, 0); PG8_STA(PG8_SA(1, 0), 0, 1); PG8_STB(PG8_SB(1, 1), bp1, 1);
      PG8_WAIT_V(6); PG8_BAR; }
    for (;;) {
        const bool has_next = S.next(ui + 1, nxt);
        if (has_next) S.a_off(nxt, R0, C0, aoffN); else { aoffN[0][0] = aoff[0][0]; aoffN[0][1] = aoff[0][1]; aoffN[1][0] = aoff[1][0]; aoffN[1][1] = aoff[1][1]; }
        for (int t = 0; t < nt; t += 2) {
            const bool last = (t == nt - 2);
            PG8_LDB(B0, 0, 0); PG8_LDB(B1, 0, 1); PG8_SCHED; PG8_LDA(At, 0, 0); PG8_STA(PG8_SA(1, 1), 1, t + 1);
            PG8_WAIT_V(8); PG8_WAIT_L(0); PG8_BAR; PG8_MMA(0, 0, At, B0); if constexpr (!HALFN) PG8_MMA(0, 1, At, B1); PG8_BAR; PG8_SCHED;
            const int t2 = last ? 0 : t + 2;
            const Unit& u2 = (last && has_next) ? nxt : cur;
            if (last) { aoff[0][0] = aoffN[0][0]; aoff[0][1] = aoffN[0][1]; aoff[1][0] = aoffN[1][0]; aoff[1][1] = aoffN[1][1]; }
            const char* b2 = S.b_tile(u2, t2); const char* b3 = S.b_tile(u2, t2 + 1);
            PG8_LDA(At, 0, 1); PG8_STB(PG8_SB(0, 0), b2, 0); PG8_STB(PG8_SB(0, 1), b2, 1); PG8_STA(PG8_SA(0, 0), 0, t2);
            PG8_WAIT_V(8); PG8_WAIT_L(0); PG8_BAR; PG8_MMA(1, 0, At, B0); if constexpr (!HALFN) PG8_MMA(1, 1, At, B1); PG8_BAR; PG8_SCHED;
            PG8_LDB(B0, 1, 0); PG8_LDB(B1, 1, 1); PG8_SCHED; PG8_LDA(At, 1, 0); PG8_STA(PG8_SA(0, 1), 1, t2);
            PG8_WAIT_V(8); PG8_WAIT_L(0); PG8_BAR; PG8_MMA(0, 0, At, B0); if constexpr (!HALFN) PG8_MMA(0, 1, At, B1); PG8_BAR; PG8_SCHED;
            PG8_LDA(At, 1, 1); PG8_STB(PG8_SB(1, 0), b3, 0); PG8_STB(PG8_SB(1, 1), b3, 1); PG8_STA(PG8_SA(1, 0), 0, t2 + 1);
            PG8_WAIT_V(8); PG8_WAIT_L(0); PG8_BAR; PG8_MMA(1, 0, At, B0); if constexpr (!HALFN) PG8_MMA(1, 1, At, B1); PG8_BAR; PG8_SCHED;
        }
        if constexpr (ALIGN_EPI) { if (wr == 0) PG8_BAR; }
        E(acc, cur, wr, wc, fr, fq);
        if (!has_next) break;
#pragma unroll
        for (int a = 0; a < 2; ++a)
#pragma unroll
            for (int b = 0; b < 2; ++b)
#pragma unroll
                for (int m = 0; m < 4; ++m)
#pragma unroll
                    for (int n = 0; n < 2; ++n) acc[a][b][m][n] = (f32x4){0.f, 0.f, 0.f, 0.f};
        cur = nxt; ++ui;
        if constexpr (ALIGN_EPI) { if (wr == 1) PG8_BAR; }
    }
    PG8_WAIT_V(0);
    if constexpr (!ALIGN_EPI) { if (wr == 0) PG8_BAR; }
    PG8_BAR;
#undef PG8_SA
#undef PG8_SB
#undef PG8_STA
#undef PG8_STB
#undef PG8_LDA
#undef PG8_LDB
#undef PG8_MMA
#undef PG8_WAIT_V
#undef PG8_WAIT_L
#undef PG8_BAR
#undef PG8_SCHED
}
}

#include <hip/hip_bf16.h>
#include <cmath>
namespace attn_body {
using bf16=__hip_bfloat16;
using bf16x8=__attribute__((ext_vector_type(8)))short;
using s16x4=__attribute__((ext_vector_type(4)))short;
using f32x16=__attribute__((ext_vector_type(16)))float;
using u32x4=__attribute__((ext_vector_type(4)))unsigned;
constexpr int BATCH=16,NHEAD=16,SEQ=4096,D=64,DM=NHEAD*D;
constexpr int NW=8,QBLK=32,QB=QBLK*NW,KVBLK=64,NQB=SEQ/QB;
constexpr int ATTN_PITCH=DM, ATTN_UNIT_ROWS=QB;
__device__ __forceinline__ int crow(int r,int hi){return (r&3)+8*(r>>2)+4*hi;}
#define SBAR() __builtin_amdgcn_sched_barrier(0)
__device__ __forceinline__ void cmask(f32x16&p0,f32x16&p1,int jb,int qrel,int hi){
  const float NEG=-INFINITY; int kb=64*jb+4*hi;
  #pragma unroll
  for(int r=0;r<16;++r){int kv=kb+(r&3)+8*(r>>2); if(kv>qrel)p0[r]=NEG; if(kv+32>qrel)p1[r]=NEG;}
}

constexpr int NSLOT=3, SLOTB=8192;
constexpr int LDS_K=0, LDS_V=NSLOT*SLOTB, LDS_WS=2*NSLOT*SLOTB, LDS_OST=LDS_WS+NW*64*4, LDS_BYTES=LDS_OST+NW*4096;
constexpr float C2=0.125f*1.4426950408889634f;
__device__ __forceinline__ void glds16(const void*gsrc,unsigned lds_dst){unsigned keep;
  asm volatile("s_mov_b32 %0, m0\n\ts_mov_b32 m0, %2\n\ts_nop 0\n\tglobal_load_lds_dwordx4 %1, off\n\ts_mov_b32 m0, %0":"=&s"(keep):"v"(gsrc),"s"(lds_dst):"memory");}
__device__ __forceinline__ float max3f(float a,float b,float c){float r;asm("v_max3_f32 %0, %1, %2, %3":"=v"(r):"v"(a),"v"(b),"v"(c));return r;}
__device__ __forceinline__ float max2f(float a,float b){float r;asm("v_max_f32_e32 %0, %1, %2":"=v"(r):"v"(a),"v"(b));return r;}
__device__ __forceinline__ float fadd_s(float a,float b){float r;asm("v_add_f32_e32 %0, %1, %2":"=v"(r):"v"(a),"v"(b));return r;}
__device__ __forceinline__ float fsub_s(float a,float b){float r;asm("v_sub_f32_e32 %0, %1, %2":"=v"(r):"v"(a),"v"(b));return r;}
typedef float f32x2_t __attribute__((ext_vector_type(2))); typedef __bf16 bf16x2_t __attribute__((ext_vector_type(2)));
__device__ __forceinline__ unsigned cvtpk_s(float lo,float hi){f32x2_t v={lo,hi};bf16x2_t b=__builtin_convertvector(v,bf16x2_t);return __builtin_bit_cast(unsigned,b);}
#define WAIT_BAR(N) asm volatile("s_waitcnt vmcnt(" #N ") lgkmcnt(0)\n\ts_barrier":::"memory")

__device__ __forceinline__ void qkt(f32x16&p0,f32x16&p1,const char*Kslot,const bf16x8*qr,const f32x16&c0,const f32x16&c1,int r32,int hi){
  const char*kb=Kslot+hi*1024+r32*16;
  #pragma unroll
  for(int d0=0;d0<4;++d0){
    const bf16x8 b0=*reinterpret_cast<const bf16x8*>(kb+d0*2048);
    const bf16x8 b1=*reinterpret_cast<const bf16x8*>(kb+d0*2048+512);
    if(d0==0){p0=__builtin_amdgcn_mfma_f32_32x32x16_bf16(b0,qr[0],c0,0,0,0);p1=__builtin_amdgcn_mfma_f32_32x32x16_bf16(b1,qr[0],c1,0,0,0);}
    else{p0=__builtin_amdgcn_mfma_f32_32x32x16_bf16(b0,qr[d0],p0,0,0,0);p1=__builtin_amdgcn_mfma_f32_32x32x16_bf16(b1,qr[d0],p1,0,0,0);}}
}
typedef __attribute__((address_space(3))) const char* lds_cptr;
typedef short v4i16_t __attribute__((ext_vector_type(4)));
__device__ __forceinline__ void kload8(bf16x8*kf,lds_cptr kp){
  kf[0]=*(const __attribute__((address_space(3))) bf16x8*)(kp);      kf[1]=*(const __attribute__((address_space(3))) bf16x8*)(kp+512);
  kf[2]=*(const __attribute__((address_space(3))) bf16x8*)(kp+2048); kf[3]=*(const __attribute__((address_space(3))) bf16x8*)(kp+2560);
  kf[4]=*(const __attribute__((address_space(3))) bf16x8*)(kp+4096); kf[5]=*(const __attribute__((address_space(3))) bf16x8*)(kp+4608);
  kf[6]=*(const __attribute__((address_space(3))) bf16x8*)(kp+6144); kf[7]=*(const __attribute__((address_space(3))) bf16x8*)(kp+6656);
}
__device__ __forceinline__ void kload2(bf16x8*kf,lds_cptr kp,int j){ kf[2*j]=*(const __attribute__((address_space(3))) bf16x8*)(kp+j*2048); kf[2*j+1]=*(const __attribute__((address_space(3))) bf16x8*)(kp+j*2048+512); }
__device__ __forceinline__ s16x4 vtr(lds_cptr p){ return __builtin_bit_cast(s16x4,__builtin_amdgcn_ds_read_tr16_b64_v4i16((__attribute__((address_space(3))) v4i16_t*)p)); }
__device__ __forceinline__ float rowmax(const f32x16&p0,const f32x16&p1){
  float a=max3f(p0[0],p0[1],p1[0]),b=max3f(p0[2],p0[3],p1[1]);a=max3f(a,p1[2],p1[3]);
  #pragma unroll
  for(int r=4;r<16;r+=4){a=max3f(a,p0[r],p0[r+1]);b=max3f(b,p0[r+2],p0[r+3]);a=max3f(a,p1[r],p1[r+1]);b=max3f(b,p1[r+2],p1[r+3]);}
  const float m=max2f(a,b);
  auto rr=__builtin_amdgcn_permlane32_swap(__float_as_uint(m),__float_as_uint(m),false,false);
  return max2f(__uint_as_float(rr[0]),__uint_as_float(rr[1]));
}
__device__ __forceinline__ void pv(f32x16*o,int vb,bf16x8 pa0,bf16x8 pa1,bf16x8 pa2,bf16x8 pa3){
  #pragma unroll
  for(int d0=0;d0<2;++d0){s16x4 lo[4],hi[4];
    #pragma unroll
    for(int ks=0;ks<4;++ks){
      asm volatile("ds_read_b64_tr_b16 %0,%1 offset:%c2":"=&v"(lo[ks]):"v"(vb),"i"(d0*4096+ks*1024):"memory");
      asm volatile("ds_read_b64_tr_b16 %0,%1 offset:%c2":"=&v"(hi[ks]):"v"(vb),"i"(d0*4096+ks*1024+512):"memory");}
    asm volatile("s_waitcnt lgkmcnt(0)":::"memory");SBAR();
    #define PK(k) (bf16x8){lo[k][0],lo[k][1],lo[k][2],lo[k][3],hi[k][0],hi[k][1],hi[k][2],hi[k][3]}
    o[d0]=__builtin_amdgcn_mfma_f32_32x32x16_bf16(pa0,PK(0),o[d0],0,0,0);
    o[d0]=__builtin_amdgcn_mfma_f32_32x32x16_bf16(pa1,PK(1),o[d0],0,0,0);
    o[d0]=__builtin_amdgcn_mfma_f32_32x32x16_bf16(pa2,PK(2),o[d0],0,0,0);
    o[d0]=__builtin_amdgcn_mfma_f32_32x32x16_bf16(pa3,PK(3),o[d0],0,0,0);
    #undef PK
  }
}

#ifndef ATTN_STORE16
#define ATTN_STORE16(p,v) (*(u32x4*)(p)=(v))
#endif
typedef float f32x4_t __attribute__((ext_vector_type(4)));
typedef __attribute__((address_space(3))) const float* fb_lptr;
__device__ __forceinline__ int f8pk(float a,float b,int old,bool hi){a=__builtin_amdgcn_fmed3f(a,-448.f,448.f);b=__builtin_amdgcn_fmed3f(b,-448.f,448.f);return hi?__builtin_amdgcn_cvt_pk_fp8_f32(a,b,old,true):__builtin_amdgcn_cvt_pk_fp8_f32(a,b,old,false);}
template<int THRL,bool NOFB> __device__ __forceinline__ void attn_unit(int b,int h,int qb,const bf16*Q,const bf16*__restrict__ K,const bf16*__restrict__ V,bf16*O,char*shm,fb_lptr fbl,const int wave0){
  int tid_=HW_TID(wave0); asm volatile("":"+v"(tid_)); const int tid=tid_,lane=tid&63,r32=lane&31,hi=lane>>5; const int wid=__builtin_amdgcn_readfirstlane(tid>>6);
  const long rowbase=(long)b*SEQ; const int q0=qb*QB;
  const bf16*Qw=Q+(rowbase+q0+wid*QBLK)*DM+h*D;
  const bf16*Kh=K+rowbase*DM+h*D,*Vh=V+rowbase*DM+h*D;
  const unsigned lds0=(unsigned)(uintptr_t)shm;
  float*wsf=(float*)(shm+LDS_WS)+wid*64;
  const bf16*ksrc=Kh+(long)lane*DM+wid*8;
  const bf16*vsrc=Vh+(long)(16*(wid&3)+(lane>>2))*DM+(wid>>2)*32+(lane&3)*8;
  const unsigned kdst=lds0+LDS_K+wid*1024, vdst=lds0+LDS_V+wid*1024;
  #define DMA_K(t,slot) glds16(ksrc+(long)(t)*KVBLK*DM,(unsigned)__builtin_amdgcn_readfirstlane(kdst+(slot)))
  #define DMA_V(t,slot) glds16(vsrc+(long)(t)*KVBLK*DM,(unsigned)__builtin_amdgcn_readfirstlane(vdst+(slot)))
  const int vb0=(int)(lds0+LDS_V)+((lane>>4)&1)*32+(lane&3)*8+(4*hi+((lane&15)>>2))*64;
  const char*Kbase=shm+LDS_K; bf16x8 kf[8];
  const lds_cptr shm3=(lds_cptr)shm; const lds_cptr kp0=shm3+LDS_K+hi*1024+r32*16; const lds_cptr vp0=shm3+LDS_V+((lane>>4)&1)*32+(lane&3)*8+(4*hi+((lane&15)>>2))*64;
  const int NT=(q0+QB)/KVBLK;
  DMA_K(0,0);DMA_V(0,0);DMA_K(1,SLOTB);
  bf16x8 qr[4];
  #pragma unroll
  for(int d0=0;d0<4;++d0)qr[d0]=*reinterpret_cast<const bf16x8*>(&Qw[(long)r32*DM+d0*16+hi*8]);
  #define FBIAS(C0,C1,t) do{ const fb_lptr fp_=fbl+64*(t)+4*hi; const float nm_=-mhat; \
    _Pragma("unroll") for(int g_=0;g_<4;++g_){ const f32x4_t a_=*(const __attribute__((address_space(3))) f32x4_t*)(fp_+8*g_); const f32x4_t b_=*(const __attribute__((address_space(3))) f32x4_t*)(fp_+32+8*g_); \
      _Pragma("unroll") for(int i_=0;i_<4;++i_){ C0[4*g_+i_]=a_[i_]+nm_; C1[4*g_+i_]=b_[i_]+nm_; } SBAR(); } }while(0)
  #define FBLOAD(X0,X1,tt,G) do{ if((G)&&!NOFB){ const fb_lptr fp_=fbl+64*(tt)+4*hi; \
    _Pragma("unroll") for(int g_=0;g_<4;++g_){ const f32x4_t a_=*(const __attribute__((address_space(3))) f32x4_t*)(fp_+8*g_); const f32x4_t b_=*(const __attribute__((address_space(3))) f32x4_t*)(fp_+32+8*g_); \
      _Pragma("unroll") for(int i_=0;i_<4;++i_){ X0[4*g_+i_]=a_[i_]; X1[4*g_+i_]=b_[i_]; } } } }while(0)
  #define FBADD(X0,X1,G) do{ if((G)&&!NOFB){ const f32x2_t nm_={-mhat,-mhat}; _Pragma("unroll") for(int r_=0;r_<16;r_+=2){ f32x2_t a_={X0[r_],X0[r_+1]},b_={X1[r_],X1[r_+1]}; a_=a_+nm_; b_=b_+nm_; X0[r_]=a_[0];X0[r_+1]=a_[1];X1[r_]=b_[0];X1[r_+1]=b_[1]; } } }while(0)
  float mhat=0.f,l_reg=0.f;f32x16 o[2];o[0]=f32x16{};o[1]=f32x16{};
  const int qrel=wid*QBLK+r32;
  #define CMASK(P0,P1,t) do{int jb_=(t)-(NT-4); if(jb_>=0)cmask(P0,P1,jb_,qrel,hi);}while(0)
  bool resc=false;
  #define START(P0,P1) do{ const float rm=rowmax(P0,P1); resc=false; \
    { const float dl=rm; mhat=fadd_s(mhat,dl); \
      _Pragma("unroll") for(int r=0;r<16;++r){P0[r]=fsub_s(P0[r],dl);P1[r]=fsub_s(P1[r],dl);} \
      } \
    _Pragma("unroll") for(int r=0;r<16;++r)P0[r]=__builtin_amdgcn_exp2f(P0[r]); }while(0)
  #define RESC() do{ if(resc){ asm volatile("s_waitcnt lgkmcnt(0)":::"memory"); \
      _Pragma("unroll") for(int d_=0;d_<2;++d_) _Pragma("unroll") for(int r=0;r<16;++r)o[d_][r]*=wsf[crow(r,hi)]; } }while(0)
  f32x16 pA0,pA1,pB0,pB1;
  int sl_prev=0,sl_cur=0,sl_next=SLOTB;
  #define ROT() do{sl_prev=sl_cur;sl_cur=sl_next;sl_next=(sl_next==(NSLOT-1)*SLOTB)?0:sl_next+SLOTB;}while(0)
  DMA_K(2,2*SLOTB);
  WAIT_BAR(3);
  FBIAS(pA0,pA1,0); qkt(pA0,pA1,Kbase,qr,pA0,pA1,r32,hi);asm volatile("s_nop 15\n\ts_nop 7":"+v"(pA0),"+v"(pA1));CMASK(pA0,pA1,0);
  START(pA0,pA1); FBLOAD(pB0,pB1,1,true); FBADD(pB0,pB1,true);
  _Pragma("unroll") for(int r=0;r<16;++r)pA1[r]=__builtin_amdgcn_exp2f(pA1[r]);
  WAIT_BAR(0);
  DMA_K(3,0);DMA_V(1,SLOTB);
  ROT();
  kload8(kf,kp0+sl_cur);
  WAIT_BAR(2);
  s16x4 vlo[8],vhi[8]; u32x4 pw0,pw1,pw2,pw3;
  #define PKW(P,B) cvtpk_s(P[B],P[B+1])
  #define PAF(k) __builtin_bit_cast(bf16x8,pw##k)
  #define VFR(i) (bf16x8){vlo[i][0],vlo[i][1],vlo[i][2],vlo[i][3],vhi[i][0],vhi[i][1],vhi[i][2],vhi[i][3]}
  #define PIN(x) asm volatile("":"+v"(x))
  #define MX3(a,b,c) __builtin_fmaxf(__builtin_fmaxf((a),(b)),(c))
  #define GAPA(MF,A0,A1,A2,A3,W0,W1,PW) do{ MF; sacc+=A0; sacc+=A1; sacc+=A2; sacc+=A3; PIN(sacc); W0; W1; PIN(PW); SBAR(); }while(0)
  #define EX(v) __builtin_amdgcn_exp2f(v)
  #define GAPB(MF,X,B) do{ MF; X[B]=EX(X[B]); X[B+1]=EX(X[B+1]); X[B+2]=EX(X[B+2]); X[B+3]=EX(X[B+3]); PIN(X); SBAR(); }while(0)
  #define VRD(i) do{ vlo[i]=vtr(vp_+(((i)>>2)*4096+((i)&3)*1024)); vhi[i]=vtr(vp_+(((i)>>2)*4096+((i)&3)*1024+512)); }while(0)
  #define KRD(G,j) do{ if(G){ kload2(kf,kp0+sl_next,j); SBAR(); } }while(0)
  #define STEP(C0,C1,P0,P1,t,GK,GV,GL) do{ SBAR(); \
    const lds_cptr vp_=vp0+sl_prev; \
    VRD(0); SBAR(); float sacc=(P0[0]+P0[1]); \
    GAPA(C0=__builtin_amdgcn_mfma_f32_32x32x16_bf16(kf[0],qr[0],C0,0,0,0), P0[2],P0[3],P0[4],P0[5],     pw0[0]=PKW(P0,0), pw0[1]=PKW(P0,2), pw0); \
    VRD(4); SBAR(); GAPA(C1=__builtin_amdgcn_mfma_f32_32x32x16_bf16(kf[1],qr[0],C1,0,0,0), P0[6],P0[7],P0[8],P0[9],     pw0[2]=PKW(P0,4), pw0[3]=PKW(P0,6), pw0); \
    VRD(1); SBAR(); GAPA(C0=__builtin_amdgcn_mfma_f32_32x32x16_bf16(kf[2],qr[1],C0,0,0,0),   P0[10],P0[11],P0[12],P0[13], pw1[0]=PKW(P0,8), pw1[1]=PKW(P0,10), pw1); \
    VRD(5); SBAR(); GAPA(C1=__builtin_amdgcn_mfma_f32_32x32x16_bf16(kf[3],qr[1],C1,0,0,0),   P0[14],P0[15],P1[0],P1[1],   pw1[2]=PKW(P0,12),pw1[3]=PKW(P0,14), pw1); \
    VRD(2); SBAR(); GAPA(C0=__builtin_amdgcn_mfma_f32_32x32x16_bf16(kf[4],qr[2],C0,0,0,0),   P1[2],P1[3],P1[4],P1[5],     pw2[0]=PKW(P1,0), pw2[1]=PKW(P1,2), pw2); \
    VRD(6); SBAR(); GAPA(C1=__builtin_amdgcn_mfma_f32_32x32x16_bf16(kf[5],qr[2],C1,0,0,0),   P1[6],P1[7],P1[8],P1[9],     pw2[2]=PKW(P1,4), pw2[3]=PKW(P1,6), pw2); \
    VRD(3); SBAR(); GAPA(C0=__builtin_amdgcn_mfma_f32_32x32x16_bf16(kf[6],qr[3],C0,0,0,0),   P1[10],P1[11],P1[12],P1[13], pw3[0]=PKW(P1,8), pw3[1]=PKW(P1,10), pw3); \
    VRD(7); SBAR(); GAPA(C1=__builtin_amdgcn_mfma_f32_32x32x16_bf16(kf[7],qr[3],C1,0,0,0),   P1[14],P1[15],0.f,0.f,       pw3[2]=PKW(P1,12),pw3[3]=PKW(P1,14), pw3); \
    l_reg+=sacc; FBLOAD(P0,P1,(t)+1,GL); \
    if(GK){DMA_K((t)+3,sl_cur);} if(GV){DMA_V((t)+1,sl_next);} \
    CMASK(C0,C1,t); \
    { float a=MX3(C0[0],C0[1],C1[0]),b=MX3(C0[2],C0[3],C1[1]); a=MX3(a,C1[2],C1[3]); \
      _Pragma("unroll") for(int r=4;r<16;r+=4){a=MX3(a,C0[r],C0[r+1]);b=MX3(b,C0[r+2],C0[r+3]);a=MX3(a,C1[r],C1[r+1]);b=MX3(b,C1[r+2],C1[r+3]);} \
      float rm=__builtin_fmaxf(a,b); { auto rr=__builtin_amdgcn_permlane32_swap(__float_as_uint(rm),__float_as_uint(rm),false,false); rm=__builtin_fmaxf(__uint_as_float(rr[0]),__uint_as_float(rr[1])); } \
      resc=false; \
      if(__builtin_expect(__any(rm>(float)THRL),0)){ const float dl=__builtin_fmaxf(rm,0.f); mhat+=dl; \
        _Pragma("unroll") for(int r=0;r<16;++r){C0[r]-=dl;C1[r]-=dl;} \
        const float f=__builtin_amdgcn_exp2f(-dl); l_reg*=f; if(hi==0)wsf[r32]=f; resc=true; } } \
    FBADD(P0,P1,GL); SBAR(); \
    GAPB(o[0]=__builtin_amdgcn_mfma_f32_32x32x16_bf16(PAF(0),VFR(0),o[0],0,0,0), C0,0); \
    GAPB(o[1]=__builtin_amdgcn_mfma_f32_32x32x16_bf16(PAF(0),VFR(4),o[1],0,0,0), C0,4); \
    KRD(GL,0); GAPB(o[0]=__builtin_amdgcn_mfma_f32_32x32x16_bf16(PAF(1),VFR(1),o[0],0,0,0), C0,8); \
    KRD(GL,1); GAPB(o[1]=__builtin_amdgcn_mfma_f32_32x32x16_bf16(PAF(1),VFR(5),o[1],0,0,0), C0,12); \
    KRD(GL,2); GAPB(o[0]=__builtin_amdgcn_mfma_f32_32x32x16_bf16(PAF(2),VFR(2),o[0],0,0,0), C1,0); \
    KRD(GL,3); GAPB(o[1]=__builtin_amdgcn_mfma_f32_32x32x16_bf16(PAF(2),VFR(6),o[1],0,0,0), C1,4); \
    GAPB(o[0]=__builtin_amdgcn_mfma_f32_32x32x16_bf16(PAF(3),VFR(3),o[0],0,0,0), C1,8); \
    GAPB(o[1]=__builtin_amdgcn_mfma_f32_32x32x16_bf16(PAF(3),VFR(7),o[1],0,0,0), C1,12); \
    }while(0)
  int t=1;
  #undef CMASK
  #define CMASK(P0,P1,t) do{}while(0)
  for(;t+5<NT;t+=2){
    STEP(pB0,pB1,pA0,pA1,t,true,true,true);     WAIT_BAR(2); RESC(); ROT();
    STEP(pA0,pA1,pB0,pB1,t+1,true,true,true);   WAIT_BAR(2); RESC(); ROT();
  }
  #undef CMASK
  #define CMASK(P0,P1,t) do{int jb_=(t)-(NT-4); if(jb_>=0)cmask(P0,P1,jb_,qrel,hi);}while(0)
  #define ENDW(tt) do{ if((tt)+3<NT){WAIT_BAR(2);} else if((tt)+2<NT){WAIT_BAR(1);} else {WAIT_BAR(0);} }while(0)
  for(;t+1<NT;t+=2){
    STEP(pB0,pB1,pA0,pA1,t,(t+3<NT),(t+1<NT),(t+1<NT));       ENDW(t);   RESC(); ROT();
    STEP(pA0,pA1,pB0,pB1,t+1,(t+4<NT),(t+2<NT),(t+2<NT));     ENDW(t+1); RESC(); ROT();
  }
  STEP(pB0,pB1,pA0,pA1,NT-1,false,false,false); RESC();
  { float sacc=pB0[0]+pB0[1]; _Pragma("unroll") for(int r=2;r<16;++r)sacc+=pB0[r]; _Pragma("unroll") for(int r=0;r<16;++r)sacc+=pB1[r]; l_reg+=sacc;
    pw0=(u32x4){PKW(pB0,0),PKW(pB0,2),PKW(pB0,4),PKW(pB0,6)};pw1=(u32x4){PKW(pB0,8),PKW(pB0,10),PKW(pB0,12),PKW(pB0,14)};pw2=(u32x4){PKW(pB1,0),PKW(pB1,2),PKW(pB1,4),PKW(pB1,6)};pw3=(u32x4){PKW(pB1,8),PKW(pB1,10),PKW(pB1,12),PKW(pB1,14)};
    SBAR(); pv(o,vb0+sl_cur,PAF(0),PAF(1),PAF(2),PAF(3)); }
  #undef PKW
  #undef PAF
  #undef VFR
  #undef PIN
  #undef MX3
  #undef GAPA
  #undef GAPB
  #undef EX
  #undef VRD
  #undef KRD
  #undef STEP
  #undef ENDW
  {auto rr=__builtin_amdgcn_permlane32_swap(__float_as_uint(l_reg),__float_as_uint(l_reg),false,false);l_reg=__uint_as_float(rr[0])+__uint_as_float(rr[1]);}
  if(hi==0)wsf[32+r32]=l_reg;asm volatile("s_waitcnt lgkmcnt(0)":::"memory");
  float rli[16];
  #pragma unroll
  for(int r=0;r<16;++r)rli[r]=__builtin_amdgcn_rcpf(wsf[32+crow(r,hi)]);
  bf16*Ow=O+(rowbase+q0+wid*QBLK)*DM+h*D;
  { bf16*stg=(bf16*)(shm+LDS_OST)+wid*2048;
    #pragma unroll
    for(int r=0;r<16;++r){const int orow=crow(r,hi);
      #pragma unroll
      for(int d0=0;d0<2;++d0)stg[orow*64+d0*32+r32]=__float2bfloat16(o[d0][r]*rli[r]);}
    asm volatile("s_waitcnt lgkmcnt(0)":::"memory");
    #pragma unroll
    for(int i=0;i<4;++i){const int row=i*8+(lane>>3),ch=lane&7; const u32x4 v=*(const u32x4*)(stg+row*64+ch*8);
      if(OUT_F8){ int w0=0,w1=0; w0=f8pk(__uint_as_float(v.x<<16),__uint_as_float(v.x&0xffff0000u),w0,false); w0=f8pk(__uint_as_float(v.y<<16),__uint_as_float(v.y&0xffff0000u),w0,true);
        w1=f8pk(__uint_as_float(v.z<<16),__uint_as_float(v.z&0xffff0000u),w1,false); w1=f8pk(__uint_as_float(v.w<<16),__uint_as_float(v.w&0xffff0000u),w1,true);
        unsigned long long pk=((unsigned long long)(unsigned)w1<<32)|(unsigned)w0; *(unsigned long long*)((unsigned char*)O+((rowbase+q0+wid*QBLK+row)*DM+h*D+ch*8))=pk; }
      else ATTN_STORE16(Ow+(long)row*DM+ch*8,v);} }
  asm volatile("s_waitcnt lgkmcnt(0)\n\ts_barrier":::"memory");
  #undef DMA_K
  #undef DMA_V
  #undef CMASK
  #undef START
  #undef RESC
  #undef FBIAS
  #undef FBLOAD
  #undef FBADD
  #undef ROT
}
constexpr int ATTN_LDS_BYTES=LDS_BYTES;
struct AttnTensors { const bf16* Q; const bf16* K; const bf16* V; bf16* O; const float* FB; };
constexpr int FB_OFF=86016;
template<int THRL=8,bool NOFB=false> __device__ __forceinline__ void attn_phase(char*lds,const AttnTensors&T,int vcu,int G,const int wave0){
  const fb_lptr fbl=(fb_lptr)(lds+FB_OFF);
  const bool fast=(G==256); const int nu=fast?16:16*((BATCH*NHEAD-vcu+G-1)/G); int cur=-1;
  for(int u=0;u<nu;++u){
    int bh,qb;
    if(fast){ bh=32*(vcu>>5)+4*(u>>1)+((vcu&31)>>3); qb=(u&1)?(vcu&7):NQB-1-(vcu&7); } else { bh=vcu+G*(u>>4); qb=NQB-1-(u&15); }
    if(bh!=cur){ cur=bh;
      { __attribute__((address_space(3))) float* fw=(__attribute__((address_space(3))) float*)(lds+FB_OFF);
        int ti_=HW_TID(wave0); asm volatile("":"+v"(ti_)); float fv_[SEQ/512]; _Pragma("unroll") for(int k_=0;k_<SEQ/512;++k_)fv_[k_]=T.FB[(size_t)bh*SEQ+ti_+512*k_]; _Pragma("unroll") for(int k_=0;k_<SEQ/512;++k_)fw[ti_+512*k_]=fv_[k_]; }
      asm volatile("s_waitcnt vmcnt(0) lgkmcnt(0)\n\ts_barrier":::"memory"); }
    attn_unit<THRL,NOFB>(bh/NHEAD,bh%NHEAD,qb,T.Q,T.K,T.V,T.O,lds,fbl,wave0);
  }
}
#undef SBAR
#undef WAIT_BAR
}

constexpr int DM = 1024, NB = 16, SEQ = 4096, NT = NB * SEQ;
constexpr int DEPTH = 4, NAL = 2;
constexpr int A_IN = 3088, A_PROJ = 3072;
constexpr int KV_OUT = 2064;
constexpr int NE = 16, DE = 512, NCLS = 24, CLS_CAP = NT;
constexpr float EPS = 1e-6f;
constexpr int NWAVES = 8;
#ifndef RSPLIT
#define RSPLIT 0
#endif
#ifndef FUSE_LOCAL
#define FUSE_LOCAL 1
#endif
#ifndef PROJ_F8
#define PROJ_F8 true
#endif
#ifndef MOE2_F8
#define MOE2_F8 true
#endif
#ifndef MOE1_F8
#define MOE1_F8 true
#endif
constexpr int MAX_RB = NT / 256 + NCLS;

constexpr size_t MiB = 1u << 20;
constexpr size_t WS_CTL = 0, CTL_ZERO_BYTES = 1 * MiB;
constexpr size_t WS_MODS = 1 * MiB;
constexpr size_t WS_KVMOD = WS_MODS + (size_t)DEPTH * NB * 6144 * 4;
constexpr size_t WS_FIN = WS_KVMOD + (size_t)NB * 2048 * 4;
constexpr size_t WS_WTS = 3 * MiB;
constexpr size_t WS_G16 = 4 * MiB;
constexpr size_t WS_FB = 8 * MiB;
constexpr size_t WS_PERM = 12 * MiB;
constexpr size_t WS_WIN = 18 * MiB, WS_WOUT = 30 * MiB, WS_WKV = 34 * MiB, WS_WQ = 38 * MiB, WS_WO = 42 * MiB;
constexpr size_t WS_BT1 = 46 * MiB;
constexpr size_t WS_PW = 110 * MiB;
constexpr size_t WS_BT2 = 174 * MiB;
constexpr size_t WS_HB = 238 * MiB;
constexpr size_t WS_BIG = 366 * MiB;
constexpr size_t WS_ACT = 750 * MiB;
constexpr size_t WS_XB = 890 * MiB;
constexpr size_t WS_END = 1018 * MiB;
static_assert(WS_FIN + (size_t)NB * 2048 * 4 <= WS_WTS && WS_ACT + (size_t)MAX_RB * 256 * 1024 * 2 <= WS_XB && WS_XB + (size_t)NT * DM * 2 <= WS_END, "d_ws map");
constexpr int CW_BAR = 4096;
constexpr int CW_XCCT = 12288;
constexpr int CW_CNT = 16384;
constexpr int RING_OFF = 0, RING_BYTES = 131072;
constexpr int LDSCTL_OFF = RING_BYTES, MISC_OFF = LDSCTL_OFF + 320;
constexpr int TAB_OFF = MISC_OFF + 128;
constexpr int LDS_BYTES = 147456;
static_assert(TAB_OFF + 256 + 4 * (NT / 256 + NCLS + 8) <= LDS_BYTES, "LDS map");

typedef unsigned short bf16;
typedef unsigned v4u __attribute__((ext_vector_type(4)));
typedef unsigned v2u __attribute__((ext_vector_type(2)));
typedef float f32x4 __attribute__((ext_vector_type(4)));
typedef short bf16x8 __attribute__((ext_vector_type(8)));
typedef GAS unsigned gu32;
#define RLX_AGENT __ATOMIC_RELAXED, __HIP_MEMORY_SCOPE_AGENT
#define LDS_WAIT() asm volatile("s_waitcnt lgkmcnt(0)" ::: "memory")
__device__ __forceinline__ unsigned f2bf(float f) { unsigned u = __builtin_bit_cast(unsigned, f); return (u + 0x7fffu + ((u >> 16) & 1u)) >> 16; }
__device__ __forceinline__ unsigned pk2(float lo, float hi) { typedef float f2_t __attribute__((ext_vector_type(2))); typedef __bf16 b2_t __attribute__((ext_vector_type(2))); const f2_t v = {lo, hi}; return __builtin_bit_cast(unsigned, __builtin_convertvector(v, b2_t)); }
__device__ __forceinline__ int cvt8(float a, float b, int old, bool hi) { a = __builtin_amdgcn_fmed3f(a, -448.f, 448.f); b = __builtin_amdgcn_fmed3f(b, -448.f, 448.f); return hi ? __builtin_amdgcn_cvt_pk_fp8_f32(a, b, old, true) : __builtin_amdgcn_cvt_pk_fp8_f32(a, b, old, false); }
__device__ __forceinline__ float bf2f(unsigned b) { return __builtin_bit_cast(float, (b & 0xffffu) << 16); }

#define XB_TMO      128
#define XB_XCNT(j)  (256  + 64 * (j))
#define XB_XSUB(j)  (1280 + 64 * (j))
#define XB_XGEN(j)  (2304 + 64 * (j))
#define XB_TOP      3328
#define XB_TOPGEN   3392
#define XCD_BAR_WORDS 3456
#define XB_SPIN_CAP (1u << 22)

__device__ __forceinline__ unsigned xb_ld(unsigned* p)              { return __hip_atomic_load(p, __ATOMIC_RELAXED, __HIP_MEMORY_SCOPE_AGENT); }
__device__ __forceinline__ unsigned xb_add(unsigned* p, unsigned v) { return __hip_atomic_fetch_add(p, v, __ATOMIC_RELAXED, __HIP_MEMORY_SCOPE_AGENT); }
__device__ __forceinline__ unsigned xb_xcc_id() { return (unsigned)__builtin_amdgcn_s_getreg((3 << 11) | 20) & 0xFu; }
#define XB_SPIN(cond, bar) do { unsigned _sp = 0; while (cond) { __builtin_amdgcn_s_sleep(1); \
    if ((++_sp & 255u) == 0u) { if (xb_ld(&(bar)[XB_TMO])) break; if (_sp > XB_SPIN_CAP) { atomicAdd(&(bar)[XB_TMO], 1u); break; } } } } while (0)

struct XcdBarrier { unsigned* bar; unsigned x; volatile LAS unsigned* st; int w0; };

__device__ __forceinline__ XcdBarrier xcd_barrier_post(unsigned* bar, volatile LAS unsigned* st, int w0) {
    XcdBarrier b; b.bar = bar; b.x = xb_xcc_id(); b.st = st; b.w0 = w0;
    if (HW_TID(w0) == 0) (void)xb_add(&bar[XB_XCNT(b.x)], 1u);
    return b;
}
__device__ __forceinline__ void xcd_barrier_complete(unsigned* bar, unsigned x, unsigned& nloc, unsigned& nx) {
    const unsigned G = gridDim.x * gridDim.y * gridDim.z;
    unsigned sum, cnt, mine, sp = 0u;
    for (;;) {
        sum = 0u; cnt = 0u; mine = 0u;
#pragma unroll
        for (unsigned j = 0; j < 16; ++j) { const unsigned c = xb_ld(&bar[XB_XCNT(j)]); sum += c; cnt += (c > 0u) ? 1u : 0u; mine = (j == x) ? c : mine; }
        if (sum == G) break;
        __builtin_amdgcn_s_sleep(1);
        if ((++sp & 255u) == 0u) { if (xb_ld(&bar[XB_TMO])) break; if (sp > XB_SPIN_CAP) { atomicAdd(&bar[XB_TMO], 1u); break; } }
    }
    nloc = mine > 0u ? mine : 1u; nx = cnt > 0u ? cnt : 1u;
}
__device__ __forceinline__ void xcd_barrier(const XcdBarrier& b) {
    asm volatile("s_waitcnt vmcnt(0)" ::: "memory");
    __syncthreads();
    if (HW_TID(b.w0) == 0) {
        unsigned* bar = b.bar; unsigned bx = b.x; asm volatile("" : "+s"(bar), "+s"(bx));
        __builtin_amdgcn_s_waitcnt(0);
        unsigned nloc = b.st[0], nx = b.st[1];
        if (nloc == 0u) { xcd_barrier_complete(bar, bx, nloc, nx); b.st[0] = nloc; b.st[1] = nx; }
        const unsigned old = xb_add(&bar[XB_XSUB(bx)], 1u);
        const unsigned gen = old / nloc;
        if (old + 1u == (gen + 1u) * nloc) {
            __builtin_amdgcn_fence(__ATOMIC_RELEASE, "agent");
            asm volatile("s_waitcnt vmcnt(0)" ::: "memory");
            const unsigned og = xb_add(&bar[XB_TOP], 1u);
            const unsigned tg = og / nx;
            if (og + 1u == (tg + 1u) * nx) xb_add(&bar[XB_TOPGEN], 1u);
            else XB_SPIN(xb_ld(&bar[XB_TOPGEN]) == tg, bar);
            __builtin_amdgcn_fence(__ATOMIC_ACQUIRE, "agent");
            xb_add(&bar[XB_XGEN(bx)], 1u);
            asm volatile("s_waitcnt vmcnt(0)" ::: "memory");
        } else {
            XB_SPIN(xb_ld(&bar[XB_XGEN(bx)]) == gen, bar);
            __builtin_amdgcn_fence(__ATOMIC_ACQUIRE, "agent");
            asm volatile("s_waitcnt vmcnt(0)" ::: "memory");
        }
    }
    __syncthreads();
}

struct Args { const float* in[25]; float* out; unsigned char* ws; int ph_lo, ph_hi; };
enum { I_X = 0, I_C, I_AWIN, I_ABG, I_AMH, I_AWOUT, I_KVNORM, I_WADAKV, I_BADAKV, I_WKV, I_BFG, I_BWQ, I_BWO, I_NMIX, I_NFFN, I_WADA, I_BADA, I_WR, I_RB, I_WG, I_WU, I_WD, I_NFIN, I_WADAF, I_BADAF };

struct Frame {
    LAS unsigned char* lds;
    volatile LAS unsigned* MISC;
    gu32* ctl;
    int wave;
    int cid;
    int vcu, G;
};

__device__ __forceinline__ float wave_sum(float v) {
#pragma unroll
    for (int o = 1; o < 64; o <<= 1) v += __shfl_xor(v, o);
    return v;
}

__device__ __forceinline__ void p0_transpose_blk(const float* W, int ldw, int k0, int n0, bf16* WT, int ldt, int drow0, LAS float* scr, int lane) {
    float tv[32];
#pragma unroll
    for (int i = 0; i < 32; ++i) tv[i] = ((const GAS float*)W)[(size_t)(k0 + 2 * i + (lane >> 5)) * ldw + n0 + (lane & 31)];
#pragma unroll
    for (int i = 0; i < 32; ++i) scr[(2 * i + (lane >> 5)) * 33 + (lane & 31)] = tv[i];
    LDS_WAIT(); asm volatile("" ::: "memory");
    const int c = lane & 7;
#pragma unroll
    for (int j = 0; j < 4; ++j) { const int n = (lane >> 3) + 8 * j; const LAS float* s = scr + (8 * c) * 33 + n;
        v4u o; o.x = pk2(s[0 * 33], s[1 * 33]); o.y = pk2(s[2 * 33], s[3 * 33]); o.z = pk2(s[4 * 33], s[5 * 33]); o.w = pk2(s[6 * 33], s[7 * 33]);
        *(GAS v4u*)(WT + (size_t)(drow0 + n) * ldt + k0 + 8 * c) = o; }
    LDS_WAIT(); asm volatile("" ::: "memory");
}
__device__ __forceinline__ void p0_transpose_blk8(const float* W, int ldw, int k0, int n0, unsigned char* WT, int ldt, int drow0, float mul, LAS float* scr, int lane) {
    float tv[32];
#pragma unroll
    for (int i = 0; i < 32; ++i) tv[i] = ((const GAS float*)W)[(size_t)(k0 + 2 * i + (lane >> 5)) * ldw + n0 + (lane & 31)];
#pragma unroll
    for (int i = 0; i < 32; ++i) scr[(2 * i + (lane >> 5)) * 33 + (lane & 31)] = tv[i];
    LDS_WAIT(); asm volatile("" ::: "memory");
    const int c = lane & 7;
#pragma unroll
    for (int j = 0; j < 4; ++j) { const int n = (lane >> 3) + 8 * j; const LAS float* s = scr + (8 * c) * 33 + n;
        int w0 = 0, w1 = 0;
        w0 = cvt8(s[0 * 33] * mul, s[1 * 33] * mul, w0, false); w0 = cvt8(s[2 * 33] * mul, s[3 * 33] * mul, w0, true);
        w1 = cvt8(s[4 * 33] * mul, s[5 * 33] * mul, w1, false); w1 = cvt8(s[6 * 33] * mul, s[7 * 33] * mul, w1, true);
        v2u o; o.x = (unsigned)w0; o.y = (unsigned)w1;
        *(GAS v2u*)(WT + (size_t)(drow0 + n) * ldt + k0 + 8 * c) = o; }
    LDS_WAIT(); asm volatile("" ::: "memory");
}
__device__ __forceinline__ void p0_prologue(Frame& F, const Args& a) {
    unsigned char* ws = a.ws; const int ptid = HW_TID(F.wave), plane = ptid & 63;
    {
        LAS float* cact = (LAS float*)(F.lds);
        LAS float* red = (LAS float*)(F.lds + 65536);
        const float* c = a.in[I_C];
        { float cv_[32];
#pragma unroll
          for (int k = 0; k < 32; ++k) cv_[k] = ((const GAS float*)c)[ptid + 512 * k];
#pragma unroll
          for (int k = 0; k < 32; ++k) { const int i = ptid + 512 * k, b = i >> 10, d = i & 1023; const float v = cv_[k]; cact[d * 16 + b] = v / (1.0f + __expf(-v)); } }
        __syncthreads();
        for (int blk = blockIdx.x; blk < 224; blk += F.G) {
            const float* W; const float* bias; float* out; int ldw, e0, ostride;
            if (blk < 192) { const int l = blk / 48; e0 = (blk % 48) * 128; W = a.in[I_WADA] + (size_t)l * DM * 6144; ldw = 6144; bias = a.in[I_BADA] + l * 6144; out = (float*)(ws + WS_MODS) + (size_t)l * NB * 6144; ostride = 6144; }
            else if (blk < 208) { e0 = (blk - 192) * 128; W = a.in[I_WADAKV]; ldw = 2048; bias = a.in[I_BADAKV]; out = (float*)(ws + WS_KVMOD); ostride = 2048; }
            else { e0 = (blk - 208) * 128; W = a.in[I_WADAF]; ldw = 2048; bias = a.in[I_BADAF]; out = (float*)(ws + WS_FIN); ostride = 2048; }
            const int col = ptid & 127, ks = ptid >> 7;
            float acc[16];
#pragma unroll
            for (int b = 0; b < 16; ++b) acc[b] = 0.f;
            const float* wp = W + (size_t)(ks * 256) * ldw + e0 + col;
#pragma clang loop unroll(disable)
            for (int d0 = 0; d0 < 256; d0 += 32) { float wv[32];
#pragma unroll
              for (int dd = 0; dd < 32; ++dd) wv[dd] = ((const GAS float*)wp)[(size_t)(d0 + dd) * ldw];
#pragma unroll
              for (int dd = 0; dd < 32; ++dd) { const int d = d0 + dd; const float w = wv[dd]; const LAS f32x4* cp = (const LAS f32x4*)(cact + (ks * 256 + d) * 16);
#pragma unroll
                for (int q = 0; q < 4; ++q) { const f32x4 cv = cp[q]; acc[4 * q + 0] += w * cv[0]; acc[4 * q + 1] += w * cv[1]; acc[4 * q + 2] += w * cv[2]; acc[4 * q + 3] += w * cv[3]; } } }
#pragma unroll
            for (int b = 0; b < 16; ++b) red[(ks * 128 + col) * 16 + b] = acc[b];
            __syncthreads();
            for (int i = ptid; i < 128 * 16; i += 512) { const int cc = i & 127, b = i >> 7;
                const float s = red[(0 * 128 + cc) * 16 + b] + red[(1 * 128 + cc) * 16 + b] + red[(2 * 128 + cc) * 16 + b] + red[(3 * 128 + cc) * 16 + b];
                out[(size_t)b * ostride + e0 + cc] = s + bias[e0 + cc]; }
            __syncthreads();
        }
    }
    __syncthreads();
    {
        static_assert(PROJ_F8 && OUT_F8 && MOE1_F8 && MOE2_F8, "the prologue converts every GEMM weight to fp8");
        LAS float* scr = (LAS float*)(F.lds + F.wave * 16384);
        const int gw = F.vcu * NWAVES + F.wave, NGW = F.G * NWAVES;
        constexpr int I_IN = 16 * 96, I_SQ = 16 * 32, I_KV = 16 * 64, I_GU = 16 * 16, I_DN = 8 * 32;
        constexpr int N_IN = 2 * I_IN, N_OUT = 2 * I_SQ, N_KV = I_KV, N_Q = 2 * I_SQ, N_O = 2 * I_SQ, N_G = 64 * I_GU, N_U = 64 * I_GU, N_D = 64 * I_DN;
        constexpr int NITEMS = N_IN + N_OUT + N_KV + N_Q + N_O + N_G + N_U + N_D;
        struct Blk { const float* W; int ldw, k0, n0; unsigned char* WT; int ldt, drow0; };
        auto decode = [&](int it) -> Blk { Blk B; int r = it;
            if (r < N_IN) { const int l = r / I_IN, q = r % I_IN, kb = q / 96, nb = q % 96; B = Blk{a.in[I_AWIN] + (size_t)l * DM * A_IN, A_IN, 64 * kb, 32 * nb, (unsigned char*)(ws + WS_WIN) + (size_t)l * A_PROJ * DM, DM, 32 * nb}; return B; } r -= N_IN;
            if (r < N_OUT) { const int l = r / I_SQ, q = r % I_SQ, kb = q / 32, nb = q % 32; B = Blk{a.in[I_AWOUT] + (size_t)l * DM * DM, DM, 64 * kb, 32 * nb, (unsigned char*)(ws + WS_WOUT) + (size_t)l * DM * DM, DM, 32 * nb}; return B; } r -= N_OUT;
            if (r < N_KV) { const int kb = r / 64, nb = r % 64; B = Blk{a.in[I_WKV], KV_OUT, 64 * kb, 32 * nb, (unsigned char*)(ws + WS_WKV), DM, 32 * nb}; return B; } r -= N_KV;
            if (r < N_Q) { const int l = r / I_SQ, q = r % I_SQ, kb = q / 32, nb = q % 32; B = Blk{a.in[I_BWQ] + (size_t)l * DM * DM, DM, 64 * kb, 32 * nb, (unsigned char*)(ws + WS_WQ) + (size_t)l * DM * DM, DM, 32 * nb}; return B; } r -= N_Q;
            if (r < N_O) { const int l = r / I_SQ, q = r % I_SQ, kb = q / 32, nb = q % 32; B = Blk{a.in[I_BWO] + (size_t)l * DM * DM, DM, 64 * kb, 32 * nb, (unsigned char*)(ws + WS_WO) + (size_t)l * DM * DM, DM, 32 * nb}; return B; } r -= N_O;
            if (r < N_G + N_U) { const int up = r >= N_G; if (up) r -= N_G; const int le = r / I_GU, q = r % I_GU, kb = q / 16, nb = q % 16; const int n0 = 32 * nb;
                B = Blk{a.in[up ? I_WU : I_WG] + (size_t)le * DM * DE, DE, 64 * kb, n0, (unsigned char*)(ws + WS_BT1) + (size_t)le * 1024 * DM, DM, (n0 >> 7) * 256 + up * 128 + (n0 & 127)}; return B; } r -= N_G + N_U;
            { const int le = r / I_DN, q = r % I_DN, kb = q / 32, nb = q % 32; B = Blk{a.in[I_WD] + (size_t)le * DE * DM, DM, 64 * kb, 32 * nb, (unsigned char*)(ws + WS_BT2) + (size_t)le * DM * DE, DE, 32 * nb}; return B; } };
        const int lane = plane;
        float tv[32];
        if (gw < NITEMS) { const Blk B = decode(gw);
#pragma unroll
            for (int i = 0; i < 32; ++i) tv[i] = ((const GAS float*)B.W)[(size_t)(B.k0 + 2 * i + (lane >> 5)) * B.ldw + B.n0 + (lane & 31)]; }
        for (int it = gw; it < NITEMS; it += NGW) {
            const Blk B = decode(it);
#pragma unroll
            for (int i = 0; i < 32; ++i) scr[(2 * i + (lane >> 5)) * 33 + (lane & 31)] = tv[i] * 32.0f;
            if (it + NGW < NITEMS) { const Blk Bn = decode(it + NGW);
#pragma unroll
                for (int i = 0; i < 32; ++i) tv[i] = ((const GAS float*)Bn.W)[(size_t)(Bn.k0 + 2 * i + (lane >> 5)) * Bn.ldw + Bn.n0 + (lane & 31)]; }
            LDS_WAIT(); asm volatile("" ::: "memory");
            const int c = lane & 7;
#pragma unroll
            for (int j = 0; j < 4; ++j) { const int n = (lane >> 3) + 8 * j; const LAS float* s = scr + (8 * c) * 33 + n;
                int w0 = 0, w1 = 0;
                w0 = cvt8(s[0 * 33], s[1 * 33], w0, false); w0 = cvt8(s[2 * 33], s[3 * 33], w0, true);
                w1 = cvt8(s[4 * 33], s[5 * 33], w1, false); w1 = cvt8(s[6 * 33], s[7 * 33], w1, true);
                v2u o; o.x = (unsigned)w0; o.y = (unsigned)w1;
                *(GAS v2u*)(B.WT + (size_t)(B.drow0 + n) * B.ldt + B.k0 + 8 * c) = o; }
            LDS_WAIT(); asm volatile("" ::: "memory");
        }
    }
}

__device__ __forceinline__ float log_sigmoidf_(float x) { return fminf(x, 0.f) - log1pf(__expf(-fabsf(x))); }
template <bool ROUTER>
__device__ __forceinline__ void norm_phase(Frame& F, const void* xv, int xbf, const float* gamma, const float* shift, const float* scale, int mstride, bf16* out,
                                           int mode, const float* W16, int ldw, const float* bias16, float* G16, float2* wts, int* perm, gu32* gcnt) {
    LAS float* wT = (LAS float*)(F.lds);
    LAS int* hist = (LAS int*)(F.lds + 65536);
    LAS int* sbase = hist + 32;
    LAS int* tinfo = hist + 64;
    LAS float* slog = (LAS float*)(F.lds + 65536 + 2048);
    int tid_ = HW_TID(F.wave); asm volatile("" : "+v"(tid_)); int bid_ = blockIdx.x; asm volatile("" : "+s"(bid_)); const int bid = bid_; const int tid = tid_, lane = tid & 63, wave = __builtin_amdgcn_readfirstlane(tid >> 6);
    if (mode != 0) { for (int i = tid; i < DM * 16; i += 512) { const int d = i >> 4, e = i & 15; wT[e * DM + d] = W16[(size_t)d * ldw + e]; } }
    if (tid < 32) hist[tid] = 0;
    __syncthreads();
    for (int chunk = bid; chunk < NT / 256; chunk += F.G) {
        const int b = chunk >> 4;
        f32x4 ga[4], sb[4];
#pragma unroll
        for (int j = 0; j < 4; ++j) { const int col = 4 * lane + 256 * j; const f32x4 g = *(const f32x4*)(gamma + col), sc = *(const f32x4*)(scale + (size_t)b * mstride + col); sb[j] = *(const f32x4*)(shift + (size_t)b * mstride + col);
            ga[j] = g * (sc + 1.0f); }
#pragma clang loop unroll(disable)
        for (int i = 0; i < 32; ++i) {
            const int row = chunk * 256 + wave * 32 + i;
            f32x4 v[4]; float s = 0.f;
            if (xbf) { const GAS v2u* xr = (const GAS v2u*)((const bf16*)xv + (size_t)row * DM) + lane;
#pragma unroll
                for (int j = 0; j < 4; ++j) { const v2u t = xr[64 * j]; v[j] = (f32x4){bf2f(t.x & 0xffffu), bf2f(t.x >> 16), bf2f(t.y & 0xffffu), bf2f(t.y >> 16)}; } }
            else { const GAS f32x4* xr = (const GAS f32x4*)((const float*)xv + (size_t)row * DM) + lane;
#pragma unroll
                for (int j = 0; j < 4; ++j) v[j] = xr[64 * j]; }
#pragma unroll
            for (int j = 0; j < 4; ++j) s += (v[j].x * v[j].x + v[j].y * v[j].y) + (v[j].z * v[j].z + v[j].w * v[j].w);
            const float r = 1.0f / sqrtf(wave_sum(s) * (1.0f / DM) + EPS);
            GAS v2u* o8 = (GAS v2u*)(out + (size_t)row * DM) + lane;
#pragma unroll
            for (int j = 0; j < 4; ++j) { v[j] = v[j] * r * ga[j] + sb[j];
                if (ROUTER ? MOE1_F8 : PROJ_F8) { int w8 = 0; w8 = cvt8(v[j].x, v[j].y, w8, false); w8 = cvt8(v[j].z, v[j].w, w8, true); ((GAS unsigned*)((unsigned char*)out + (size_t)row * DM))[lane + 64 * j] = (unsigned)w8; }
                else { v2u w; w.x = pk2(v[j].x, v[j].y); w.y = pk2(v[j].z, v[j].w); o8[64 * j] = w; } }
            if (mode == 0) continue;
            float p[16];
#pragma unroll
            for (int e = 0; e < 16; ++e) { float a = 0.f;
#pragma unroll
                for (int j = 0; j < 4; ++j) { const f32x4 w = *(const LAS f32x4*)(wT + e * DM + 4 * lane + 256 * j); a += (v[j].x * w.x + v[j].y * w.y) + (v[j].z * w.z + v[j].w * w.w); }
                p[e] = a; }
#pragma unroll
            for (int k = 0; k < 8; ++k) { const bool hi = lane & 32; const float mine = hi ? p[k + 8] : p[k], send = hi ? p[k] : p[k + 8]; p[k] = mine + __shfl_xor(send, 32); }
#pragma unroll
            for (int k = 0; k < 4; ++k) { const bool hi = lane & 16; const float mine = hi ? p[k + 4] : p[k], send = hi ? p[k] : p[k + 4]; p[k] = mine + __shfl_xor(send, 16); }
#pragma unroll
            for (int k = 0; k < 2; ++k) { const bool hi = lane & 8; const float mine = hi ? p[k + 2] : p[k], send = hi ? p[k] : p[k + 2]; p[k] = mine + __shfl_xor(send, 8); }
            { const bool hi = lane & 4; const float mine = hi ? p[1] : p[0], send = hi ? p[0] : p[1]; p[0] = mine + __shfl_xor(send, 4); }
            p[0] += __shfl_xor(p[0], 2); p[0] += __shfl_xor(p[0], 1);
            if ((lane & 3) == 0) slog[(wave * 32 + i) * 16 + ((lane >> 2) & 15)] = p[0];
        }
        if (mode != 0) {
            if (!ROUTER) {
#pragma clang loop unroll(disable)
                for (int k = 0; k < 8; ++k) { const int idx = lane + 64 * k, e = idx & 15; float g = slog[wave * 512 + idx] + bias16[e];
                    if (mode == 1) { g = 15.0f * tanhf(g * (1.0f / 15.0f)); if (e >= 8) g = log_sigmoidf_(g); } else g = log_sigmoidf_(g);
                    G16[(size_t)(chunk * 256 + wave * 32) * 16 + idx] = g; }
            } else if (lane < 32) {
                const int row = chunk * 256 + wave * 32 + lane;
                float aff[16], sel[16];
#pragma unroll
                for (int q4 = 0; q4 < 4; ++q4) { const f32x4 lg = *(const LAS f32x4*)(slog + (wave * 32 + lane) * 16 + 4 * q4);
#pragma unroll
                    for (int q = 0; q < 4; ++q) { aff[4 * q4 + q] = 1.0f / (1.0f + __expf(-lg[q])); sel[4 * q4 + q] = aff[4 * q4 + q] + bias16[4 * q4 + q]; } }
                float gs[4];
#pragma unroll
                for (int g = 0; g < 4; ++g) { const float s0 = sel[4 * g], s1 = sel[4 * g + 1], s2 = sel[4 * g + 2], s3 = sel[4 * g + 3];
                    const float a = fmaxf(s0, s1), bb = fminf(s0, s1), c = fmaxf(s2, s3), d = fminf(s2, s3);
                    gs[g] = fmaxf(a, c) + fmaxf(fminf(a, c), fmaxf(bb, d)); }
                int grp = 0; float best = gs[0];
#pragma unroll
                for (int g = 1; g < 4; ++g) if (gs[g] > best) { best = gs[g]; grp = g; }
                float sg[4], ag[4];
#pragma unroll
                for (int q = 0; q < 4; ++q) { sg[q] = grp == 0 ? sel[q] : grp == 1 ? sel[4 + q] : grp == 2 ? sel[8 + q] : sel[12 + q]; ag[q] = grp == 0 ? aff[q] : grp == 1 ? aff[4 + q] : grp == 2 ? aff[8 + q] : aff[12 + q]; }
                int i1 = 0; float b1 = sg[0];
#pragma unroll
                for (int q = 1; q < 4; ++q) if (sg[q] > b1) { b1 = sg[q]; i1 = q; }
                int i2 = -1; float b2 = 0.f;
#pragma unroll
                for (int q = 0; q < 4; ++q) if (q != i1 && (i2 < 0 || sg[q] > b2)) { b2 = sg[q]; i2 = q; }
                const int ea = i1 < i2 ? i1 : i2, eb = i1 < i2 ? i2 : i1;
                const float wa = ea == 0 ? ag[0] : ea == 1 ? ag[1] : ag[2], wb = eb == 1 ? ag[1] : eb == 2 ? ag[2] : ag[3];
                const float inv = 1.0f / (wa + wb);
                const int pid = ea == 0 ? eb - 1 : ea == 1 ? eb + 1 : 5;
                const int cls = grp * 6 + pid;
                wts[row] = make_float2(wa * inv, wb * inv); const int rk = __hip_atomic_fetch_add(&hist[cls], 1, __ATOMIC_RELAXED, __HIP_MEMORY_SCOPE_WORKGROUP); tinfo[wave * 32 + lane] = cls | (rk << 8);
            }
        }
        if (ROUTER) {
            __syncthreads();
            if (tid < NCLS) { const int n = hist[tid]; sbase[tid] = n ? (int)__hip_atomic_fetch_add(gcnt + tid, (unsigned)n, RLX_AGENT) : 0; }
            __syncthreads();
            if (tid < 256) { const int ti = tinfo[tid], cls = ti & 255, rk = ti >> 8; perm[(size_t)cls * CLS_CAP + sbase[cls] + rk] = chunk * 256 + tid; }
            __syncthreads();
            if (tid < 32) hist[tid] = 0;
            __syncthreads();
        }
    }
    __syncthreads();
}
template <bool ROUTER>
__device__ __forceinline__ void normT_phase(Frame& F, const void* xv, int xbf, const float* gamma, const float* shift, const float* scale, int mstride, bf16* out,
                                            int mode, const float* W16, int ldw, const float* bias16, float* G16, float2* wts, int* perm, gu32* gcnt) {
    constexpr bool OUT8 = ROUTER ? MOE1_F8 : PROJ_F8;
    constexpr int WP = 1032;
    LAS float* sG = (LAS float*)(F.lds);
    LAS float* sS = sG + 1024;
    LAS bf16* sWh = (LAS bf16*)(F.lds + 8192);
    LAS bf16* sWl = sWh + 16 * WP;
    LAS float* slog = (LAS float*)(F.lds + 8192 + 2 * 16 * WP * 2);
    LAS int* hist = (LAS int*)(slog + 8 * 32 * 16);
    LAS int* sbase = hist + 32;
    LAS int* tinfo = hist + 64;
    LAS v2u* tw = (LAS v2u*)(tinfo + 256);
    int tid_ = HW_TID(F.wave); asm volatile("" : "+v"(tid_)); int bid_ = blockIdx.x; asm volatile("" : "+s"(bid_)); const int bid = bid_;
    const int tid = tid_, lane = tid & 63, wave = __builtin_amdgcn_readfirstlane(tid >> 6), r = lane & 15, g = lane >> 4;
    if (mode != 0) {
        float wv[32];
#pragma unroll
        for (int k = 0; k < 32; ++k) { const int i = tid + 512 * k; wv[k] = ((const GAS float*)W16)[(size_t)(i >> 4) * ldw + (i & 15)]; }
#pragma unroll
        for (int k = 0; k < 32; ++k) { const int i = tid + 512 * k, d = i >> 4, e = i & 15; const float w = wv[k]; const unsigned hi = f2bf(w); sWh[e * WP + d] = (bf16)hi; sWl[e * WP + d] = (bf16)f2bf(w - bf2f(hi)); } }
    if (tid < 32) hist[tid] = 0;
    int cur_b = -1;
    for (int chunk = bid; chunk < NT / 256; chunk += F.G) {
        const int b = chunk >> 4;
        if (b != cur_b) { cur_b = b; __syncthreads();
            { const float g0 = gamma[tid], g1 = gamma[tid + 512], c0 = scale[(size_t)b * mstride + tid], c1 = scale[(size_t)b * mstride + tid + 512], h0 = shift[(size_t)b * mstride + tid], h1 = shift[(size_t)b * mstride + tid + 512];
              sG[tid] = g0 * (1.0f + c0); sG[tid + 512] = g1 * (1.0f + c1); sS[tid] = h0; sS[tid + 512] = h1; } }
        __syncthreads();
#pragma clang loop unroll(disable)
        for (int tt = 0; tt < 2; ++tt) {
            const int row = chunk * 256 + wave * 32 + 16 * tt + r;
            v4u xp[16][2]; float ss = 0.f;
            if (xbf) { const GAS v4u* xr = (const GAS v4u*)((const bf16*)xv + (size_t)row * DM + 16 * g);
#pragma unroll
                for (int kp = 0; kp < 16; ++kp) { xp[kp][0] = xr[8 * kp]; xp[kp][1] = xr[8 * kp + 1]; } }
            else { const GAS f32x4* xr = (const GAS f32x4*)((const float*)xv + (size_t)row * DM + 16 * g);
#pragma unroll
                for (int kp = 0; kp < 16; ++kp) { const f32x4 a = xr[16 * kp], b2 = xr[16 * kp + 1], c = xr[16 * kp + 2], d = xr[16 * kp + 3];
                    xp[kp][0] = (v4u){pk2(a.x, a.y), pk2(a.z, a.w), pk2(b2.x, b2.y), pk2(b2.z, b2.w)}; xp[kp][1] = (v4u){pk2(c.x, c.y), pk2(c.z, c.w), pk2(d.x, d.y), pk2(d.z, d.w)};
                    if (kp & 1) asm volatile("" ::: "memory"); } }
#pragma unroll
            for (int kp = 0; kp < 16; ++kp)
#pragma unroll
                for (int q = 0; q < 2; ++q)
#pragma unroll
                    for (int j = 0; j < 4; ++j) { const float lo = bf2f(xp[kp][q][j] & 0xffffu), hi = bf2f(xp[kp][q][j] >> 16); ss += lo * lo + hi * hi; }
            ss += __shfl_xor(ss, 16); ss += __shfl_xor(ss, 32);
            const float rr = 1.0f / sqrtf(ss * (1.0f / DM) + EPS);
#pragma unroll
            for (int kp = 0; kp < 16; ++kp) { asm volatile("" : "+v"(xp[kp][0]), "+v"(xp[kp][1])); }
            f32x4 acc = (f32x4){0.f, 0.f, 0.f, 0.f};
#pragma unroll
            for (int kp = 0; kp < 16; ++kp) {
                asm volatile("" ::: "memory");
                const int c0 = 64 * kp + 16 * g;
                bf16x8 ahi[2], alo[2];
#pragma unroll
                for (int q = 0; q < 2; ++q) { const f32x4 g0 = *(const LAS f32x4*)(sG + c0 + 8 * q), g1 = *(const LAS f32x4*)(sG + c0 + 8 * q + 4), s0 = *(const LAS f32x4*)(sS + c0 + 8 * q), s1 = *(const LAS f32x4*)(sS + c0 + 8 * q + 4);
                    float h[8];
#pragma unroll
                    for (int j = 0; j < 4; ++j) { const float lo = bf2f(xp[kp][q][j] & 0xffffu), hi = bf2f(xp[kp][q][j] >> 16);
                        const float gg0 = j < 2 ? g0[2 * j] : g1[2 * j - 4], gg1 = j < 2 ? g0[2 * j + 1] : g1[2 * j - 3], sh0 = j < 2 ? s0[2 * j] : s1[2 * j - 4], sh1 = j < 2 ? s0[2 * j + 1] : s1[2 * j - 3];
                        h[2 * j] = lo * rr * gg0 + sh0; h[2 * j + 1] = hi * rr * gg1 + sh1; }
                    v4u hp;
#pragma unroll
                    for (int j = 0; j < 4; ++j) hp[j] = pk2(h[2 * j], h[2 * j + 1]);
                    ahi[q] = __builtin_bit_cast(bf16x8, hp);
                    if (ROUTER && RSPLIT) { v4u lp;
#pragma unroll
                        for (int j = 0; j < 4; ++j) lp[j] = pk2(h[2 * j] - bf2f(hp[j] & 0xffffu), h[2 * j + 1] - bf2f(hp[j] >> 16));
                        alo[q] = __builtin_bit_cast(bf16x8, lp); }
                    if (OUT8) { int w0 = 0, w1 = 0;
                        w0 = cvt8(h[0], h[1], w0, false); w0 = cvt8(h[2], h[3], w0, true);
                        w1 = cvt8(h[4], h[5], w1, false); w1 = cvt8(h[6], h[7], w1, true);
                        v2u o; o.x = (unsigned)w0; o.y = (unsigned)w1; *(GAS v2u*)((unsigned char*)out + (size_t)row * DM + c0 + 8 * q) = o; }
                    else *(GAS v4u*)(out + (size_t)row * DM + c0 + 8 * q) = hp;
                }
                if (mode != 0) {
#pragma unroll
                    for (int q = 0; q < 2; ++q) { const bf16x8 bh = *(const LAS bf16x8*)(sWh + r * WP + c0 + 8 * q), bl = *(const LAS bf16x8*)(sWl + r * WP + c0 + 8 * q);
                        acc = __builtin_amdgcn_mfma_f32_16x16x32_bf16(ahi[q], bh, acc, 0, 0, 0); if (ROUTER && RSPLIT) { acc = __builtin_amdgcn_mfma_f32_16x16x32_bf16(alo[q], bh, acc, 0, 0, 0); acc = __builtin_amdgcn_mfma_f32_16x16x32_bf16(ahi[q], bl, acc, 0, 0, 0); } } }
            }
            if (mode != 0) {
                const int e = r;
                if (!ROUTER) { const float be = bias16[e];
#pragma unroll
                    for (int i = 0; i < 4; ++i) { float gv = acc[i] + be;
                        if (mode == 1) { gv = 15.0f * tanhf(gv * (1.0f / 15.0f)); if (e >= 8) gv = log_sigmoidf_(gv); } else gv = log_sigmoidf_(gv);
                        G16[(size_t)(chunk * 256 + wave * 32 + 16 * tt + 4 * g + i) * 16 + e] = gv; } }
                else {
#pragma unroll
                    for (int i = 0; i < 4; ++i) slog[(wave * 32 + 16 * tt + 4 * g + i) * 16 + e] = acc[i]; }
            }
        }
        if (ROUTER) {
            if (lane < 32) {
                const int row = chunk * 256 + wave * 32 + lane;
                float aff[16], sel[16];
#pragma unroll
                for (int q4 = 0; q4 < 4; ++q4) { const f32x4 lg = *(const LAS f32x4*)(slog + (wave * 32 + lane) * 16 + 4 * q4);
#pragma unroll
                    for (int q = 0; q < 4; ++q) { aff[4 * q4 + q] = 1.0f / (1.0f + __expf(-lg[q])); sel[4 * q4 + q] = aff[4 * q4 + q] + bias16[4 * q4 + q]; } }
                float gs[4];
#pragma unroll
                for (int gq = 0; gq < 4; ++gq) { const float s0 = sel[4 * gq], s1 = sel[4 * gq + 1], s2 = sel[4 * gq + 2], s3 = sel[4 * gq + 3];
                    const float a = fmaxf(s0, s1), bb = fminf(s0, s1), c = fmaxf(s2, s3), d = fminf(s2, s3);
                    gs[gq] = fmaxf(a, c) + fmaxf(fminf(a, c), fmaxf(bb, d)); }
                int grp = 0; float best = gs[0];
#pragma unroll
                for (int gq = 1; gq < 4; ++gq) if (gs[gq] > best) { best = gs[gq]; grp = gq; }
                float sg[4], ag[4];
#pragma unroll
                for (int q = 0; q < 4; ++q) { sg[q] = grp == 0 ? sel[q] : grp == 1 ? sel[4 + q] : grp == 2 ? sel[8 + q] : sel[12 + q]; ag[q] = grp == 0 ? aff[q] : grp == 1 ? aff[4 + q] : grp == 2 ? aff[8 + q] : aff[12 + q]; }
                int i1 = 0; float b1 = sg[0];
#pragma unroll
                for (int q = 1; q < 4; ++q) if (sg[q] > b1) { b1 = sg[q]; i1 = q; }
                int i2 = -1; float b2 = 0.f;
#pragma unroll
                for (int q = 0; q < 4; ++q) if (q != i1 && (i2 < 0 || sg[q] > b2)) { b2 = sg[q]; i2 = q; }
                const int ea = i1 < i2 ? i1 : i2, eb = i1 < i2 ? i2 : i1;
                const float wa = ea == 0 ? ag[0] : ea == 1 ? ag[1] : ag[2], wb = eb == 1 ? ag[1] : eb == 2 ? ag[2] : ag[3];
                const float inv = 1.0f / (wa + wb);
                const int pid = ea == 0 ? eb - 1 : ea == 1 ? eb + 1 : 5;
                const int cls = grp * 6 + pid;
                const int rk = __hip_atomic_fetch_add(&hist[cls], 1, __ATOMIC_RELAXED, __HIP_MEMORY_SCOPE_WORKGROUP); tinfo[wave * 32 + lane] = cls | (rk << 8); tw[wave * 32 + lane] = (v2u){__builtin_bit_cast(unsigned, wa * inv), __builtin_bit_cast(unsigned, wb * inv)}; (void)row;
            }
            __syncthreads();
            if (tid < NCLS) { const int n = hist[tid]; sbase[tid] = n ? (int)__hip_atomic_fetch_add(gcnt + tid, (unsigned)n, RLX_AGENT) : 0; }
            __syncthreads();
            if (tid < 256) { const int ti = tinfo[tid], cls = ti & 255, rk = ti >> 8; const v2u w2 = tw[tid]; const size_t pi = (size_t)cls * CLS_CAP + sbase[cls] + rk; perm[pi] = chunk * 256 + tid;
                ((GAS v4u*)wts)[pi] = (v4u){(unsigned)(chunk * 256 + tid), w2.x, w2.y, 0u}; }
            __syncthreads();
            if (tid < 32) hist[tid] = 0;
        }
    }
    __syncthreads();
}
__device__ __forceinline__ void final_norm_phase(Frame& F, const bf16* xb, float* out, const float* gamma, const float* shift, const float* scale, int mstride) {
    int tid_ = HW_TID(F.wave); asm volatile("" : "+v"(tid_)); int bid_ = blockIdx.x; asm volatile("" : "+s"(bid_)); const int bid = bid_; const int lane = tid_ & 63, wave = __builtin_amdgcn_readfirstlane(tid_ >> 6);
    for (int chunk = bid; chunk < NT / 256; chunk += F.G) {
        const int b = chunk >> 4;
        f32x4 ga[4], sb[4];
#pragma unroll
        for (int j = 0; j < 4; ++j) { const int col = 4 * lane + 256 * j; const f32x4 g = *(const f32x4*)(gamma + col), sc = *(const f32x4*)(scale + (size_t)b * mstride + col); sb[j] = *(const f32x4*)(shift + (size_t)b * mstride + col);
            ga[j] = g * (sc + 1.0f); }
        const int row0 = chunk * 256 + wave * 32;
        v2u tn[4];
#pragma unroll
        for (int j = 0; j < 4; ++j) tn[j] = ((const GAS v2u*)(xb + (size_t)row0 * DM) + lane)[64 * j];
#pragma clang loop unroll(disable)
        for (int i = 0; i < 32; ++i) {
            const int row = row0 + i;
            v2u t[4];
#pragma unroll
            for (int j = 0; j < 4; ++j) t[j] = tn[j];
            if (i + 1 < 32) {
#pragma unroll
                for (int j = 0; j < 4; ++j) tn[j] = ((const GAS v2u*)(xb + (size_t)(row + 1) * DM) + lane)[64 * j]; }
            GAS f32x4* orow = (GAS f32x4*)(out + (size_t)row * DM) + lane;
            f32x4 v[4]; float s = 0.f;
#pragma unroll
            for (int j = 0; j < 4; ++j) { v[j] = (f32x4){bf2f(t[j].x & 0xffffu), bf2f(t[j].x >> 16), bf2f(t[j].y & 0xffffu), bf2f(t[j].y >> 16)}; s += (v[j].x * v[j].x + v[j].y * v[j].y) + (v[j].z * v[j].z + v[j].w * v[j].w); }
            const float r = 1.0f / sqrtf(wave_sum(s) * (1.0f / DM) + EPS);
#pragma unroll
            for (int j = 0; j < 4; ++j) orow[64 * j] = v[j] * r * ga[j] + sb[j];
        }
    }
}

__device__ __forceinline__ void fcum_phase(Frame& F, const float* logf, float* FB) {
    LAS float* wtot = (LAS float*)(F.lds);
    int tid_ = HW_TID(F.wave); asm volatile("" : "+v"(tid_)); int bid_ = blockIdx.x; asm volatile("" : "+s"(bid_)); const int bid = bid_; const int tid = tid_, lane = tid & 63, wave = __builtin_amdgcn_readfirstlane(tid >> 6);
    for (int chain = bid; chain < NB * 16; chain += F.G) {
        const int b = chain >> 4, hh = chain & 15;
        float v[8]; float run = 0.f;
#pragma unroll
        for (int j = 0; j < 8; ++j) { run += logf[((size_t)b * SEQ + tid * 8 + j) * 16 + hh]; v[j] = run; }
        float inc = run;
#pragma unroll
        for (int o = 1; o < 64; o <<= 1) { const float t = __shfl_up(inc, o); if (lane >= o) inc += t; }
        if (lane == 63) wtot[wave] = inc;
        __syncthreads();
        float base = inc - run;
        for (int w = 0; w < wave; ++w) base += wtot[w];
#pragma unroll
        for (int j = 0; j < 8; ++j) FB[(size_t)chain * SEQ + tid * 8 + j] = -(base + v[j]) * 1.4426950408889634f;
        __syncthreads();
    }
}

__device__ __forceinline__ float wave_scan_add(float v, int lane) {
#pragma unroll
    for (int o = 1; o < 64; o <<= 1) { const float t = __shfl_up(v, o); if (lane >= o) v += t; }
    return v;
}
__device__ __forceinline__ float wave_scan_max(float v, int lane) {
#pragma unroll
    for (int o = 1; o < 64; o <<= 1) { const float t = __shfl_up(v, o); if (lane >= o) v = fmaxf(v, t); }
    return v;
}
__device__ __forceinline__ void cell_phase(Frame& F, const bf16* PROJ, const float* G16, const float* mhn, bf16* HS) {
    constexpr int PST = 72;
    LAS bf16* sQ = (LAS bf16*)(F.lds);
    LAS bf16* sK = sQ + 64 * PST;
    LAS bf16* sKT = sK + 64 * PST;
    LAS bf16* sW = sKT + 64 * PST;
    LAS bf16* sVT = sW + 64 * PST;
    LAS bf16* sCT = sVT + 128 * PST;
    LAS float* fz = (LAS float*)(sCT + 128 * PST);
    LAS float* sU = fz, *sM = fz + 64, *sA = fz + 128, *sEm = fz + 192, *sWk = fz + 256, *sInv = fz + 320, *sN = fz + 384, *sScal = fz + 448, *sSS = fz + 512;
    int tid_ = HW_TID(F.wave); asm volatile("" : "+v"(tid_)); int bid_ = blockIdx.x; asm volatile("" : "+s"(bid_)); const int bid = bid_;
    const int tid = tid_, lane = tid & 63, w = __builtin_amdgcn_readfirstlane(tid >> 6), fr = lane & 15, fq = lane >> 4;
    for (int chain = bid; chain < NB * 8; chain += F.G) {
        const int b = chain >> 3, hh = chain & 7;
        f32x4 accC[4];
#pragma unroll
        for (int ni = 0; ni < 4; ++ni) accC[ni] = (f32x4){0.f, 0.f, 0.f, 0.f};
        for (int i = tid; i < 128 * PST; i += 512) sCT[i] = 0;
        if (tid < 64) sN[tid] = 0.f;
        float m_prev = 0.f;
        __syncthreads();
        for (int c = 0; c < SEQ / 64; ++c) {
            const size_t t0 = (size_t)b * SEQ + 64 * c;
            const int row = tid >> 3, seg = tid & 7;
            const bf16* pr = PROJ + (t0 + row) * A_PROJ + hh * 64 + seg * 8;
            const v4u qv = *(const GAS v4u*)pr, kv = *(const GAS v4u*)(pr + 512);
            const bf16* pv = PROJ + (t0 + row) * A_PROJ + 1024 + hh * 128 + seg * 8;
            const v4u v0 = *(const GAS v4u*)pv, v1 = *(const GAS v4u*)(pv + 64);
            float ig = 0.f, lf = 0.f;
            if (tid < 64) { ig = G16[(t0 + tid) * 16 + hh]; lf = G16[(t0 + tid) * 16 + 8 + hh]; }
            *(LAS v4u*)(sQ + row * PST + seg * 8) = qv;
            *(LAS v4u*)(sK + row * PST + seg * 8) = kv;
#pragma unroll
            for (int j = 0; j < 4; ++j) { sVT[(seg * 8 + 2 * j) * PST + row] = (bf16)(v0[j] & 0xffffu); sVT[(seg * 8 + 2 * j + 1) * PST + row] = (bf16)(v0[j] >> 16);
                sVT[(64 + seg * 8 + 2 * j) * PST + row] = (bf16)(v1[j] & 0xffffu); sVT[(64 + seg * 8 + 2 * j + 1) * PST + row] = (bf16)(v1[j] >> 16); }
            if (w == 0) {
                const float bc = wave_scan_add(lf, lane), u = ig - bc, pm = wave_scan_max(u, lane), M = fmaxf(m_prev, pm);
                const float M63 = __shfl(M, 63), bl = __shfl(bc, 63);
                sU[lane] = u; sM[lane] = M; sA[lane] = __expf(m_prev - M); sEm[lane] = __expf(-(bc + M)); sWk[lane] = __expf(u - M63);
                if (lane == 0) { sScal[0] = __expf(m_prev - M63); sScal[1] = bl + M63; }
            }
            __syncthreads();
            { const float wk = sWk[row];
#pragma unroll
              for (int j = 0; j < 4; ++j) { sKT[(seg * 8 + 2 * j) * PST + row] = (bf16)f2bf(bf2f(kv[j] & 0xffffu) * wk); sKT[(seg * 8 + 2 * j + 1) * PST + row] = (bf16)f2bf(bf2f(kv[j] >> 16) * wk); } }
            { const int mi = w >> 1;
#pragma unroll
              for (int nn = 0; nn < 2; ++nn) { const int ni = (w & 1) * 2 + nn; f32x4 acc = (f32x4){0.f, 0.f, 0.f, 0.f};
#pragma unroll
                for (int ks = 0; ks < 2; ++ks) { const bf16x8 av = *(const LAS bf16x8*)(sQ + (16 * mi + fr) * PST + 32 * ks + 8 * fq), bv = *(const LAS bf16x8*)(sK + (16 * ni + fr) * PST + 32 * ks + 8 * fq);
                    acc = __builtin_amdgcn_mfma_f32_16x16x32_bf16(av, bv, acc, 0, 0, 0); }
                const int s = 16 * ni + fr; const float us = sU[s];
#pragma unroll
                for (int i = 0; i < 4; ++i) { const int t = 16 * mi + 4 * fq + i; const float wv = (s <= t) ? __expf(us - sM[t]) * acc[i] : 0.f; sW[t * PST + s] = (bf16)f2bf(wv); } } }
            __syncthreads();
            { const int t = tid >> 3, part = tid & 7; float d1 = 0.f, qn = 0.f;
#pragma unroll
              for (int j = 0; j < 8; ++j) { d1 += bf2f(sW[t * PST + part * 8 + j]); qn += bf2f(sQ[t * PST + part * 8 + j]) * sN[part * 8 + j]; }
              d1 += __shfl_xor(d1, 1); d1 += __shfl_xor(d1, 2); d1 += __shfl_xor(d1, 4); qn += __shfl_xor(qn, 1); qn += __shfl_xor(qn, 2); qn += __shfl_xor(qn, 4);
              const float den = d1 + sA[t] * qn; if (part == 0) sInv[t] = 1.0f / fmaxf(fabsf(den), sEm[t]); }
            f32x4 acc[4];
#pragma unroll
            for (int mi = 0; mi < 4; ++mi) acc[mi] = (f32x4){0.f, 0.f, 0.f, 0.f};
#pragma unroll
            for (int ks = 0; ks < 2; ++ks) { const bf16x8 bq = *(const LAS bf16x8*)(sCT + (16 * w + fr) * PST + 32 * ks + 8 * fq);
#pragma unroll
                for (int mi = 0; mi < 4; ++mi) { const bf16x8 av = *(const LAS bf16x8*)(sQ + (16 * mi + fr) * PST + 32 * ks + 8 * fq); acc[mi] = __builtin_amdgcn_mfma_f32_16x16x32_bf16(av, bq, acc[mi], 0, 0, 0); } }
#pragma unroll
            for (int mi = 0; mi < 4; ++mi)
#pragma unroll
                for (int i = 0; i < 4; ++i) acc[mi][i] *= sA[16 * mi + 4 * fq + i];
#pragma unroll
            for (int ks = 0; ks < 2; ++ks) { const bf16x8 bv = *(const LAS bf16x8*)(sVT + (16 * w + fr) * PST + 32 * ks + 8 * fq);
#pragma unroll
                for (int mi = 0; mi < 4; ++mi) { const bf16x8 av = *(const LAS bf16x8*)(sW + (16 * mi + fr) * PST + 32 * ks + 8 * fq); acc[mi] = __builtin_amdgcn_mfma_f32_16x16x32_bf16(av, bv, acc[mi], 0, 0, 0); } }
            __syncthreads();
#pragma unroll
            for (int mi = 0; mi < 4; ++mi)
#pragma unroll
                for (int i = 0; i < 4; ++i) { const int t = 16 * mi + 4 * fq + i; const float hv = acc[mi][i] * sInv[t]; acc[mi][i] = hv; float sq = hv * hv;
                    sq += __shfl_xor(sq, 1); sq += __shfl_xor(sq, 2); sq += __shfl_xor(sq, 4); sq += __shfl_xor(sq, 8); if (fr == 0) sSS[w * 64 + t] = sq; }
            __syncthreads();
            { const int col = hh * 128 + 16 * w + fr; const float mh = mhn[col];
#pragma unroll
              for (int mi = 0; mi < 4; ++mi)
#pragma unroll
                for (int i = 0; i < 4; ++i) { const int t = 16 * mi + 4 * fq + i; float tot = 0.f;
#pragma unroll
                    for (int ww = 0; ww < 8; ++ww) tot += sSS[ww * 64 + t];
                    const float rn = 1.0f / sqrtf(tot * (1.0f / 128.0f) + EPS);
                    const float og = bf2f(PROJ[(t0 + t) * A_PROJ + 2048 + col]);
                    HS[(t0 + t) * DM + col] = (bf16)f2bf(acc[mi][i] * rn * mh * og); } }
            { const float decay = sScal[0];
#pragma unroll
              for (int ni = 0; ni < 4; ++ni) accC[ni] = accC[ni] * decay;
#pragma unroll
              for (int ks = 0; ks < 2; ++ks) { const bf16x8 av = *(const LAS bf16x8*)(sVT + (16 * w + fr) * PST + 32 * ks + 8 * fq);
#pragma unroll
                for (int ni = 0; ni < 4; ++ni) { const bf16x8 bv = *(const LAS bf16x8*)(sKT + (16 * ni + fr) * PST + 32 * ks + 8 * fq); accC[ni] = __builtin_amdgcn_mfma_f32_16x16x32_bf16(av, bv, accC[ni], 0, 0, 0); } }
#pragma unroll
              for (int ni = 0; ni < 4; ++ni)
#pragma unroll
                for (int i = 0; i < 4; ++i) sCT[(16 * w + 4 * fq + i) * PST + 16 * ni + fr] = (bf16)f2bf(accC[ni][i]);
              const int d = tid >> 3, part = tid & 7; float sk = 0.f;
#pragma unroll
              for (int j = 0; j < 8; ++j) sk += bf2f(sKT[d * PST + part * 8 + j]);
              sk += __shfl_xor(sk, 1); sk += __shfl_xor(sk, 2); sk += __shfl_xor(sk, 4);
              if (part == 0) sN[d] = decay * sN[d] + sk;
              m_prev = sScal[1]; }
            __syncthreads();
        }
    }
}

typedef short v4i16_t __attribute__((ext_vector_type(4)));
__device__ __forceinline__ unsigned img_off(unsigned row, unsigned ch) { return 256u * row + 16u * (ch ^ (((row & 3u) << 2) | ((row >> 2) & 3u))); }
__device__ __forceinline__ bf16x8 tr_frag(const LAS unsigned char* img, int lane, int c, int rbase, int rstep) {
    const int q = (lane & 15) >> 2, p = lane & 3;
    const v4i16_t lo = __builtin_amdgcn_ds_read_tr16_b64_v4i16((LAS v4i16_t*)(img + img_off(rbase + q, 2 * c + (p >> 1)) + 8 * (p & 1)));
    const v4i16_t hi = __builtin_amdgcn_ds_read_tr16_b64_v4i16((LAS v4i16_t*)(img + img_off(rbase + rstep + q, 2 * c + (p >> 1)) + 8 * (p & 1)));
    return (bf16x8){lo[0], lo[1], lo[2], lo[3], hi[0], hi[1], hi[2], hi[3]};
}
__device__ __forceinline__ void cellA_phase(Frame& F, const bf16* PROJ, const float* G16, bf16* CTS, float* NS, float* MS, float* SCN) {
    LAS unsigned char* img0 = F.lds;
    LAS float* sU = (LAS float*)(F.lds + 32768);
    LAS float* sPM = sU + 4096;
    LAS float* sBL = sPM + 64;
    int tid_ = HW_TID(F.wave); asm volatile("" : "+v"(tid_)); int bid_ = blockIdx.x; asm volatile("" : "+s"(bid_)); const int bid = bid_;
    const int tid = tid_, lane = tid & 63, w = __builtin_amdgcn_readfirstlane(tid >> 6), fr = lane & 15, fq = lane >> 4;
    const int vt = w & 3, dh = w >> 2, row = tid >> 3, seg = tid & 7;
    bf16x8 ones;
#pragma unroll
    for (int j = 0; j < 8; ++j) ones[j] = (short)0x3F80;
    for (int chain = bid; chain < NB * 16; chain += F.G) {
        const int bh = chain >> 1, vh = chain & 1, b = bh >> 3, hh = bh & 7;
        float igs[8], lfs[8];
#pragma unroll
        for (int k = 0; k < 8; ++k) { const float* pg = G16 + ((size_t)b * SEQ + 64 * (w + 8 * k) + lane) * 16 + hh; igs[k] = ((const GAS float*)pg)[0]; lfs[k] = ((const GAS float*)pg)[8]; }
#pragma unroll
        for (int k = 0; k < 8; ++k) { const int c = w + 8 * k; const float ig = igs[k], lf = lfs[k];
            const float bc = wave_scan_add(lf, lane), u = ig - bc, pm = wave_scan_max(u, lane); sU[c * 64 + lane] = u; if (lane == 63) { sPM[c] = pm; sBL[c] = bc; }
            if (vh == 0) { GAS float* sv = (GAS float*)SCN + ((size_t)(bh * 64 + c) * 3) * 64 + lane; sv[0] = u; sv[64] = pm; sv[128] = bc; } }
        f32x4 accC[2], accN[2];
#pragma unroll
        for (int mt = 0; mt < 2; ++mt) { accC[mt] = (f32x4){0.f, 0.f, 0.f, 0.f}; accN[mt] = (f32x4){0.f, 0.f, 0.f, 0.f}; }
        float m_prev = 0.f;
        const bf16* pk = PROJ + ((size_t)b * SEQ + row) * A_PROJ + 512 + hh * 64 + seg * 8;
        const bf16* pv = PROJ + ((size_t)b * SEQ + row) * A_PROJ + 1024 + hh * 128 + vh * 64 + seg * 8;
        v4u kv = *(const GAS v4u*)pk, vv = *(const GAS v4u*)pv;
        pk += (size_t)64 * A_PROJ; pv += (size_t)64 * A_PROJ;
        v4u kv2 = *(const GAS v4u*)pk, vv2 = *(const GAS v4u*)pv;
        __syncthreads();
        for (int c = 0; c < SEQ / 64; ++c) {
            LAS unsigned char* img = img0 + (c & 1) * 16384;
            const float M63 = fmaxf(m_prev, sPM[c]), decay = __expf(m_prev - M63), m_new = sBL[c] + M63, wkr = __expf(sU[c * 64 + row] - M63);
            { bf16* cs = CTS + ((size_t)(bh * 64 + c) * 128 + vh * 64 + 16 * vt + fr) * 64 + 32 * dh + 4 * fq;
#pragma unroll
              for (int mt = 0; mt < 2; ++mt) { v2u o; o.x = pk2(accC[mt][0], accC[mt][1]); o.y = pk2(accC[mt][2], accC[mt][3]); *(GAS v2u*)(cs + 16 * mt) = o; }
              if (vh == 0 && vt == 0 && fr == 0) { *(GAS f32x4*)(NS + (size_t)(bh * 64 + c) * 64 + 32 * dh + 4 * fq) = accN[0]; *(GAS f32x4*)(NS + (size_t)(bh * 64 + c) * 64 + 32 * dh + 16 + 4 * fq) = accN[1]; }
              if (vh == 0 && tid == 0) ((GAS float*)MS)[bh * 64 + c] = m_prev; }
            { v4u ks;
#pragma unroll
              for (int j = 0; j < 4; ++j) ks[j] = pk2(bf2f(kv[j] & 0xffffu) * wkr, bf2f(kv[j] >> 16) * wkr);
              *(LAS v4u*)(img + img_off(row, seg)) = ks; *(LAS v4u*)(img + img_off(row, 8 + seg)) = vv; }
            kv = kv2; vv = vv2;
            if (c + 2 < SEQ / 64) { pk += (size_t)64 * A_PROJ; pv += (size_t)64 * A_PROJ; kv2 = *(const GAS v4u*)pk; vv2 = *(const GAS v4u*)pv; }
            __syncthreads();
#pragma unroll
            for (int mt = 0; mt < 2; ++mt) { accC[mt] = accC[mt] * decay; accN[mt] = accN[mt] * decay; }
#pragma unroll
            for (int ks = 0; ks < 2; ++ks) { const bf16x8 bv = tr_frag(img, lane, 4 + vt, 32 * ks + 8 * fq, 4);
#pragma unroll
                for (int mt = 0; mt < 2; ++mt) { const bf16x8 av = tr_frag(img, lane, 2 * dh + mt, 32 * ks + 8 * fq, 4);
                    accC[mt] = __builtin_amdgcn_mfma_f32_16x16x32_bf16(av, bv, accC[mt], 0, 0, 0); accN[mt] = __builtin_amdgcn_mfma_f32_16x16x32_bf16(av, ones, accN[mt], 0, 0, 0); } }
            m_prev = m_new;
        }
        __syncthreads();
    }
}
struct CellOps { bf16x8 oq[2], ok[4][2]; float u, pm, bc, m_c; };
#define CELL_LOAD_OPS(D, rb_, hh_, mi_) do { const size_t t0_ = (size_t)(rb_) * 64; const int bh_ = ((rb_) >> 6) * 8 + (hh_), c_ = (rb_) & 63; \
    _Pragma("unroll") for (int ks = 0; ks < 2; ++ks) D.oq[ks] = *(const GAS bf16x8*)(PROJ + (t0_ + 16 * (mi_) + fr) * A_PROJ + (hh_) * 64 + 32 * ks + 8 * fq); \
    _Pragma("unroll") for (int si = 0; si < 4; ++si) if (si <= (mi_)) { _Pragma("unroll") for (int ks = 0; ks < 2; ++ks) D.ok[si][ks] = *(const GAS bf16x8*)(PROJ + (t0_ + 16 * si + fr) * A_PROJ + 512 + (hh_) * 64 + 32 * ks + 8 * fq); } \
    { const GAS float* sv_ = (const GAS float*)SCN + ((size_t)(bh_ * 64 + c_) * 3) * 64 + lane; D.u = sv_[0]; D.pm = sv_[64]; D.bc = sv_[128]; } \
    D.m_c = ((const GAS float*)MS)[bh_ * 64 + c_]; } while (0)
__device__ __forceinline__ void cellB_phase(Frame& F, const bf16* PROJ, const float* G16, const float* mhn, const bf16* CTS, const float* NS, const float* MS, const float* SCN, bf16* HS, int local) {
    constexpr int OP = 136;
    LAS unsigned char* vimg0 = F.lds;
    LAS bf16* stg0 = (LAS bf16*)(F.lds + 65536);
    int tid_ = HW_TID(F.wave); asm volatile("" : "+v"(tid_)); int bid_ = blockIdx.x; asm volatile("" : "+s"(bid_)); const int bid = bid_;
    const int tid = tid_, lane = tid & 63, w = __builtin_amdgcn_readfirstlane(tid >> 6), fr = lane & 15, fq = lane >> 4;
    const int hs = w >> 2, wj = w & 3;
    LAS bf16* stg = stg0 + w * (16 * OP + 32);
    for (int rb = local ? 4 * bid : bid, rbe = local ? 4 * bid + 4 : NT / 64; rb < rbe; rb += local ? 1 : F.G) {
        const int b = rb >> 6, c = rb & 63; const size_t t0 = (size_t)rb * 64;
#pragma clang loop unroll(disable)
        for (int it = 0; it < 2; ++it) {
            __syncthreads();
#pragma unroll
            for (int ps = 0; ps < 2; ++ps) { const int hv = 4 * it + 2 * hs + ps;
#pragma unroll
                for (int k = 0; k < 4; ++k) { const int q = 4 * wj + k, row = 4 * q + (lane >> 4), pc = lane & 15, ch = pc ^ (((row & 3) << 2) | ((row >> 2) & 3));
                    __builtin_amdgcn_global_load_lds((const unsigned*)(PROJ + (t0 + row) * A_PROJ + 1024 + hv * 128 + ch * 8), (LAS unsigned*)(vimg0 + (2 * hs + ps) * 16384 + q * 1024), 16, 0, 0); } }
            CellOps nxt; CELL_LOAD_OPS(nxt, rb, 4 * it + 2 * hs, wj);
            asm volatile("s_waitcnt vmcnt(0)" ::: "memory"); __syncthreads();
#pragma clang loop unroll(disable)
            for (int ps = 0; ps < 2; ++ps) {
                const int hh = 4 * it + 2 * hs + ps, bh = b * 8 + hh, mi = ps ? 3 - wj : wj;
                const LAS unsigned char* vimg = vimg0 + (2 * hs + ps) * 16384;
#define qf nxt.oq
#define kf nxt.ok
            const float u = nxt.u, pm = nxt.pm, bc = nxt.bc, m_c = nxt.m_c;
            f32x4 nv[2][2];
            { const float* np = NS + (size_t)(bh * 64 + c) * 64;
#pragma unroll
              for (int ks = 0; ks < 2; ++ks) { nv[ks][0] = *(const GAS f32x4*)(np + 32 * ks + 8 * fq); nv[ks][1] = *(const GAS f32x4*)(np + 32 * ks + 8 * fq + 4); } }
            const bf16* ctp = CTS + ((size_t)(bh * 64 + c) * 128 + fr) * 64 + 8 * fq;
            bf16x8 ctf[4][2];
#pragma unroll
            for (int cv = 0; cv < 4; ++cv)
#pragma unroll
                for (int ks = 0; ks < 2; ++ks) ctf[cv][ks] = *(const GAS bf16x8*)(ctp + (size_t)cv * 16 * 64 + 32 * ks);
            asm volatile("" ::: "memory");
            const float M = fmaxf(m_c, pm), av = __expf(m_c - M), em = __expf(-(bc + M));
            const int tme = 16 * mi + fr;
            const float Mt = __shfl(M, tme), at = __shfl(av, tme), et = __shfl(em, tme);
            bf16x8 wf[2]; float d1 = 0.f;
#pragma unroll
            for (int si = 0; si < 4; ++si) {
                unsigned w01 = 0u, w23 = 0u;
                if (si <= mi) { f32x4 acc = (f32x4){0.f, 0.f, 0.f, 0.f};
#pragma unroll
                    for (int ks = 0; ks < 2; ++ks) acc = __builtin_amdgcn_mfma_f32_16x16x32_bf16(kf[si][ks], qf[ks], acc, 0, 0, 0);
                    float wv[4];
#pragma unroll
                    for (int i = 0; i < 4; ++i) { const int s = 16 * si + 4 * fq + i; const float us = __shfl(u, s); wv[i] = (s <= tme) ? __expf(us - Mt) * acc[i] : 0.f; }
                    w01 = pk2(wv[0], wv[1]); w23 = pk2(wv[2], wv[3]);
                    d1 += (bf2f(w01 & 0xffffu) + bf2f(w01 >> 16)) + (bf2f(w23 & 0xffffu) + bf2f(w23 >> 16)); }
                wf[si >> 1][(si & 1) * 4 + 0] = (short)(w01 & 0xffffu); wf[si >> 1][(si & 1) * 4 + 1] = (short)(w01 >> 16); wf[si >> 1][(si & 1) * 4 + 2] = (short)(w23 & 0xffffu); wf[si >> 1][(si & 1) * 4 + 3] = (short)(w23 >> 16);
            }
            d1 += __shfl_xor(d1, 16); d1 += __shfl_xor(d1, 32);
            float qn = 0.f;
#pragma unroll
            for (int ks = 0; ks < 2; ++ks)
#pragma unroll
                for (int j = 0; j < 8; ++j) qn += bf2f((unsigned)(unsigned short)qf[ks][j]) * nv[ks][j >> 2][j & 3];
            qn += __shfl_xor(qn, 16); qn += __shfl_xor(qn, 32);
            const float inv = 1.0f / fmaxf(fabsf(d1 + at * qn), et);
            asm volatile("" ::: "memory");
            v4u og[2][2];
#pragma unroll
            for (int hlf = 0; hlf < 2; ++hlf) { const bf16* po = PROJ + (t0 + 16 * mi + (lane >> 3) + 8 * hlf) * A_PROJ + 2048 + hh * 128 + (lane & 7) * 16; og[hlf][0] = *(const GAS v4u*)po; og[hlf][1] = *(const GAS v4u*)(po + 8); }
            asm volatile("" ::: "memory");
            float a_i[4], inv_i[4];
#pragma unroll
            for (int i = 0; i < 4; ++i) { a_i[i] = __shfl(at, 4 * fq + i); inv_i[i] = __shfl(inv, 4 * fq + i); }
            float ssq[4] = {0.f, 0.f, 0.f, 0.f};
#pragma unroll
            for (int cv = 0; cv < 8; ++cv) { f32x4 a = (f32x4){0.f, 0.f, 0.f, 0.f};
#pragma unroll
                for (int ks = 0; ks < 2; ++ks) a = __builtin_amdgcn_mfma_f32_16x16x32_bf16(qf[ks], ctf[cv & 3][ks], a, 0, 0, 0);
                if (cv < 4) {
#pragma unroll
                    for (int ks = 0; ks < 2; ++ks) ctf[cv & 3][ks] = *(const GAS bf16x8*)(ctp + (size_t)(cv + 4) * 16 * 64 + 32 * ks); }
#pragma unroll
                for (int i = 0; i < 4; ++i) a[i] *= a_i[i];
#pragma unroll
                for (int ks = 0; ks < 2; ++ks) if (2 * ks <= mi) { const bf16x8 vf = tr_frag(vimg, lane, cv, 32 * ks + 4 * fq, 16); a = __builtin_amdgcn_mfma_f32_16x16x32_bf16(wf[ks], vf, a, 0, 0, 0); }
#pragma unroll
                for (int i = 0; i < 4; ++i) { a[i] *= inv_i[i]; ssq[i] += a[i] * a[i]; stg[(4 * fq + i) * OP + 16 * cv + fr] = (bf16)f2bf(a[i]); } }
            float rn[4];
#pragma unroll
            for (int i = 0; i < 4; ++i) { float s = ssq[i]; s += __shfl_xor(s, 1); s += __shfl_xor(s, 2); s += __shfl_xor(s, 4); s += __shfl_xor(s, 8); rn[i] = 1.0f / sqrtf(s * (1.0f / 128.0f) + EPS); }
            { LAS float* srn = (LAS float*)(stg + 16 * OP);
#pragma unroll
              for (int i = 0; i < 4; ++i) if (fr == 0) srn[4 * fq + i] = rn[i]; }
            LDS_WAIT(); asm volatile("" ::: "memory");
            f32x4 mhq[4];
#pragma unroll
            for (int q = 0; q < 4; ++q) mhq[q] = ((const GAS f32x4*)(mhn + hh * 128 + (lane & 7) * 16))[q];
#pragma unroll
            for (int hlf = 0; hlf < 2; ++hlf) { const int r = (lane >> 3) + 8 * hlf, sg = lane & 7;
                const v4u h0 = *(const LAS v4u*)(stg + r * OP + sg * 16), h1 = *(const LAS v4u*)(stg + r * OP + sg * 16 + 8);
                const v4u g0 = og[hlf][0], g1 = og[hlf][1]; v4u o0, o1; const float rnr = ((const LAS float*)(stg + 16 * OP))[r];
#pragma unroll
                for (int j = 0; j < 4; ++j) { const f32x4 m0 = mhq[j >> 1], m1 = mhq[2 + (j >> 1)]; const int e = (j & 1) * 2;
                    o0[j] = pk2(bf2f(h0[j] & 0xffffu) * rnr * m0[e] * bf2f(g0[j] & 0xffffu), bf2f(h0[j] >> 16) * rnr * m0[e + 1] * bf2f(g0[j] >> 16));
                    o1[j] = pk2(bf2f(h1[j] & 0xffffu) * rnr * m1[e] * bf2f(g1[j] & 0xffffu), bf2f(h1[j] >> 16) * rnr * m1[e + 1] * bf2f(g1[j] >> 16)); }
                if (OUT_F8) { v4u o8;
#pragma unroll
                    for (int j = 0; j < 2; ++j) { int w0 = 0, w1 = 0;
                        w0 = cvt8(bf2f(o0[2 * j] & 0xffffu), bf2f(o0[2 * j] >> 16), w0, false); w0 = cvt8(bf2f(o0[2 * j + 1] & 0xffffu), bf2f(o0[2 * j + 1] >> 16), w0, true);
                        w1 = cvt8(bf2f(o1[2 * j] & 0xffffu), bf2f(o1[2 * j] >> 16), w1, false); w1 = cvt8(bf2f(o1[2 * j + 1] & 0xffffu), bf2f(o1[2 * j + 1] >> 16), w1, true);
                        o8[j] = (unsigned)w0; o8[2 + j] = (unsigned)w1; }
                    *(GAS v4u*)((unsigned char*)HS + (t0 + 16 * mi + r) * DM + hh * 128 + sg * 16) = o8; }
                else { bf16* ho = HS + (t0 + 16 * mi + r) * DM + hh * 128 + sg * 16;
                    *(GAS v4u*)ho = o0; *(GAS v4u*)(ho + 8) = o1; } }
            LDS_WAIT(); asm volatile("" ::: "memory");
            if (ps == 0) CELL_LOAD_OPS(nxt, rb, hh + 1, 3 - wj);
            }
#undef qf
#undef kf
        }
    }
    __syncthreads();
}

struct DenseProb {
    const bf16* A; int lda; const bf16* Bt; int ldb; int K; int esz, scale_w, scale_a; pg8::StaticOrder S;
    int local, lw;
    __device__ __forceinline__ bool next(int i, pg8::Unit& u) const { if (local) { if (i >= S.nN) return false; u.pm = lw; u.pn = i; u.cls = 0; u.lb = 0; u.hf = 0; u.r0 = 0; return true; } return S.next(i, u); }
    __device__ __forceinline__ const char* a_base() const { return (const char*)A; }
    __device__ __forceinline__ void a_off(const pg8::Unit& u, int R0, int C0, unsigned (&o)[2][2]) const {
#pragma unroll
        for (int h = 0; h < 2; ++h)
#pragma unroll
            for (int i = 0; i < 2; ++i) o[h][i] = (unsigned)((u.pm * 256 + h * 128 + R0 + 64 * i) * lda) * esz + (unsigned)C0 * 2u; }
    __device__ __forceinline__ const char* b_tile(const pg8::Unit& u, int tt) const { return (const char*)Bt + (size_t)u.pn * 256 * ldb * esz + (size_t)tt * 128; }
};
struct ClassTab { const LAS int* blkstart; const LAS int* ncls; };
__device__ __forceinline__ void class_of(const ClassTab& T, pg8::Unit& u) { const int c = T.blkstart[64 + u.pm]; u.cls = c; u.lb = u.pm - T.blkstart[c]; }
__device__ __forceinline__ void pair_of(int cls, int& ea, int& eb) { const int g = cls / 6, p = cls % 6; const int a = p < 3 ? 0 : p < 5 ? 1 : 2, b = p < 3 ? p + 1 : p < 5 ? p - 1 : 3; ea = g * 4 + a; eb = g * 4 + b; }
struct Moe1Prob {
    const bf16* A; int ldb; int K; int esz, scale_w, scale_a; int dense_dbg; const bf16* Bt1l; const int* perm; ClassTab T; pg8::StaticOrder S;
    __device__ __forceinline__ bool next(int i, pg8::Unit& u) const { if (!S.next(i, u)) return false; class_of(T, u); return true; }
    __device__ __forceinline__ const char* a_base() const { return (const char*)A; }
    __device__ __forceinline__ void a_off(const pg8::Unit& u, int R0, int C0, unsigned (&o)[2][2]) const {
        const int n = T.ncls[u.cls];
#pragma unroll
        for (int h = 0; h < 2; ++h)
#pragma unroll
            for (int i = 0; i < 2; ++i) { int pos = u.lb * 256 + h * 128 + R0 + 64 * i; pos = pos < n ? pos : n - 1; int tok = perm[(size_t)u.cls * CLS_CAP + pos]; if (dense_dbg) tok = u.pm * 256 + h * 128 + R0 + 64 * i; o[h][i] = (unsigned)(tok * DM) * esz + (unsigned)C0 * 2u; } }
    __device__ __forceinline__ const char* b_tile(const pg8::Unit& u, int tt) const { int ea, eb; pair_of(u.cls, ea, eb); const int e = u.pn < 4 ? ea : eb;
        return (const char*)Bt1l + ((size_t)e * 1024 + (size_t)(u.pn & 3) * 256) * DM * esz + (size_t)tt * 128; }
};
struct Moe2Prob {
    const bf16* A; int ldb; int K; int esz, scale_w, scale_a; int halfmode; const bf16* Bt2l; ClassTab T; pg8::StaticOrder S;
    __device__ __forceinline__ bool next(int i, pg8::Unit& u) const {
        const int R = S.nwg / S.G, rem = S.nwg - R * S.G;
        if (2 * rem > S.G) { if (halfmode || !S.next(i, u)) return false; class_of(T, u); return true; }
        if (!halfmode) { if (i >= R || !S.next(i, u)) return false; class_of(T, u); return true; }
        if (i > 0 || S.c >= 2 * rem) return false;
        if (!S.next_L((long)R * S.G + (S.c >> 1), u)) return false;
        u.hf = 1; u.r0 = 128 * (S.c & 1); class_of(T, u); return true; }
    __device__ __forceinline__ const char* a_base() const { return (const char*)A; }
    __device__ __forceinline__ void a_off(const pg8::Unit& u, int R0, int C0, unsigned (&o)[2][2]) const {
#pragma unroll
        for (int h = 0; h < 2; ++h)
#pragma unroll
            for (int i = 0; i < 2; ++i) o[h][i] = (unsigned)((u.pm * 256 + h * 128 + R0 + 64 * i) * DM) * esz + (unsigned)C0 * 2u; }
    __device__ __forceinline__ const char* b_tile(const pg8::Unit& u, int tt) const { int ea, eb; pair_of(u.cls, ea, eb); const int half = (esz == 2) ? 8 : 4; const int e = tt < half ? ea : eb;
        return (const char*)Bt2l + ((size_t)e * 1024 + (size_t)u.pn * 256 + u.r0) * DE * esz + (size_t)(tt & (half - 1)) * 128; }
};

struct EpiProj {
    static constexpr bool PERM = true;
    bf16* O; int ldc; int split_cols; size_t split_stride; int nscale; float scale; int sig_from;
    __device__ __forceinline__ void operator()(const pg8::f32x4 (&acc)[2][2][4][2], const pg8::Unit& u, int wr, int wc, int fr, int fq) const {
        const int row0 = u.pm * 256 + wr * 64 + fr; int colt = u.pn * 256; bf16* base = O;
        if (split_cols) { const int t = colt / split_cols; base += (size_t)t * split_stride; colt -= t * split_cols; }
        const float sc = u.pn < nscale ? scale : 1.0f; const bool sg = u.pn >= sig_from;
        const int col0 = colt + wc * 32 + 8 * fq;
#pragma unroll
        for (int ai = 0; ai < 2; ++ai)
#pragma unroll
            for (int m = 0; m < 4; ++m) { bf16* rowp = base + (size_t)(row0 + ai * 128 + m * 16) * ldc + col0;
#pragma unroll
                for (int bj = 0; bj < 2; ++bj) { pg8::f32x4 v0 = acc[ai][bj][m][0] * sc, v1 = acc[ai][bj][m][1] * sc;
                    if (sg) {
#pragma unroll
                        for (int j = 0; j < 4; ++j) { v0[j] = pg8::sigmoidf_(v0[j]); v1[j] = pg8::sigmoidf_(v1[j]); } }
                    pg8::u32x4 w; w.x = pg8::cvt_pk_bf16(v0[0], v0[1]); w.y = pg8::cvt_pk_bf16(v0[2], v0[3]); w.z = pg8::cvt_pk_bf16(v1[0], v1[1]); w.w = pg8::cvt_pk_bf16(v1[2], v1[3]);
                    *(pg8::u32x4*)(rowp + bj * 128) = w; } }
    }
};
struct EpiRes {
    static constexpr bool PERM = true;
    const void* base; int base_bf; bf16* out; const float* gate; int gstride;
    __device__ __forceinline__ void operator()(const pg8::f32x4 (&acc)[2][2][4][2], const pg8::Unit& u, int wr, int wc, int fr, int fq) const {
        const int row0 = u.pm * 256 + wr * 64 + fr, col0 = u.pn * 256 + wc * 32 + 8 * fq;
        const float* gp = gate + (size_t)(u.pm >> 4) * gstride + col0;
        pg8::f32x4 gv[2][2];
#pragma unroll
        for (int bj = 0; bj < 2; ++bj)
#pragma unroll
            for (int n = 0; n < 2; ++n) gv[bj][n] = *(const GAS pg8::f32x4*)(gp + bj * 128 + n * 4);
#pragma unroll
        for (int ai = 0; ai < 2; ++ai)
#pragma unroll
            for (int mp = 0; mp < 2; ++mp) {
                pg8::u32x4 t[2][2]; pg8::f32x4 f0[2][2], f1[2][2];
#pragma unroll
                for (int q = 0; q < 2; ++q) { const size_t off = (size_t)(row0 + ai * 128 + (2 * mp + q) * 16) * DM + col0;
#pragma unroll
                    for (int bj = 0; bj < 2; ++bj) {
                        if (base_bf) t[q][bj] = *(const GAS pg8::u32x4*)((const bf16*)base + off + bj * 128);
                        else { f0[q][bj] = *(const GAS pg8::f32x4*)((const float*)base + off + bj * 128); f1[q][bj] = *(const GAS pg8::f32x4*)((const float*)base + off + bj * 128 + 4); } } }
#pragma unroll
                for (int q = 0; q < 2; ++q) { const int m = 2 * mp + q; const size_t off = (size_t)(row0 + ai * 128 + m * 16) * DM + col0;
#pragma unroll
                    for (int bj = 0; bj < 2; ++bj) { pg8::f32x4 b0, b1;
                        if (base_bf) { const pg8::u32x4 tt = t[q][bj]; b0 = (pg8::f32x4){bf2f(tt.x & 0xffffu), bf2f(tt.x >> 16), bf2f(tt.y & 0xffffu), bf2f(tt.y >> 16)}; b1 = (pg8::f32x4){bf2f(tt.z & 0xffffu), bf2f(tt.z >> 16), bf2f(tt.w & 0xffffu), bf2f(tt.w >> 16)}; }
                        else { b0 = f0[q][bj]; b1 = f1[q][bj]; }
                        const pg8::f32x4 v0 = b0 + gv[bj][0] * acc[ai][bj][m][0], v1 = b1 + gv[bj][1] * acc[ai][bj][m][1];
                        pg8::u32x4 w; w.x = pg8::cvt_pk_bf16(v0[0], v0[1]); w.y = pg8::cvt_pk_bf16(v0[2], v0[3]); w.z = pg8::cvt_pk_bf16(v1[0], v1[1]); w.w = pg8::cvt_pk_bf16(v1[2], v1[3]);
                        *(GAS pg8::u32x4*)(out + off + bj * 128) = w; } } }
    }
};
struct EpiResScatter {
    static constexpr bool PERM = true;
    bf16* x; const float* gate; int gstride; const int* perm; ClassTab T;
    __device__ __forceinline__ void operator()(const pg8::f32x4 (&acc)[2][2][4][2], const pg8::Unit& u, int wr, int wc, int fr, int fq) const {
        const int n = T.ncls[u.cls]; const int col0 = u.pn * 256 + u.r0 + wc * 32 + 8 * fq;
        int tok[2][4];
#pragma unroll
        for (int ai = 0; ai < 2; ++ai)
#pragma unroll
            for (int m = 0; m < 4; ++m) { int pos = u.lb * 256 + ai * 128 + wr * 64 + m * 16 + fr; pos = pos < n ? pos : n - 1; tok[ai][m] = ((const GAS int*)perm)[(size_t)u.cls * CLS_CAP + pos]; }
#pragma unroll
        for (int ai = 0; ai < 2; ++ai)
#pragma unroll
            for (int mp = 0; mp < 2; ++mp) {
                pg8::u32x4 xv[2][2]; pg8::f32x4 gv[2][2][2];
#pragma unroll
                for (int q = 0; q < 2; ++q) { const int tk = tok[ai][2 * mp + q]; const GAS bf16* xp = (const GAS bf16*)x + (size_t)tk * DM + col0; const GAS float* gp = (const GAS float*)gate + (size_t)(tk >> 12) * gstride + col0;
#pragma unroll
                    for (int bj = 0; bj < 2; ++bj) { if (bj == 1 && u.hf) continue; xv[q][bj] = *(const GAS pg8::u32x4*)(xp + bj * 128); gv[q][bj][0] = *(const GAS pg8::f32x4*)(gp + bj * 128); gv[q][bj][1] = *(const GAS pg8::f32x4*)(gp + bj * 128 + 4); } }
#pragma unroll
                for (int q = 0; q < 2; ++q) { const int m = 2 * mp + q; const int pos = u.lb * 256 + ai * 128 + wr * 64 + m * 16 + fr;
                    if (pos < n) { GAS bf16* xp = (GAS bf16*)x + (size_t)tok[ai][m] * DM + col0;
#pragma unroll
                        for (int bj = 0; bj < 2; ++bj) { if (bj == 1 && u.hf) continue; const pg8::u32x4 t = xv[q][bj];
                            const pg8::f32x4 b0 = (pg8::f32x4){bf2f(t.x & 0xffffu), bf2f(t.x >> 16), bf2f(t.y & 0xffffu), bf2f(t.y >> 16)}, b1 = (pg8::f32x4){bf2f(t.z & 0xffffu), bf2f(t.z >> 16), bf2f(t.w & 0xffffu), bf2f(t.w >> 16)};
                            const pg8::f32x4 v0 = b0 + gv[q][bj][0] * acc[ai][bj][m][0], v1 = b1 + gv[q][bj][1] * acc[ai][bj][m][1];
                            pg8::u32x4 w; w.x = pg8::cvt_pk_bf16(v0[0], v0[1]); w.y = pg8::cvt_pk_bf16(v0[2], v0[3]); w.z = pg8::cvt_pk_bf16(v1[0], v1[1]); w.w = pg8::cvt_pk_bf16(v1[2], v1[3]);
                            *(GAS pg8::u32x4*)(xp + bj * 128) = w; } } } }
    }
};
struct EpiAct {
    static constexpr bool PERM = true;
    bf16* act; const int* perm; const float2* wts; ClassTab T;
    __device__ __forceinline__ void operator()(const pg8::f32x4 (&acc)[2][2][4][2], const pg8::Unit& u, int wr, int wc, int fr, int fq) const {
        const int n = T.ncls[u.cls]; const int second = u.pn >> 2; const int col0 = second * 512 + (u.pn & 3) * 128 + wc * 32 + 8 * fq;
        float wtv[2][4];
#pragma unroll
        for (int ai = 0; ai < 2; ++ai)
#pragma unroll
            for (int m = 0; m < 4; ++m) { int pos = u.lb * 256 + ai * 128 + wr * 64 + m * 16 + fr; pos = pos < n ? pos : n - 1;
                const pg8::u32x2 pe = *(const GAS pg8::u32x2*)((const unsigned*)wts + ((size_t)u.cls * CLS_CAP + pos) * 4 + 1); wtv[ai][m] = __builtin_bit_cast(float, second ? pe.y : pe.x); }
#pragma unroll
        for (int ai = 0; ai < 2; ++ai)
#pragma unroll
            for (int m = 0; m < 4; ++m) { const int lr = ai * 128 + wr * 64 + m * 16 + fr; const float wt = wtv[ai][m];
                pg8::f32x4 g0 = acc[ai][0][m][0], g1 = acc[ai][0][m][1]; const pg8::f32x4 u0 = acc[ai][1][m][0], u1 = acc[ai][1][m][1];
#pragma unroll
                for (int j = 0; j < 4; ++j) { g0[j] = g0[j] * pg8::sigmoidf_(g0[j]) * u0[j] * wt; g1[j] = g1[j] * pg8::sigmoidf_(g1[j]) * u1[j] * wt; }
                if (MOE2_F8) { int w0 = 0, w1 = 0;
                    w0 = cvt8(g0[0] * 4.f, g0[1] * 4.f, w0, false); w0 = cvt8(g0[2] * 4.f, g0[3] * 4.f, w0, true);
                    w1 = cvt8(g1[0] * 4.f, g1[1] * 4.f, w1, false); w1 = cvt8(g1[2] * 4.f, g1[3] * 4.f, w1, true);
                    pg8::u32x2 w; w.x = (unsigned)w0; w.y = (unsigned)w1; *(pg8::u32x2*)((unsigned char*)act + (size_t)(u.pm * 256 + lr) * DM + col0) = w; }
                else { pg8::u32x4 w; w.x = pg8::cvt_pk_bf16(g0[0], g0[1]); w.y = pg8::cvt_pk_bf16(g0[2], g0[3]); w.z = pg8::cvt_pk_bf16(g1[0], g1[1]); w.w = pg8::cvt_pk_bf16(g1[2], g1[3]);
                    *(pg8::u32x4*)(act + (size_t)(u.pm * 256 + lr) * DM + col0) = w; } }
    }
};
__device__ __forceinline__ void build_class_tab(Frame& F, gu32* gcnt) {
    LAS int* blkstart = (LAS int*)(F.lds + TAB_OFF); LAS int* ncls = blkstart + 32;
    const int t = HW_TID(F.wave);
    if (t < NCLS) ncls[t] = (int)__hip_atomic_load(gcnt + t, RLX_AGENT);
    __syncthreads();
    if (t == 0) { int run = 0; for (int c = 0; c < NCLS; ++c) { blkstart[c] = run; run += (ncls[c] + 255) >> 8; } blkstart[NCLS] = run; }
    __syncthreads();
    if (t < blkstart[NCLS]) { int c = 0; while (c < NCLS - 1 && t >= blkstart[c + 1]) ++c; blkstart[64 + t] = c; }
    __syncthreads();
}

__global__ void __launch_bounds__(NWAVES * 64, 2) mk_fwd(Args args) {
    extern __shared__ __attribute__((aligned(16))) unsigned char lds[];
    Frame F;
    F.lds = (LAS unsigned char*)lds;
    F.MISC = (volatile LAS unsigned*)(F.lds + MISC_OFF);
    F.wave = __builtin_amdgcn_readfirstlane((int)threadIdx.x >> 6);
    F.G = gridDim.x; { const int bx = blockIdx.x; F.vcu = (F.G % 8 == 0) ? (bx % 8) * (F.G / 8) + bx / 8 : bx; F.cid = bx; }
    unsigned char* ws = args.ws;
    F.ctl = (gu32*)(ws + WS_CTL);
    for (int u = HW_TID(F.wave); u < (LDS_BYTES - LDSCTL_OFF) / 4; u += NWAVES * 64) ((LAS unsigned*)(F.lds + LDSCTL_OFF))[u] = 0u;
    __syncthreads();
    const int lo = args.ph_lo, hi = args.ph_hi;
    const bool multi = (hi - lo) > 1;
    XcdBarrier bar; bar.bar = (unsigned*)(F.ctl + CW_BAR); bar.x = 0; bar.st = nullptr; bar.w0 = F.wave;
    if (multi) bar = xcd_barrier_post((unsigned*)(F.ctl + CW_BAR), F.MISC + 8, F.wave);
    if (multi && HW_TID(F.wave) == 0) { const unsigned xcc = xb_xcc_id(); F.MISC[20] = xcc; F.MISC[21] = __hip_atomic_fetch_add(F.ctl + CW_XCCT + 64 * xcc, 1u, RLX_AGENT); }
    int ph = 0;
#define REPEAT(N) _Pragma("clang loop unroll(disable)") for (int rep_ = 0; rep_ < (N); ++rep_)
#ifndef REP_NORM1
#define REP_NORM1 1
#endif
#ifndef REP_PROJ
#define REP_PROJ 1
#endif
#ifndef REP_CELL
#define REP_CELL 1
#endif
#ifndef REP_CELLB
#define REP_CELLB 1
#endif
#ifndef REP_ATTN_NOFB
#define REP_ATTN_NOFB 0
#endif
#ifndef REP_ATTN
#define REP_ATTN 1
#endif
#ifndef REP_MOE1_DENSE
#define REP_MOE1_DENSE 0
#endif
#ifndef REP_MOE1
#define REP_MOE1 1
#endif
#ifndef REP_NORM2N
#define REP_NORM2N 0
#endif
#ifdef PROBE_TYPE
    const bool pr_me = (blockIdx.x == 0 && HW_TID(F.wave) == 0);
#define PH_BEGIN(run, ty) const bool run = (lo <= ph && ph < hi); ++ph; const bool pr_on = pr_me && ((ty) == PROBE_TYPE); if (pr_on) { const unsigned long long t_ = __builtin_amdgcn_s_memrealtime(); F.MISC[16] = (unsigned)t_; F.MISC[17] = (unsigned)(t_ >> 32); }
#define PH_END(run) do { if (run && ph < hi) xcd_barrier(bar); if (pr_on) { const unsigned long long t0_ = ((unsigned long long)F.MISC[17] << 32) | F.MISC[16], a_ = (((unsigned long long)F.MISC[19] << 32) | F.MISC[18]) + (__builtin_amdgcn_s_memrealtime() - t0_); F.MISC[18] = (unsigned)a_; F.MISC[19] = (unsigned)(a_ >> 32); } } while (0)
#else
#define PH_BEGIN(run, ty) const bool run = (lo <= ph && ph < hi); ++ph;
#define PH_END(run) do { if (run && ph < hi) xcd_barrier(bar); } while (0)
#endif
    const bool chain = FUSE_LOCAL && (F.G == NT / 256);
#define PH_END_CHAIN(run) do { if (chain) { if (run && ph < hi) { asm volatile("s_waitcnt vmcnt(0)" ::: "memory"); __syncthreads(); } } else PH_END(run); } while (0)

    bf16* const X = (bf16*)(args.ws + WS_XB);

    { PH_BEGIN(run, 0) if (run) {
#ifndef DIS_P0
 p0_prologue(F, args);
#endif
 } PH_END(run); }

    if (multi && lo == 0 && F.G == 256) {
        unsigned cj[8];
#pragma unroll
        for (int j = 0; j < 8; ++j) cj[j] = __hip_atomic_load(F.ctl + CW_XCCT + 64 * j, RLX_AGENT);
        bool ok = true;
#pragma unroll
        for (int j = 0; j < 8; ++j) ok = ok & (cj[j] == 32u);
        if (ok) { const int xcc = (int)F.MISC[20], idx = (int)F.MISC[21]; F.vcu = __builtin_amdgcn_readfirstlane(xcc * 32 + idx); F.cid = __builtin_amdgcn_readfirstlane(idx * 8 + xcc); }
    }
    for (int step = 0; step < 5; ++step) {
        unsigned char* ws = args.ws; asm volatile("" : "+s"(ws));
        float* const MODS = (float*)(ws + WS_MODS);
        bf16* const HB = (bf16*)(ws + WS_HB);
        bf16* const BIG = (bf16*)(ws + WS_BIG);
        bf16* const ACT = (bf16*)(ws + WS_ACT);
        float* const G16 = (float*)(ws + WS_G16);
        float* const FB = (float*)(ws + WS_FB);
        float2* const WTS = (float2*)(ws + WS_PW);
        int* const PERM = (int*)(ws + WS_PERM);
        bf16* const Kb = BIG; bf16* const Vb = BIG + (size_t)NT * DM; bf16* const Qb = BIG + (size_t)2 * NT * DM;
        const int kind = step < 2 ? 0 : step == 2 ? 1 : 2;
        const int L = step < 2 ? step : step == 2 ? 2 : step - 1;
        const void* xin = (L == 0) ? (const void*)args.in[I_X] : (const void*)X; const int xin_bf = (L != 0);
        const float* mods = MODS + (size_t)L * NB * 6144;
        { PH_BEGIN(run, 1) if (run) {
#ifndef DIS_NORM1
            const float* gam = kind == 1 ? args.in[I_KVNORM] : args.in[I_NMIX] + L * DM;
            const float* shf = kind == 1 ? (const float*)(ws + WS_KVMOD) : mods; const float* scl = shf + 1024; const int mstr = kind == 1 ? 2048 : 6144;
            const int nmode = kind == 0 ? 1 : kind == 1 ? 2 : 0;
            const float* w16 = kind == 0 ? args.in[I_AWIN] + (size_t)L * DM * A_IN + A_PROJ : args.in[I_WKV] + 2048; const int ldw16 = kind == 0 ? A_IN : KV_OUT;
            const float* b16 = kind == 0 ? args.in[I_ABG] + L * 16 : args.in[I_BFG];
            REPEAT(REP_NORM1) normT_phase<false>(F, xin, xin_bf, gam, shf, scl, mstr, HB, nmode, w16, ldw16, b16, G16, nullptr, nullptr, nullptr);
#endif
          } if (kind == 1) PH_END(run); else PH_END_CHAIN(run); }
        { PH_BEGIN(run, 2) if (run) {
#ifndef DIS_PROJ
            if (kind == 1) fcum_phase(F, G16, FB);
            DenseProb P; P.A = HB; P.lda = DM; P.ldb = DM; P.K = DM; P.esz = PROJ_F8 ? 1 : 2; P.scale_w = 0x7a7a7a7a; P.scale_a = 0x7f7f7f7f;
            constexpr int WE = PROJ_F8 ? 1 : 2;
            EpiProj E; E.split_cols = 0; E.split_stride = 0; E.nscale = 0; E.scale = 1.f; E.sig_from = 1 << 30;
            if (kind == 0) { P.Bt = (const bf16*)(ws + WS_WIN + (size_t)L * A_PROJ * DM * WE); P.S.init(NT / 256, A_PROJ / 256, F.G, F.cid); E.O = BIG; E.ldc = A_PROJ; E.nscale = 2; E.scale = 0.125f; E.sig_from = 8; }
            else if (kind == 1) { P.Bt = (const bf16*)(ws + WS_WKV); P.S.init(NT / 256, 8, F.G, F.cid); E.O = Kb; E.ldc = DM; E.split_cols = 1024; E.split_stride = (size_t)NT * DM; }
            else { P.Bt = (const bf16*)(ws + WS_WQ + (size_t)(L - 2) * DM * DM * WE); P.S.init(NT / 256, 4, F.G, F.cid); E.O = Qb; E.ldc = DM; E.nscale = 4; E.scale = attn_body::C2; }
            P.local = chain ? 1 : 0; P.lw = (int)blockIdx.x;
            REPEAT(REP_PROJ) pg8::gemm_phase<EpiProj, DenseProb, true, PROJ_F8>(F.lds + RING_OFF, F.wave, P, E);
#endif
          } PH_END(run); }
        if (kind == 1) continue;
        bf16* const CTS = ACT; float* const NS = (float*)(ws + WS_ACT + (size_t)128 * MiB); float* const MS = NS + (size_t)NB * 8 * 64 * 64; float* const SCN = MS + NB * 8 * 64;
        if (kind == 0) { PH_BEGIN(run, 3) if (run) {
#ifndef DIS_CELL
            REPEAT(REP_CELL) cellA_phase(F, BIG, G16, CTS, NS, MS, SCN);
#endif
          } PH_END(run); }
        { PH_BEGIN(run, (kind == 0 ? 4 : 10)) if (run) {
#ifndef DIS_CELL
            if (kind == 0) REPEAT(REP_CELLB) cellB_phase(F, BIG, G16, args.in[I_AMH] + L * DM, CTS, NS, MS, SCN, HB, chain ? 1 : 0);
#endif
#ifndef DIS_ATTN
            if (kind == 2) REPEAT(REP_ATTN) { const attn_body::AttnTensors AT{(const attn_body::bf16*)Qb, (const attn_body::bf16*)Kb, (const attn_body::bf16*)Vb, (attn_body::bf16*)(rep_ + 1 < REP_ATTN ? ACT : (OUT_F8 ? HB : Qb)), FB};
                   if (rep_ + 1 < REP_ATTN) attn_body::attn_phase<60, (REP_ATTN_NOFB != 0)>((char*)lds + RING_OFF, AT, F.vcu, F.G, F.wave); else attn_body::attn_phase<60>((char*)lds + RING_OFF, AT, F.vcu, F.G, F.wave); }
#endif
          } if (kind == 0) PH_END_CHAIN(run); else PH_END(run); }
        { PH_BEGIN(run, 5) if (run) {
#ifndef DIS_OUT
            DenseProb P; P.A = (kind == 0 || OUT_F8) ? HB : Qb; P.lda = DM; P.ldb = DM; P.K = DM; P.esz = OUT_F8 ? 1 : 2; P.scale_w = 0x7a7a7a7a; P.scale_a = 0x7f7f7f7f;
            P.Bt = kind == 0 ? (const bf16*)(ws + WS_WOUT + (size_t)L * DM * DM * (OUT_F8 ? 1 : 2)) : (const bf16*)(ws + WS_WO + (size_t)(L - 2) * DM * DM * (OUT_F8 ? 1 : 2));
            P.S.init(NT / 256, 4, F.G, F.cid); P.local = chain ? 1 : 0; P.lw = (int)blockIdx.x;
            EpiRes E; E.base = xin; E.base_bf = xin_bf; E.out = X; E.gate = mods + 2048; E.gstride = 6144;
            pg8::gemm_phase<EpiRes, DenseProb, true, OUT_F8>(F.lds + RING_OFF, F.wave, P, E);
#endif
          } PH_END_CHAIN(run); }
        gu32* const gcnt = (gu32*)(ws + WS_CTL) + CW_CNT + L * 32;
        { PH_BEGIN(run, 6) if (run) {
#ifndef DIS_NORM2
            REPEAT(REP_NORM2N) norm_phase<false>(F, X, 1, args.in[I_NFFN] + L * DM, mods + 3072, mods + 4096, 6144, ACT, 0, nullptr, 0, nullptr, nullptr, nullptr, nullptr, nullptr);
            normT_phase<true>(F, X, 1, args.in[I_NFFN] + L * DM, mods + 3072, mods + 4096, 6144, HB, 3, args.in[I_WR], 16, args.in[I_RB], nullptr, WTS, PERM, gcnt);
#endif
          } PH_END(run); }
        const ClassTab CT{(const LAS int*)(F.lds + TAB_OFF), (const LAS int*)(F.lds + TAB_OFF) + 32};
        { PH_BEGIN(run, 7) if (run) {
#ifndef DIS_MOE1
            build_class_tab(F, gcnt);
            Moe1Prob P; P.A = HB; P.ldb = DM; P.K = DM; P.esz = MOE1_F8 ? 1 : 2; P.scale_w = 0x7a7a7a7a; P.scale_a = 0x7f7f7f7f;
            P.Bt1l = (const bf16*)(ws + WS_BT1 + (size_t)L * 16 * 1024 * DM * (MOE1_F8 ? 1 : 2)); P.perm = PERM; P.T = CT;
            P.S.init(CT.blkstart[NCLS], 8, F.G, F.cid);
            EpiAct E; E.act = ACT; E.perm = PERM; E.wts = WTS; E.T = CT;
            REPEAT(REP_MOE1) { P.dense_dbg = (rep_ + 1 < REP_MOE1) ? REP_MOE1_DENSE : 0; pg8::gemm_phase<EpiAct, Moe1Prob, true, MOE1_F8>(F.lds + RING_OFF, F.wave, P, E); }
#endif
          } PH_END(run); }
        { PH_BEGIN(run, 8) if (run) {
#ifndef DIS_MOE2
            build_class_tab(F, gcnt);
            Moe2Prob P; P.A = ACT; P.ldb = DE; P.K = DM; P.esz = MOE2_F8 ? 1 : 2; P.scale_w = 0x7a7a7a7a; P.scale_a = 0x7d7d7d7d; P.Bt2l = (const bf16*)(ws + WS_BT2 + (size_t)L * 16 * DM * DE * (MOE2_F8 ? 1 : 2)); P.T = CT;
            P.S.init(CT.blkstart[NCLS], 4, F.G, F.cid);
            EpiResScatter E; E.x = X; E.gate = mods + 5120; E.gstride = 6144; E.perm = PERM; E.T = CT;
            P.halfmode = 0; pg8::gemm_phase<EpiResScatter, Moe2Prob, true, MOE2_F8>(F.lds + RING_OFF, F.wave, P, E);
            P.halfmode = 1; pg8::gemm_phase<EpiResScatter, Moe2Prob, true, MOE2_F8, true>(F.lds + RING_OFF, F.wave, P, E);
#endif
          } PH_END(run); }
    }
    { PH_BEGIN(run, 9) if (run) {
#ifndef DIS_FINAL
 final_norm_phase(F, X, args.out, args.in[I_NFIN], (const float*)(args.ws + WS_FIN), (const float*)(args.ws + WS_FIN) + 1024, 2048);
#endif
 } }
#ifdef PROBE_TYPE
    if (pr_me) { const unsigned long long t = __builtin_amdgcn_s_memrealtime(); const unsigned long long pr_acc = ((unsigned long long)F.MISC[19] << 32) | F.MISC[18]; while (__builtin_amdgcn_s_memrealtime() - t < 2 * pr_acc) __builtin_amdgcn_s_sleep(8); }
#endif
#undef PH_BEGIN
#undef PH_END
}
constexpr int N_PHASES = 1 + 2 * 8 + 2 + 2 * 7 + 1;

#ifndef MK_SPLIT
#define MK_SPLIT 0
#endif
extern "C" void kernel_launch(void* const* d_in, const int* in_sizes, int n_in, void* d_out, int out_size, void* d_ws, size_t ws_size, hipStream_t stream) {
    static int grid = 0;
    if (grid == 0) {
        if (n_in != 25 || in_sizes[0] != NT * DM || out_size != NT * DM || ws_size < WS_END) { fprintf(stderr, "kernel_launch: unexpected shapes (n_in %d, in0 %d, out %d, ws %zu); nothing launched\n", n_in, n_in > 0 ? in_sizes[0] : -1, out_size, ws_size); grid = -1; return; }
        int dev = 0, cus = 0, per_cu = 0;
        if (hipGetDevice(&dev) != hipSuccess || hipDeviceGetAttribute(&cus, hipDeviceAttributeMultiprocessorCount, dev) != hipSuccess) { grid = -1; return; }
        if (hipFuncSetAttribute((const void*)mk_fwd, hipFuncAttributeMaxDynamicSharedMemorySize, LDS_BYTES) != hipSuccess) { fprintf(stderr, "kernel_launch: hipFuncSetAttribute failed\n"); grid = -1; return; }
        if (hipOccupancyMaxActiveBlocksPerMultiprocessor(&per_cu, (const void*)mk_fwd, NWAVES * 64, LDS_BYTES) != hipSuccess || per_cu < 1) { fprintf(stderr, "kernel_launch: occupancy query reports %d workgroups per CU\n", per_cu); }
        (void)hipGetLastError();
        grid = cus;
    }
    if (grid < 0) return;
    if (hipMemsetAsync((char*)d_ws + WS_CTL, 0, CTL_ZERO_BYTES, stream) != hipSuccess) return;
    Args a{};
    for (int i = 0; i < 25; ++i) a.in[i] = (const float*)d_in[i];
    a.out = (float*)d_out; a.ws = (unsigned char*)d_ws;
#if MK_SPLIT
    for (int p = 0; p < N_PHASES; ++p) { a.ph_lo = p; a.ph_hi = p + 1; hipLaunchKernelGGL(mk_fwd, dim3(grid), dim3(NWAVES * 64), LDS_BYTES, stream, a); }
#else
    a.ph_lo = 0; a.ph_hi = N_PHASES;
    hipLaunchKernelGGL(mk_fwd, dim3(grid), dim3(NWAVES * 64), LDS_BYTES, stream, a);
#endif
}
```

```cpp
#include <hip/hip_runtime.h>
#include <hip/hip_bf16.h>
#include <cstdio>
#include <cstdint>
#ifndef PG8_WGM
#define PG8_WGM 8
#endif
#ifndef OUT_F8
#define OUT_F8 true
#endif
#define LAS __attribute__((address_space(3)))
#define GAS __attribute__((address_space(1)))
__device__ __forceinline__ int hw_tid_(int wave0) { unsigned z = 0u; asm volatile("" : "+s"(z)); return wave0 * 64 + (int)__builtin_amdgcn_mbcnt_hi(~0u, __builtin_amdgcn_mbcnt_lo(~0u, z)); }
#define HW_TID(wave0) hw_tid_(wave0)

namespace pg8 {
typedef unsigned short bf16_t;
typedef short bf16x8 __attribute__((ext_vector_type(8)));
typedef float f32x4 __attribute__((ext_vector_type(4)));
typedef unsigned u32x4 __attribute__((ext_vector_type(4)));
typedef unsigned u32x2 __attribute__((ext_vector_type(2)));
constexpr int BM = 256, BK = 64, HALF = 128, HTB = HALF * BK * 2  , STAGE_BYTES = 8 * HTB, NXCD = 8, WGM = PG8_WGM;

__host__ __device__ __forceinline__ int lds_byte(int r, int c) { const int st = (r >> 4) * 2 + (c >> 5), rr = r & 15, cc = c & 31, ob = rr * 64 + cc * 2; return st * 1024 + (ob ^ (((ob >> 9) & 1) << 5)); }
__host__ __device__ __forceinline__ void stage_rc(int b, int& R, int& C) { const int st = b / 1024, sb = b % 1024, swz = sb ^ (((sb >> 9) & 1) << 5); R = (st >> 1) * 16 + swz / 64; C = (st & 1) * 32 + (swz % 64) / 2; }
__host__ __device__ __forceinline__ int perm32(int rho) { const int n = rho >> 4, i = rho & 15; return 8 * (i >> 2) + 4 * n + (i & 3); }

struct Unit { int pm, pn, cls, lb, hf, r0; };

struct StaticOrder {
    int nM, nN, nwg, G, c;
    __device__ __forceinline__ void init(int nM_, int nN_, int G_, int c_) { nM = nM_; nN = nN_; nwg = nM * nN; G = G_; c = c_; }
    __device__ __forceinline__ bool next(int i, Unit& u) const { return next_L((long)i * G + c, u); }
    __device__ __forceinline__ bool next_L(long L, Unit& u) const {
        if (L >= nwg) return false;
        int wgid = (int)L; { const int q = nwg / NXCD, r = nwg % NXCD, xcd = wgid % NXCD, off = wgid / NXCD; wgid = (xcd < r ? xcd * (q + 1) : r * (q + 1) + (xcd - r) * q) + off; }
        const int nig = WGM * nN, gid = wgid / nig, fm = gid * WGM, gsz = (nM - fm) < WGM ? (nM - fm) : WGM;
        u.pm = fm + ((wgid % nig) % gsz); u.pn = (wgid % nig) / gsz; u.cls = 0; u.lb = 0; u.hf = 0; u.r0 = 0; return true;
    }
};

__device__ __forceinline__ unsigned cvt_pk_bf16(float lo, float hi) { unsigned r; asm volatile("v_cvt_pk_bf16_f32 %0, %1, %2" : "=v"(r) : "v"(lo), "v"(hi)); return r; }
__device__ __forceinline__ float sigmoidf_(float x) { return __builtin_amdgcn_rcpf(1.0f + __expf(-x)); }
typedef int v4i_t __attribute__((ext_vector_type(4)));
typedef int v8i_t __attribute__((ext_vector_type(8)));
__device__ __forceinline__ v8i_t cat8(bf16x8 lo, bf16x8 hi) { const v4i_t a = __builtin_bit_cast(v4i_t, lo), b = __builtin_bit_cast(v4i_t, hi); return __builtin_shufflevector(a, b, 0, 1, 2, 3, 4, 5, 6, 7); }

template <class Epi, class Prob, bool ALIGN_EPI, bool F8 = false, bool HALFN = false>
__device__ __forceinline__ void gemm_phase(LAS unsigned char* lds, const int wave0, const Prob& S, const Epi& E) {
    int tid_ = HW_TID(wave0); asm volatile("" : "+v"(tid_));
    const int tid = tid_, wid = __builtin_amdgcn_readfirstlane(tid >> 6), lane = tid & 63, wr = wid >> 2, wc = wid & 3, fr = lane & 15, fq = lane >> 4;
    constexpr int ESZ = F8 ? 1 : 2;
    const int K = S.K, nt = K / (F8 ? 2 * BK : BK);
    int R0, C0; stage_rc(tid * 16, R0, C0);
    const int Rb0 = Epi::PERM ? ((R0 & ~31) + perm32(R0 & 31)) : R0;
    unsigned voffB[2]; voffB[0] = (unsigned)(Rb0 * S.ldb) * ESZ + (unsigned)C0 * 2u; voffB[1] = (unsigned)((Rb0 + 64) * S.ldb) * ESZ + (unsigned)C0 * 2u;
    const size_t hstepB = (size_t)HALF * S.ldb * ESZ;
    const unsigned ldsw = (unsigned)wid * 1024u;
    const int aoff_l = lds_byte(wr * 64 + fr, F8 ? fq * 16 : fq * 8), boff_l = lds_byte(wc * 32 + fr, F8 ? fq * 16 : fq * 8);
    const int aoff_h = F8 ? lds_byte(wr * 64 + fr, fq * 16 + 8) : aoff_l + 1024, boff_h = F8 ? lds_byte(wc * 32 + fr, fq * 16 + 8) : boff_l + 1024;
    const int sc_w = S.scale_w, sc_a = S.scale_a;
    const char* const Ab = S.a_base();
#define PG8_SA(b, h) (((b) * 2 + (h)) * HTB)
#define PG8_SB(b, h) ((4 + (b) * 2 + (h)) * HTB)
#define PG8_STA(bufoff, h, tt) do { _Pragma("unroll") for (int _i = 0; _i < 2; ++_i) \
        __builtin_amdgcn_global_load_lds((const unsigned*)(Ab + (size_t)aoff[h][_i] + (size_t)(tt) * (BK * 2)), (LAS unsigned*)(lds + (bufoff) + ldsw + _i * 8192), 16, 0, 0); } while (0)
#define PG8_STB(bufoff, bp, h) do { _Pragma("unroll") for (int _i = 0; _i < 2; ++_i) \
        __builtin_amdgcn_global_load_lds((const unsigned*)((bp) + (h) * hstepB + voffB[_i]), (LAS unsigned*)(lds + (bufoff) + ldsw + _i * 8192), 16, 0, 0); } while (0)
#define PG8_LDA(dst, b, h) do { _Pragma("unroll") for (int m = 0; m < 4; ++m) _Pragma("unroll") for (int k = 0; k < 2; ++k) dst[m][k] = *(const LAS bf16x8*)(lds + PG8_SA(b, h) + (k ? aoff_h : aoff_l) + m * 2048); } while (0)
#define PG8_LDB(dst, b, h) do { _Pragma("unroll") for (int n = 0; n < 2; ++n) _Pragma("unroll") for (int k = 0; k < 2; ++k) dst[n][k] = *(const LAS bf16x8*)(lds + PG8_SB(b, h) + (k ? boff_h : boff_l) + n * 2048); } while (0)
#define PG8_MMA(ai, bj, At, Bt) do { __builtin_amdgcn_s_setprio(1); _Pragma("unroll") for (int m = 0; m < 4; ++m) _Pragma("unroll") for (int n = 0; n < 2; ++n) { \
        if constexpr (F8) acc[ai][bj][m][n] = __builtin_amdgcn_mfma_scale_f32_16x16x128_f8f6f4(cat8(Bt[n][0], Bt[n][1]), cat8(At[m][0], At[m][1]), acc[ai][bj][m][n], 0, 0, 0, sc_w, 0, sc_a); \
        else { _Pragma("unroll") for (int k = 0; k < 2; ++k) acc[ai][bj][m][n] = __builtin_amdgcn_mfma_f32_16x16x32_bf16(Bt[n][k], At[m][k], acc[ai][bj][m][n], 0, 0, 0); } } __builtin_amdgcn_s_setprio(0); } while (0)
#define PG8_WAIT_V(n) asm volatile("s_waitcnt vmcnt(" #n ")" ::: "memory")
#define PG8_WAIT_L(n) asm volatile("s_waitcnt lgkmcnt(" #n ")" ::: "memory")
#define PG8_BAR __builtin_amdgcn_s_barrier()
#define PG8_SCHED __builtin_amdgcn_sched_barrier(0)
    Unit cur, nxt; int ui = 0;
    if (!S.next(0, cur)) return;
    f32x4 acc[2][2][4][2];
#pragma unroll
    for (int a = 0; a < 2; ++a)
#pragma unroll
        for (int b = 0; b < 2; ++b)
#pragma unroll
            for (int m = 0; m < 4; ++m)
#pragma unroll
                for (int n = 0; n < 2; ++n) acc[a][b][m][n] = (f32x4){0.f, 0.f, 0.f, 0.f};
    bf16x8 At[4][2], B0[2][2], B1[2][2];
    unsigned aoff[2][2], aoffN[2][2];
    S.a_off(cur, R0, C0, aoff);
    { const char* bp0 = S.b_tile(cur, 0); const char* bp1 = S.b_tile(cur, 1);
      PG8_STB(PG8_SB(0, 0), bp0, 0); PG8_STB(PG8_SB(0, 1), bp0, 1); PG8_STA(PG8_SA(0, 0), 0, 0); PG8_STA(PG8_SA(0, 1), 1, 0);
      if (wr == 1) PG8_BAR;
      PG8_WAIT_V(2); PG8_BAR;
      PG8_STB(PG8_SB(1, 0), bp1, 0); PG8_STA(PG8_SA(1, 0), 0, 1); PG8_STB(PG8_SB(1, 1), bp1, 1);
      PG8_WAIT_V(6); PG8_BAR; }
    for (;;) {
        const bool has_next = S.next(ui + 1, nxt);
        if (has_next) S.a_off(nxt, R0, C0, aoffN); else { aoffN[0][0] = aoff[0][0]; aoffN[0][1] = aoff[0][1]; aoffN[1][0] = aoff[1][0]; aoffN[1][1] = aoff[1][1]; }
        for (int t = 0; t < nt; t += 2) {
            const bool last = (t == nt - 2);
            PG8_LDB(B0, 0, 0); PG8_LDB(B1, 0, 1); PG8_SCHED; PG8_LDA(At, 0, 0); PG8_STA(PG8_SA(1, 1), 1, t + 1);
            PG8_WAIT_V(8); PG8_WAIT_L(0); PG8_BAR; PG8_MMA(0, 0, At, B0); if constexpr (!HALFN) PG8_MMA(0, 1, At, B1); PG8_BAR; PG8_SCHED;
            const int t2 = last ? 0 : t + 2;
            const Unit& u2 = (last && has_next) ? nxt : cur;
            if (last) { aoff[0][0] = aoffN[0][0]; aoff[0][1] = aoffN[0][1]; aoff[1][0] = aoffN[1][0]; aoff[1][1] = aoffN[1][1]; }
            const char* b2 = S.b_tile(u2, t2); const char* b3 = S.b_tile(u2, t2 + 1);
            PG8_LDA(At, 0, 1); PG8_STB(PG8_SB(0, 0), b2, 0); PG8_STB(PG8_SB(0, 1), b2, 1); PG8_STA(PG8_SA(0, 0), 0, t2);
            PG8_WAIT_V(8); PG8_WAIT_L(0); PG8_BAR; PG8_MMA(1, 0, At, B0); if constexpr (!HALFN) PG8_MMA(1, 1, At, B1); PG8_BAR; PG8_SCHED;
            PG8_LDB(B0, 1, 0); PG8_LDB(B1, 1, 1); PG8_SCHED; PG8_LDA(At, 1, 0); PG8_STA(PG8_SA(0, 1), 1, t2);
            PG8_WAIT_V(8); PG8_WAIT_L(0); PG8_BAR; PG8_MMA(0, 0, At, B0); if constexpr (!HALFN) PG8_MMA(0, 1, At, B1); PG8_BAR; PG8_SCHED;
            PG8_LDA(At, 1, 1); PG8_STB(PG8_SB(1, 0), b3, 0); PG8_STB(PG8_SB(1, 1), b3, 1); PG8_STA(PG8_SA(1, 0), 0, t2 + 1);
            PG8_WAIT_V(8); PG8_WAIT_L(0); PG8_BAR; PG8_MMA(1, 0, At, B0); if constexpr (!HALFN) PG8_MMA(1, 1, At, B1); PG8_BAR; PG8_SCHED;
        }
        if constexpr (ALIGN_EPI) { if (wr == 0) PG8_BAR; }
        E(acc, cur, wr, wc, fr, fq);
        if (!has_next) break;
#pragma unroll
        for (int a = 0; a < 2; ++a)
#pragma unroll
            for (int b = 0; b < 2; ++b)
#pragma unroll
                for (int m = 0; m < 4; ++m)
#pragma unroll
                    for (int n = 0; n < 2; ++n) acc[a][b][m][n] = (f32x4){0.f, 0.f, 0.f, 0.f};
        cur = nxt; ++ui;
        if constexpr (ALIGN_EPI) { if (wr == 1) PG8_BAR; }
    }
    PG8_WAIT_V(0);
    if constexpr (!ALIGN_EPI) { if (wr == 0) PG8_BAR; }
    PG8_BAR;
#undef PG8_SA
#undef PG8_SB
#undef PG8_STA
#undef PG8_STB
#undef PG8_LDA
#undef PG8_LDB
#undef PG8_MMA
#undef PG8_WAIT_V
#undef PG8_WAIT_L
#undef PG8_BAR
#undef PG8_SCHED
}
}

#include <hip/hip_bf16.h>
#include <cmath>
namespace attn_body {
using bf16=__hip_bfloat16;
using bf16x8=__attribute__((ext_vector_type(8)))short;
using s16x4=__attribute__((ext_vector_type(4)))short;
using f32x16=__attribute__((ext_vector_type(16)))float;
using u32x4=__attribute__((ext_vector_type(4)))unsigned;
constexpr int BATCH=16,NHEAD=16,SEQ=4096,D=64,DM=NHEAD*D;
constexpr int NW=8,QBLK=32,QB=QBLK*NW,KVBLK=64,NQB=SEQ/QB;
constexpr int ATTN_PITCH=DM, ATTN_UNIT_ROWS=QB;
__device__ __forceinline__ int crow(int r,int hi){return (r&3)+8*(r>>2)+4*hi;}
#define SBAR() __builtin_amdgcn_sched_barrier(0)
__device__ __forceinline__ void cmask(f32x16&p0,f32x16&p1,int jb,int qrel,int hi){
  const float NEG=-INFINITY; int kb=64*jb+4*hi;
  #pragma unroll
  for(int r=0;r<16;++r){int kv=kb+(r&3)+8*(r>>2); if(kv>qrel)p0[r]=NEG; if(kv+32>qrel)p1[r]=NEG;}
}

constexpr int NSLOT=3, SLOTB=8192;
constexpr int LDS_K=0, LDS_V=NSLOT*SLOTB, LDS_WS=2*NSLOT*SLOTB, LDS_OST=LDS_WS+NW*64*4, LDS_BYTES=LDS_OST+NW*4096;
constexpr float C2=0.125f*1.4426950408889634f;
__device__ __forceinline__ void glds16(const void*gsrc,unsigned lds_dst){unsigned keep;
  asm volatile("s_mov_b32 %0, m0\n\ts_mov_b32 m0, %2\n\ts_nop 0\n\tglobal_load_lds_dwordx4 %1, off\n\ts_mov_b32 m0, %0":"=&s"(keep):"v"(gsrc),"s"(lds_dst):"memory");}
__device__ __forceinline__ float max3f(float a,float b,float c){float r;asm("v_max3_f32 %0, %1, %2, %3":"=v"(r):"v"(a),"v"(b),"v"(c));return r;}
__device__ __forceinline__ float max2f(float a,float b){float r;asm("v_max_f32_e32 %0, %1, %2":"=v"(r):"v"(a),"v"(b));return r;}
__device__ __forceinline__ float fadd_s(float a,float b){float r;asm("v_add_f32_e32 %0, %1, %2":"=v"(r):"v"(a),"v"(b));return r;}
__device__ __forceinline__ float fsub_s(float a,float b){float r;asm("v_sub_f32_e32 %0, %1, %2":"=v"(r):"v"(a),"v"(b));return r;}
typedef float f32x2_t __attribute__((ext_vector_type(2))); typedef __bf16 bf16x2_t __attribute__((ext_vector_type(2)));
__device__ __forceinline__ unsigned cvtpk_s(float lo,float hi){f32x2_t v={lo,hi};bf16x2_t b=__builtin_convertvector(v,bf16x2_t);return __builtin_bit_cast(unsigned,b);}
#define WAIT_BAR(N) asm volatile("s_waitcnt vmcnt(" #N ") lgkmcnt(0)\n\ts_barrier":::"memory")

__device__ __forceinline__ void qkt(f32x16&p0,f32x16&p1,const char*Kslot,const bf16x8*qr,const f32x16&c0,const f32x16&c1,int r32,int hi){
  const char*kb=Kslot+hi*1024+r32*16;
  #pragma unroll
  for(int d0=0;d0<4;++d0){
    const bf16x8 b0=*reinterpret_cast<const bf16x8*>(kb+d0*2048);
    const bf16x8 b1=*reinterpret_cast<const bf16x8*>(kb+d0*2048+512);
    if(d0==0){p0=__builtin_amdgcn_mfma_f32_32x32x16_bf16(b0,qr[0],c0,0,0,0);p1=__builtin_amdgcn_mfma_f32_32x32x16_bf16(b1,qr[0],c1,0,0,0);}
    else{p0=__builtin_amdgcn_mfma_f32_32x32x16_bf16(b0,qr[d0],p0,0,0,0);p1=__builtin_amdgcn_mfma_f32_32x32x16_bf16(b1,qr[d0],p1,0,0,0);}}
}
typedef __attribute__((address_space(3))) const char* lds_cptr;
typedef short v4i16_t __attribute__((ext_vector_type(4)));
__device__ __forceinline__ void kload8(bf16x8*kf,lds_cptr kp){
  kf[0]=*(const __attribute__((address_space(3))) bf16x8*)(kp);      kf[1]=*(const __attribute__((address_space(3))) bf16x8*)(kp+512);
  kf[2]=*(const __attribute__((address_space(3))) bf16x8*)(kp+2048); kf[3]=*(const __attribute__((address_space(3))) bf16x8*)(kp+2560);
  kf[4]=*(const __attribute__((address_space(3))) bf16x8*)(kp+4096); kf[5]=*(const __attribute__((address_space(3))) bf16x8*)(kp+4608);
  kf[6]=*(const __attribute__((address_space(3))) bf16x8*)(kp+6144); kf[7]=*(const __attribute__((address_space(3))) bf16x8*)(kp+6656);
}
__device__ __forceinline__ void kload2(bf16x8*kf,lds_cptr kp,int j){ kf[2*j]=*(const __attribute__((address_space(3))) bf16x8*)(kp+j*2048); kf[2*j+1]=*(const __attribute__((address_space(3))) bf16x8*)(kp+j*2048+512); }
__device__ __forceinline__ s16x4 vtr(lds_cptr p){ return __builtin_bit_cast(s16x4,__builtin_amdgcn_ds_read_tr16_b64_v4i16((__attribute__((address_space(3))) v4i16_t*)p)); }
__device__ __forceinline__ float rowmax(const f32x16&p0,const f32x16&p1){
  float a=max3f(p0[0],p0[1],p1[0]),b=max3f(p0[2],p0[3],p1[1]);a=max3f(a,p1[2],p1[3]);
  #pragma unroll
  for(int r=4;r<16;r+=4){a=max3f(a,p0[r],p0[r+1]);b=max3f(b,p0[r+2],p0[r+3]);a=max3f(a,p1[r],p1[r+1]);b=max3f(b,p1[r+2],p1[r+3]);}
  const float m=max2f(a,b);
  auto rr=__builtin_amdgcn_permlane32_swap(__float_as_uint(m),__float_as_uint(m),false,false);
  return max2f(__uint_as_float(rr[0]),__uint_as_float(rr[1]));
}
__device__ __forceinline__ void pv(f32x16*o,int vb,bf16x8 pa0,bf16x8 pa1,bf16x8 pa2,bf16x8 pa3){
  #pragma unroll
  for(int d0=0;d0<2;++d0){s16x4 lo[4],hi[4];
    #pragma unroll
    for(int ks=0;ks<4;++ks){
      asm volatile("ds_read_b64_tr_b16 %0,%1 offset:%c2":"=&v"(lo[ks]):"v"(vb),"i"(d0*4096+ks*1024):"memory");
      asm volatile("ds_read_b64_tr_b16 %0,%1 offset:%c2":"=&v"(hi[ks]):"v"(vb),"i"(d0*4096+ks*1024+512):"memory");}
    asm volatile("s_waitcnt lgkmcnt(0)":::"memory");SBAR();
    #define PK(k) (bf16x8){lo[k][0],lo[k][1],lo[k][2],lo[k][3],hi[k][0],hi[k][1],hi[k][2],hi[k][3]}
    o[d0]=__builtin_amdgcn_mfma_f32_32x32x16_bf16(pa0,PK(0),o[d0],0,0,0);
    o[d0]=__builtin_amdgcn_mfma_f32_32x32x16_bf16(pa1,PK(1),o[d0],0,0,0);
    o[d0]=__builtin_amdgcn_mfma_f32_32x32x16_bf16(pa2,PK(2),o[d0],0,0,0);
    o[d0]=__builtin_amdgcn_mfma_f32_32x32x16_bf16(pa3,PK(3),o[d0],0,0,0);
    #undef PK
  }
}

#ifndef ATTN_STORE16
#define ATTN_STORE16(p,v) (*(u32x4*)(p)=(v))
#endif
typedef float f32x4_t __attribute__((ext_vector_type(4)));
typedef __attribute__((address_space(3))) const float* fb_lptr;
__device__ __forceinline__ int f8pk(float a,float b,int old,bool hi){a=__builtin_amdgcn_fmed3f(a,-448.f,448.f);b=__builtin_amdgcn_fmed3f(b,-448.f,448.f);return hi?__builtin_amdgcn_cvt_pk_fp8_f32(a,b,old,true):__builtin_amdgcn_cvt_pk_fp8_f32(a,b,old,false);}
template<int THRL,bool NOFB> __device__ __forceinline__ void attn_unit(int b,int h,int qb,const bf16*Q,const bf16*__restrict__ K,const bf16*__restrict__ V,bf16*O,char*shm,fb_lptr fbl,const int wave0){
  int tid_=HW_TID(wave0); asm volatile("":"+v"(tid_)); const int tid=tid_,lane=tid&63,r32=lane&31,hi=lane>>5; const int wid=__builtin_amdgcn_readfirstlane(tid>>6);
  const long rowbase=(long)b*SEQ; const int q0=qb*QB;
  const bf16*Qw=Q+(rowbase+q0+wid*QBLK)*DM+h*D;
  const bf16*Kh=K+rowbase*DM+h*D,*Vh=V+rowbase*DM+h*D;
  const unsigned lds0=(unsigned)(uintptr_t)shm;
  float*wsf=(float*)(shm+LDS_WS)+wid*64;
  const bf16*ksrc=Kh+(long)lane*DM+wid*8;
  const bf16*vsrc=Vh+(long)(16*(wid&3)+(lane>>2))*DM+(wid>>2)*32+(lane&3)*8;
  const unsigned kdst=lds0+LDS_K+wid*1024, vdst=lds0+LDS_V+wid*1024;
  #define DMA_K(t,slot) glds16(ksrc+(long)(t)*KVBLK*DM,(unsigned)__builtin_amdgcn_readfirstlane(kdst+(slot)))
  #define DMA_V(t,slot) glds16(vsrc+(long)(t)*KVBLK*DM,(unsigned)__builtin_amdgcn_readfirstlane(vdst+(slot)))
  const int vb0=(int)(lds0+LDS_V)+((lane>>4)&1)*32+(lane&3)*8+(4*hi+((lane&15)>>2))*64;
  const char*Kbase=shm+LDS_K; bf16x8 kf[8];
  const lds_cptr shm3=(lds_cptr)shm; const lds_cptr kp0=shm3+LDS_K+hi*1024+r32*16; const lds_cptr vp0=shm3+LDS_V+((lane>>4)&1)*32+(lane&3)*8+(4*hi+((lane&15)>>2))*64;
  const int NT=(q0+QB)/KVBLK;
  DMA_K(0,0);DMA_V(0,0);DMA_K(1,SLOTB);
  bf16x8 qr[4];
  #pragma unroll
  for(int d0=0;d0<4;++d0)qr[d0]=*reinterpret_cast<const bf16x8*>(&Qw[(long)r32*DM+d0*16+hi*8]);
  #define FBIAS(C0,C1,t) do{ const fb_lptr fp_=fbl+64*(t)+4*hi; const float nm_=-mhat; \
    _Pragma("unroll") for(int g_=0;g_<4;++g_){ const f32x4_t a_=*(const __attribute__((address_space(3))) f32x4_t*)(fp_+8*g_); const f32x4_t b_=*(const __attribute__((address_space(3))) f32x4_t*)(fp_+32+8*g_); \
      _Pragma("unroll") for(int i_=0;i_<4;++i_){ C0[4*g_+i_]=a_[i_]+nm_; C1[4*g_+i_]=b_[i_]+nm_; } SBAR(); } }while(0)
  #define FBLOAD(X0,X1,tt,G) do{ if((G)&&!NOFB){ const fb_lptr fp_=fbl+64*(tt)+4*hi; \
    _Pragma("unroll") for(int g_=0;g_<4;++g_){ const f32x4_t a_=*(const __attribute__((address_space(3))) f32x4_t*)(fp_+8*g_); const f32x4_t b_=*(const __attribute__((address_space(3))) f32x4_t*)(fp_+32+8*g_); \
      _Pragma("unroll") for(int i_=0;i_<4;++i_){ X0[4*g_+i_]=a_[i_]; X1[4*g_+i_]=b_[i_]; } } } }while(0)
  #define FBADD(X0,X1,G) do{ if((G)&&!NOFB){ const f32x2_t nm_={-mhat,-mhat}; _Pragma("unroll") for(int r_=0;r_<16;r_+=2){ f32x2_t a_={X0[r_],X0[r_+1]},b_={X1[r_],X1[r_+1]}; a_=a_+nm_; b_=b_+nm_; X0[r_]=a_[0];X0[r_+1]=a_[1];X1[r_]=b_[0];X1[r_+1]=b_[1]; } } }while(0)
  float mhat=0.f,l_reg=0.f;f32x16 o[2];o[0]=f32x16{};o[1]=f32x16{};
  const int qrel=wid*QBLK+r32;
  #define CMASK(P0,P1,t) do{int jb_=(t)-(NT-4); if(jb_>=0)cmask(P0,P1,jb_,qrel,hi);}while(0)
  bool resc=false;
  #define START(P0,P1) do{ const float rm=rowmax(P0,P1); resc=false; \
    { const float dl=rm; mhat=fadd_s(mhat,dl); \
      _Pragma("unroll") for(int r=0;r<16;++r){P0[r]=fsub_s(P0[r],dl);P1[r]=fsub_s(P1[r],dl);} \
      } \
    _Pragma("unroll") for(int r=0;r<16;++r)P0[r]=__builtin_amdgcn_exp2f(P0[r]); }while(0)
  #define RESC() do{ if(resc){ asm volatile("s_waitcnt lgkmcnt(0)":::"memory"); \
      _Pragma("unroll") for(int d_=0;d_<2;++d_) _Pragma("unroll") for(int r=0;r<16;++r)o[d_][r]*=wsf[crow(r,hi)]; } }while(0)
  f32x16 pA0,pA1,pB0,pB1;
  int sl_prev=0,sl_cur=0,sl_next=SLOTB;
  #define ROT() do{sl_prev=sl_cur;sl_cur=sl_next;sl_next=(sl_next==(NSLOT-1)*SLOTB)?0:sl_next+SLOTB;}while(0)
  DMA_K(2,2*SLOTB);
  WAIT_BAR(3);
  FBIAS(pA0,pA1,0); qkt(pA0,pA1,Kbase,qr,pA0,pA1,r32,hi);asm volatile("s_nop 15\n\ts_nop 7":"+v"(pA0),"+v"(pA1));CMASK(pA0,pA1,0);
  START(pA0,pA1); FBLOAD(pB0,pB1,1,true); FBADD(pB0,pB1,true);
  _Pragma("unroll") for(int r=0;r<16;++r)pA1[r]=__builtin_amdgcn_exp2f(pA1[r]);
  WAIT_BAR(0);
  DMA_K(3,0);DMA_V(1,SLOTB);
  ROT();
  kload8(kf,kp0+sl_cur);
  WAIT_BAR(2);
  s16x4 vlo[8],vhi[8]; u32x4 pw0,pw1,pw2,pw3;
  #define PKW(P,B) cvtpk_s(P[B],P[B+1])
  #define PAF(k) __builtin_bit_cast(bf16x8,pw##k)
  #define VFR(i) (bf16x8){vlo[i][0],vlo[i][1],vlo[i][2],vlo[i][3],vhi[i][0],vhi[i][1],vhi[i][2],vhi[i][3]}
  #define PIN(x) asm volatile("":"+v"(x))
  #define MX3(a,b,c) __builtin_fmaxf(__builtin_fmaxf((a),(b)),(c))
  #define GAPA(MF,A0,A1,A2,A3,W0,W1,PW) do{ MF; sacc+=A0; sacc+=A1; sacc+=A2; sacc+=A3; PIN(sacc); W0; W1; PIN(PW); SBAR(); }while(0)
  #define EX(v) __builtin_amdgcn_exp2f(v)
  #define GAPB(MF,X,B) do{ MF; X[B]=EX(X[B]); X[B+1]=EX(X[B+1]); X[B+2]=EX(X[B+2]); X[B+3]=EX(X[B+3]); PIN(X); SBAR(); }while(0)
  #define VRD(i) do{ vlo[i]=vtr(vp_+(((i)>>2)*4096+((i)&3)*1024)); vhi[i]=vtr(vp_+(((i)>>2)*4096+((i)&3)*1024+512)); }while(0)
  #define KRD(G,j) do{ if(G){ kload2(kf,kp0+sl_next,j); SBAR(); } }while(0)
  #define STEP(C0,C1,P0,P1,t,GK,GV,GL) do{ SBAR(); \
    const lds_cptr vp_=vp0+sl_prev; \
    VRD(0); SBAR(); float sacc=(P0[0]+P0[1]); \
    GAPA(C0=__builtin_amdgcn_mfma_f32_32x32x16_bf16(kf[0],qr[0],C0,0,0,0), P0[2],P0[3],P0[4],P0[5],     pw0[0]=PKW(P0,0), pw0[1]=PKW(P0,2), pw0); \
    VRD(4); SBAR(); GAPA(C1=__builtin_amdgcn_mfma_f32_32x32x16_bf16(kf[1],qr[0],C1,0,0,0), P0[6],P0[7],P0[8],P0[9],     pw0[2]=PKW(P0,4), pw0[3]=PKW(P0,6), pw0); \
    VRD(1); SBAR(); GAPA(C0=__builtin_amdgcn_mfma_f32_32x32x16_bf16(kf[2],qr[1],C0,0,0,0),   P0[10],P0[11],P0[12],P0[13], pw1[0]=PKW(P0,8), pw1[1]=PKW(P0,10), pw1); \
    VRD(5); SBAR(); GAPA(C1=__builtin_amdgcn_mfma_f32_32x32x16_bf16(kf[3],qr[1],C1,0,0,0),   P0[14],P0[15],P1[0],P1[1],   pw1[2]=PKW(P0,12),pw1[3]=PKW(P0,14), pw1); \
    VRD(2); SBAR(); GAPA(C0=__builtin_amdgcn_mfma_f32_32x32x16_bf16(kf[4],qr[2],C0,0,0,0),   P1[2],P1[3],P1[4],P1[5],     pw2[0]=PKW(P1,0), pw2[1]=PKW(P1,2), pw2); \
    VRD(6); SBAR(); GAPA(C1=__builtin_amdgcn_mfma_f32_32x32x16_bf16(kf[5],qr[2],C1,0,0,0),   P1[6],P1[7],P1[8],P1[9],     pw2[2]=PKW(P1,4), pw2[3]=PKW(P1,6), pw2); \
    VRD(3); SBAR(); GAPA(C0=__builtin_amdgcn_mfma_f32_32x32x16_bf16(kf[6],qr[3],C0,0,0,0),   P1[10],P1[11],P1[12],P1[13], pw3[0]=PKW(P1,8), pw3[1]=PKW(P1,10), pw3); \
    VRD(7); SBAR(); GAPA(C1=__builtin_amdgcn_mfma_f32_32x32x16_bf16(kf[7],qr[3],C1,0,0,0),   P1[14],P1[15],0.f,0.f,       pw3[2]=PKW(P1,12),pw3[3]=PKW(P1,14), pw3); \
    l_reg+=sacc; FBLOAD(P0,P1,(t)+1,GL); \
    if(GK){DMA_K((t)+3,sl_cur);} if(GV){DMA_V((t)+1,sl_next);} \
    CMASK(C0,C1,t); \
    { float a=MX3(C0[0],C0[1],C1[0]),b=MX3(C0[2],C0[3],C1[1]); a=MX3(a,C1[2],C1[3]); \
      _Pragma("unroll") for(int r=4;r<16;r+=4){a=MX3(a,C0[r],C0[r+1]);b=MX3(b,C0[r+2],C0[r+3]);a=MX3(a,C1[r],C1[r+1]);b=MX3(b,C1[r+2],C1[r+3]);} \
      float rm=__builtin_fmaxf(a,b); { auto rr=__builtin_amdgcn_permlane32_swap(__float_as_uint(rm),__float_as_uint(rm),false,false); rm=__builtin_fmaxf(__uint_as_float(rr[0]),__uint_as_float(rr[1])); } \
      resc=false; \
      if(__builtin_expect(__any(rm>(float)THRL),0)){ const float dl=__builtin_fmaxf(rm,0.f); mhat+=dl; \
        _Pragma("unroll") for(int r=0;r<16;++r){C0[r]-=dl;C1[r]-=dl;} \
        const float f=__builtin_amdgcn_exp2f(-dl); l_reg*=f; if(hi==0)wsf[r32]=f; resc=true; } } \
    FBADD(P0,P1,GL); SBAR(); \
    GAPB(o[0]=__builtin_amdgcn_mfma_f32_32x32x16_bf16(PAF(0),VFR(0),o[0],0,0,0), C0,0); \
    GAPB(o[1]=__builtin_amdgcn_mfma_f32_32x32x16_bf16(PAF(0),VFR(4),o[1],0,0,0), C0,4); \
    KRD(GL,0); GAPB(o[0]=__builtin_amdgcn_mfma_f32_32x32x16_bf16(PAF(1),VFR(1),o[0],0,0,0), C0,8); \
    KRD(GL,1); GAPB(o[1]=__builtin_amdgcn_mfma_f32_32x32x16_bf16(PAF(1),VFR(5),o[1],0,0,0), C0,12); \
    KRD(GL,2); GAPB(o[0]=__builtin_amdgcn_mfma_f32_32x32x16_bf16(PAF(2),VFR(2),o[0],0,0,0), C1,0); \
    KRD(GL,3); GAPB(o[1]=__builtin_amdgcn_mfma_f32_32x32x16_bf16(PAF(2),VFR(6),o[1],0,0,0), C1,4); \
    GAPB(o[0]=__builtin_amdgcn_mfma_f32_32x32x16_bf16(PAF(3),VFR(3),o[0],0,0,0), C1,8); \
    GAPB(o[1]=__builtin_amdgcn_mfma_f32_32x32x16_bf16(PAF(3),VFR(7),o[1],0,0,0), C1,12); \
    }while(0)
  int t=1;
  #undef CMASK
  #define CMASK(P0,P1,t) do{}while(0)
  for(;t+5<NT;t+=2){
    STEP(pB0,pB1,pA0,pA1,t,true,true,true);     WAIT_BAR(2); RESC(); ROT();
    STEP(pA0,pA1,pB0,pB1,t+1,true,true,true);   WAIT_BAR(2); RESC(); ROT();
  }
  #undef CMASK
  #define CMASK(P0,P1,t) do{int jb_=(t)-(NT-4); if(jb_>=0)cmask(P0,P1,jb_,qrel,hi);}while(0)
  #define ENDW(tt) do{ if((tt)+3<NT){WAIT_BAR(2);} else if((tt)+2<NT){WAIT_BAR(1);} else {WAIT_BAR(0);} }while(0)
  for(;t+1<NT;t+=2){
    STEP(pB0,pB1,pA0,pA1,t,(t+3<NT),(t+1<NT),(t+1<NT));       ENDW(t);   RESC(); ROT();
    STEP(pA0,pA1,pB0,pB1,t+1,(t+4<NT),(t+2<NT),(t+2<NT));     ENDW(t+1); RESC(); ROT();
  }
  STEP(pB0,pB1,pA0,pA1,NT-1,false,false,false); RESC();
  { float sacc=pB0[0]+pB0[1]; _Pragma("unroll") for(int r=2;r<16;++r)sacc+=pB0[r]; _Pragma("unroll") for(int r=0;r<16;++r)sacc+=pB1[r]; l_reg+=sacc;
    pw0=(u32x4){PKW(pB0,0),PKW(pB0,2),PKW(pB0,4),PKW(pB0,6)};pw1=(u32x4){PKW(pB0,8),PKW(pB0,10),PKW(pB0,12),PKW(pB0,14)};pw2=(u32x4){PKW(pB1,0),PKW(pB1,2),PKW(pB1,4),PKW(pB1,6)};pw3=(u32x4){PKW(pB1,8),PKW(pB1,10),PKW(pB1,12),PKW(pB1,14)};
    SBAR(); pv(o,vb0+sl_cur,PAF(0),PAF(1),PAF(2),PAF(3)); }
  #undef PKW
  #undef PAF
  #undef VFR
  #undef PIN
  #undef MX3
  #undef GAPA
  #undef GAPB
  #undef EX
  #undef VRD
  #undef KRD
  #undef STEP
  #undef ENDW
  {auto rr=__builtin_amdgcn_permlane32_swap(__float_as_uint(l_reg),__float_as_uint(l_reg),false,false);l_reg=__uint_as_float(rr[0])+__uint_as_float(rr[1]);}
  if(hi==0)wsf[32+r32]=l_reg;asm volatile("s_waitcnt lgkmcnt(0)":::"memory");
  float rli[16];
  #pragma unroll
  for(int r=0;r<16;++r)rli[r]=__builtin_amdgcn_rcpf(wsf[32+crow(r,hi)]);
  bf16*Ow=O+(rowbase+q0+wid*QBLK)*DM+h*D;
  { bf16*stg=(bf16*)(shm+LDS_OST)+wid*2048;
    #pragma unroll
    for(int r=0;r<16;++r){const int orow=crow(r,hi);
      #pragma unroll
      for(int d0=0;d0<2;++d0)stg[orow*64+d0*32+r32]=__float2bfloat16(o[d0][r]*rli[r]);}
    asm volatile("s_waitcnt lgkmcnt(0)":::"memory");
    #pragma unroll
    for(int i=0;i<4;++i){const int row=i*8+(lane>>3),ch=lane&7; const u32x4 v=*(const u32x4*)(stg+row*64+ch*8);
      if(OUT_F8){ int w0=0,w1=0; w0=f8pk(__uint_as_float(v.x<<16),__uint_as_float(v.x&0xffff0000u),w0,false); w0=f8pk(__uint_as_float(v.y<<16),__uint_as_float(v.y&0xffff0000u),w0,true);
        w1=f8pk(__uint_as_float(v.z<<16),__uint_as_float(v.z&0xffff0000u),w1,false); w1=f8pk(__uint_as_float(v.w<<16),__uint_as_float(v.w&0xffff0000u),w1,true);
        unsigned long long pk=((unsigned long long)(unsigned)w1<<32)|(unsigned)w0; *(unsigned long long*)((unsigned char*)O+((rowbase+q0+wid*QBLK+row)*DM+h*D+ch*8))=pk; }
      else ATTN_STORE16(Ow+(long)row*DM+ch*8,v);} }
  asm volatile("s_waitcnt lgkmcnt(0)\n\ts_barrier":::"memory");
  #undef DMA_K
  #undef DMA_V
  #undef CMASK
  #undef START
  #undef RESC
  #undef FBIAS
  #undef FBLOAD
  #undef FBADD
  #undef ROT
}
constexpr int ATTN_LDS_BYTES=LDS_BYTES;
struct AttnTensors { const bf16* Q; const bf16* K; const bf16* V; bf16* O; const float* FB; };
constexpr int FB_OFF=86016;
template<int THRL=8,bool NOFB=false> __device__ __forceinline__ void attn_phase(char*lds,const AttnTensors&T,int vcu,int G,const int wave0){
  const fb_lptr fbl=(fb_lptr)(lds+FB_OFF);
  const bool fast=(G==256); const int nu=fast?16:16*((BATCH*NHEAD-vcu+G-1)/G); int cur=-1;
  for(int u=0;u<nu;++u){
    int bh,qb;
    if(fast){ bh=32*(vcu>>5)+4*(u>>1)+((vcu&31)>>3); qb=(u&1)?(vcu&7):NQB-1-(vcu&7); } else { bh=vcu+G*(u>>4); qb=NQB-1-(u&15); }
    if(bh!=cur){ cur=bh;
      { __attribute__((address_space(3))) float* fw=(__attribute__((address_space(3))) float*)(lds+FB_OFF);
        int ti_=HW_TID(wave0); asm volatile("":"+v"(ti_)); float fv_[SEQ/512]; _Pragma("unroll") for(int k_=0;k_<SEQ/512;++k_)fv_[k_]=T.FB[(size_t)bh*SEQ+ti_+512*k_]; _Pragma("unroll") for(int k_=0;k_<SEQ/512;++k_)fw[ti_+512*k_]=fv_[k_]; }
      asm volatile("s_waitcnt vmcnt(0) lgkmcnt(0)\n\ts_barrier":::"memory"); }
    attn_unit<THRL,NOFB>(bh/NHEAD,bh%NHEAD,qb,T.Q,T.K,T.V,T.O,lds,fbl,wave0);
  }
}
#undef SBAR
#undef WAIT_BAR
}

constexpr int DM = 1024, NB = 16, SEQ = 4096, NT = NB * SEQ;
constexpr int DEPTH = 4, NAL = 2;
constexpr int A_IN = 3088, A_PROJ = 3072;
constexpr int KV_OUT = 2064;
constexpr int NE = 16, DE = 512, NCLS = 24, CLS_CAP = NT;
constexpr float EPS = 1e-6f;
constexpr int NWAVES = 8;
#ifndef RSPLIT
#define RSPLIT 0
#endif
#ifndef FUSE_LOCAL
#define FUSE_LOCAL 1
#endif
#ifndef PROJ_F8
#define PROJ_F8 true
#endif
#ifndef MOE2_F8
#define MOE2_F8 true
#endif
#ifndef MOE1_F8
#define MOE1_F8 true
#endif
constexpr int MAX_RB = NT / 256 + NCLS;

constexpr size_t MiB = 1u << 20;
constexpr size_t WS_CTL = 0, CTL_ZERO_BYTES = 1 * MiB;
constexpr size_t WS_MODS = 1 * MiB;
constexpr size_t WS_KVMOD = WS_MODS + (size_t)DEPTH * NB * 6144 * 4;
constexpr size_t WS_FIN = WS_KVMOD + (size_t)NB * 2048 * 4;
constexpr size_t WS_WTS = 3 * MiB, WS_MODS16 = 3 * MiB;
constexpr size_t WS_G16 = 4 * MiB;
constexpr size_t WS_FB = 8 * MiB;
constexpr size_t WS_PERM = 12 * MiB;
constexpr size_t WS_WIN = 18 * MiB, WS_WOUT = 30 * MiB, WS_WKV = 34 * MiB, WS_WQ = 38 * MiB, WS_WO = 42 * MiB;
constexpr size_t WS_BT1 = 46 * MiB;
constexpr size_t WS_PW = 110 * MiB;
constexpr size_t WS_BT2 = 174 * MiB;
constexpr size_t WS_HB = 238 * MiB;
constexpr size_t WS_BIG = 366 * MiB;
constexpr size_t WS_ACT = 750 * MiB;
constexpr size_t WS_XB = 890 * MiB;
constexpr size_t WS_END = 1018 * MiB;
static_assert(WS_FIN + (size_t)NB * 2048 * 4 <= WS_WTS && WS_ACT + (size_t)MAX_RB * 256 * 1024 * 2 <= WS_XB && WS_XB + (size_t)NT * DM * 2 <= WS_END, "d_ws map");
constexpr int CW_BAR = 4096;
constexpr int CW_XCCT = 12288;
constexpr int CW_CNT = 16384;
constexpr int RING_OFF = 0, RING_BYTES = 131072;
constexpr int LDSCTL_OFF = RING_BYTES, MISC_OFF = LDSCTL_OFF + 320;
constexpr int TAB_OFF = MISC_OFF + 128;
constexpr int LDS_BYTES = 147456;
static_assert(TAB_OFF + 256 + 4 * (NT / 256 + NCLS + 8) <= LDS_BYTES, "LDS map");

typedef unsigned short bf16;
typedef unsigned v4u __attribute__((ext_vector_type(4)));
typedef unsigned v2u __attribute__((ext_vector_type(2)));
typedef float f32x4 __attribute__((ext_vector_type(4)));
typedef short bf16x8 __attribute__((ext_vector_type(8)));
typedef GAS unsigned gu32;
#define RLX_AGENT __ATOMIC_RELAXED, __HIP_MEMORY_SCOPE_AGENT
#define LDS_WAIT() asm volatile("s_waitcnt lgkmcnt(0)" ::: "memory")
__device__ __forceinline__ unsigned f2bf(float f) { unsigned u = __builtin_bit_cast(unsigned, f); return (u + 0x7fffu + ((u >> 16) & 1u)) >> 16; }
__device__ __forceinline__ unsigned pk2(float lo, float hi) { typedef float f2_t __attribute__((ext_vector_type(2))); typedef __bf16 b2_t __attribute__((ext_vector_type(2))); const f2_t v = {lo, hi}; return __builtin_bit_cast(unsigned, __builtin_convertvector(v, b2_t)); }
__device__ __forceinline__ int cvt8(float a, float b, int old, bool hi) { a = __builtin_amdgcn_fmed3f(a, -448.f, 448.f); b = __builtin_amdgcn_fmed3f(b, -448.f, 448.f); return hi ? __builtin_amdgcn_cvt_pk_fp8_f32(a, b, old, true) : __builtin_amdgcn_cvt_pk_fp8_f32(a, b, old, false); }
__device__ __forceinline__ float bf2f(unsigned b) { return __builtin_bit_cast(float, (b & 0xffffu) << 16); }

#define XB_TMO      128
#define XB_XCNT(j)  (256  + 64 * (j))
#define XB_XSUB(j)  (1280 + 64 * (j))
#define XB_XGEN(j)  (2304 + 64 * (j))
#define XB_TOP      3328
#define XB_TOPGEN   3392
#define XCD_BAR_WORDS 3456
#define XB_SPIN_CAP (1u << 22)

__device__ __forceinline__ unsigned xb_ld(unsigned* p)              { return __hip_atomic_load(p, __ATOMIC_RELAXED, __HIP_MEMORY_SCOPE_AGENT); }
__device__ __forceinline__ unsigned xb_add(unsigned* p, unsigned v) { return __hip_atomic_fetch_add(p, v, __ATOMIC_RELAXED, __HIP_MEMORY_SCOPE_AGENT); }
__device__ __forceinline__ unsigned xb_xcc_id() { return (unsigned)__builtin_amdgcn_s_getreg((3 << 11) | 20) & 0xFu; }
#define XB_SPIN(cond, bar) do { unsigned _sp = 0; while (cond) { __builtin_amdgcn_s_sleep(1); \
    if ((++_sp & 255u) == 0u) { if (xb_ld(&(bar)[XB_TMO])) break; if (_sp > XB_SPIN_CAP) { atomicAdd(&(bar)[XB_TMO], 1u); break; } } } } while (0)

struct XcdBarrier { unsigned* bar; unsigned x; volatile LAS unsigned* st; int w0; };

__device__ __forceinline__ XcdBarrier xcd_barrier_post(unsigned* bar, volatile LAS unsigned* st, int w0) {
    XcdBarrier b; b.bar = bar; b.x = xb_xcc_id(); b.st = st; b.w0 = w0;
    if (HW_TID(w0) == 0) (void)xb_add(&bar[XB_XCNT(b.x)], 1u);
    return b;
}
__device__ __forceinline__ void xcd_barrier_complete(unsigned* bar, unsigned x, unsigned& nloc, unsigned& nx) {
    const unsigned G = gridDim.x * gridDim.y * gridDim.z;
    unsigned sum, cnt, mine, sp = 0u;
    for (;;) {
        sum = 0u; cnt = 0u; mine = 0u;
#pragma unroll
        for (unsigned j = 0; j < 16; ++j) { const unsigned c = xb_ld(&bar[XB_XCNT(j)]); sum += c; cnt += (c > 0u) ? 1u : 0u; mine = (j == x) ? c : mine; }
        if (sum == G) break;
        __builtin_amdgcn_s_sleep(1);
        if ((++sp & 255u) == 0u) { if (xb_ld(&bar[XB_TMO])) break; if (sp > XB_SPIN_CAP) { atomicAdd(&bar[XB_TMO], 1u); break; } }
    }
    nloc = mine > 0u ? mine : 1u; nx = cnt > 0u ? cnt : 1u;
}
__device__ __forceinline__ void xcd_barrier(const XcdBarrier& b) {
    asm volatile("s_waitcnt vmcnt(0)" ::: "memory");
    __syncthreads();
    if (HW_TID(b.w0) == 0) {
        unsigned* bar = b.bar; unsigned bx = b.x; asm volatile("" : "+s"(bar), "+s"(bx));
        __builtin_amdgcn_s_waitcnt(0);
        unsigned nloc = b.st[0], nx = b.st[1];
        if (nloc == 0u) { xcd_barrier_complete(bar, bx, nloc, nx); b.st[0] = nloc; b.st[1] = nx; }
        const unsigned old = xb_add(&bar[XB_XSUB(bx)], 1u);
        const unsigned gen = old / nloc;
        if (old + 1u == (gen + 1u) * nloc) {
            __builtin_amdgcn_fence(__ATOMIC_RELEASE, "agent");
            asm volatile("s_waitcnt vmcnt(0)" ::: "memory");
            const unsigned og = xb_add(&bar[XB_TOP], 1u);
            const unsigned tg = og / nx;
            if (og + 1u == (tg + 1u) * nx) xb_add(&bar[XB_TOPGEN], 1u);
            else XB_SPIN(xb_ld(&bar[XB_TOPGEN]) == tg, bar);
            __builtin_amdgcn_fence(__ATOMIC_ACQUIRE, "agent");
            xb_add(&bar[XB_XGEN(bx)], 1u);
            asm volatile("s_waitcnt vmcnt(0)" ::: "memory");
        } else {
            XB_SPIN(xb_ld(&bar[XB_XGEN(bx)]) == gen, bar);
            __builtin_amdgcn_fence(__ATOMIC_ACQUIRE, "agent");
            asm volatile("s_waitcnt vmcnt(0)" ::: "memory");
        }
    }
    __syncthreads();
}

struct Args { const float* in[25]; float* out; unsigned char* ws; int ph_lo, ph_hi; };
enum { I_X = 0, I_C, I_AWIN, I_ABG, I_AMH, I_AWOUT, I_KVNORM, I_WADAKV, I_BADAKV, I_WKV, I_BFG, I_BWQ, I_BWO, I_NMIX, I_NFFN, I_WADA, I_BADA, I_WR, I_RB, I_WG, I_WU, I_WD, I_NFIN, I_WADAF, I_BADAF };

struct Frame {
    LAS unsigned char* lds;
    volatile LAS unsigned* MISC;
    gu32* ctl;
    int wave;
    int cid;
    int vcu, G;
};

__device__ __forceinline__ float wave_sum(float v) {
#pragma unroll
    for (int o = 1; o < 64; o <<= 1) v += __shfl_xor(v, o);
    return v;
}

__device__ __forceinline__ void p0_transpose_blk(const float* W, int ldw, int k0, int n0, bf16* WT, int ldt, int drow0, LAS float* scr, int lane) {
    float tv[32];
#pragma unroll
    for (int i = 0; i < 32; ++i) tv[i] = ((const GAS float*)W)[(size_t)(k0 + 2 * i + (lane >> 5)) * ldw + n0 + (lane & 31)];
#pragma unroll
    for (int i = 0; i < 32; ++i) scr[(2 * i + (lane >> 5)) * 33 + (lane & 31)] = tv[i];
    LDS_WAIT(); asm volatile("" ::: "memory");
    const int c = lane & 7;
#pragma unroll
    for (int j = 0; j < 4; ++j) { const int n = (lane >> 3) + 8 * j; const LAS float* s = scr + (8 * c) * 33 + n;
        v4u o; o.x = pk2(s[0 * 33], s[1 * 33]); o.y = pk2(s[2 * 33], s[3 * 33]); o.z = pk2(s[4 * 33], s[5 * 33]); o.w = pk2(s[6 * 33], s[7 * 33]);
        *(GAS v4u*)(WT + (size_t)(drow0 + n) * ldt + k0 + 8 * c) = o; }
    LDS_WAIT(); asm volatile("" ::: "memory");
}
__device__ __forceinline__ void p0_transpose_blk8(const float* W, int ldw, int k0, int n0, unsigned char* WT, int ldt, int drow0, float mul, LAS float* scr, int lane) {
    float tv[32];
#pragma unroll
    for (int i = 0; i < 32; ++i) tv[i] = ((const GAS float*)W)[(size_t)(k0 + 2 * i + (lane >> 5)) * ldw + n0 + (lane & 31)];
#pragma unroll
    for (int i = 0; i < 32; ++i) scr[(2 * i + (lane >> 5)) * 33 + (lane & 31)] = tv[i];
    LDS_WAIT(); asm volatile("" ::: "memory");
    const int c = lane & 7;
#pragma unroll
    for (int j = 0; j < 4; ++j) { const int n = (lane >> 3) + 8 * j; const LAS float* s = scr + (8 * c) * 33 + n;
        int w0 = 0, w1 = 0;
        w0 = cvt8(s[0 * 33] * mul, s[1 * 33] * mul, w0, false); w0 = cvt8(s[2 * 33] * mul, s[3 * 33] * mul, w0, true);
        w1 = cvt8(s[4 * 33] * mul, s[5 * 33] * mul, w1, false); w1 = cvt8(s[6 * 33] * mul, s[7 * 33] * mul, w1, true);
        v2u o; o.x = (unsigned)w0; o.y = (unsigned)w1;
        *(GAS v2u*)(WT + (size_t)(drow0 + n) * ldt + k0 + 8 * c) = o; }
    LDS_WAIT(); asm volatile("" ::: "memory");
}
__device__ __forceinline__ void p0_prologue(Frame& F, const Args& a) {
    unsigned char* ws = a.ws; const int ptid = HW_TID(F.wave), plane = ptid & 63;
    {
        LAS float* cact = (LAS float*)(F.lds);
        LAS float* red = (LAS float*)(F.lds + 65536);
        const float* c = a.in[I_C];
        { float cv_[32];
#pragma unroll
          for (int k = 0; k < 32; ++k) cv_[k] = ((const GAS float*)c)[ptid + 512 * k];
#pragma unroll
          for (int k = 0; k < 32; ++k) { const int i = ptid + 512 * k, b = i >> 10, d = i & 1023; const float v = cv_[k]; cact[d * 16 + b] = v / (1.0f + __expf(-v)); } }
        __syncthreads();
        for (int blk = blockIdx.x; blk < 224; blk += F.G) {
            const float* W; const float* bias; float* out; bf16* out16 = nullptr; int ldw, e0, ostride;
            if (blk < 192) { const int l = blk / 48; e0 = (blk % 48) * 128; W = a.in[I_WADA] + (size_t)l * DM * 6144; ldw = 6144; bias = a.in[I_BADA] + l * 6144; out = (float*)(ws + WS_MODS) + (size_t)l * NB * 6144; ostride = 6144; out16 = (bf16*)(ws + WS_MODS16) + (size_t)l * NB * 6144; }
            else if (blk < 208) { e0 = (blk - 192) * 128; W = a.in[I_WADAKV]; ldw = 2048; bias = a.in[I_BADAKV]; out = (float*)(ws + WS_KVMOD); ostride = 2048; }
            else { e0 = (blk - 208) * 128; W = a.in[I_WADAF]; ldw = 2048; bias = a.in[I_BADAF]; out = (float*)(ws + WS_FIN); ostride = 2048; }
            const int col = ptid & 127, ks = ptid >> 7;
            float acc[16];
#pragma unroll
            for (int b = 0; b < 16; ++b) acc[b] = 0.f;
            const float* wp = W + (size_t)(ks * 256) * ldw + e0 + col;
#pragma clang loop unroll(disable)
            for (int d0 = 0; d0 < 256; d0 += 32) { float wv[32];
#pragma unroll
              for (int dd = 0; dd < 32; ++dd) wv[dd] = ((const GAS float*)wp)[(size_t)(d0 + dd) * ldw];
#pragma unroll
              for (int dd = 0; dd < 32; ++dd) { const int d = d0 + dd; const float w = wv[dd]; const LAS f32x4* cp = (const LAS f32x4*)(cact + (ks * 256 + d) * 16);
#pragma unroll
                for (int q = 0; q < 4; ++q) { const f32x4 cv = cp[q]; acc[4 * q + 0] += w * cv[0]; acc[4 * q + 1] += w * cv[1]; acc[4 * q + 2] += w * cv[2]; acc[4 * q + 3] += w * cv[3]; } } }
#pragma unroll
            for (int b = 0; b < 16; ++b) red[(ks * 128 + col) * 16 + b] = acc[b];
            __syncthreads();
            for (int i = ptid; i < 128 * 16; i += 512) { const int cc = i & 127, b = i >> 7;
                const float s = red[(0 * 128 + cc) * 16 + b] + red[(1 * 128 + cc) * 16 + b] + red[(2 * 128 + cc) * 16 + b] + red[(3 * 128 + cc) * 16 + b];
                const float v = s + bias[e0 + cc]; out[(size_t)b * ostride + e0 + cc] = v; if (out16) out16[(size_t)b * 6144 + e0 + cc] = (bf16)f2bf(v); }
            __syncthreads();
        }
    }
    __syncthreads();
    {
        static_assert(PROJ_F8 && OUT_F8 && MOE1_F8 && MOE2_F8, "the prologue converts every GEMM weight to fp8");
        LAS float* scr = (LAS float*)(F.lds + F.wave * 16384);
        const int gw = F.vcu * NWAVES + F.wave, NGW = F.G * NWAVES;
        constexpr int I_IN = 16 * 96, I_SQ = 16 * 32, I_KV = 16 * 64, I_GU = 16 * 16, I_DN = 8 * 32;
        constexpr int N_IN = 2 * I_IN, N_OUT = 2 * I_SQ, N_KV = I_KV, N_Q = 2 * I_SQ, N_O = 2 * I_SQ, N_G = 64 * I_GU, N_U = 64 * I_GU, N_D = 64 * I_DN;
        constexpr int NITEMS = N_IN + N_OUT + N_KV + N_Q + N_O + N_G + N_U + N_D;
        struct Blk { const float* W; int ldw, k0, n0; unsigned char* WT; int ldt, drow0; };
        auto decode = [&](int it) -> Blk { Blk B; int r = it;
            if (r < N_IN) { const int l = r / I_IN, q = r % I_IN, kb = q / 96, nb = q % 96; B = Blk{a.in[I_AWIN] + (size_t)l * DM * A_IN, A_IN, 64 * kb, 32 * nb, (unsigned char*)(ws + WS_WIN) + (size_t)l * A_PROJ * DM, DM, 32 * nb}; return B; } r -= N_IN;
            if (r < N_OUT) { const int l = r / I_SQ, q = r % I_SQ, kb = q / 32, nb = q % 32; B = Blk{a.in[I_AWOUT] + (size_t)l * DM * DM, DM, 64 * kb, 32 * nb, (unsigned char*)(ws + WS_WOUT) + (size_t)l * DM * DM, DM, 32 * nb}; return B; } r -= N_OUT;
            if (r < N_KV) { const int kb = r / 64, nb = r % 64; B = Blk{a.in[I_WKV], KV_OUT, 64 * kb, 32 * nb, (unsigned char*)(ws + WS_WKV), DM, 32 * nb}; return B; } r -= N_KV;
            if (r < N_Q) { const int l = r / I_SQ, q = r % I_SQ, kb = q / 32, nb = q % 32; B = Blk{a.in[I_BWQ] + (size_t)l * DM * DM, DM, 64 * kb, 32 * nb, (unsigned char*)(ws + WS_WQ) + (size_t)l * DM * DM, DM, 32 * nb}; return B; } r -= N_Q;
            if (r < N_O) { const int l = r / I_SQ, q = r % I_SQ, kb = q / 32, nb = q % 32; B = Blk{a.in[I_BWO] + (size_t)l * DM * DM, DM, 64 * kb, 32 * nb, (unsigned char*)(ws + WS_WO) + (size_t)l * DM * DM, DM, 32 * nb}; return B; } r -= N_O;
            if (r < N_G + N_U) { const int up = r >= N_G; if (up) r -= N_G; const int le = r / I_GU, q = r % I_GU, kb = q / 16, nb = q % 16; const int n0 = 32 * nb;
                B = Blk{a.in[up ? I_WU : I_WG] + (size_t)le * DM * DE, DE, 64 * kb, n0, (unsigned char*)(ws + WS_BT1) + (size_t)le * 1024 * DM, DM, (n0 >> 7) * 256 + up * 128 + (n0 & 127)}; return B; } r -= N_G + N_U;
            { const int le = r / I_DN, q = r % I_DN, kb = q / 32, nb = q % 32; B = Blk{a.in[I_WD] + (size_t)le * DE * DM, DM, 64 * kb, 32 * nb, (unsigned char*)(ws + WS_BT2) + (size_t)le * DM * DE, DE, 32 * nb}; return B; } };
        const int lane = plane;
        float tv[32];
        if (gw < NITEMS) { const Blk B = decode(gw);
#pragma unroll
            for (int i = 0; i < 32; ++i) tv[i] = ((const GAS float*)B.W)[(size_t)(B.k0 + 2 * i + (lane >> 5)) * B.ldw + B.n0 + (lane & 31)]; }
        for (int it = gw; it < NITEMS; it += NGW) {
            const Blk B = decode(it);
#pragma unroll
            for (int i = 0; i < 32; ++i) scr[(2 * i + (lane >> 5)) * 33 + (lane & 31)] = tv[i] * 32.0f;
            if (it + NGW < NITEMS) { const Blk Bn = decode(it + NGW);
#pragma unroll
                for (int i = 0; i < 32; ++i) tv[i] = ((const GAS float*)Bn.W)[(size_t)(Bn.k0 + 2 * i + (lane >> 5)) * Bn.ldw + Bn.n0 + (lane & 31)]; }
            LDS_WAIT(); asm volatile("" ::: "memory");
            const int c = lane & 7;
#pragma unroll
            for (int j = 0; j < 4; ++j) { const int n = (lane >> 3) + 8 * j; const LAS float* s = scr + (8 * c) * 33 + n;
                int w0 = 0, w1 = 0;
                w0 = cvt8(s[0 * 33], s[1 * 33], w0, false); w0 = cvt8(s[2 * 33], s[3 * 33], w0, true);
                w1 = cvt8(s[4 * 33], s[5 * 33], w1, false); w1 = cvt8(s[6 * 33], s[7 * 33], w1, true);
                v2u o; o.x = (unsigned)w0; o.y = (unsigned)w1;
                *(GAS v2u*)(B.WT + (size_t)(B.drow0 + n) * B.ldt + B.k0 + 8 * c) = o; }
            LDS_WAIT(); asm volatile("" ::: "memory");
        }
    }
}

__device__ __forceinline__ float log_sigmoidf_(float x) { return fminf(x, 0.f) - log1pf(__expf(-fabsf(x))); }
template <bool ROUTER>
__device__ __forceinline__ void norm_phase(Frame& F, const void* xv, int xbf, const float* gamma, const float* shift, const float* scale, int mstride, bf16* out,
                                           int mode, const float* W16, int ldw, const float* bias16, float* G16, float2* wts, int* perm, gu32* gcnt) {
    LAS float* wT = (LAS float*)(F.lds);
    LAS int* hist = (LAS int*)(F.lds + 65536);
    LAS int* sbase = hist + 32;
    LAS int* tinfo = hist + 64;
    LAS float* slog = (LAS float*)(F.lds + 65536 + 2048);
    int tid_ = HW_TID(F.wave); asm volatile("" : "+v"(tid_)); int bid_ = blockIdx.x; asm volatile("" : "+s"(bid_)); const int bid = bid_; const int tid = tid_, lane = tid & 63, wave = __builtin_amdgcn_readfirstlane(tid >> 6);
    if (mode != 0) { for (int i = tid; i < DM * 16; i += 512) { const int d = i >> 4, e = i & 15; wT[e * DM + d] = W16[(size_t)d * ldw + e]; } }
    if (tid < 32) hist[tid] = 0;
    __syncthreads();
    for (int chunk = bid; chunk < NT / 256; chunk += F.G) {
        const int b = chunk >> 4;
        f32x4 ga[4], sb[4];
#pragma unroll
        for (int j = 0; j < 4; ++j) { const int col = 4 * lane + 256 * j; const f32x4 g = *(const f32x4*)(gamma + col), sc = *(const f32x4*)(scale + (size_t)b * mstride + col); sb[j] = *(const f32x4*)(shift + (size_t)b * mstride + col);
            ga[j] = g * (sc + 1.0f); }
#pragma clang loop unroll(disable)
        for (int i = 0; i < 32; ++i) {
            const int row = chunk * 256 + wave * 32 + i;
            f32x4 v[4]; float s = 0.f;
            if (xbf) { const GAS v2u* xr = (const GAS v2u*)((const bf16*)xv + (size_t)row * DM) + lane;
#pragma unroll
                for (int j = 0; j < 4; ++j) { const v2u t = xr[64 * j]; v[j] = (f32x4){bf2f(t.x & 0xffffu), bf2f(t.x >> 16), bf2f(t.y & 0xffffu), bf2f(t.y >> 16)}; } }
            else { const GAS f32x4* xr = (const GAS f32x4*)((const float*)xv + (size_t)row * DM) + lane;
#pragma unroll
                for (int j = 0; j < 4; ++j) v[j] = xr[64 * j]; }
#pragma unroll
            for (int j = 0; j < 4; ++j) s += (v[j].x * v[j].x + v[j].y * v[j].y) + (v[j].z * v[j].z + v[j].w * v[j].w);
            const float r = 1.0f / sqrtf(wave_sum(s) * (1.0f / DM) + EPS);
            GAS v2u* o8 = (GAS v2u*)(out + (size_t)row * DM) + lane;
#pragma unroll
            for (int j = 0; j < 4; ++j) { v[j] = v[j] * r * ga[j] + sb[j];
                if (ROUTER ? MOE1_F8 : PROJ_F8) { int w8 = 0; w8 = cvt8(v[j].x, v[j].y, w8, false); w8 = cvt8(v[j].z, v[j].w, w8, true); ((GAS unsigned*)((unsigned char*)out + (size_t)row * DM))[lane + 64 * j] = (unsigned)w8; }
                else { v2u w; w.x = pk2(v[j].x, v[j].y); w.y = pk2(v[j].z, v[j].w); o8[64 * j] = w; } }
            if (mode == 0) continue;
            float p[16];
#pragma unroll
            for (int e = 0; e < 16; ++e) { float a = 0.f;
#pragma unroll
                for (int j = 0; j < 4; ++j) { const f32x4 w = *(const LAS f32x4*)(wT + e * DM + 4 * lane + 256 * j); a += (v[j].x * w.x + v[j].y * w.y) + (v[j].z * w.z + v[j].w * w.w); }
                p[e] = a; }
#pragma unroll
            for (int k = 0; k < 8; ++k) { const bool hi = lane & 32; const float mine = hi ? p[k + 8] : p[k], send = hi ? p[k] : p[k + 8]; p[k] = mine + __shfl_xor(send, 32); }
#pragma unroll
            for (int k = 0; k < 4; ++k) { const bool hi = lane & 16; const float mine = hi ? p[k + 4] : p[k], send = hi ? p[k] : p[k + 4]; p[k] = mine + __shfl_xor(send, 16); }
#pragma unroll
            for (int k = 0; k < 2; ++k) { const bool hi = lane & 8; const float mine = hi ? p[k + 2] : p[k], send = hi ? p[k] : p[k + 2]; p[k] = mine + __shfl_xor(send, 8); }
            { const bool hi = lane & 4; const float mine = hi ? p[1] : p[0], send = hi ? p[0] : p[1]; p[0] = mine + __shfl_xor(send, 4); }
            p[0] += __shfl_xor(p[0], 2); p[0] += __shfl_xor(p[0], 1);
            if ((lane & 3) == 0) slog[(wave * 32 + i) * 16 + ((lane >> 2) & 15)] = p[0];
        }
        if (mode != 0) {
            if (!ROUTER) {
#pragma clang loop unroll(disable)
                for (int k = 0; k < 8; ++k) { const int idx = lane + 64 * k, e = idx & 15; float g = slog[wave * 512 + idx] + bias16[e];
                    if (mode == 1) { g = 15.0f * tanhf(g * (1.0f / 15.0f)); if (e >= 8) g = log_sigmoidf_(g); } else g = log_sigmoidf_(g);
                    G16[(size_t)(chunk * 256 + wave * 32) * 16 + idx] = g; }
            } else if (lane < 32) {
                const int row = chunk * 256 + wave * 32 + lane;
                float aff[16], sel[16];
#pragma unroll
                for (int q4 = 0; q4 < 4; ++q4) { const f32x4 lg = *(const LAS f32x4*)(slog + (wave * 32 + lane) * 16 + 4 * q4);
#pragma unroll
                    for (int q = 0; q < 4; ++q) { aff[4 * q4 + q] = 1.0f / (1.0f + __expf(-lg[q])); sel[4 * q4 + q] = aff[4 * q4 + q] + bias16[4 * q4 + q]; } }
                float gs[4];
#pragma unroll
                for (int g = 0; g < 4; ++g) { const float s0 = sel[4 * g], s1 = sel[4 * g + 1], s2 = sel[4 * g + 2], s3 = sel[4 * g + 3];
                    const float a = fmaxf(s0, s1), bb = fminf(s0, s1), c = fmaxf(s2, s3), d = fminf(s2, s3);
                    gs[g] = fmaxf(a, c) + fmaxf(fminf(a, c), fmaxf(bb, d)); }
                int grp = 0; float best = gs[0];
#pragma unroll
                for (int g = 1; g < 4; ++g) if (gs[g] > best) { best = gs[g]; grp = g; }
                float sg[4], ag[4];
#pragma unroll
                for (int q = 0; q < 4; ++q) { sg[q] = grp == 0 ? sel[q] : grp == 1 ? sel[4 + q] : grp == 2 ? sel[8 + q] : sel[12 + q]; ag[q] = grp == 0 ? aff[q] : grp == 1 ? aff[4 + q] : grp == 2 ? aff[8 + q] : aff[12 + q]; }
                int i1 = 0; float b1 = sg[0];
#pragma unroll
                for (int q = 1; q < 4; ++q) if (sg[q] > b1) { b1 = sg[q]; i1 = q; }
                int i2 = -1; float b2 = 0.f;
#pragma unroll
                for (int q = 0; q < 4; ++q) if (q != i1 && (i2 < 0 || sg[q] > b2)) { b2 = sg[q]; i2 = q; }
                const int ea = i1 < i2 ? i1 : i2, eb = i1 < i2 ? i2 : i1;
                const float wa = ea == 0 ? ag[0] : ea == 1 ? ag[1] : ag[2], wb = eb == 1 ? ag[1] : eb == 2 ? ag[2] : ag[3];
                const float inv = 1.0f / (wa + wb);
                const int pid = ea == 0 ? eb - 1 : ea == 1 ? eb + 1 : 5;
                const int cls = grp * 6 + pid;
                wts[row] = make_float2(wa * inv, wb * inv); const int rk = __hip_atomic_fetch_add(&hist[cls], 1, __ATOMIC_RELAXED, __HIP_MEMORY_SCOPE_WORKGROUP); tinfo[wave * 32 + lane] = cls | (rk << 8);
            }
        }
        if (ROUTER) {
            __syncthreads();
            if (tid < NCLS) { const int n = hist[tid]; sbase[tid] = n ? (int)__hip_atomic_fetch_add(gcnt + tid, (unsigned)n, RLX_AGENT) : 0; }
            __syncthreads();
            if (tid < 256) { const int ti = tinfo[tid], cls = ti & 255, rk = ti >> 8; perm[(size_t)cls * CLS_CAP + sbase[cls] + rk] = chunk * 256 + tid; }
            __syncthreads();
            if (tid < 32) hist[tid] = 0;
            __syncthreads();
        }
    }
    __syncthreads();
}
template <bool ROUTER>
__device__ __forceinline__ void normT_phase(Frame& F, const void* xv, int xbf, const float* gamma, const float* shift, const float* scale, int mstride, bf16* out,
                                            int mode, const float* W16, int ldw, const float* bias16, float* G16, float2* wts, int* perm, gu32* gcnt) {
    constexpr bool OUT8 = ROUTER ? MOE1_F8 : PROJ_F8;
    constexpr int WP = 1032;
    LAS float* sG = (LAS float*)(F.lds);
    LAS float* sS = sG + 1024;
    LAS bf16* sWh = (LAS bf16*)(F.lds + 8192);
    LAS bf16* sWl = sWh + 16 * WP;
    LAS float* slog = (LAS float*)(F.lds + 8192 + 2 * 16 * WP * 2);
    LAS int* hist = (LAS int*)(slog + 8 * 32 * 16);
    LAS int* sbase = hist + 32;
    LAS int* tinfo = hist + 64;
    LAS v2u* tw = (LAS v2u*)(tinfo + 256);
    int tid_ = HW_TID(F.wave); asm volatile("" : "+v"(tid_)); int bid_ = blockIdx.x; asm volatile("" : "+s"(bid_)); const int bid = bid_;
    const int tid = tid_, lane = tid & 63, wave = __builtin_amdgcn_readfirstlane(tid >> 6), r = lane & 15, g = lane >> 4;
    if (mode != 0) {
        float wv[32];
#pragma unroll
        for (int k = 0; k < 32; ++k) { const int i = tid + 512 * k; wv[k] = ((const GAS float*)W16)[(size_t)(i >> 4) * ldw + (i & 15)]; }
#pragma unroll
        for (int k = 0; k < 32; ++k) { const int i = tid + 512 * k, d = i >> 4, e = i & 15; const float w = wv[k]; const unsigned hi = f2bf(w); sWh[e * WP + d] = (bf16)hi; sWl[e * WP + d] = (bf16)f2bf(w - bf2f(hi)); } }
    if (tid < 32) hist[tid] = 0;
    int cur_b = -1;
    for (int chunk = bid; chunk < NT / 256; chunk += F.G) {
        const int b = chunk >> 4;
        if (b != cur_b) { cur_b = b; __syncthreads();
            { const float g0 = gamma[tid], g1 = gamma[tid + 512], c0 = scale[(size_t)b * mstride + tid], c1 = scale[(size_t)b * mstride + tid + 512], h0 = shift[(size_t)b * mstride + tid], h1 = shift[(size_t)b * mstride + tid + 512];
              sG[tid] = g0 * (1.0f + c0); sG[tid + 512] = g1 * (1.0f + c1); sS[tid] = h0; sS[tid + 512] = h1; } }
        __syncthreads();
#pragma clang loop unroll(disable)
        for (int tt = 0; tt < 2; ++tt) {
            const int row = chunk * 256 + wave * 32 + 16 * tt + r;
            v4u xp[16][2]; float ss = 0.f;
            if (xbf) { const GAS v4u* xr = (const GAS v4u*)((const bf16*)xv + (size_t)row * DM + 16 * g);
#pragma unroll
                for (int kp = 0; kp < 16; ++kp) { xp[kp][0] = xr[8 * kp]; xp[kp][1] = xr[8 * kp + 1]; } }
            else { const GAS f32x4* xr = (const GAS f32x4*)((const float*)xv + (size_t)row * DM + 16 * g);
#pragma unroll
                for (int kp = 0; kp < 16; ++kp) { const f32x4 a = xr[16 * kp], b2 = xr[16 * kp + 1], c = xr[16 * kp + 2], d = xr[16 * kp + 3];
                    xp[kp][0] = (v4u){pk2(a.x, a.y), pk2(a.z, a.w), pk2(b2.x, b2.y), pk2(b2.z, b2.w)}; xp[kp][1] = (v4u){pk2(c.x, c.y), pk2(c.z, c.w), pk2(d.x, d.y), pk2(d.z, d.w)};
                    if (kp & 1) asm volatile("" ::: "memory"); } }
#pragma unroll
            for (int kp = 0; kp < 16; ++kp)
#pragma unroll
                for (int q = 0; q < 2; ++q)
#pragma unroll
                    for (int j = 0; j < 4; ++j) { const float lo = bf2f(xp[kp][q][j] & 0xffffu), hi = bf2f(xp[kp][q][j] >> 16); ss += lo * lo + hi * hi; }
            ss += __shfl_xor(ss, 16); ss += __shfl_xor(ss, 32);
            const float rr = 1.0f / sqrtf(ss * (1.0f / DM) + EPS);
#pragma unroll
            for (int kp = 0; kp < 16; ++kp) { asm volatile("" : "+v"(xp[kp][0]), "+v"(xp[kp][1])); }
            f32x4 acc = (f32x4){0.f, 0.f, 0.f, 0.f};
#pragma unroll
            for (int kp = 0; kp < 16; ++kp) {
                asm volatile("" ::: "memory");
                const int c0 = 64 * kp + 16 * g;
                bf16x8 ahi[2], alo[2];
#pragma unroll
                for (int q = 0; q < 2; ++q) { const f32x4 g0 = *(const LAS f32x4*)(sG + c0 + 8 * q), g1 = *(const LAS f32x4*)(sG + c0 + 8 * q + 4), s0 = *(const LAS f32x4*)(sS + c0 + 8 * q), s1 = *(const LAS f32x4*)(sS + c0 + 8 * q + 4);
                    float h[8];
#pragma unroll
                    for (int j = 0; j < 4; ++j) { const float lo = bf2f(xp[kp][q][j] & 0xffffu), hi = bf2f(xp[kp][q][j] >> 16);
                        const float gg0 = j < 2 ? g0[2 * j] : g1[2 * j - 4], gg1 = j < 2 ? g0[2 * j + 1] : g1[2 * j - 3], sh0 = j < 2 ? s0[2 * j] : s1[2 * j - 4], sh1 = j < 2 ? s0[2 * j + 1] : s1[2 * j - 3];
                        h[2 * j] = lo * rr * gg0 + sh0; h[2 * j + 1] = hi * rr * gg1 + sh1; }
                    v4u hp;
#pragma unroll
                    for (int j = 0; j < 4; ++j) hp[j] = pk2(h[2 * j], h[2 * j + 1]);
                    ahi[q] = __builtin_bit_cast(bf16x8, hp);
                    if (ROUTER && RSPLIT) { v4u lp;
#pragma unroll
                        for (int j = 0; j < 4; ++j) lp[j] = pk2(h[2 * j] - bf2f(hp[j] & 0xffffu), h[2 * j + 1] - bf2f(hp[j] >> 16));
                        alo[q] = __builtin_bit_cast(bf16x8, lp); }
                    if (OUT8) { int w0 = 0, w1 = 0;
                        w0 = cvt8(h[0], h[1], w0, false); w0 = cvt8(h[2], h[3], w0, true);
                        w1 = cvt8(h[4], h[5], w1, false); w1 = cvt8(h[6], h[7], w1, true);
                        v2u o; o.x = (unsigned)w0; o.y = (unsigned)w1; *(GAS v2u*)((unsigned char*)out + (size_t)row * DM + c0 + 8 * q) = o; }
                    else *(GAS v4u*)(out + (size_t)row * DM + c0 + 8 * q) = hp;
                }
                if (mode != 0) {
#pragma unroll
                    for (int q = 0; q < 2; ++q) { const bf16x8 bh = *(const LAS bf16x8*)(sWh + r * WP + c0 + 8 * q), bl = *(const LAS bf16x8*)(sWl + r * WP + c0 + 8 * q);
                        acc = __builtin_amdgcn_mfma_f32_16x16x32_bf16(ahi[q], bh, acc, 0, 0, 0); if (ROUTER && RSPLIT) { acc = __builtin_amdgcn_mfma_f32_16x16x32_bf16(alo[q], bh, acc, 0, 0, 0); acc = __builtin_amdgcn_mfma_f32_16x16x32_bf16(ahi[q], bl, acc, 0, 0, 0); } } }
            }
            if (mode != 0) {
                const int e = r;
                if (!ROUTER) { const float be = bias16[e];
#pragma unroll
                    for (int i = 0; i < 4; ++i) { float gv = acc[i] + be;
                        if (mode == 1) { gv = 15.0f * tanhf(gv * (1.0f / 15.0f)); if (e >= 8) gv = log_sigmoidf_(gv); } else gv = log_sigmoidf_(gv);
                        G16[(size_t)(chunk * 256 + wave * 32 + 16 * tt + 4 * g + i) * 16 + e] = gv; } }
                else {
#pragma unroll
                    for (int i = 0; i < 4; ++i) slog[(wave * 32 + 16 * tt + 4 * g + i) * 16 + e] = acc[i]; }
            }
        }
        if (ROUTER) {
            if (lane < 32) {
                const int row = chunk * 256 + wave * 32 + lane;
                float aff[16], sel[16];
#pragma unroll
                for (int q4 = 0; q4 < 4; ++q4) { const f32x4 lg = *(const LAS f32x4*)(slog + (wave * 32 + lane) * 16 + 4 * q4);
#pragma unroll
                    for (int q = 0; q < 4; ++q) { aff[4 * q4 + q] = 1.0f / (1.0f + __expf(-lg[q])); sel[4 * q4 + q] = aff[4 * q4 + q] + bias16[4 * q4 + q]; } }
                float gs[4];
#pragma unroll
                for (int gq = 0; gq < 4; ++gq) { const float s0 = sel[4 * gq], s1 = sel[4 * gq + 1], s2 = sel[4 * gq + 2], s3 = sel[4 * gq + 3];
                    const float a = fmaxf(s0, s1), bb = fminf(s0, s1), c = fmaxf(s2, s3), d = fminf(s2, s3);
                    gs[gq] = fmaxf(a, c) + fmaxf(fminf(a, c), fmaxf(bb, d)); }
                int grp = 0; float best = gs[0];
#pragma unroll
                for (int gq = 1; gq < 4; ++gq) if (gs[gq] > best) { best = gs[gq]; grp = gq; }
                float sg[4], ag[4];
#pragma unroll
                for (int q = 0; q < 4; ++q) { sg[q] = grp == 0 ? sel[q] : grp == 1 ? sel[4 + q] : grp == 2 ? sel[8 + q] : sel[12 + q]; ag[q] = grp == 0 ? aff[q] : grp == 1 ? aff[4 + q] : grp == 2 ? aff[8 + q] : aff[12 + q]; }
                int i1 = 0; float b1 = sg[0];
#pragma unroll
                for (int q = 1; q < 4; ++q) if (sg[q] > b1) { b1 = sg[q]; i1 = q; }
                int i2 = -1; float b2 = 0.f;
#pragma unroll
                for (int q = 0; q < 4; ++q) if (q != i1 && (i2 < 0 || sg[q] > b2)) { b2 = sg[q]; i2 = q; }
                const int ea = i1 < i2 ? i1 : i2, eb = i1 < i2 ? i2 : i1;
                const float wa = ea == 0 ? ag[0] : ea == 1 ? ag[1] : ag[2], wb = eb == 1 ? ag[1] : eb == 2 ? ag[2] : ag[3];
                const float inv = 1.0f / (wa + wb);
                const int pid = ea == 0 ? eb - 1 : ea == 1 ? eb + 1 : 5;
                const int cls = grp * 6 + pid;
                const int rk = __hip_atomic_fetch_add(&hist[cls], 1, __ATOMIC_RELAXED, __HIP_MEMORY_SCOPE_WORKGROUP); tinfo[wave * 32 + lane] = cls | (rk << 8); tw[wave * 32 + lane] = (v2u){__builtin_bit_cast(unsigned, wa * inv), __builtin_bit_cast(unsigned, wb * inv)}; (void)row;
            }
            __syncthreads();
            if (tid < NCLS) { const int n = hist[tid]; sbase[tid] = n ? (int)__hip_atomic_fetch_add(gcnt + tid, (unsigned)n, RLX_AGENT) : 0; }
            __syncthreads();
            if (tid < 256) { const int ti = tinfo[tid], cls = ti & 255, rk = ti >> 8; const v2u w2 = tw[tid]; const size_t pi = (size_t)cls * CLS_CAP + sbase[cls] + rk; perm[pi] = chunk * 256 + tid;
                ((GAS v4u*)wts)[pi] = (v4u){(unsigned)(chunk * 256 + tid), w2.x, w2.y, 0u}; }
            __syncthreads();
            if (tid < 32) hist[tid] = 0;
        }
    }
    __syncthreads();
}
__device__ __forceinline__ void final_norm_phase(Frame& F, const bf16* xb, float* out, const float* gamma, const float* shift, const float* scale, int mstride) {
    int tid_ = HW_TID(F.wave); asm volatile("" : "+v"(tid_)); int bid_ = blockIdx.x; asm volatile("" : "+s"(bid_)); const int bid = bid_; const int lane = tid_ & 63, wave = __builtin_amdgcn_readfirstlane(tid_ >> 6);
    for (int chunk = bid; chunk < NT / 256; chunk += F.G) {
        const int b = chunk >> 4;
        f32x4 ga[4], sb[4];
#pragma unroll
        for (int j = 0; j < 4; ++j) { const int col = 4 * lane + 256 * j; const f32x4 g = *(const f32x4*)(gamma + col), sc = *(const f32x4*)(scale + (size_t)b * mstride + col); sb[j] = *(const f32x4*)(shift + (size_t)b * mstride + col);
            ga[j] = g * (sc + 1.0f); }
        const int row0 = chunk * 256 + wave * 32;
        v2u tn[4];
#pragma unroll
        for (int j = 0; j < 4; ++j) tn[j] = ((const GAS v2u*)(xb + (size_t)row0 * DM) + lane)[64 * j];
#pragma clang loop unroll(disable)
        for (int i = 0; i < 32; ++i) {
            const int row = row0 + i;
            v2u t[4];
#pragma unroll
            for (int j = 0; j < 4; ++j) t[j] = tn[j];
            if (i + 1 < 32) {
#pragma unroll
                for (int j = 0; j < 4; ++j) tn[j] = ((const GAS v2u*)(xb + (size_t)(row + 1) * DM) + lane)[64 * j]; }
            GAS f32x4* orow = (GAS f32x4*)(out + (size_t)row * DM) + lane;
            f32x4 v[4]; float s = 0.f;
#pragma unroll
            for (int j = 0; j < 4; ++j) { v[j] = (f32x4){bf2f(t[j].x & 0xffffu), bf2f(t[j].x >> 16), bf2f(t[j].y & 0xffffu), bf2f(t[j].y >> 16)}; s += (v[j].x * v[j].x + v[j].y * v[j].y) + (v[j].z * v[j].z + v[j].w * v[j].w); }
            const float r = 1.0f / sqrtf(wave_sum(s) * (1.0f / DM) + EPS);
#pragma unroll
            for (int j = 0; j < 4; ++j) orow[64 * j] = v[j] * r * ga[j] + sb[j];
        }
    }
}

__device__ __forceinline__ void fcum_phase(Frame& F, const float* logf, float* FB) {
    LAS float* wtot = (LAS float*)(F.lds);
    int tid_ = HW_TID(F.wave); asm volatile("" : "+v"(tid_)); int bid_ = blockIdx.x; asm volatile("" : "+s"(bid_)); const int bid = bid_; const int tid = tid_, lane = tid & 63, wave = __builtin_amdgcn_readfirstlane(tid >> 6);
    for (int chain = bid; chain < NB * 16; chain += F.G) {
        const int b = chain >> 4, hh = chain & 15;
        float v[8]; float run = 0.f;
#pragma unroll
        for (int j = 0; j < 8; ++j) { run += logf[((size_t)b * SEQ + tid * 8 + j) * 16 + hh]; v[j] = run; }
        float inc = run;
#pragma unroll
        for (int o = 1; o < 64; o <<= 1) { const float t = __shfl_up(inc, o); if (lane >= o) inc += t; }
        if (lane == 63) wtot[wave] = inc;
        __syncthreads();
        float base = inc - run;
        for (int w = 0; w < wave; ++w) base += wtot[w];
#pragma unroll
        for (int j = 0; j < 8; ++j) FB[(size_t)chain * SEQ + tid * 8 + j] = -(base + v[j]) * 1.4426950408889634f;
        __syncthreads();
    }
}

__device__ __forceinline__ float wave_scan_add(float v, int lane) {
#pragma unroll
    for (int o = 1; o < 64; o <<= 1) { const float t = __shfl_up(v, o); if (lane >= o) v += t; }
    return v;
}
__device__ __forceinline__ float wave_scan_max(float v, int lane) {
#pragma unroll
    for (int o = 1; o < 64; o <<= 1) { const float t = __shfl_up(v, o); if (lane >= o) v = fmaxf(v, t); }
    return v;
}
__device__ __forceinline__ void cell_phase(Frame& F, const bf16* PROJ, const float* G16, const float* mhn, bf16* HS) {
    constexpr int PST = 72;
    LAS bf16* sQ = (LAS bf16*)(F.lds);
    LAS bf16* sK = sQ + 64 * PST;
    LAS bf16* sKT = sK + 64 * PST;
    LAS bf16* sW = sKT + 64 * PST;
    LAS bf16* sVT = sW + 64 * PST;
    LAS bf16* sCT = sVT + 128 * PST;
    LAS float* fz = (LAS float*)(sCT + 128 * PST);
    LAS float* sU = fz, *sM = fz + 64, *sA = fz + 128, *sEm = fz + 192, *sWk = fz + 256, *sInv = fz + 320, *sN = fz + 384, *sScal = fz + 448, *sSS = fz + 512;
    int tid_ = HW_TID(F.wave); asm volatile("" : "+v"(tid_)); int bid_ = blockIdx.x; asm volatile("" : "+s"(bid_)); const int bid = bid_;
    const int tid = tid_, lane = tid & 63, w = __builtin_amdgcn_readfirstlane(tid >> 6), fr = lane & 15, fq = lane >> 4;
    for (int chain = bid; chain < NB * 8; chain += F.G) {
        const int b = chain >> 3, hh = chain & 7;
        f32x4 accC[4];
#pragma unroll
        for (int ni = 0; ni < 4; ++ni) accC[ni] = (f32x4){0.f, 0.f, 0.f, 0.f};
        for (int i = tid; i < 128 * PST; i += 512) sCT[i] = 0;
        if (tid < 64) sN[tid] = 0.f;
        float m_prev = 0.f;
        __syncthreads();
        for (int c = 0; c < SEQ / 64; ++c) {
            const size_t t0 = (size_t)b * SEQ + 64 * c;
            const int row = tid >> 3, seg = tid & 7;
            const bf16* pr = PROJ + (t0 + row) * A_PROJ + hh * 64 + seg * 8;
            const v4u qv = *(const GAS v4u*)pr, kv = *(const GAS v4u*)(pr + 512);
            const bf16* pv = PROJ + (t0 + row) * A_PROJ + 1024 + hh * 128 + seg * 8;
            const v4u v0 = *(const GAS v4u*)pv, v1 = *(const GAS v4u*)(pv + 64);
            float ig = 0.f, lf = 0.f;
            if (tid < 64) { ig = G16[(t0 + tid) * 16 + hh]; lf = G16[(t0 + tid) * 16 + 8 + hh]; }
            *(LAS v4u*)(sQ + row * PST + seg * 8) = qv;
            *(LAS v4u*)(sK + row * PST + seg * 8) = kv;
#pragma unroll
            for (int j = 0; j < 4; ++j) { sVT[(seg * 8 + 2 * j) * PST + row] = (bf16)(v0[j] & 0xffffu); sVT[(seg * 8 + 2 * j + 1) * PST + row] = (bf16)(v0[j] >> 16);
                sVT[(64 + seg * 8 + 2 * j) * PST + row] = (bf16)(v1[j] & 0xffffu); sVT[(64 + seg * 8 + 2 * j + 1) * PST + row] = (bf16)(v1[j] >> 16); }
            if (w == 0) {
                const float bc = wave_scan_add(lf, lane), u = ig - bc, pm = wave_scan_max(u, lane), M = fmaxf(m_prev, pm);
                const float M63 = __shfl(M, 63), bl = __shfl(bc, 63);
                sU[lane] = u; sM[lane] = M; sA[lane] = __expf(m_prev - M); sEm[lane] = __expf(-(bc + M)); sWk[lane] = __expf(u - M63);
                if (lane == 0) { sScal[0] = __expf(m_prev - M63); sScal[1] = bl + M63; }
            }
            __syncthreads();
            { const float wk = sWk[row];
#pragma unroll
              for (int j = 0; j < 4; ++j) { sKT[(seg * 8 + 2 * j) * PST + row] = (bf16)f2bf(bf2f(kv[j] & 0xffffu) * wk); sKT[(seg * 8 + 2 * j + 1) * PST + row] = (bf16)f2bf(bf2f(kv[j] >> 16) * wk); } }
            { const int mi = w >> 1;
#pragma unroll
              for (int nn = 0; nn < 2; ++nn) { const int ni = (w & 1) * 2 + nn; f32x4 acc = (f32x4){0.f, 0.f, 0.f, 0.f};
#pragma unroll
                for (int ks = 0; ks < 2; ++ks) { const bf16x8 av = *(const LAS bf16x8*)(sQ + (16 * mi + fr) * PST + 32 * ks + 8 * fq), bv = *(const LAS bf16x8*)(sK + (16 * ni + fr) * PST + 32 * ks + 8 * fq);
                    acc = __builtin_amdgcn_mfma_f32_16x16x32_bf16(av, bv, acc, 0, 0, 0); }
                const int s = 16 * ni + fr; const float us = sU[s];
#pragma unroll
                for (int i = 0; i < 4; ++i) { const int t = 16 * mi + 4 * fq + i; const float wv = (s <= t) ? __expf(us - sM[t]) * acc[i] : 0.f; sW[t * PST + s] = (bf16)f2bf(wv); } } }
            __syncthreads();
            { const int t = tid >> 3, part = tid & 7; float d1 = 0.f, qn = 0.f;
#pragma unroll
              for (int j = 0; j < 8; ++j) { d1 += bf2f(sW[t * PST + part * 8 + j]); qn += bf2f(sQ[t * PST + part * 8 + j]) * sN[part * 8 + j]; }
              d1 += __shfl_xor(d1, 1); d1 += __shfl_xor(d1, 2); d1 += __shfl_xor(d1, 4); qn += __shfl_xor(qn, 1); qn += __shfl_xor(qn, 2); qn += __shfl_xor(qn, 4);
              const float den = d1 + sA[t] * qn; if (part == 0) sInv[t] = 1.0f / fmaxf(fabsf(den), sEm[t]); }
            f32x4 acc[4];
#pragma unroll
            for (int mi = 0; mi < 4; ++mi) acc[mi] = (f32x4){0.f, 0.f, 0.f, 0.f};
#pragma unroll
            for (int ks = 0; ks < 2; ++ks) { const bf16x8 bq = *(const LAS bf16x8*)(sCT + (16 * w + fr) * PST + 32 * ks + 8 * fq);
#pragma unroll
                for (int mi = 0; mi < 4; ++mi) { const bf16x8 av = *(const LAS bf16x8*)(sQ + (16 * mi + fr) * PST + 32 * ks + 8 * fq); acc[mi] = __builtin_amdgcn_mfma_f32_16x16x32_bf16(av, bq, acc[mi], 0, 0, 0); } }
#pragma unroll
            for (int mi = 0; mi < 4; ++mi)
#pragma unroll
                for (int i = 0; i < 4; ++i) acc[mi][i] *= sA[16 * mi + 4 * fq + i];
#pragma unroll
            for (int ks = 0; ks < 2; ++ks) { const bf16x8 bv = *(const LAS bf16x8*)(sVT + (16 * w + fr) * PST + 32 * ks + 8 * fq);
#pragma unroll
                for (int mi = 0; mi < 4; ++mi) { const bf16x8 av = *(const LAS bf16x8*)(sW + (16 * mi + fr) * PST + 32 * ks + 8 * fq); acc[mi] = __builtin_amdgcn_mfma_f32_16x16x32_bf16(av, bv, acc[mi], 0, 0, 0); } }
            __syncthreads();
#pragma unroll
            for (int mi = 0; mi < 4; ++mi)
#pragma unroll
                for (int i = 0; i < 4; ++i) { const int t = 16 * mi + 4 * fq + i; const float hv = acc[mi][i] * sInv[t]; acc[mi][i] = hv; float sq = hv * hv;
                    sq += __shfl_xor(sq, 1); sq += __shfl_xor(sq, 2); sq += __shfl_xor(sq, 4); sq += __shfl_xor(sq, 8); if (fr == 0) sSS[w * 64 + t] = sq; }
            __syncthreads();
            { const int col = hh * 128 + 16 * w + fr; const float mh = mhn[col];
#pragma unroll
              for (int mi = 0; mi < 4; ++mi)
#pragma unroll
                for (int i = 0; i < 4; ++i) { const int t = 16 * mi + 4 * fq + i; float tot = 0.f;
#pragma unroll
                    for (int ww = 0; ww < 8; ++ww) tot += sSS[ww * 64 + t];
                    const float rn = 1.0f / sqrtf(tot * (1.0f / 128.0f) + EPS);
                    const float og = bf2f(PROJ[(t0 + t) * A_PROJ + 2048 + col]);
                    HS[(t0 + t) * DM + col] = (bf16)f2bf(acc[mi][i] * rn * mh * og); } }
            { const float decay = sScal[0];
#pragma unroll
              for (int ni = 0; ni < 4; ++ni) accC[ni] = accC[ni] * decay;
#pragma unroll
              for (int ks = 0; ks < 2; ++ks) { const bf16x8 av = *(const LAS bf16x8*)(sVT + (16 * w + fr) * PST + 32 * ks + 8 * fq);
#pragma unroll
                for (int ni = 0; ni < 4; ++ni) { const bf16x8 bv = *(const LAS bf16x8*)(sKT + (16 * ni + fr) * PST + 32 * ks + 8 * fq); accC[ni] = __builtin_amdgcn_mfma_f32_16x16x32_bf16(av, bv, accC[ni], 0, 0, 0); } }
#pragma unroll
              for (int ni = 0; ni < 4; ++ni)
#pragma unroll
                for (int i = 0; i < 4; ++i) sCT[(16 * w + 4 * fq + i) * PST + 16 * ni + fr] = (bf16)f2bf(accC[ni][i]);
              const int d = tid >> 3, part = tid & 7; float sk = 0.f;
#pragma unroll
              for (int j = 0; j < 8; ++j) sk += bf2f(sKT[d * PST + part * 8 + j]);
              sk += __shfl_xor(sk, 1); sk += __shfl_xor(sk, 2); sk += __shfl_xor(sk, 4);
              if (part == 0) sN[d] = decay * sN[d] + sk;
              m_prev = sScal[1]; }
            __syncthreads();
        }
    }
}

typedef short v4i16_t __attribute__((ext_vector_type(4)));
__device__ __forceinline__ unsigned img_off(unsigned row, unsigned ch) { return 256u * row + 16u * (ch ^ (((row & 3u) << 2) | ((row >> 2) & 3u))); }
__device__ __forceinline__ bf16x8 tr_frag(const LAS unsigned char* img, int lane, int c, int rbase, int rstep) {
    const int q = (lane & 15) >> 2, p = lane & 3;
    const v4i16_t lo = __builtin_amdgcn_ds_read_tr16_b64_v4i16((LAS v4i16_t*)(img + img_off(rbase + q, 2 * c + (p >> 1)) + 8 * (p & 1)));
    const v4i16_t hi = __builtin_amdgcn_ds_read_tr16_b64_v4i16((LAS v4i16_t*)(img + img_off(rbase + rstep + q, 2 * c + (p >> 1)) + 8 * (p & 1)));
    return (bf16x8){lo[0], lo[1], lo[2], lo[3], hi[0], hi[1], hi[2], hi[3]};
}
__device__ __forceinline__ void cellA_phase(Frame& F, const bf16* PROJ, const float* G16, bf16* CTS, float* NS, float* MS, float* SCN) {
    LAS unsigned char* img0 = F.lds;
    LAS float* sU = (LAS float*)(F.lds + 32768);
    LAS float* sPM = sU + 4096;
    LAS float* sBL = sPM + 64;
    int tid_ = HW_TID(F.wave); asm volatile("" : "+v"(tid_)); int bid_ = blockIdx.x; asm volatile("" : "+s"(bid_)); const int bid = bid_;
    const int tid = tid_, lane = tid & 63, w = __builtin_amdgcn_readfirstlane(tid >> 6), fr = lane & 15, fq = lane >> 4;
    const int vt = w & 3, dh = w >> 2, row = tid >> 3, seg = tid & 7;
    bf16x8 ones;
#pragma unroll
    for (int j = 0; j < 8; ++j) ones[j] = (short)0x3F80;
    for (int chain = bid; chain < NB * 16; chain += F.G) {
        const int bh = chain >> 1, vh = chain & 1, b = bh >> 3, hh = bh & 7;
        float igs[8], lfs[8];
#pragma unroll
        for (int k = 0; k < 8; ++k) { const float* pg = G16 + ((size_t)b * SEQ + 64 * (w + 8 * k) + lane) * 16 + hh; igs[k] = ((const GAS float*)pg)[0]; lfs[k] = ((const GAS float*)pg)[8]; }
#pragma unroll
        for (int k = 0; k < 8; ++k) { const int c = w + 8 * k; const float ig = igs[k], lf = lfs[k];
            const float bc = wave_scan_add(lf, lane), u = ig - bc, pm = wave_scan_max(u, lane); sU[c * 64 + lane] = u; if (lane == 63) { sPM[c] = pm; sBL[c] = bc; }
            if (vh == 0) { GAS float* sv = (GAS float*)SCN + ((size_t)(bh * 64 + c) * 3) * 64 + lane; sv[0] = u; sv[64] = pm; sv[128] = bc; } }
        f32x4 accC[2], accN[2];
#pragma unroll
        for (int mt = 0; mt < 2; ++mt) { accC[mt] = (f32x4){0.f, 0.f, 0.f, 0.f}; accN[mt] = (f32x4){0.f, 0.f, 0.f, 0.f}; }
        float m_prev = 0.f;
        const bf16* pk = PROJ + ((size_t)b * SEQ + row) * A_PROJ + 512 + hh * 64 + seg * 8;
        const bf16* pv = PROJ + ((size_t)b * SEQ + row) * A_PROJ + 1024 + hh * 128 + vh * 64 + seg * 8;
        v4u kv = *(const GAS v4u*)pk, vv = *(const GAS v4u*)pv;
        pk += (size_t)64 * A_PROJ; pv += (size_t)64 * A_PROJ;
        v4u kv2 = *(const GAS v4u*)pk, vv2 = *(const GAS v4u*)pv;
        __syncthreads();
        for (int c = 0; c < SEQ / 64; ++c) {
            LAS unsigned char* img = img0 + (c & 1) * 16384;
            const float M63 = fmaxf(m_prev, sPM[c]), decay = __expf(m_prev - M63), m_new = sBL[c] + M63, wkr = __expf(sU[c * 64 + row] - M63);
            { bf16* cs = CTS + ((size_t)(bh * 64 + c) * 128 + vh * 64 + 16 * vt + fr) * 64 + 32 * dh + 4 * fq;
#pragma unroll
              for (int mt = 0; mt < 2; ++mt) { v2u o; o.x = pk2(accC[mt][0], accC[mt][1]); o.y = pk2(accC[mt][2], accC[mt][3]); *(GAS v2u*)(cs + 16 * mt) = o; }
              if (vh == 0 && vt == 0 && fr == 0) { *(GAS f32x4*)(NS + (size_t)(bh * 64 + c) * 64 + 32 * dh + 4 * fq) = accN[0]; *(GAS f32x4*)(NS + (size_t)(bh * 64 + c) * 64 + 32 * dh + 16 + 4 * fq) = accN[1]; }
              if (vh == 0 && tid == 0) ((GAS float*)MS)[bh * 64 + c] = m_prev; }
            { v4u ks;
#pragma unroll
              for (int j = 0; j < 4; ++j) ks[j] = pk2(bf2f(kv[j] & 0xffffu) * wkr, bf2f(kv[j] >> 16) * wkr);
              *(LAS v4u*)(img + img_off(row, seg)) = ks; *(LAS v4u*)(img + img_off(row, 8 + seg)) = vv; }
            kv = kv2; vv = vv2;
            if (c + 2 < SEQ / 64) { pk += (size_t)64 * A_PROJ; pv += (size_t)64 * A_PROJ; kv2 = *(const GAS v4u*)pk; vv2 = *(const GAS v4u*)pv; }
            __syncthreads();
#pragma unroll
            for (int mt = 0; mt < 2; ++mt) { accC[mt] = accC[mt] * decay; accN[mt] = accN[mt] * decay; }
#pragma unroll
            for (int ks = 0; ks < 2; ++ks) { const bf16x8 bv = tr_frag(img, lane, 4 + vt, 32 * ks + 8 * fq, 4);
#pragma unroll
                for (int mt = 0; mt < 2; ++mt) { const bf16x8 av = tr_frag(img, lane, 2 * dh + mt, 32 * ks + 8 * fq, 4);
                    accC[mt] = __builtin_amdgcn_mfma_f32_16x16x32_bf16(av, bv, accC[mt], 0, 0, 0); accN[mt] = __builtin_amdgcn_mfma_f32_16x16x32_bf16(av, ones, accN[mt], 0, 0, 0); } }
            m_prev = m_new;
        }
        __syncthreads();
    }
}
struct CellOps { bf16x8 oq[2], ok[4][2]; float u, pm, bc, m_c; };
#define CELL_LOAD_OPS(D, rb_, hh_, mi_) do { const size_t t0_ = (size_t)(rb_) * 64; const int bh_ = ((rb_) >> 6) * 8 + (hh_), c_ = (rb_) & 63; \
    _Pragma("unroll") for (int ks = 0; ks < 2; ++ks) D.oq[ks] = *(const GAS bf16x8*)(PROJ + (t0_ + 16 * (mi_) + fr) * A_PROJ + (hh_) * 64 + 32 * ks + 8 * fq); \
    _Pragma("unroll") for (int si = 0; si < 4; ++si) if (si <= (mi_)) { _Pragma("unroll") for (int ks = 0; ks < 2; ++ks) D.ok[si][ks] = *(const GAS bf16x8*)(PROJ + (t0_ + 16 * si + fr) * A_PROJ + 512 + (hh_) * 64 + 32 * ks + 8 * fq); } \
    { const GAS float* sv_ = (const GAS float*)SCN + ((size_t)(bh_ * 64 + c_) * 3) * 64 + lane; D.u = sv_[0]; D.pm = sv_[64]; D.bc = sv_[128]; } \
    D.m_c = ((const GAS float*)MS)[bh_ * 64 + c_]; } while (0)
__device__ __forceinline__ void cellB_phase(Frame& F, const bf16* PROJ, const float* G16, const float* mhn, const bf16* CTS, const float* NS, const float* MS, const float* SCN, bf16* HS, int local) {
    constexpr int OP = 136;
    LAS unsigned char* vimg0 = F.lds;
    LAS bf16* stg0 = (LAS bf16*)(F.lds + 65536);
    int tid_ = HW_TID(F.wave); asm volatile("" : "+v"(tid_)); int bid_ = blockIdx.x; asm volatile("" : "+s"(bid_)); const int bid = bid_;
    const int tid = tid_, lane = tid & 63, w = __builtin_amdgcn_readfirstlane(tid >> 6), fr = lane & 15, fq = lane >> 4;
    const int hs = w >> 2, wj = w & 3;
    LAS bf16* stg = stg0 + w * (16 * OP + 32);
    for (int rb = local ? 4 * bid : bid, rbe = local ? 4 * bid + 4 : NT / 64; rb < rbe; rb += local ? 1 : F.G) {
        const int b = rb >> 6, c = rb & 63; const size_t t0 = (size_t)rb * 64;
#pragma clang loop unroll(disable)
        for (int it = 0; it < 2; ++it) {
            __syncthreads();
#pragma unroll
            for (int ps = 0; ps < 2; ++ps) { const int hv = 4 * it + 2 * hs + ps;
#pragma unroll
                for (int k = 0; k < 4; ++k) { const int q = 4 * wj + k, row = 4 * q + (lane >> 4), pc = lane & 15, ch = pc ^ (((row & 3) << 2) | ((row >> 2) & 3));
                    __builtin_amdgcn_global_load_lds((const unsigned*)(PROJ + (t0 + row) * A_PROJ + 1024 + hv * 128 + ch * 8), (LAS unsigned*)(vimg0 + (2 * hs + ps) * 16384 + q * 1024), 16, 0, 0); } }
            CellOps nxt; CELL_LOAD_OPS(nxt, rb, 4 * it + 2 * hs, wj);
            asm volatile("s_waitcnt vmcnt(0)" ::: "memory"); __syncthreads();
#pragma clang loop unroll(disable)
            for (int ps = 0; ps < 2; ++ps) {
                const int hh = 4 * it + 2 * hs + ps, bh = b * 8 + hh, mi = ps ? 3 - wj : wj;
                const LAS unsigned char* vimg = vimg0 + (2 * hs + ps) * 16384;
#define qf nxt.oq
#define kf nxt.ok
            const float u = nxt.u, pm = nxt.pm, bc = nxt.bc, m_c = nxt.m_c;
            f32x4 nv[2][2];
            { const float* np = NS + (size_t)(bh * 64 + c) * 64;
#pragma unroll
              for (int ks = 0; ks < 2; ++ks) { nv[ks][0] = *(const GAS f32x4*)(np + 32 * ks + 8 * fq); nv[ks][1] = *(const GAS f32x4*)(np + 32 * ks + 8 * fq + 4); } }
            const bf16* ctp = CTS + ((size_t)(bh * 64 + c) * 128 + fr) * 64 + 8 * fq;
            bf16x8 ctf[4][2];
#pragma unroll
            for (int cv = 0; cv < 4; ++cv)
#pragma unroll
                for (int ks = 0; ks < 2; ++ks) ctf[cv][ks] = *(const GAS bf16x8*)(ctp + (size_t)cv * 16 * 64 + 32 * ks);
            asm volatile("" ::: "memory");
            const float M = fmaxf(m_c, pm), av = __expf(m_c - M), em = __expf(-(bc + M));
            const int tme = 16 * mi + fr;
            const float Mt = __shfl(M, tme), at = __shfl(av, tme), et = __shfl(em, tme);
            bf16x8 wf[2]; float d1 = 0.f;
#pragma unroll
            for (int si = 0; si < 4; ++si) {
                unsigned w01 = 0u, w23 = 0u;
                if (si <= mi) { f32x4 acc = (f32x4){0.f, 0.f, 0.f, 0.f};
#pragma unroll
                    for (int ks = 0; ks < 2; ++ks) acc = __builtin_amdgcn_mfma_f32_16x16x32_bf16(kf[si][ks], qf[ks], acc, 0, 0, 0);
                    float wv[4];
#pragma unroll
                    for (int i = 0; i < 4; ++i) { const int s = 16 * si + 4 * fq + i; const float us = __shfl(u, s); wv[i] = (s <= tme) ? __expf(us - Mt) * acc[i] : 0.f; }
                    w01 = pk2(wv[0], wv[1]); w23 = pk2(wv[2], wv[3]);
                    d1 += (bf2f(w01 & 0xffffu) + bf2f(w01 >> 16)) + (bf2f(w23 & 0xffffu) + bf2f(w23 >> 16)); }
                wf[si >> 1][(si & 1) * 4 + 0] = (short)(w01 & 0xffffu); wf[si >> 1][(si & 1) * 4 + 1] = (short)(w01 >> 16); wf[si >> 1][(si & 1) * 4 + 2] = (short)(w23 & 0xffffu); wf[si >> 1][(si & 1) * 4 + 3] = (short)(w23 >> 16);
            }
            d1 += __shfl_xor(d1, 16); d1 += __shfl_xor(d1, 32);
            float qn = 0.f;
#pragma unroll
            for (int ks = 0; ks < 2; ++ks)
#pragma unroll
                for (int j = 0; j < 8; ++j) qn += bf2f((unsigned)(unsigned short)qf[ks][j]) * nv[ks][j >> 2][j & 3];
            qn += __shfl_xor(qn, 16); qn += __shfl_xor(qn, 32);
            const float inv = 1.0f / fmaxf(fabsf(d1 + at * qn), et);
            asm volatile("" ::: "memory");
            v4u og[2][2];
#pragma unroll
            for (int hlf = 0; hlf < 2; ++hlf) { const bf16* po = PROJ + (t0 + 16 * mi + (lane >> 3) + 8 * hlf) * A_PROJ + 2048 + hh * 128 + (lane & 7) * 16; og[hlf][0] = *(const GAS v4u*)po; og[hlf][1] = *(const GAS v4u*)(po + 8); }
            asm volatile("" ::: "memory");
            float a_i[4], inv_i[4];
#pragma unroll
            for (int i = 0; i < 4; ++i) { a_i[i] = __shfl(at, 4 * fq + i); inv_i[i] = __shfl(inv, 4 * fq + i); }
            float ssq[4] = {0.f, 0.f, 0.f, 0.f};
#pragma unroll
            for (int cv = 0; cv < 8; ++cv) { f32x4 a = (f32x4){0.f, 0.f, 0.f, 0.f};
#pragma unroll
                for (int ks = 0; ks < 2; ++ks) a = __builtin_amdgcn_mfma_f32_16x16x32_bf16(qf[ks], ctf[cv & 3][ks], a, 0, 0, 0);
                if (cv < 4) {
#pragma unroll
                    for (int ks = 0; ks < 2; ++ks) ctf[cv & 3][ks] = *(const GAS bf16x8*)(ctp + (size_t)(cv + 4) * 16 * 64 + 32 * ks); }
#pragma unroll
                for (int i = 0; i < 4; ++i) a[i] *= a_i[i];
#pragma unroll
                for (int ks = 0; ks < 2; ++ks) if (2 * ks <= mi) { const bf16x8 vf = tr_frag(vimg, lane, cv, 32 * ks + 4 * fq, 16); a = __builtin_amdgcn_mfma_f32_16x16x32_bf16(wf[ks], vf, a, 0, 0, 0); }
#pragma unroll
                for (int i = 0; i < 4; ++i) { a[i] *= inv_i[i]; ssq[i] += a[i] * a[i]; stg[(4 * fq + i) * OP + 16 * cv + fr] = (bf16)f2bf(a[i]); } }
            float rn[4];
#pragma unroll
            for (int i = 0; i < 4; ++i) { float s = ssq[i]; s += __shfl_xor(s, 1); s += __shfl_xor(s, 2); s += __shfl_xor(s, 4); s += __shfl_xor(s, 8); rn[i] = 1.0f / sqrtf(s * (1.0f / 128.0f) + EPS); }
            { LAS float* srn = (LAS float*)(stg + 16 * OP);
#pragma unroll
              for (int i = 0; i < 4; ++i) if (fr == 0) srn[4 * fq + i] = rn[i]; }
            LDS_WAIT(); asm volatile("" ::: "memory");
            f32x4 mhq[4];
#pragma unroll
            for (int q = 0; q < 4; ++q) mhq[q] = ((const GAS f32x4*)(mhn + hh * 128 + (lane & 7) * 16))[q];
#pragma unroll
            for (int hlf = 0; hlf < 2; ++hlf) { const int r = (lane >> 3) + 8 * hlf, sg = lane & 7;
                const v4u h0 = *(const LAS v4u*)(stg + r * OP + sg * 16), h1 = *(const LAS v4u*)(stg + r * OP + sg * 16 + 8);
                const v4u g0 = og[hlf][0], g1 = og[hlf][1]; v4u o0, o1; const float rnr = ((const LAS float*)(stg + 16 * OP))[r];
#pragma unroll
                for (int j = 0; j < 4; ++j) { const f32x4 m0 = mhq[j >> 1], m1 = mhq[2 + (j >> 1)]; const int e = (j & 1) * 2;
                    o0[j] = pk2(bf2f(h0[j] & 0xffffu) * rnr * m0[e] * bf2f(g0[j] & 0xffffu), bf2f(h0[j] >> 16) * rnr * m0[e + 1] * bf2f(g0[j] >> 16));
                    o1[j] = pk2(bf2f(h1[j] & 0xffffu) * rnr * m1[e] * bf2f(g1[j] & 0xffffu), bf2f(h1[j] >> 16) * rnr * m1[e + 1] * bf2f(g1[j] >> 16)); }
                if (OUT_F8) { v4u o8;
#pragma unroll
                    for (int j = 0; j < 2; ++j) { int w0 = 0, w1 = 0;
                        w0 = cvt8(bf2f(o0[2 * j] & 0xffffu), bf2f(o0[2 * j] >> 16), w0, false); w0 = cvt8(bf2f(o0[2 * j + 1] & 0xffffu), bf2f(o0[2 * j + 1] >> 16), w0, true);
                        w1 = cvt8(bf2f(o1[2 * j] & 0xffffu), bf2f(o1[2 * j] >> 16), w1, false); w1 = cvt8(bf2f(o1[2 * j + 1] & 0xffffu), bf2f(o1[2 * j + 1] >> 16), w1, true);
                        o8[j] = (unsigned)w0; o8[2 + j] = (unsigned)w1; }
                    *(GAS v4u*)((unsigned char*)HS + (t0 + 16 * mi + r) * DM + hh * 128 + sg * 16) = o8; }
                else { bf16* ho = HS + (t0 + 16 * mi + r) * DM + hh * 128 + sg * 16;
                    *(GAS v4u*)ho = o0; *(GAS v4u*)(ho + 8) = o1; } }
            LDS_WAIT(); asm volatile("" ::: "memory");
            if (ps == 0) CELL_LOAD_OPS(nxt, rb, hh + 1, 3 - wj);
            }
#undef qf
#undef kf
        }
    }
    __syncthreads();
}

struct DenseProb {
    const bf16* A; int lda; const bf16* Bt; int ldb; int K; int esz, scale_w, scale_a; pg8::StaticOrder S;
    int local, lw;
    __device__ __forceinline__ bool next(int i, pg8::Unit& u) const { if (local) { if (i >= S.nN) return false; u.pm = lw; u.pn = i; u.cls = 0; u.lb = 0; u.hf = 0; u.r0 = 0; return true; } return S.next(i, u); }
    __device__ __forceinline__ const char* a_base() const { return (const char*)A; }
    __device__ __forceinline__ void a_off(const pg8::Unit& u, int R0, int C0, unsigned (&o)[2][2]) const {
#pragma unroll
        for (int h = 0; h < 2; ++h)
#pragma unroll
            for (int i = 0; i < 2; ++i) o[h][i] = (unsigned)((u.pm * 256 + h * 128 + R0 + 64 * i) * lda) * esz + (unsigned)C0 * 2u; }
    __device__ __forceinline__ const char* b_tile(const pg8::Unit& u, int tt) const { return (const char*)Bt + (size_t)u.pn * 256 * ldb * esz + (size_t)tt * 128; }
};
struct ClassTab { const LAS int* blkstart; const LAS int* ncls; };
__device__ __forceinline__ void class_of(const ClassTab& T, pg8::Unit& u) { const int c = T.blkstart[64 + u.pm]; u.cls = c; u.lb = u.pm - T.blkstart[c]; }
__device__ __forceinline__ void pair_of(int cls, int& ea, int& eb) { const int g = cls / 6, p = cls % 6; const int a = p < 3 ? 0 : p < 5 ? 1 : 2, b = p < 3 ? p + 1 : p < 5 ? p - 1 : 3; ea = g * 4 + a; eb = g * 4 + b; }
struct Moe1Prob {
    const bf16* A; int ldb; int K; int esz, scale_w, scale_a; int dense_dbg; const bf16* Bt1l; const int* perm; ClassTab T; pg8::StaticOrder S;
    __device__ __forceinline__ bool next(int i, pg8::Unit& u) const { if (!S.next(i, u)) return false; class_of(T, u); return true; }
    __device__ __forceinline__ const char* a_base() const { return (const char*)A; }
    __device__ __forceinline__ void a_off(const pg8::Unit& u, int R0, int C0, unsigned (&o)[2][2]) const {
        const int n = T.ncls[u.cls];
#pragma unroll
        for (int h = 0; h < 2; ++h)
#pragma unroll
            for (int i = 0; i < 2; ++i) { int pos = u.lb * 256 + h * 128 + R0 + 64 * i; pos = pos < n ? pos : n - 1; int tok = perm[(size_t)u.cls * CLS_CAP + pos]; if (dense_dbg) tok = u.pm * 256 + h * 128 + R0 + 64 * i; o[h][i] = (unsigned)(tok * DM) * esz + (unsigned)C0 * 2u; } }
    __device__ __forceinline__ const char* b_tile(const pg8::Unit& u, int tt) const { int ea, eb; pair_of(u.cls, ea, eb); const int e = u.pn < 4 ? ea : eb;
        return (const char*)Bt1l + ((size_t)e * 1024 + (size_t)(u.pn & 3) * 256) * DM * esz + (size_t)tt * 128; }
};
struct Moe2Prob {
    const bf16* A; int ldb; int K; int esz, scale_w, scale_a; int halfmode; const bf16* Bt2l; ClassTab T; pg8::StaticOrder S;
    __device__ __forceinline__ bool next(int i, pg8::Unit& u) const {
        const int R = S.nwg / S.G, rem = S.nwg - R * S.G;
        if (2 * rem > S.G) { if (halfmode || !S.next(i, u)) return false; class_of(T, u); return true; }
        if (!halfmode) { if (i >= R || !S.next(i, u)) return false; class_of(T, u); return true; }
        if (i > 0 || S.c >= 2 * rem) return false;
        if (!S.next_L((long)R * S.G + (S.c >> 1), u)) return false;
        u.hf = 1; u.r0 = 128 * (S.c & 1); class_of(T, u); return true; }
    __device__ __forceinline__ const char* a_base() const { return (const char*)A; }
    __device__ __forceinline__ void a_off(const pg8::Unit& u, int R0, int C0, unsigned (&o)[2][2]) const {
#pragma unroll
        for (int h = 0; h < 2; ++h)
#pragma unroll
            for (int i = 0; i < 2; ++i) o[h][i] = (unsigned)((u.pm * 256 + h * 128 + R0 + 64 * i) * DM) * esz + (unsigned)C0 * 2u; }
    __device__ __forceinline__ const char* b_tile(const pg8::Unit& u, int tt) const { int ea, eb; pair_of(u.cls, ea, eb); const int half = (esz == 2) ? 8 : 4; const int e = tt < half ? ea : eb;
        return (const char*)Bt2l + ((size_t)e * 1024 + (size_t)u.pn * 256 + u.r0) * DE * esz + (size_t)(tt & (half - 1)) * 128; }
};

struct EpiProj {
    static constexpr bool PERM = true;
    bf16* O; int ldc; int split_cols; size_t split_stride; int nscale; float scale; int sig_from;
    __device__ __forceinline__ void operator()(const pg8::f32x4 (&acc)[2][2][4][2], const pg8::Unit& u, int wr, int wc, int fr, int fq) const {
        const int row0 = u.pm * 256 + wr * 64 + fr; int colt = u.pn * 256; bf16* base = O;
        if (split_cols) { const int t = colt / split_cols; base += (size_t)t * split_stride; colt -= t * split_cols; }
        const float sc = u.pn < nscale ? scale : 1.0f; const bool sg = u.pn >= sig_from;
        const int col0 = colt + wc * 32 + 8 * fq;
#pragma unroll
        for (int ai = 0; ai < 2; ++ai)
#pragma unroll
            for (int m = 0; m < 4; ++m) { bf16* rowp = base + (size_t)(row0 + ai * 128 + m * 16) * ldc + col0;
#pragma unroll
                for (int bj = 0; bj < 2; ++bj) { pg8::f32x4 v0 = acc[ai][bj][m][0] * sc, v1 = acc[ai][bj][m][1] * sc;
                    if (sg) {
#pragma unroll
                        for (int j = 0; j < 4; ++j) { v0[j] = pg8::sigmoidf_(v0[j]); v1[j] = pg8::sigmoidf_(v1[j]); } }
                    pg8::u32x4 w; w.x = pg8::cvt_pk_bf16(v0[0], v0[1]); w.y = pg8::cvt_pk_bf16(v0[2], v0[3]); w.z = pg8::cvt_pk_bf16(v1[0], v1[1]); w.w = pg8::cvt_pk_bf16(v1[2], v1[3]);
                    *(pg8::u32x4*)(rowp + bj * 128) = w; } }
    }
};
#ifndef ERES_RB
#define ERES_RB 4
#endif
#ifndef ERES_RF
#define ERES_RF 2
#endif
struct EpiRes {
    static constexpr bool PERM = true;
    const void* base; int base_bf; bf16* out; const float* gate; int gstride;
    __device__ __forceinline__ void operator()(const pg8::f32x4 (&acc)[2][2][4][2], const pg8::Unit& u, int wr, int wc, int fr, int fq) const {
        const int row0 = u.pm * 256 + wr * 64 + fr, col0 = u.pn * 256 + wc * 32 + 8 * fq;
        const float* gp = gate + (size_t)(u.pm >> 4) * gstride + col0;
        pg8::f32x4 gv[2][2];
#pragma unroll
        for (int bj = 0; bj < 2; ++bj)
#pragma unroll
            for (int n = 0; n < 2; ++n) gv[bj][n] = *(const GAS pg8::f32x4*)(gp + bj * 128 + n * 4);
        if (base_bf) {
            constexpr int RB = ERES_RB;
#pragma unroll
            for (int g = 0; g < 8 / RB; ++g) {
                pg8::u32x4 t[RB][2];
#pragma unroll
                for (int q = 0; q < RB; ++q) { const int r = g * RB + q, ai = r >> 2, m = r & 3; const unsigned off = ((unsigned)(row0 + ai * 128 + m * 16) * DM + (unsigned)col0) * 2u;
#pragma unroll
                    for (int bj = 0; bj < 2; ++bj) t[q][bj] = *(const GAS pg8::u32x4*)((const GAS char*)base + off + bj * 256); }
#pragma unroll
                for (int q = 0; q < RB; ++q) { const int r = g * RB + q, ai = r >> 2, m = r & 3; const unsigned off = ((unsigned)(row0 + ai * 128 + m * 16) * DM + (unsigned)col0) * 2u;
#pragma unroll
                    for (int bj = 0; bj < 2; ++bj) { const pg8::u32x4 tt = t[q][bj];
                        const pg8::f32x4 b0 = (pg8::f32x4){bf2f(tt.x & 0xffffu), bf2f(tt.x >> 16), bf2f(tt.y & 0xffffu), bf2f(tt.y >> 16)}, b1 = (pg8::f32x4){bf2f(tt.z & 0xffffu), bf2f(tt.z >> 16), bf2f(tt.w & 0xffffu), bf2f(tt.w >> 16)};
                        const pg8::f32x4 v0 = b0 + gv[bj][0] * acc[ai][bj][m][0], v1 = b1 + gv[bj][1] * acc[ai][bj][m][1];
                        pg8::u32x4 w; w.x = pg8::cvt_pk_bf16(v0[0], v0[1]); w.y = pg8::cvt_pk_bf16(v0[2], v0[3]); w.z = pg8::cvt_pk_bf16(v1[0], v1[1]); w.w = pg8::cvt_pk_bf16(v1[2], v1[3]);
                        *(GAS pg8::u32x4*)((GAS char*)out + off + bj * 256) = w; } } }
        } else {
            constexpr int RF = ERES_RF;
#pragma unroll
            for (int g = 0; g < 8 / RF; ++g) {
                pg8::f32x4 f0[RF][2], f1[RF][2];
#pragma unroll
                for (int q = 0; q < RF; ++q) { const int r = g * RF + q, ai = r >> 2, m = r & 3; const size_t off = (size_t)(row0 + ai * 128 + m * 16) * DM + col0;
#pragma unroll
                    for (int bj = 0; bj < 2; ++bj) { f0[q][bj] = *(const GAS pg8::f32x4*)((const float*)base + off + bj * 128); f1[q][bj] = *(const GAS pg8::f32x4*)((const float*)base + off + bj * 128 + 4); } }
#pragma unroll
                for (int q = 0; q < RF; ++q) { const int r = g * RF + q, ai = r >> 2, m = r & 3; const size_t off = (size_t)(row0 + ai * 128 + m * 16) * DM + col0;
#pragma unroll
                    for (int bj = 0; bj < 2; ++bj) {
                        const pg8::f32x4 v0 = f0[q][bj] + gv[bj][0] * acc[ai][bj][m][0], v1 = f1[q][bj] + gv[bj][1] * acc[ai][bj][m][1];
                        pg8::u32x4 w; w.x = pg8::cvt_pk_bf16(v0[0], v0[1]); w.y = pg8::cvt_pk_bf16(v0[2], v0[3]); w.z = pg8::cvt_pk_bf16(v1[0], v1[1]); w.w = pg8::cvt_pk_bf16(v1[2], v1[3]);
                        *(GAS pg8::u32x4*)(out + off + bj * 128) = w; } } }
        }
    }
};
#ifndef MOE2_HALF_FIRST
#define MOE2_HALF_FIRST 1
#endif
#ifndef REP_MOE2
#define REP_MOE2 1
#endif
#ifndef REP_MOE1
#define REP_MOE1 1
#endif
#ifndef ESC_RB
#define ESC_RB 4
#endif
struct EpiResScatter {
    static constexpr bool PERM = true;
    bf16* x; const bf16* gate16; int gstride; const int* perm; ClassTab T; int skip = 0;
    __device__ __forceinline__ void operator()(const pg8::f32x4 (&acc)[2][2][4][2], const pg8::Unit& u, int wr, int wc, int fr, int fq) const {
#if REP_MOE2 > 1
        if (skip) return;
#endif
        const int n = T.ncls[u.cls]; const int col0 = u.pn * 256 + u.r0 + wc * 32 + 8 * fq;
        int tok[2][4];
#pragma unroll
        for (int ai = 0; ai < 2; ++ai)
#pragma unroll
            for (int m = 0; m < 4; ++m) { int pos = u.lb * 256 + ai * 128 + wr * 64 + m * 16 + fr; pos = pos < n ? pos : n - 1; tok[ai][m] = ((const GAS int*)perm)[(size_t)u.cls * CLS_CAP + pos]; }
#pragma unroll
        for (int g_ = 0; g_ < 8 / ESC_RB; ++g_) {
            pg8::u32x4 xv[ESC_RB][2], gw[ESC_RB][2];
#pragma unroll
            for (int q = 0; q < ESC_RB; ++q) { const int r_ = g_ * ESC_RB + q, ai = r_ >> 2, m = r_ & 3; const int tk = tok[ai][m]; const GAS char* xp = (const GAS char*)x + ((unsigned)tk * DM + (unsigned)col0) * 2u; const GAS char* gp = (const GAS char*)gate16 + ((unsigned)(tk >> 12) * (unsigned)gstride + (unsigned)col0) * 2u;
#pragma unroll
                for (int bj = 0; bj < 2; ++bj) { if (bj == 1 && u.hf) continue; xv[q][bj] = *(const GAS pg8::u32x4*)(xp + bj * 256); gw[q][bj] = *(const GAS pg8::u32x4*)(gp + bj * 256); } }
#pragma unroll
            for (int q = 0; q < ESC_RB; ++q) { const int r_ = g_ * ESC_RB + q, ai = r_ >> 2, m = r_ & 3; const int pos = u.lb * 256 + ai * 128 + wr * 64 + m * 16 + fr;
                if (pos < n) { GAS char* xp = (GAS char*)x + ((unsigned)tok[ai][m] * DM + (unsigned)col0) * 2u;
#pragma unroll
                    for (int bj = 0; bj < 2; ++bj) { if (bj == 1 && u.hf) continue; const pg8::u32x4 t = xv[q][bj], g = gw[q][bj];
                        const pg8::f32x4 b0 = (pg8::f32x4){bf2f(t.x & 0xffffu), bf2f(t.x >> 16), bf2f(t.y & 0xffffu), bf2f(t.y >> 16)}, b1 = (pg8::f32x4){bf2f(t.z & 0xffffu), bf2f(t.z >> 16), bf2f(t.w & 0xffffu), bf2f(t.w >> 16)};
                        const pg8::f32x4 g0 = (pg8::f32x4){bf2f(g.x & 0xffffu), bf2f(g.x >> 16), bf2f(g.y & 0xffffu), bf2f(g.y >> 16)}, g1 = (pg8::f32x4){bf2f(g.z & 0xffffu), bf2f(g.z >> 16), bf2f(g.w & 0xffffu), bf2f(g.w >> 16)};
                        const pg8::f32x4 v0 = b0 + g0 * acc[ai][bj][m][0], v1 = b1 + g1 * acc[ai][bj][m][1];
                        pg8::u32x4 w; w.x = pg8::cvt_pk_bf16(v0[0], v0[1]); w.y = pg8::cvt_pk_bf16(v0[2], v0[3]); w.z = pg8::cvt_pk_bf16(v1[0], v1[1]); w.w = pg8::cvt_pk_bf16(v1[2], v1[3]);
                        *(GAS pg8::u32x4*)(xp + bj * 256) = w; } } } }
    }
};
struct EpiAct {
    static constexpr bool PERM = true;
    bf16* act; const int* perm; const float2* wts; ClassTab T; int skip = 0;
    __device__ __forceinline__ void operator()(const pg8::f32x4 (&acc)[2][2][4][2], const pg8::Unit& u, int wr, int wc, int fr, int fq) const {
#if REP_MOE1 > 1
        if (skip) return;
#endif
        const int n = T.ncls[u.cls]; const int second = u.pn >> 2; const int col0 = second * 512 + (u.pn & 3) * 128 + wc * 32 + 8 * fq;
        float wtv[2][4];
#pragma unroll
        for (int ai = 0; ai < 2; ++ai)
#pragma unroll
            for (int m = 0; m < 4; ++m) { int pos = u.lb * 256 + ai * 128 + wr * 64 + m * 16 + fr; pos = pos < n ? pos : n - 1;
                const pg8::u32x2 pe = *(const GAS pg8::u32x2*)((const unsigned*)wts + ((size_t)u.cls * CLS_CAP + pos) * 4 + 1); wtv[ai][m] = __builtin_bit_cast(float, second ? pe.y : pe.x); }
#pragma unroll
        for (int ai = 0; ai < 2; ++ai)
#pragma unroll
            for (int m = 0; m < 4; ++m) { const int lr = ai * 128 + wr * 64 + m * 16 + fr; const float wt = wtv[ai][m];
                pg8::f32x4 g0 = acc[ai][0][m][0], g1 = acc[ai][0][m][1]; const pg8::f32x4 u0 = acc[ai][1][m][0], u1 = acc[ai][1][m][1];
#pragma unroll
                for (int j = 0; j < 4; ++j) { g0[j] = g0[j] * pg8::sigmoidf_(g0[j]) * u0[j] * wt; g1[j] = g1[j] * pg8::sigmoidf_(g1[j]) * u1[j] * wt; }
                if (MOE2_F8) { int w0 = 0, w1 = 0;
                    w0 = cvt8(g0[0] * 4.f, g0[1] * 4.f, w0, false); w0 = cvt8(g0[2] * 4.f, g0[3] * 4.f, w0, true);
                    w1 = cvt8(g1[0] * 4.f, g1[1] * 4.f, w1, false); w1 = cvt8(g1[2] * 4.f, g1[3] * 4.f, w1, true);
                    pg8::u32x2 w; w.x = (unsigned)w0; w.y = (unsigned)w1; *(pg8::u32x2*)((unsigned char*)act + (size_t)(u.pm * 256 + lr) * DM + col0) = w; }
                else { pg8::u32x4 w; w.x = pg8::cvt_pk_bf16(g0[0], g0[1]); w.y = pg8::cvt_pk_bf16(g0[2], g0[3]); w.z = pg8::cvt_pk_bf16(g1[0], g1[1]); w.w = pg8::cvt_pk_bf16(g1[2], g1[3]);
                    *(pg8::u32x4*)(act + (size_t)(u.pm * 256 + lr) * DM + col0) = w; } }
    }
};
__device__ __forceinline__ void build_class_tab(Frame& F, gu32* gcnt) {
    LAS int* blkstart = (LAS int*)(F.lds + TAB_OFF); LAS int* ncls = blkstart + 32;
    const int t = HW_TID(F.wave);
    if (t < NCLS) ncls[t] = (int)__hip_atomic_load(gcnt + t, RLX_AGENT);
    __syncthreads();
    if (t == 0) { int run = 0; for (int c = 0; c < NCLS; ++c) { blkstart[c] = run; run += (ncls[c] + 255) >> 8; } blkstart[NCLS] = run; }
    __syncthreads();
    if (t < blkstart[NCLS]) { int c = 0; while (c < NCLS - 1 && t >= blkstart[c + 1]) ++c; blkstart[64 + t] = c; }
    __syncthreads();
}

__global__ void __launch_bounds__(NWAVES * 64, 2) mk_fwd(Args args) {
    extern __shared__ __attribute__((aligned(16))) unsigned char lds[];
    Frame F;
    F.lds = (LAS unsigned char*)lds;
    F.MISC = (volatile LAS unsigned*)(F.lds + MISC_OFF);
    F.wave = __builtin_amdgcn_readfirstlane((int)threadIdx.x >> 6);
    F.G = gridDim.x; { const int bx = blockIdx.x; F.vcu = (F.G % 8 == 0) ? (bx % 8) * (F.G / 8) + bx / 8 : bx; F.cid = bx; }
    unsigned char* ws = args.ws;
    F.ctl = (gu32*)(ws + WS_CTL);
    for (int u = HW_TID(F.wave); u < (LDS_BYTES - LDSCTL_OFF) / 4; u += NWAVES * 64) ((LAS unsigned*)(F.lds + LDSCTL_OFF))[u] = 0u;
    __syncthreads();
    const int lo = args.ph_lo, hi = args.ph_hi;
    const bool multi = (hi - lo) > 1;
    XcdBarrier bar; bar.bar = (unsigned*)(F.ctl + CW_BAR); bar.x = 0; bar.st = nullptr; bar.w0 = F.wave;
    if (multi) bar = xcd_barrier_post((unsigned*)(F.ctl + CW_BAR), F.MISC + 8, F.wave);
    if (multi && HW_TID(F.wave) == 0) { const unsigned xcc = xb_xcc_id(); F.MISC[20] = xcc; F.MISC[21] = __hip_atomic_fetch_add(F.ctl + CW_XCCT + 64 * xcc, 1u, RLX_AGENT); }
    int ph = 0;
#define REPEAT(N) _Pragma("clang loop unroll(disable)") for (int rep_ = 0; rep_ < (N); ++rep_)
#ifndef REP_NORM1
#define REP_NORM1 1
#endif
#ifndef REP_PROJ
#define REP_PROJ 1
#endif
#ifndef REP_CELL
#define REP_CELL 1
#endif
#ifndef REP_CELLB
#define REP_CELLB 1
#endif
#ifndef REP_ATTN_NOFB
#define REP_ATTN_NOFB 0
#endif
#ifndef REP_ATTN
#define REP_ATTN 1
#endif
#ifndef REP_MOE1_DENSE
#define REP_MOE1_DENSE 0
#endif
#ifndef REP_MOE1
#define REP_MOE1 1
#endif
#ifndef REP_MOE2
#define REP_MOE2 1
#endif
#ifndef REP_MOE2_SKIP
#define REP_MOE2_SKIP 0
#endif
#ifndef REP_MOE1_SKIP
#define REP_MOE1_SKIP 0
#endif
#ifndef REP_NORM2N
#define REP_NORM2N 0
#endif
#ifdef PROBE_TYPE
    const bool pr_me = (blockIdx.x == 0 && HW_TID(F.wave) == 0);
#define PH_BEGIN(run, ty) const bool run = (lo <= ph && ph < hi); ++ph; const bool pr_on = pr_me && ((ty) == PROBE_TYPE); if (pr_on) { const unsigned long long t_ = __builtin_amdgcn_s_memrealtime(); F.MISC[16] = (unsigned)t_; F.MISC[17] = (unsigned)(t_ >> 32); }
#define PH_END(run) do { if (run && ph < hi) xcd_barrier(bar); if (pr_on) { const unsigned long long t0_ = ((unsigned long long)F.MISC[17] << 32) | F.MISC[16], a_ = (((unsigned long long)F.MISC[19] << 32) | F.MISC[18]) + (__builtin_amdgcn_s_memrealtime() - t0_); F.MISC[18] = (unsigned)a_; F.MISC[19] = (unsigned)(a_ >> 32); } } while (0)
#else
#define PH_BEGIN(run, ty) const bool run = (lo <= ph && ph < hi); ++ph;
#define PH_END(run) do { if (run && ph < hi) xcd_barrier(bar); } while (0)
#endif
    const bool chain = FUSE_LOCAL && (F.G == NT / 256);
#define PH_END_CHAIN(run) do { if (chain) { if (run && ph < hi) { asm volatile("s_waitcnt vmcnt(0)" ::: "memory"); __syncthreads(); } } else PH_END(run); } while (0)

    bf16* const X = (bf16*)(args.ws + WS_XB);

    { PH_BEGIN(run, 0) if (run) {
#ifndef DIS_P0
 p0_prologue(F, args);
#endif
 } PH_END(run); }

    if (multi && lo == 0 && F.G == 256) {
        unsigned cj[8];
#pragma unroll
        for (int j = 0; j < 8; ++j) cj[j] = __hip_atomic_load(F.ctl + CW_XCCT + 64 * j, RLX_AGENT);
        bool ok = true;
#pragma unroll
        for (int j = 0; j < 8; ++j) ok = ok & (cj[j] == 32u);
        if (ok) { const int xcc = (int)F.MISC[20], idx = (int)F.MISC[21]; F.vcu = __builtin_amdgcn_readfirstlane(xcc * 32 + idx); F.cid = __builtin_amdgcn_readfirstlane(idx * 8 + xcc); }
    }
    for (int step = 0; step < 5; ++step) {
        unsigned char* ws = args.ws; asm volatile("" : "+s"(ws));
        float* const MODS = (float*)(ws + WS_MODS);
        bf16* const HB = (bf16*)(ws + WS_HB);
        bf16* const BIG = (bf16*)(ws + WS_BIG);
        bf16* const ACT = (bf16*)(ws + WS_ACT);
        float* const G16 = (float*)(ws + WS_G16);
        float* const FB = (float*)(ws + WS_FB);
        float2* const WTS = (float2*)(ws + WS_PW);
        int* const PERM = (int*)(ws + WS_PERM);
        bf16* const Kb = BIG; bf16* const Vb = BIG + (size_t)NT * DM; bf16* const Qb = BIG + (size_t)2 * NT * DM;
        const int kind = step < 2 ? 0 : step == 2 ? 1 : 2;
        const int L = step < 2 ? step : step == 2 ? 2 : step - 1;
        const void* xin = (L == 0) ? (const void*)args.in[I_X] : (const void*)X; const int xin_bf = (L != 0);
        const float* mods = MODS + (size_t)L * NB * 6144;
        { PH_BEGIN(run, 1) if (run) {
#ifndef DIS_NORM1
            const float* gam = kind == 1 ? args.in[I_KVNORM] : args.in[I_NMIX] + L * DM;
            const float* shf = kind == 1 ? (const float*)(ws + WS_KVMOD) : mods; const float* scl = shf + 1024; const int mstr = kind == 1 ? 2048 : 6144;
            const int nmode = kind == 0 ? 1 : kind == 1 ? 2 : 0;
            const float* w16 = kind == 0 ? args.in[I_AWIN] + (size_t)L * DM * A_IN + A_PROJ : args.in[I_WKV] + 2048; const int ldw16 = kind == 0 ? A_IN : KV_OUT;
            const float* b16 = kind == 0 ? args.in[I_ABG] + L * 16 : args.in[I_BFG];
            REPEAT(REP_NORM1) normT_phase<false>(F, xin, xin_bf, gam, shf, scl, mstr, HB, nmode, w16, ldw16, b16, G16, nullptr, nullptr, nullptr);
#endif
          } if (kind == 1) PH_END(run); else PH_END_CHAIN(run); }
        { PH_BEGIN(run, 2) if (run) {
#ifndef DIS_PROJ
            if (kind == 1) fcum_phase(F, G16, FB);
            DenseProb P; P.A = HB; P.lda = DM; P.ldb = DM; P.K = DM; P.esz = PROJ_F8 ? 1 : 2; P.scale_w = 0x7a7a7a7a; P.scale_a = 0x7f7f7f7f;
            constexpr int WE = PROJ_F8 ? 1 : 2;
            EpiProj E; E.split_cols = 0; E.split_stride = 0; E.nscale = 0; E.scale = 1.f; E.sig_from = 1 << 30;
            if (kind == 0) { P.Bt = (const bf16*)(ws + WS_WIN + (size_t)L * A_PROJ * DM * WE); P.S.init(NT / 256, A_PROJ / 256, F.G, F.cid); E.O = BIG; E.ldc = A_PROJ; E.nscale = 2; E.scale = 0.125f; E.sig_from = 8; }
            else if (kind == 1) { P.Bt = (const bf16*)(ws + WS_WKV); P.S.init(NT / 256, 8, F.G, F.cid); E.O = Kb; E.ldc = DM; E.split_cols = 1024; E.split_stride = (size_t)NT * DM; }
            else { P.Bt = (const bf16*)(ws + WS_WQ + (size_t)(L - 2) * DM * DM * WE); P.S.init(NT / 256, 4, F.G, F.cid); E.O = Qb; E.ldc = DM; E.nscale = 4; E.scale = attn_body::C2; }
            P.local = chain ? 1 : 0; P.lw = (int)blockIdx.x;
            REPEAT(REP_PROJ) pg8::gemm_phase<EpiProj, DenseProb, true, PROJ_F8>(F.lds + RING_OFF, F.wave, P, E);
#endif
          } PH_END(run); }
        if (kind == 1) continue;
        bf16* const CTS = ACT; float* const NS = (float*)(ws + WS_ACT + (size_t)128 * MiB); float* const MS = NS + (size_t)NB * 8 * 64 * 64; float* const SCN = MS + NB * 8 * 64;
        if (kind == 0) { PH_BEGIN(run, 3) if (run) {
#ifndef DIS_CELL
            REPEAT(REP_CELL) cellA_phase(F, BIG, G16, CTS, NS, MS, SCN);
#endif
          } PH_END(run); }
        { PH_BEGIN(run, (kind == 0 ? 4 : 10)) if (run) {
#ifndef DIS_CELL
            if (kind == 0) REPEAT(REP_CELLB) cellB_phase(F, BIG, G16, args.in[I_AMH] + L * DM, CTS, NS, MS, SCN, HB, chain ? 1 : 0);
#endif
#ifndef DIS_ATTN
            if (kind == 2) REPEAT(REP_ATTN) { const attn_body::AttnTensors AT{(const attn_body::bf16*)Qb, (const attn_body::bf16*)Kb, (const attn_body::bf16*)Vb, (attn_body::bf16*)(rep_ + 1 < REP_ATTN ? ACT : (OUT_F8 ? HB : Qb)), FB};
                   if (rep_ + 1 < REP_ATTN) attn_body::attn_phase<60, (REP_ATTN_NOFB != 0)>((char*)lds + RING_OFF, AT, F.vcu, F.G, F.wave); else attn_body::attn_phase<60>((char*)lds + RING_OFF, AT, F.vcu, F.G, F.wave); }
#endif
          } if (kind == 0) PH_END_CHAIN(run); else PH_END(run); }
        { PH_BEGIN(run, 5) if (run) {
#ifndef DIS_OUT
            DenseProb P; P.A = (kind == 0 || OUT_F8) ? HB : Qb; P.lda = DM; P.ldb = DM; P.K = DM; P.esz = OUT_F8 ? 1 : 2; P.scale_w = 0x7a7a7a7a; P.scale_a = 0x7f7f7f7f;
            P.Bt = kind == 0 ? (const bf16*)(ws + WS_WOUT + (size_t)L * DM * DM * (OUT_F8 ? 1 : 2)) : (const bf16*)(ws + WS_WO + (size_t)(L - 2) * DM * DM * (OUT_F8 ? 1 : 2));
            P.S.init(NT / 256, 4, F.G, F.cid); P.local = chain ? 1 : 0; P.lw = (int)blockIdx.x;
            EpiRes E; E.base = xin; E.base_bf = xin_bf; E.out = X; E.gate = mods + 2048; E.gstride = 6144;
            pg8::gemm_phase<EpiRes, DenseProb, true, OUT_F8>(F.lds + RING_OFF, F.wave, P, E);
#endif
          } PH_END_CHAIN(run); }
        gu32* const gcnt = (gu32*)(ws + WS_CTL) + CW_CNT + L * 32;
        { PH_BEGIN(run, 6) if (run) {
#ifndef DIS_NORM2
            REPEAT(REP_NORM2N) norm_phase<false>(F, X, 1, args.in[I_NFFN] + L * DM, mods + 3072, mods + 4096, 6144, ACT, 0, nullptr, 0, nullptr, nullptr, nullptr, nullptr, nullptr);
            normT_phase<true>(F, X, 1, args.in[I_NFFN] + L * DM, mods + 3072, mods + 4096, 6144, HB, 3, args.in[I_WR], 16, args.in[I_RB], nullptr, WTS, PERM, gcnt);
#endif
          } PH_END(run); }
        const ClassTab CT{(const LAS int*)(F.lds + TAB_OFF), (const LAS int*)(F.lds + TAB_OFF) + 32};
        { PH_BEGIN(run, 7) if (run) {
#ifndef DIS_MOE1
            build_class_tab(F, gcnt);
            Moe1Prob P; P.A = HB; P.ldb = DM; P.K = DM; P.esz = MOE1_F8 ? 1 : 2; P.scale_w = 0x7a7a7a7a; P.scale_a = 0x7f7f7f7f;
            P.Bt1l = (const bf16*)(ws + WS_BT1 + (size_t)L * 16 * 1024 * DM * (MOE1_F8 ? 1 : 2)); P.perm = PERM; P.T = CT;
            P.S.init(CT.blkstart[NCLS], 8, F.G, F.cid);
            EpiAct E; E.act = ACT; E.perm = PERM; E.wts = WTS; E.T = CT;
            REPEAT(REP_MOE1) { P.dense_dbg = (rep_ + 1 < REP_MOE1) ? REP_MOE1_DENSE : 0; E.skip = (rep_ + 1 < REP_MOE1) ? REP_MOE1_SKIP : 0; pg8::gemm_phase<EpiAct, Moe1Prob, true, MOE1_F8>(F.lds + RING_OFF, F.wave, P, E); }
#endif
          } PH_END(run); }
        { PH_BEGIN(run, 8) if (run) {
#ifndef DIS_MOE2
            build_class_tab(F, gcnt);
            Moe2Prob P; P.A = ACT; P.ldb = DE; P.K = DM; P.esz = MOE2_F8 ? 1 : 2; P.scale_w = 0x7a7a7a7a; P.scale_a = 0x7d7d7d7d; P.Bt2l = (const bf16*)(ws + WS_BT2 + (size_t)L * 16 * DM * DE * (MOE2_F8 ? 1 : 2)); P.T = CT;
            P.S.init(CT.blkstart[NCLS], 4, F.G, F.cid);
            EpiResScatter E; E.x = X; E.gate16 = (const bf16*)(ws + WS_MODS16) + (size_t)L * NB * 6144 + 5120; E.gstride = 6144; E.perm = PERM; E.T = CT;
            REPEAT(REP_MOE2) {
#if REP_MOE2 > 1
            E.x = (rep_ + 1 < REP_MOE2) ? (bf16*)args.out : X; E.skip = (rep_ + 1 < REP_MOE2) ? REP_MOE2_SKIP : 0;
#endif
#if MOE2_HALF_FIRST
            P.halfmode = 1; pg8::gemm_phase<EpiResScatter, Moe2Prob, true, MOE2_F8, true>(F.lds + RING_OFF, F.wave, P, E);
            P.halfmode = 0; pg8::gemm_phase<EpiResScatter, Moe2Prob, true, MOE2_F8>(F.lds + RING_OFF, F.wave, P, E); }
#else
            P.halfmode = 0; pg8::gemm_phase<EpiResScatter, Moe2Prob, true, MOE2_F8>(F.lds + RING_OFF, F.wave, P, E);
            P.halfmode = 1; pg8::gemm_phase<EpiResScatter, Moe2Prob, true, MOE2_F8, true>(F.lds + RING_OFF, F.wave, P, E); }
#endif
#endif
          } PH_END(run); }
    }
    { PH_BEGIN(run, 9) if (run) {
#ifndef DIS_FINAL
 final_norm_phase(F, X, args.out, args.in[I_NFIN], (const float*)(args.ws + WS_FIN), (const float*)(args.ws + WS_FIN) + 1024, 2048);
#endif
 } }
#ifdef PROBE_TYPE
    if (pr_me) { const unsigned long long t = __builtin_amdgcn_s_memrealtime(); const unsigned long long pr_acc = ((unsigned long long)F.MISC[19] << 32) | F.MISC[18]; while (__builtin_amdgcn_s_memrealtime() - t < 2 * pr_acc) __builtin_amdgcn_s_sleep(8); }
#endif
#undef PH_BEGIN
#undef PH_END
}
constexpr int N_PHASES = 1 + 2 * 8 + 2 + 2 * 7 + 1;

#ifndef MK_SPLIT
#define MK_SPLIT 0
#endif
extern "C" void kernel_launch(void* const* d_in, const int* in_sizes, int n_in, void* d_out, int out_size, void* d_ws, size_t ws_size, hipStream_t stream) {
    static int grid = 0;
    if (grid == 0) {
        if (n_in != 25 || in_sizes[0] != NT * DM || out_size != NT * DM || ws_size < WS_END) { fprintf(stderr, "kernel_launch: unexpected shapes (n_in %d, in0 %d, out %d, ws %zu); nothing launched\n", n_in, n_in > 0 ? in_sizes[0] : -1, out_size, ws_size); grid = -1; return; }
        int dev = 0, cus = 0, per_cu = 0;
        if (hipGetDevice(&dev) != hipSuccess || hipDeviceGetAttribute(&cus, hipDeviceAttributeMultiprocessorCount, dev) != hipSuccess) { grid = -1; return; }
        if (hipFuncSetAttribute((const void*)mk_fwd, hipFuncAttributeMaxDynamicSharedMemorySize, LDS_BYTES) != hipSuccess) { fprintf(stderr, "kernel_launch: hipFuncSetAttribute failed\n"); grid = -1; return; }
        if (hipOccupancyMaxActiveBlocksPerMultiprocessor(&per_cu, (const void*)mk_fwd, NWAVES * 64, LDS_BYTES) != hipSuccess || per_cu < 1) { fprintf(stderr, "kernel_launch: occupancy query reports %d workgroups per CU\n", per_cu); }
        (void)hipGetLastError();
        grid = cus;
    }
    if (grid < 0) return;
    if (hipMemsetAsync((char*)d_ws + WS_CTL, 0, CTL_ZERO_BYTES, stream) != hipSuccess) return;
    Args a{};
    for (int i = 0; i < 25; ++i) a.in[i] = (const float*)d_in[i];
    a.out = (float*)d_out; a.ws = (unsigned char*)d_ws;
#if MK_SPLIT
    for (int p = 0; p < N_PHASES; ++p) { a.ph_lo = p; a.ph_hi = p + 1; hipLaunchKernelGGL(mk_fwd, dim3(grid), dim3(NWAVES * 64), LDS_BYTES, stream, a); }
#else
    a.ph_lo = 0; a.ph_hi = N_PHASES;
    hipLaunchKernelGGL(mk_fwd, dim3(grid), dim3(NWAVES * 64), LDS_BYTES, stream, a);
#endif
}
```

```cpp
#include <hip/hip_runtime.h>
#include <hip/hip_bf16.h>
#include <cstdio>
#include <cstdint>
#ifndef PG8_WGM
#define PG8_WGM 8
#endif
#ifndef OUT_F8
#define OUT_F8 true
#endif
#define LAS __attribute__((address_space(3)))
#define GAS __attribute__((address_space(1)))
__device__ __forceinline__ int hw_tid_(int wave0) { unsigned z = 0u; asm volatile("" : "+s"(z)); return wave0 * 64 + (int)__builtin_amdgcn_mbcnt_hi(~0u, __builtin_amdgcn_mbcnt_lo(~0u, z)); }
#define HW_TID(wave0) hw_tid_(wave0)

namespace pg8 {
typedef unsigned short bf16_t;
typedef short bf16x8 __attribute__((ext_vector_type(8)));
typedef float f32x4 __attribute__((ext_vector_type(4)));
typedef unsigned u32x4 __attribute__((ext_vector_type(4)));
typedef unsigned u32x2 __attribute__((ext_vector_type(2)));
constexpr int BM = 256, BK = 64, HALF = 128, HTB = HALF * BK * 2  , STAGE_BYTES = 8 * HTB, NXCD = 8, WGM = PG8_WGM;

__host__ __device__ __forceinline__ int lds_byte(int r, int c) { const int st = (r >> 4) * 2 + (c >> 5), rr = r & 15, cc = c & 31, ob = rr * 64 + cc * 2; return st * 1024 + (ob ^ (((ob >> 9) & 1) << 5)); }
__host__ __device__ __forceinline__ void stage_rc(int b, int& R, int& C) { const int st = b / 1024, sb = b % 1024, swz = sb ^ (((sb >> 9) & 1) << 5); R = (st >> 1) * 16 + swz / 64; C = (st & 1) * 32 + (swz % 64) / 2; }
__host__ __device__ __forceinline__ int perm32(int rho) { const int n = rho >> 4, i = rho & 15; return 8 * (i >> 2) + 4 * n + (i & 3); }

struct Unit { int pm, pn, cls, lb, hf, r0; };

struct StaticOrder {
    int nM, nN, nwg, G, c;
    __device__ __forceinline__ void init(int nM_, int nN_, int G_, int c_) { nM = nM_; nN = nN_; nwg = nM * nN; G = G_; c = c_; }
    __device__ __forceinline__ bool next(int i, Unit& u) const { return next_L((long)i * G + c, u); }
    __device__ __forceinline__ bool next_L(long L, Unit& u) const {
        if (L >= nwg) return false;
        int wgid = (int)L; { const int q = nwg / NXCD, r = nwg % NXCD, xcd = wgid % NXCD, off = wgid / NXCD; wgid = (xcd < r ? xcd * (q + 1) : r * (q + 1) + (xcd - r) * q) + off; }
        const int nig = WGM * nN, gid = wgid / nig, fm = gid * WGM, gsz = (nM - fm) < WGM ? (nM - fm) : WGM;
        u.pm = fm + ((wgid % nig) % gsz); u.pn = (wgid % nig) / gsz; u.cls = 0; u.lb = 0; u.hf = 0; u.r0 = 0; return true;
    }
};

__device__ __forceinline__ unsigned cvt_pk_bf16(float lo, float hi) { unsigned r; asm volatile("v_cvt_pk_bf16_f32 %0, %1, %2" : "=v"(r) : "v"(lo), "v"(hi)); return r; }
__device__ __forceinline__ float sigmoidf_(float x) { return __builtin_amdgcn_rcpf(1.0f + __expf(-x)); }
typedef int v4i_t __attribute__((ext_vector_type(4)));
typedef int v8i_t __attribute__((ext_vector_type(8)));
__device__ __forceinline__ v8i_t cat8(bf16x8 lo, bf16x8 hi) { const v4i_t a = __builtin_bit_cast(v4i_t, lo), b = __builtin_bit_cast(v4i_t, hi); return __builtin_shufflevector(a, b, 0, 1, 2, 3, 4, 5, 6, 7); }

template <class Epi, class Prob, bool ALIGN_EPI, bool F8 = false, bool HALFN = false>
__device__ __forceinline__ void gemm_phase(LAS unsigned char* lds, const int wave0, const Prob& S, const Epi& E) {
    int tid_ = HW_TID(wave0); asm volatile("" : "+v"(tid_));
    const int tid = tid_, wid = __builtin_amdgcn_readfirstlane(tid >> 6), lane = tid & 63, wr = wid >> 2, wc = wid & 3, fr = lane & 15, fq = lane >> 4;
    constexpr int ESZ = F8 ? 1 : 2;
    const int K = S.K, nt = K / (F8 ? 2 * BK : BK);
    int R0, C0; stage_rc(tid * 16, R0, C0);
    const int Rb0 = Epi::PERM ? ((R0 & ~31) + perm32(R0 & 31)) : R0;
    unsigned voffB[2]; voffB[0] = (unsigned)(Rb0 * S.ldb) * ESZ + (unsigned)C0 * 2u; voffB[1] = (unsigned)((Rb0 + 64) * S.ldb) * ESZ + (unsigned)C0 * 2u;
    const size_t hstepB = (size_t)HALF * S.ldb * ESZ;
    const unsigned ldsw = (unsigned)wid * 1024u;
    const int aoff_l = lds_byte(wr * 64 + fr, F8 ? fq * 16 : fq * 8), boff_l = lds_byte(wc * 32 + fr, F8 ? fq * 16 : fq * 8);
    const int aoff_h = F8 ? lds_byte(wr * 64 + fr, fq * 16 + 8) : aoff_l + 1024, boff_h = F8 ? lds_byte(wc * 32 + fr, fq * 16 + 8) : boff_l + 1024;
    const int sc_w = S.scale_w, sc_a = S.scale_a;
    const char* const Ab = S.a_base();
#define PG8_SA(b, h) (((b) * 2 + (h)) * HTB)
#define PG8_SB(b, h) ((4 + (b) * 2 + (h)) * HTB)
#define PG8_STA(bufoff, h, tt) do { _Pragma("unroll") for (int _i = 0; _i < 2; ++_i) \
        __builtin_amdgcn_global_load_lds((const unsigned*)(Ab + (size_t)aoff[h][_i] + (size_t)(tt) * (BK * 2)), (LAS unsigned*)(lds + (bufoff) + ldsw + _i * 8192), 16, 0, 0); } while (0)
#define PG8_STB(bufoff, bp, h) do { _Pragma("unroll") for (int _i = 0; _i < 2; ++_i) \
        __builtin_amdgcn_global_load_lds((const unsigned*)((bp) + (h) * hstepB + voffB[_i]), (LAS unsigned*)(lds + (bufoff) + ldsw + _i * 8192), 16, 0, 0); } while (0)
#define PG8_LDA(dst, b, h) do { _Pragma("unroll") for (int m = 0; m < 4; ++m) _Pragma("unroll") for (int k = 0; k < 2; ++k) dst[m][k] = *(const LAS bf16x8*)(lds + PG8_SA(b, h) + (k ? aoff_h : aoff_l) + m * 2048); } while (0)
#define PG8_LDB(dst, b, h) do { _Pragma("unroll") for (int n = 0; n < 2; ++n) _Pragma("unroll") for (int k = 0; k < 2; ++k) dst[n][k] = *(const LAS bf16x8*)(lds + PG8_SB(b, h) + (k ? boff_h : boff_l) + n * 2048); } while (0)
#define PG8_MMA(ai, bj, At, Bt) do { __builtin_amdgcn_s_setprio(1); _Pragma("unroll") for (int m = 0; m < 4; ++m) _Pragma("unroll") for (int n = 0; n < 2; ++n) { \
        if constexpr (F8) acc[ai][bj][m][n] = __builtin_amdgcn_mfma_scale_f32_16x16x128_f8f6f4(cat8(Bt[n][0], Bt[n][1]), cat8(At[m][0], At[m][1]), acc[ai][bj][m][n], 0, 0, 0, sc_w, 0, sc_a); \
        else { _Pragma("unroll") for (int k = 0; k < 2; ++k) acc[ai][bj][m][n] = __builtin_amdgcn_mfma_f32_16x16x32_bf16(Bt[n][k], At[m][k], acc[ai][bj][m][n], 0, 0, 0); } } __builtin_amdgcn_s_setprio(0); } while (0)
#define PG8_WAIT_V(n) asm volatile("s_waitcnt vmcnt(" #n ")" ::: "memory")
#define PG8_WAIT_L(n) asm volatile("s_waitcnt lgkmcnt(" #n ")" ::: "memory")
#define PG8_BAR __builtin_amdgcn_s_barrier()
#define PG8_SCHED __builtin_amdgcn_sched_barrier(0)
    Unit cur, nxt; int ui = 0;
    if (!S.next(0, cur)) return;
    f32x4 acc[2][2][4][2];
#pragma unroll
    for (int a = 0; a < 2; ++a)
#pragma unroll
        for (int b = 0; b < 2; ++b)
#pragma unroll
            for (int m = 0; m < 4; ++m)
#pragma unroll
                for (int n = 0; n < 2; ++n) acc[a][b][m][n] = (f32x4){0.f, 0.f, 0.f, 0.f};
    bf16x8 At[4][2], B0[2][2], B1[2][2];
    unsigned aoff[2][2], aoffN[2][2];
    S.a_off(cur, R0, C0, aoff);
    { const char* bp0 = S.b_tile(cur, 0); const char* bp1 = S.b_tile(cur, 1);
      PG8_STB(PG8_SB(0, 0), bp0, 0); PG8_STB(PG8_SB(0, 1), bp0, 1); PG8_STA(PG8_SA(0, 0), 0, 0); PG8_STA(PG8_SA(0, 1), 1, 0);
      if (wr == 1) PG8_BAR;
      PG8_WAIT_V(2); PG8_BAR;
      PG8_STB(PG8_SB(1, 0), bp1, 0); PG8_STA(PG8_SA(1, 0), 0, 1); PG8_STB(PG8_SB(1, 1), bp1, 1);
      PG8_WAIT_V(6); PG8_BAR; }
    for (;;) {
        const bool has_next = S.next(ui + 1, nxt);
        if (has_next) S.a_off(nxt, R0, C0, aoffN); else { aoffN[0][0] = aoff[0][0]; aoffN[0][1] = aoff[0][1]; aoffN[1][0] = aoff[1][0]; aoffN[1][1] = aoff[1][1]; }
        for (int t = 0; t < nt; t += 2) {
            const bool last = (t == nt - 2);
            PG8_LDB(B0, 0, 0); PG8_LDB(B1, 0, 1); PG8_SCHED; PG8_LDA(At, 0, 0); PG8_STA(PG8_SA(1, 1), 1, t + 1);
            PG8_WAIT_V(8); PG8_WAIT_L(0); PG8_BAR; PG8_MMA(0, 0, At, B0); if constexpr (!HALFN) PG8_MMA(0, 1, At, B1); PG8_BAR; PG8_SCHED;
            const int t2 = last ? 0 : t + 2;
            const Unit& u2 = (last && has_next) ? nxt : cur;
            if (last) { aoff[0][0] = aoffN[0][0]; aoff[0][1] = aoffN[0][1]; aoff[1][0] = aoffN[1][0]; aoff[1][1] = aoffN[1][1]; }
            const char* b2 = S.b_tile(u2, t2); const char* b3 = S.b_tile(u2, t2 + 1);
            PG8_LDA(At, 0, 1); PG8_STB(PG8_SB(0, 0), b2, 0); PG8_STB(PG8_SB(0, 1), b2, 1); PG8_STA(PG8_SA(0, 0), 0, t2);
            PG8_WAIT_V(8); PG8_WAIT_L(0); PG8_BAR; PG8_MMA(1, 0, At, B0); if constexpr (!HALFN) PG8_MMA(1, 1, At, B1); PG8_BAR; PG8_SCHED;
            PG8_LDB(B0, 1, 0); PG8_LDB(B1, 1, 1); PG8_SCHED; PG8_LDA(At, 1, 0); PG8_STA(PG8_SA(0, 1), 1, t2);
            PG8_WAIT_V(8); PG8_WAIT_L(0); PG8_BAR; PG8_MMA(0, 0, At, B0); if constexpr (!HALFN) PG8_MMA(0, 1, At, B1); PG8_BAR; PG8_SCHED;
            PG8_LDA(At, 1, 1); PG8_STB(PG8_SB(1, 0), b3, 0); PG8_STB(PG8_SB(1, 1), b3, 1); PG8_STA(PG8_SA(1, 0), 0, t2 + 1);
            PG8_WAIT_V(8); PG8_WAIT_L(0); PG8_BAR; PG8_MMA(1, 0, At, B0); if constexpr (!HALFN) PG8_MMA(1, 1, At, B1); PG8_BAR; PG8_SCHED;
        }
        if constexpr (ALIGN_EPI) { if (wr == 0) PG8_BAR; }
        E(acc, cur, wr, wc, fr, fq);
        if (!has_next) break;
#pragma unroll
        for (int a = 0; a < 2; ++a)
#pragma unroll
            for (int b = 0; b < 2; ++b)
#pragma unroll
                for (int m = 0; m < 4; ++m)
#pragma unroll
                    for (int n = 0; n < 2; ++n) acc[a][b][m][n] = (f32x4){0.f, 0.f, 0.f, 0.f};
        cur = nxt; ++ui;
        if constexpr (ALIGN_EPI) { if (wr == 1) PG8_BAR; }
    }
    PG8_WAIT_V(0);
    if constexpr (!ALIGN_EPI) { if (wr == 0) PG8_BAR; }
    PG8_BAR;
#undef PG8_SA
#undef PG8_SB
#undef PG8_STA
#undef PG8_STB
#undef PG8_LDA
#undef PG8_LDB
#undef PG8_MMA
#undef PG8_WAIT_V
#undef PG8_WAIT_L
#undef PG8_BAR
#undef PG8_SCHED
}
}

#include <hip/hip_bf16.h>
#include <cmath>
namespace attn_body {
using bf16=__hip_bfloat16;
using bf16x8=__attribute__((ext_vector_type(8)))short;
using s16x4=__attribute__((ext_vector_type(4)))short;
using f32x16=__attribute__((ext_vector_type(16)))float;
using u32x4=__attribute__((ext_vector_type(4)))unsigned;
constexpr int BATCH=16,NHEAD=16,SEQ=4096,D=64,DM=NHEAD*D;
constexpr int NW=8,QBLK=32,QB=QBLK*NW,KVBLK=64,NQB=SEQ/QB;
constexpr int ATTN_PITCH=DM, ATTN_UNIT_ROWS=QB;
__device__ __forceinline__ int crow(int r,int hi){return (r&3)+8*(r>>2)+4*hi;}
#define SBAR() __builtin_amdgcn_sched_barrier(0)
__device__ __forceinline__ void cmask(f32x16&p0,f32x16&p1,int jb,int qrel,int hi){
  const float NEG=-INFINITY; int kb=64*jb+4*hi;
  #pragma unroll
  for(int r=0;r<16;++r){int kv=kb+(r&3)+8*(r>>2); if(kv>qrel)p0[r]=NEG; if(kv+32>qrel)p1[r]=NEG;}
}

constexpr int NSLOT=3, SLOTB=8192;
constexpr int LDS_K=0, LDS_V=NSLOT*SLOTB, LDS_WS=2*NSLOT*SLOTB, LDS_OST=LDS_WS+NW*64*4, LDS_BYTES=LDS_OST+NW*4096;
constexpr float C2=0.125f*1.4426950408889634f;
__device__ __forceinline__ void glds16(const void*gsrc,unsigned lds_dst){unsigned keep;
  asm volatile("s_mov_b32 %0, m0\n\ts_mov_b32 m0, %2\n\ts_nop 0\n\tglobal_load_lds_dwordx4 %1, off\n\ts_mov_b32 m0, %0":"=&s"(keep):"v"(gsrc),"s"(lds_dst):"memory");}
__device__ __forceinline__ float max3f(float a,float b,float c){float r;asm("v_max3_f32 %0, %1, %2, %3":"=v"(r):"v"(a),"v"(b),"v"(c));return r;}
__device__ __forceinline__ float max2f(float a,float b){float r;asm("v_max_f32_e32 %0, %1, %2":"=v"(r):"v"(a),"v"(b));return r;}
__device__ __forceinline__ float fadd_s(float a,float b){float r;asm("v_add_f32_e32 %0, %1, %2":"=v"(r):"v"(a),"v"(b));return r;}
__device__ __forceinline__ float fsub_s(float a,float b){float r;asm("v_sub_f32_e32 %0, %1, %2":"=v"(r):"v"(a),"v"(b));return r;}
typedef float f32x2_t __attribute__((ext_vector_type(2))); typedef __bf16 bf16x2_t __attribute__((ext_vector_type(2)));
__device__ __forceinline__ unsigned cvtpk_s(float lo,float hi){f32x2_t v={lo,hi};bf16x2_t b=__builtin_convertvector(v,bf16x2_t);return __builtin_bit_cast(unsigned,b);}
#define WAIT_BAR(N) asm volatile("s_waitcnt vmcnt(" #N ") lgkmcnt(0)\n\ts_barrier":::"memory")

__device__ __forceinline__ void qkt(f32x16&p0,f32x16&p1,const char*Kslot,const bf16x8*qr,const f32x16&c0,const f32x16&c1,int r32,int hi){
  const char*kb=Kslot+hi*1024+r32*16;
  #pragma unroll
  for(int d0=0;d0<4;++d0){
    const bf16x8 b0=*reinterpret_cast<const bf16x8*>(kb+d0*2048);
    const bf16x8 b1=*reinterpret_cast<const bf16x8*>(kb+d0*2048+512);
    if(d0==0){p0=__builtin_amdgcn_mfma_f32_32x32x16_bf16(b0,qr[0],c0,0,0,0);p1=__builtin_amdgcn_mfma_f32_32x32x16_bf16(b1,qr[0],c1,0,0,0);}
    else{p0=__builtin_amdgcn_mfma_f32_32x32x16_bf16(b0,qr[d0],p0,0,0,0);p1=__builtin_amdgcn_mfma_f32_32x32x16_bf16(b1,qr[d0],p1,0,0,0);}}
}
typedef __attribute__((address_space(3))) const char* lds_cptr;
typedef short v4i16_t __attribute__((ext_vector_type(4)));
__device__ __forceinline__ void kload8(bf16x8*kf,lds_cptr kp){
  kf[0]=*(const __attribute__((address_space(3))) bf16x8*)(kp);      kf[1]=*(const __attribute__((address_space(3))) bf16x8*)(kp+512);
  kf[2]=*(const __attribute__((address_space(3))) bf16x8*)(kp+2048); kf[3]=*(const __attribute__((address_space(3))) bf16x8*)(kp+2560);
  kf[4]=*(const __attribute__((address_space(3))) bf16x8*)(kp+4096); kf[5]=*(const __attribute__((address_space(3))) bf16x8*)(kp+4608);
  kf[6]=*(const __attribute__((address_space(3))) bf16x8*)(kp+6144); kf[7]=*(const __attribute__((address_space(3))) bf16x8*)(kp+6656);
}
__device__ __forceinline__ void kload2(bf16x8*kf,lds_cptr kp,int j){ kf[2*j]=*(const __attribute__((address_space(3))) bf16x8*)(kp+j*2048); kf[2*j+1]=*(const __attribute__((address_space(3))) bf16x8*)(kp+j*2048+512); }
__device__ __forceinline__ s16x4 vtr(lds_cptr p){ return __builtin_bit_cast(s16x4,__builtin_amdgcn_ds_read_tr16_b64_v4i16((__attribute__((address_space(3))) v4i16_t*)p)); }
__device__ __forceinline__ float rowmax(const f32x16&p0,const f32x16&p1){
  float a=max3f(p0[0],p0[1],p1[0]),b=max3f(p0[2],p0[3],p1[1]);a=max3f(a,p1[2],p1[3]);
  #pragma unroll
  for(int r=4;r<16;r+=4){a=max3f(a,p0[r],p0[r+1]);b=max3f(b,p0[r+2],p0[r+3]);a=max3f(a,p1[r],p1[r+1]);b=max3f(b,p1[r+2],p1[r+3]);}
  const float m=max2f(a,b);
  auto rr=__builtin_amdgcn_permlane32_swap(__float_as_uint(m),__float_as_uint(m),false,false);
  return max2f(__uint_as_float(rr[0]),__uint_as_float(rr[1]));
}
__device__ __forceinline__ void pv(f32x16*o,int vb,bf16x8 pa0,bf16x8 pa1,bf16x8 pa2,bf16x8 pa3){
  #pragma unroll
  for(int d0=0;d0<2;++d0){s16x4 lo[4],hi[4];
    #pragma unroll
    for(int ks=0;ks<4;++ks){
      asm volatile("ds_read_b64_tr_b16 %0,%1 offset:%c2":"=&v"(lo[ks]):"v"(vb),"i"(d0*4096+ks*1024):"memory");
      asm volatile("ds_read_b64_tr_b16 %0,%1 offset:%c2":"=&v"(hi[ks]):"v"(vb),"i"(d0*4096+ks*1024+512):"memory");}
    asm volatile("s_waitcnt lgkmcnt(0)":::"memory");SBAR();
    #define PK(k) (bf16x8){lo[k][0],lo[k][1],lo[k][2],lo[k][3],hi[k][0],hi[k][1],hi[k][2],hi[k][3]}
    o[d0]=__builtin_amdgcn_mfma_f32_32x32x16_bf16(pa0,PK(0),o[d0],0,0,0);
    o[d0]=__builtin_amdgcn_mfma_f32_32x32x16_bf16(pa1,PK(1),o[d0],0,0,0);
    o[d0]=__builtin_amdgcn_mfma_f32_32x32x16_bf16(pa2,PK(2),o[d0],0,0,0);
    o[d0]=__builtin_amdgcn_mfma_f32_32x32x16_bf16(pa3,PK(3),o[d0],0,0,0);
    #undef PK
  }
}

#ifndef ATTN_STORE16
#define ATTN_STORE16(p,v) (*(u32x4*)(p)=(v))
#endif
typedef float f32x4_t __attribute__((ext_vector_type(4)));
typedef __attribute__((address_space(3))) const float* fb_lptr;
__device__ __forceinline__ int f8pk(float a,float b,int old,bool hi){a=__builtin_amdgcn_fmed3f(a,-448.f,448.f);b=__builtin_amdgcn_fmed3f(b,-448.f,448.f);return hi?__builtin_amdgcn_cvt_pk_fp8_f32(a,b,old,true):__builtin_amdgcn_cvt_pk_fp8_f32(a,b,old,false);}
template<int THRL,bool NOFB> __device__ __forceinline__ void attn_unit(int b,int h,int qb,const bf16*Q,const bf16*__restrict__ K,const bf16*__restrict__ V,bf16*O,char*shm,fb_lptr fbl,const int wave0){
  int tid_=HW_TID(wave0); asm volatile("":"+v"(tid_)); const int tid=tid_,lane=tid&63,r32=lane&31,hi=lane>>5; const int wid=__builtin_amdgcn_readfirstlane(tid>>6);
  const long rowbase=(long)b*SEQ; const int q0=qb*QB;
  const bf16*Qw=Q+(rowbase+q0+wid*QBLK)*DM+h*D;
  const bf16*Kh=K+rowbase*DM+h*D,*Vh=V+rowbase*DM+h*D;
  const unsigned lds0=(unsigned)(uintptr_t)shm;
  float*wsf=(float*)(shm+LDS_WS)+wid*64;
  const bf16*ksrc=Kh+(long)lane*DM+wid*8;
  const bf16*vsrc=Vh+(long)(16*(wid&3)+(lane>>2))*DM+(wid>>2)*32+(lane&3)*8;
  const unsigned kdst=lds0+LDS_K+wid*1024, vdst=lds0+LDS_V+wid*1024;
  #define DMA_K(t,slot) glds16(ksrc+(long)(t)*KVBLK*DM,(unsigned)__builtin_amdgcn_readfirstlane(kdst+(slot)))
  #define DMA_V(t,slot) glds16(vsrc+(long)(t)*KVBLK*DM,(unsigned)__builtin_amdgcn_readfirstlane(vdst+(slot)))
  const int vb0=(int)(lds0+LDS_V)+((lane>>4)&1)*32+(lane&3)*8+(4*hi+((lane&15)>>2))*64;
  const char*Kbase=shm+LDS_K; bf16x8 kf[8];
  const lds_cptr shm3=(lds_cptr)shm; const lds_cptr kp0=shm3+LDS_K+hi*1024+r32*16; const lds_cptr vp0=shm3+LDS_V+((lane>>4)&1)*32+(lane&3)*8+(4*hi+((lane&15)>>2))*64;
  const int NT=(q0+QB)/KVBLK;
  DMA_K(0,0);DMA_V(0,0);DMA_K(1,SLOTB);
  bf16x8 qr[4];
  #pragma unroll
  for(int d0=0;d0<4;++d0)qr[d0]=*(const GAS bf16x8*)(&Qw[(long)r32*DM+d0*16+hi*8]);
  #define FBIAS(C0,C1,t) do{ const fb_lptr fp_=fbl+64*(t)+4*hi; const float nm_=-mhat; \
    _Pragma("unroll") for(int g_=0;g_<4;++g_){ const f32x4_t a_=*(const __attribute__((address_space(3))) f32x4_t*)(fp_+8*g_); const f32x4_t b_=*(const __attribute__((address_space(3))) f32x4_t*)(fp_+32+8*g_); \
      _Pragma("unroll") for(int i_=0;i_<4;++i_){ C0[4*g_+i_]=a_[i_]+nm_; C1[4*g_+i_]=b_[i_]+nm_; } SBAR(); } }while(0)
  #define FBLOAD(X0,X1,tt,G) do{ if((G)&&!NOFB){ const fb_lptr fp_=fbl+64*(tt)+4*hi; \
    _Pragma("unroll") for(int g_=0;g_<4;++g_){ const f32x4_t a_=*(const __attribute__((address_space(3))) f32x4_t*)(fp_+8*g_); const f32x4_t b_=*(const __attribute__((address_space(3))) f32x4_t*)(fp_+32+8*g_); \
      _Pragma("unroll") for(int i_=0;i_<4;++i_){ X0[4*g_+i_]=a_[i_]; X1[4*g_+i_]=b_[i_]; } } } }while(0)
  #define FBADD(X0,X1,G) do{ if((G)&&!NOFB){ const f32x2_t nm_={-mhat,-mhat}; _Pragma("unroll") for(int r_=0;r_<16;r_+=2){ f32x2_t a_={X0[r_],X0[r_+1]},b_={X1[r_],X1[r_+1]}; a_=a_+nm_; b_=b_+nm_; X0[r_]=a_[0];X0[r_+1]=a_[1];X1[r_]=b_[0];X1[r_+1]=b_[1]; } } }while(0)
  float mhat=0.f,l_reg=0.f;f32x16 o[2];o[0]=f32x16{};o[1]=f32x16{};
  const int qrel=wid*QBLK+r32;
  #define CMASK(P0,P1,t) do{int jb_=(t)-(NT-4); if(jb_>=0)cmask(P0,P1,jb_,qrel,hi);}while(0)
  bool resc=false;
  #define START(P0,P1) do{ const float rm=rowmax(P0,P1); resc=false; \
    { const float dl=rm; mhat=fadd_s(mhat,dl); \
      _Pragma("unroll") for(int r=0;r<16;++r){P0[r]=fsub_s(P0[r],dl);P1[r]=fsub_s(P1[r],dl);} \
      } \
    _Pragma("unroll") for(int r=0;r<16;++r)P0[r]=__builtin_amdgcn_exp2f(P0[r]); }while(0)
  #define RESC() do{ if(resc){ asm volatile("s_waitcnt lgkmcnt(0)":::"memory"); \
      _Pragma("unroll") for(int d_=0;d_<2;++d_) _Pragma("unroll") for(int r=0;r<16;++r)o[d_][r]*=wsf[crow(r,hi)]; } }while(0)
  f32x16 pA0,pA1,pB0,pB1;
  int sl_prev=0,sl_cur=0,sl_next=SLOTB;
  #define ROT() do{sl_prev=sl_cur;sl_cur=sl_next;sl_next=(sl_next==(NSLOT-1)*SLOTB)?0:sl_next+SLOTB;}while(0)
  DMA_K(2,2*SLOTB);
  WAIT_BAR(3);
  FBIAS(pA0,pA1,0); qkt(pA0,pA1,Kbase,qr,pA0,pA1,r32,hi);asm volatile("s_nop 15\n\ts_nop 7":"+v"(pA0),"+v"(pA1));CMASK(pA0,pA1,0);
  START(pA0,pA1); FBLOAD(pB0,pB1,1,true); FBADD(pB0,pB1,true);
  _Pragma("unroll") for(int r=0;r<16;++r)pA1[r]=__builtin_amdgcn_exp2f(pA1[r]);
  WAIT_BAR(0);
  DMA_K(3,0);DMA_V(1,SLOTB);
  ROT();
  kload8(kf,kp0+sl_cur);
  WAIT_BAR(2);
  s16x4 vlo[8],vhi[8]; u32x4 pw0,pw1,pw2,pw3;
  #define PKW(P,B) cvtpk_s(P[B],P[B+1])
  #define PAF(k) __builtin_bit_cast(bf16x8,pw##k)
  #define VFR(i) (bf16x8){vlo[i][0],vlo[i][1],vlo[i][2],vlo[i][3],vhi[i][0],vhi[i][1],vhi[i][2],vhi[i][3]}
  #define PIN(x) asm volatile("":"+v"(x))
  #define MX3(a,b,c) __builtin_fmaxf(__builtin_fmaxf((a),(b)),(c))
  #define GAPA(MF,A0,A1,A2,A3,W0,W1,PW) do{ MF; sacc+=A0; sacc+=A1; sacc+=A2; sacc+=A3; PIN(sacc); W0; W1; PIN(PW); SBAR(); }while(0)
  #define EX(v) __builtin_amdgcn_exp2f(v)
  #define GAPB(MF,X,B) do{ MF; X[B]=EX(X[B]); X[B+1]=EX(X[B+1]); X[B+2]=EX(X[B+2]); X[B+3]=EX(X[B+3]); PIN(X); SBAR(); }while(0)
  #define VRD(i) do{ vlo[i]=vtr(vp_+(((i)>>2)*4096+((i)&3)*1024)); vhi[i]=vtr(vp_+(((i)>>2)*4096+((i)&3)*1024+512)); }while(0)
  #define KRD(G,j) do{ if(G){ kload2(kf,kp0+sl_next,j); SBAR(); } }while(0)
  #define STEP(C0,C1,P0,P1,t,GK,GV,GL) do{ SBAR(); \
    const lds_cptr vp_=vp0+sl_prev; \
    VRD(0); SBAR(); float sacc=(P0[0]+P0[1]); \
    GAPA(C0=__builtin_amdgcn_mfma_f32_32x32x16_bf16(kf[0],qr[0],C0,0,0,0), P0[2],P0[3],P0[4],P0[5],     pw0[0]=PKW(P0,0), pw0[1]=PKW(P0,2), pw0); \
    VRD(4); SBAR(); GAPA(C1=__builtin_amdgcn_mfma_f32_32x32x16_bf16(kf[1],qr[0],C1,0,0,0), P0[6],P0[7],P0[8],P0[9],     pw0[2]=PKW(P0,4), pw0[3]=PKW(P0,6), pw0); \
    VRD(1); SBAR(); GAPA(C0=__builtin_amdgcn_mfma_f32_32x32x16_bf16(kf[2],qr[1],C0,0,0,0),   P0[10],P0[11],P0[12],P0[13], pw1[0]=PKW(P0,8), pw1[1]=PKW(P0,10), pw1); \
    VRD(5); SBAR(); GAPA(C1=__builtin_amdgcn_mfma_f32_32x32x16_bf16(kf[3],qr[1],C1,0,0,0),   P0[14],P0[15],P1[0],P1[1],   pw1[2]=PKW(P0,12),pw1[3]=PKW(P0,14), pw1); \
    VRD(2); SBAR(); GAPA(C0=__builtin_amdgcn_mfma_f32_32x32x16_bf16(kf[4],qr[2],C0,0,0,0),   P1[2],P1[3],P1[4],P1[5],     pw2[0]=PKW(P1,0), pw2[1]=PKW(P1,2), pw2); \
    VRD(6); SBAR(); GAPA(C1=__builtin_amdgcn_mfma_f32_32x32x16_bf16(kf[5],qr[2],C1,0,0,0),   P1[6],P1[7],P1[8],P1[9],     pw2[2]=PKW(P1,4), pw2[3]=PKW(P1,6), pw2); \
    VRD(3); SBAR(); GAPA(C0=__builtin_amdgcn_mfma_f32_32x32x16_bf16(kf[6],qr[3],C0,0,0,0),   P1[10],P1[11],P1[12],P1[13], pw3[0]=PKW(P1,8), pw3[1]=PKW(P1,10), pw3); \
    VRD(7); SBAR(); GAPA(C1=__builtin_amdgcn_mfma_f32_32x32x16_bf16(kf[7],qr[3],C1,0,0,0),   P1[14],P1[15],0.f,0.f,       pw3[2]=PKW(P1,12),pw3[3]=PKW(P1,14), pw3); \
    l_reg+=sacc; FBLOAD(P0,P1,(t)+1,GL); \
    if(GK){DMA_K((t)+3,sl_cur);} if(GV){DMA_V((t)+1,sl_next);} \
    CMASK(C0,C1,t); \
    { float a=MX3(C0[0],C0[1],C1[0]),b=MX3(C0[2],C0[3],C1[1]); a=MX3(a,C1[2],C1[3]); \
      _Pragma("unroll") for(int r=4;r<16;r+=4){a=MX3(a,C0[r],C0[r+1]);b=MX3(b,C0[r+2],C0[r+3]);a=MX3(a,C1[r],C1[r+1]);b=MX3(b,C1[r+2],C1[r+3]);} \
      float rm=__builtin_fmaxf(a,b); { auto rr=__builtin_amdgcn_permlane32_swap(__float_as_uint(rm),__float_as_uint(rm),false,false); rm=__builtin_fmaxf(__uint_as_float(rr[0]),__uint_as_float(rr[1])); } \
      resc=false; \
      if(__builtin_expect(__any(rm>(float)THRL),0)){ const float dl=__builtin_fmaxf(rm,0.f); mhat+=dl; \
        _Pragma("unroll") for(int r=0;r<16;++r){C0[r]-=dl;C1[r]-=dl;} \
        const float f=__builtin_amdgcn_exp2f(-dl); l_reg*=f; if(hi==0)wsf[r32]=f; resc=true; } } \
    FBADD(P0,P1,GL); SBAR(); \
    GAPB(o[0]=__builtin_amdgcn_mfma_f32_32x32x16_bf16(PAF(0),VFR(0),o[0],0,0,0), C0,0); \
    GAPB(o[1]=__builtin_amdgcn_mfma_f32_32x32x16_bf16(PAF(0),VFR(4),o[1],0,0,0), C0,4); \
    KRD(GL,0); GAPB(o[0]=__builtin_amdgcn_mfma_f32_32x32x16_bf16(PAF(1),VFR(1),o[0],0,0,0), C0,8); \
    KRD(GL,1); GAPB(o[1]=__builtin_amdgcn_mfma_f32_32x32x16_bf16(PAF(1),VFR(5),o[1],0,0,0), C0,12); \
    KRD(GL,2); GAPB(o[0]=__builtin_amdgcn_mfma_f32_32x32x16_bf16(PAF(2),VFR(2),o[0],0,0,0), C1,0); \
    KRD(GL,3); GAPB(o[1]=__builtin_amdgcn_mfma_f32_32x32x16_bf16(PAF(2),VFR(6),o[1],0,0,0), C1,4); \
    GAPB(o[0]=__builtin_amdgcn_mfma_f32_32x32x16_bf16(PAF(3),VFR(3),o[0],0,0,0), C1,8); \
    GAPB(o[1]=__builtin_amdgcn_mfma_f32_32x32x16_bf16(PAF(3),VFR(7),o[1],0,0,0), C1,12); \
    }while(0)
  int t=1;
  #undef CMASK
  #define CMASK(P0,P1,t) do{}while(0)
  for(;t+5<NT;t+=2){
    STEP(pB0,pB1,pA0,pA1,t,true,true,true);     WAIT_BAR(2); RESC(); ROT();
    STEP(pA0,pA1,pB0,pB1,t+1,true,true,true);   WAIT_BAR(2); RESC(); ROT();
  }
  #undef CMASK
  #define CMASK(P0,P1,t) do{int jb_=(t)-(NT-4); if(jb_>=0)cmask(P0,P1,jb_,qrel,hi);}while(0)
  #define ENDW(tt) do{ if((tt)+3<NT){WAIT_BAR(2);} else if((tt)+2<NT){WAIT_BAR(1);} else {WAIT_BAR(0);} }while(0)
  for(;t+1<NT;t+=2){
    STEP(pB0,pB1,pA0,pA1,t,(t+3<NT),(t+1<NT),(t+1<NT));       ENDW(t);   RESC(); ROT();
    STEP(pA0,pA1,pB0,pB1,t+1,(t+4<NT),(t+2<NT),(t+2<NT));     ENDW(t+1); RESC(); ROT();
  }
  STEP(pB0,pB1,pA0,pA1,NT-1,false,false,false); RESC();
  { float sacc=pB0[0]+pB0[1]; _Pragma("unroll") for(int r=2;r<16;++r)sacc+=pB0[r]; _Pragma("unroll") for(int r=0;r<16;++r)sacc+=pB1[r]; l_reg+=sacc;
    pw0=(u32x4){PKW(pB0,0),PKW(pB0,2),PKW(pB0,4),PKW(pB0,6)};pw1=(u32x4){PKW(pB0,8),PKW(pB0,10),PKW(pB0,12),PKW(pB0,14)};pw2=(u32x4){PKW(pB1,0),PKW(pB1,2),PKW(pB1,4),PKW(pB1,6)};pw3=(u32x4){PKW(pB1,8),PKW(pB1,10),PKW(pB1,12),PKW(pB1,14)};
    SBAR(); pv(o,vb0+sl_cur,PAF(0),PAF(1),PAF(2),PAF(3)); }
  #undef PKW
  #undef PAF
  #undef VFR
  #undef PIN
  #undef MX3
  #undef GAPA
  #undef GAPB
  #undef EX
  #undef VRD
  #undef KRD
  #undef STEP
  #undef ENDW
  {auto rr=__builtin_amdgcn_permlane32_swap(__float_as_uint(l_reg),__float_as_uint(l_reg),false,false);l_reg=__uint_as_float(rr[0])+__uint_as_float(rr[1]);}
  if(hi==0)wsf[32+r32]=l_reg;asm volatile("s_waitcnt lgkmcnt(0)":::"memory");
  float rli[16];
  #pragma unroll
  for(int r=0;r<16;++r)rli[r]=__builtin_amdgcn_rcpf(wsf[32+crow(r,hi)]);
  bf16*Ow=O+(rowbase+q0+wid*QBLK)*DM+h*D;
  { bf16*stg=(bf16*)(shm+LDS_OST)+wid*2048;
    #pragma unroll
    for(int r=0;r<16;++r){const int orow=crow(r,hi);
      #pragma unroll
      for(int d0=0;d0<2;++d0)stg[orow*64+d0*32+r32]=__float2bfloat16(o[d0][r]*rli[r]);}
    asm volatile("s_waitcnt lgkmcnt(0)":::"memory");
    #pragma unroll
    for(int i=0;i<4;++i){const int row=i*8+(lane>>3),ch=lane&7; const u32x4 v=*(const u32x4*)(stg+row*64+ch*8);
      if(OUT_F8){ int w0=0,w1=0; w0=f8pk(__uint_as_float(v.x<<16),__uint_as_float(v.x&0xffff0000u),w0,false); w0=f8pk(__uint_as_float(v.y<<16),__uint_as_float(v.y&0xffff0000u),w0,true);
        w1=f8pk(__uint_as_float(v.z<<16),__uint_as_float(v.z&0xffff0000u),w1,false); w1=f8pk(__uint_as_float(v.w<<16),__uint_as_float(v.w&0xffff0000u),w1,true);
        unsigned long long pk=((unsigned long long)(unsigned)w1<<32)|(unsigned)w0; *(GAS unsigned long long*)((unsigned char*)O+((rowbase+q0+wid*QBLK+row)*DM+h*D+ch*8))=pk; }
      else ATTN_STORE16(Ow+(long)row*DM+ch*8,v);} }
  asm volatile("s_waitcnt lgkmcnt(0)\n\ts_barrier":::"memory");
  #undef DMA_K
  #undef DMA_V
  #undef CMASK
  #undef START
  #undef RESC
  #undef FBIAS
  #undef FBLOAD
  #undef FBADD
  #undef ROT
}
constexpr int ATTN_LDS_BYTES=LDS_BYTES;
struct AttnTensors { const bf16* Q; const bf16* K; const bf16* V; bf16* O; const float* FB; };
constexpr int FB_OFF=86016;
template<int THRL=8,bool NOFB=false> __device__ __forceinline__ void attn_phase(char*lds,const AttnTensors&T,int vcu,int G,const int wave0){
  const fb_lptr fbl=(fb_lptr)(lds+FB_OFF);
  const bool fast=(G==256); const int nu=fast?16:16*((BATCH*NHEAD-vcu+G-1)/G); int cur=-1;
  for(int u=0;u<nu;++u){
    int bh,qb;
    if(fast){ bh=32*(vcu>>5)+4*(u>>1)+((vcu&31)>>3); qb=(u&1)?(vcu&7):NQB-1-(vcu&7); } else { bh=vcu+G*(u>>4); qb=NQB-1-(u&15); }
    if(bh!=cur){ cur=bh;
      { __attribute__((address_space(3))) float* fw=(__attribute__((address_space(3))) float*)(lds+FB_OFF);
        int ti_=HW_TID(wave0); asm volatile("":"+v"(ti_)); float fv_[SEQ/512]; _Pragma("unroll") for(int k_=0;k_<SEQ/512;++k_)fv_[k_]=((const GAS float*)T.FB)[(size_t)bh*SEQ+ti_+512*k_]; _Pragma("unroll") for(int k_=0;k_<SEQ/512;++k_)fw[ti_+512*k_]=fv_[k_]; }
      asm volatile("s_waitcnt vmcnt(0) lgkmcnt(0)\n\ts_barrier":::"memory"); }
    attn_unit<THRL,NOFB>(bh/NHEAD,bh%NHEAD,qb,T.Q,T.K,T.V,T.O,lds,fbl,wave0);
  }
}
#undef SBAR
#undef WAIT_BAR
}

constexpr int DM = 1024, NB = 16, SEQ = 4096, NT = NB * SEQ;
constexpr int DEPTH = 4, NAL = 2;
constexpr int A_IN = 3088, A_PROJ = 3072;
constexpr int KV_OUT = 2064;
constexpr int NE = 16, DE = 512, NCLS = 24, CLS_CAP = NT;
constexpr float EPS = 1e-6f;
constexpr int NWAVES = 8;
#ifndef RSPLIT
#define RSPLIT 0
#endif
#ifndef FUSE_LOCAL
#define FUSE_LOCAL 1
#endif
#ifndef PROJ_F8
#define PROJ_F8 true
#endif
#ifndef MOE2_F8
#define MOE2_F8 true
#endif
#ifndef MOE1_F8
#define MOE1_F8 true
#endif
constexpr int MAX_RB = NT / 256 + NCLS;

constexpr size_t MiB = 1u << 20;
constexpr size_t WS_CTL = 0, CTL_ZERO_BYTES = 1 * MiB;
constexpr size_t WS_MODS = 1 * MiB;
constexpr size_t WS_KVMOD = WS_MODS + (size_t)DEPTH * NB * 6144 * 4;
constexpr size_t WS_FIN = WS_KVMOD + (size_t)NB * 2048 * 4;
constexpr size_t WS_WTS = 3 * MiB, WS_MODS16 = 3 * MiB;
constexpr size_t WS_G16 = 4 * MiB;
constexpr size_t WS_FB = 8 * MiB;
constexpr size_t WS_PERM = 12 * MiB;
constexpr size_t WS_WIN = 18 * MiB, WS_WOUT = 30 * MiB, WS_WKV = 34 * MiB, WS_WQ = 38 * MiB, WS_WO = 42 * MiB;
constexpr size_t WS_DUMP = 32 * MiB;
constexpr size_t WS_BT1 = 46 * MiB;
constexpr size_t WS_PW = 110 * MiB;
constexpr size_t WS_BT2 = 174 * MiB;
constexpr size_t WS_HB = 238 * MiB;
constexpr size_t WS_BIG = 366 * MiB;
constexpr size_t WS_ACT = 750 * MiB;
constexpr size_t WS_XB = 890 * MiB;
constexpr size_t WS_END = 1018 * MiB;
static_assert(WS_FIN + (size_t)NB * 2048 * 4 <= WS_WTS && WS_ACT + (size_t)MAX_RB * 256 * 1024 * 2 <= WS_XB && WS_XB + (size_t)NT * DM * 2 <= WS_END, "d_ws map");
constexpr int CW_BAR = 4096;
constexpr int CW_XCCT = 12288;
constexpr int CW_CNT = 16384;
constexpr int RING_OFF = 0, RING_BYTES = 131072;
constexpr int LDSCTL_OFF = RING_BYTES, MISC_OFF = LDSCTL_OFF + 320;
constexpr int TAB_OFF = MISC_OFF + 128;
constexpr int LDS_BYTES = 147456;
static_assert(TAB_OFF + 256 + 4 * (NT / 256 + NCLS + 8) <= LDS_BYTES, "LDS map");

typedef unsigned short bf16;
typedef unsigned v4u __attribute__((ext_vector_type(4)));
typedef unsigned v2u __attribute__((ext_vector_type(2)));
typedef float f32x4 __attribute__((ext_vector_type(4)));
typedef short bf16x8 __attribute__((ext_vector_type(8)));
typedef GAS unsigned gu32;
#define RLX_AGENT __ATOMIC_RELAXED, __HIP_MEMORY_SCOPE_AGENT
#define LDS_WAIT() asm volatile("s_waitcnt lgkmcnt(0)" ::: "memory")
__device__ __forceinline__ unsigned f2bf(float f) { unsigned u = __builtin_bit_cast(unsigned, f); return (u + 0x7fffu + ((u >> 16) & 1u)) >> 16; }
__device__ __forceinline__ unsigned pk2(float lo, float hi) { typedef float f2_t __attribute__((ext_vector_type(2))); typedef __bf16 b2_t __attribute__((ext_vector_type(2))); const f2_t v = {lo, hi}; return __builtin_bit_cast(unsigned, __builtin_convertvector(v, b2_t)); }
__device__ __forceinline__ int cvt8(float a, float b, int old, bool hi) { a = __builtin_amdgcn_fmed3f(a, -448.f, 448.f); b = __builtin_amdgcn_fmed3f(b, -448.f, 448.f); return hi ? __builtin_amdgcn_cvt_pk_fp8_f32(a, b, old, true) : __builtin_amdgcn_cvt_pk_fp8_f32(a, b, old, false); }
__device__ __forceinline__ float bf2f(unsigned b) { return __builtin_bit_cast(float, (b & 0xffffu) << 16); }

#define XB_TMO      128
#define XB_XCNT(j)  (256  + 64 * (j))
#define XB_XSUB(j)  (1280 + 64 * (j))
#define XB_XGEN(j)  (2304 + 64 * (j))
#define XB_TOP      3328
#define XB_TOPGEN   3392
#define XCD_BAR_WORDS 3456
#define XB_SPIN_CAP (1u << 22)

__device__ __forceinline__ unsigned xb_ld(unsigned* p)              { return __hip_atomic_load(p, __ATOMIC_RELAXED, __HIP_MEMORY_SCOPE_AGENT); }
__device__ __forceinline__ unsigned xb_add(unsigned* p, unsigned v) { return __hip_atomic_fetch_add(p, v, __ATOMIC_RELAXED, __HIP_MEMORY_SCOPE_AGENT); }
__device__ __forceinline__ unsigned xb_xcc_id() { return (unsigned)__builtin_amdgcn_s_getreg((3 << 11) | 20) & 0xFu; }
#define XB_SPIN(cond, bar) do { unsigned _sp = 0; while (cond) { __builtin_amdgcn_s_sleep(1); \
    if ((++_sp & 255u) == 0u) { if (xb_ld(&(bar)[XB_TMO])) break; if (_sp > XB_SPIN_CAP) { atomicAdd(&(bar)[XB_TMO], 1u); break; } } } } while (0)

struct XcdBarrier { unsigned* bar; unsigned x; volatile LAS unsigned* st; int w0; };

__device__ __forceinline__ XcdBarrier xcd_barrier_post(unsigned* bar, volatile LAS unsigned* st, int w0) {
    XcdBarrier b; b.bar = bar; b.x = xb_xcc_id(); b.st = st; b.w0 = w0;
    if (HW_TID(w0) == 0) (void)xb_add(&bar[XB_XCNT(b.x)], 1u);
    return b;
}
__device__ __forceinline__ void xcd_barrier_complete(unsigned* bar, unsigned x, unsigned& nloc, unsigned& nx) {
    const unsigned G = gridDim.x * gridDim.y * gridDim.z;
    unsigned sum, cnt, mine, sp = 0u;
    for (;;) {
        sum = 0u; cnt = 0u; mine = 0u;
#pragma unroll
        for (unsigned j = 0; j < 16; ++j) { const unsigned c = xb_ld(&bar[XB_XCNT(j)]); sum += c; cnt += (c > 0u) ? 1u : 0u; mine = (j == x) ? c : mine; }
        if (sum == G) break;
        __builtin_amdgcn_s_sleep(1);
        if ((++sp & 255u) == 0u) { if (xb_ld(&bar[XB_TMO])) break; if (sp > XB_SPIN_CAP) { atomicAdd(&bar[XB_TMO], 1u); break; } }
    }
    nloc = mine > 0u ? mine : 1u; nx = cnt > 0u ? cnt : 1u;
}
__device__ __forceinline__ void xcd_barrier(const XcdBarrier& b) {
    asm volatile("s_waitcnt vmcnt(0)" ::: "memory");
    __syncthreads();
    if (HW_TID(b.w0) == 0) {
        unsigned* bar = b.bar; unsigned bx = b.x; asm volatile("" : "+s"(bar), "+s"(bx));
        __builtin_amdgcn_s_waitcnt(0);
        unsigned nloc = b.st[0], nx = b.st[1];
        if (nloc == 0u) { xcd_barrier_complete(bar, bx, nloc, nx); b.st[0] = nloc; b.st[1] = nx; }
        const unsigned old = xb_add(&bar[XB_XSUB(bx)], 1u);
        const unsigned gen = old / nloc;
        if (old + 1u == (gen + 1u) * nloc) {
            __builtin_amdgcn_fence(__ATOMIC_RELEASE, "agent");
            asm volatile("s_waitcnt vmcnt(0)" ::: "memory");
            const unsigned og = xb_add(&bar[XB_TOP], 1u);
            const unsigned tg = og / nx;
            if (og + 1u == (tg + 1u) * nx) xb_add(&bar[XB_TOPGEN], 1u);
            else XB_SPIN(xb_ld(&bar[XB_TOPGEN]) == tg, bar);
            __builtin_amdgcn_fence(__ATOMIC_ACQUIRE, "agent");
            xb_add(&bar[XB_XGEN(bx)], 1u);
            asm volatile("s_waitcnt vmcnt(0)" ::: "memory");
        } else {
            XB_SPIN(xb_ld(&bar[XB_XGEN(bx)]) == gen, bar);
            __builtin_amdgcn_fence(__ATOMIC_ACQUIRE, "agent");
            asm volatile("s_waitcnt vmcnt(0)" ::: "memory");
        }
    }
    __syncthreads();
}

struct Args { const float* in[25]; float* out; unsigned char* ws; int ph_lo, ph_hi; };
enum { I_X = 0, I_C, I_AWIN, I_ABG, I_AMH, I_AWOUT, I_KVNORM, I_WADAKV, I_BADAKV, I_WKV, I_BFG, I_BWQ, I_BWO, I_NMIX, I_NFFN, I_WADA, I_BADA, I_WR, I_RB, I_WG, I_WU, I_WD, I_NFIN, I_WADAF, I_BADAF };

struct Frame {
    LAS unsigned char* lds;
    volatile LAS unsigned* MISC;
    gu32* ctl;
    int wave;
    int cid;
    int vcu, G;
};

__device__ __forceinline__ float wave_sum(float v) {
#pragma unroll
    for (int o = 1; o < 64; o <<= 1) v += __shfl_xor(v, o);
    return v;
}

__device__ __forceinline__ void p0_transpose_blk(const float* W, int ldw, int k0, int n0, bf16* WT, int ldt, int drow0, LAS float* scr, int lane) {
    float tv[32];
#pragma unroll
    for (int i = 0; i < 32; ++i) tv[i] = ((const GAS float*)W)[(size_t)(k0 + 2 * i + (lane >> 5)) * ldw + n0 + (lane & 31)];
#pragma unroll
    for (int i = 0; i < 32; ++i) scr[(2 * i + (lane >> 5)) * 33 + (lane & 31)] = tv[i];
    LDS_WAIT(); asm volatile("" ::: "memory");
    const int c = lane & 7;
#pragma unroll
    for (int j = 0; j < 4; ++j) { const int n = (lane >> 3) + 8 * j; const LAS float* s = scr + (8 * c) * 33 + n;
        v4u o; o.x = pk2(s[0 * 33], s[1 * 33]); o.y = pk2(s[2 * 33], s[3 * 33]); o.z = pk2(s[4 * 33], s[5 * 33]); o.w = pk2(s[6 * 33], s[7 * 33]);
        *(GAS v4u*)(WT + (size_t)(drow0 + n) * ldt + k0 + 8 * c) = o; }
    LDS_WAIT(); asm volatile("" ::: "memory");
}
__device__ __forceinline__ void p0_transpose_blk8(const float* W, int ldw, int k0, int n0, unsigned char* WT, int ldt, int drow0, float mul, LAS float* scr, int lane) {
    float tv[32];
#pragma unroll
    for (int i = 0; i < 32; ++i) tv[i] = ((const GAS float*)W)[(size_t)(k0 + 2 * i + (lane >> 5)) * ldw + n0 + (lane & 31)];
#pragma unroll
    for (int i = 0; i < 32; ++i) scr[(2 * i + (lane >> 5)) * 33 + (lane & 31)] = tv[i];
    LDS_WAIT(); asm volatile("" ::: "memory");
    const int c = lane & 7;
#pragma unroll
    for (int j = 0; j < 4; ++j) { const int n = (lane >> 3) + 8 * j; const LAS float* s = scr + (8 * c) * 33 + n;
        int w0 = 0, w1 = 0;
        w0 = cvt8(s[0 * 33] * mul, s[1 * 33] * mul, w0, false); w0 = cvt8(s[2 * 33] * mul, s[3 * 33] * mul, w0, true);
        w1 = cvt8(s[4 * 33] * mul, s[5 * 33] * mul, w1, false); w1 = cvt8(s[6 * 33] * mul, s[7 * 33] * mul, w1, true);
        v2u o; o.x = (unsigned)w0; o.y = (unsigned)w1;
        *(GAS v2u*)(WT + (size_t)(drow0 + n) * ldt + k0 + 8 * c) = o; }
    LDS_WAIT(); asm volatile("" ::: "memory");
}
__device__ __forceinline__ void p0_prologue(Frame& F, const Args& a) {
    unsigned char* ws = a.ws; const int ptid = HW_TID(F.wave), plane = ptid & 63;
    {
        LAS float* cact = (LAS float*)(F.lds);
        LAS float* red = (LAS float*)(F.lds + 65536);
        const float* c = a.in[I_C];
        { float cv_[32];
#pragma unroll
          for (int k = 0; k < 32; ++k) cv_[k] = ((const GAS float*)c)[ptid + 512 * k];
#pragma unroll
          for (int k = 0; k < 32; ++k) { const int i = ptid + 512 * k, b = i >> 10, d = i & 1023; const float v = cv_[k]; cact[d * 16 + b] = v / (1.0f + __expf(-v)); } }
        __syncthreads();
        for (int blk = blockIdx.x; blk < 224; blk += F.G) {
            const float* W; const float* bias; float* out; bf16* out16 = nullptr; int ldw, e0, ostride;
            if (blk < 192) { const int l = blk / 48; e0 = (blk % 48) * 128; W = a.in[I_WADA] + (size_t)l * DM * 6144; ldw = 6144; bias = a.in[I_BADA] + l * 6144; out = (float*)(ws + WS_MODS) + (size_t)l * NB * 6144; ostride = 6144; out16 = (bf16*)(ws + WS_MODS16) + (size_t)l * NB * 6144; }
            else if (blk < 208) { e0 = (blk - 192) * 128; W = a.in[I_WADAKV]; ldw = 2048; bias = a.in[I_BADAKV]; out = (float*)(ws + WS_KVMOD); ostride = 2048; }
            else { e0 = (blk - 208) * 128; W = a.in[I_WADAF]; ldw = 2048; bias = a.in[I_BADAF]; out = (float*)(ws + WS_FIN); ostride = 2048; }
            const int col = ptid & 127, ks = ptid >> 7;
            float acc[16];
#pragma unroll
            for (int b = 0; b < 16; ++b) acc[b] = 0.f;
            const float* wp = W + (size_t)(ks * 256) * ldw + e0 + col;
#pragma clang loop unroll(disable)
            for (int d0 = 0; d0 < 256; d0 += 32) { float wv[32];
#pragma unroll
              for (int dd = 0; dd < 32; ++dd) wv[dd] = ((const GAS float*)wp)[(size_t)(d0 + dd) * ldw];
#pragma unroll
              for (int dd = 0; dd < 32; ++dd) { const int d = d0 + dd; const float w = wv[dd]; const LAS f32x4* cp = (const LAS f32x4*)(cact + (ks * 256 + d) * 16);
#pragma unroll
                for (int q = 0; q < 4; ++q) { const f32x4 cv = cp[q]; acc[4 * q + 0] += w * cv[0]; acc[4 * q + 1] += w * cv[1]; acc[4 * q + 2] += w * cv[2]; acc[4 * q + 3] += w * cv[3]; } } }
#pragma unroll
            for (int b = 0; b < 16; ++b) red[(ks * 128 + col) * 16 + b] = acc[b];
            __syncthreads();
            for (int i = ptid; i < 128 * 16; i += 512) { const int cc = i & 127, b = i >> 7;
                const float s = red[(0 * 128 + cc) * 16 + b] + red[(1 * 128 + cc) * 16 + b] + red[(2 * 128 + cc) * 16 + b] + red[(3 * 128 + cc) * 16 + b];
                const float v = s + bias[e0 + cc]; out[(size_t)b * ostride + e0 + cc] = v; if (out16) out16[(size_t)b * 6144 + e0 + cc] = (bf16)f2bf(v); }
            __syncthreads();
        }
    }
    __syncthreads();
    {
        static_assert(PROJ_F8 && OUT_F8 && MOE1_F8 && MOE2_F8, "the prologue converts every GEMM weight to fp8");
        LAS float* scr = (LAS float*)(F.lds + F.wave * 16384);
        const int gw = F.vcu * NWAVES + F.wave, NGW = F.G * NWAVES;
        constexpr int I_IN = 16 * 96, I_SQ = 16 * 32, I_KV = 16 * 64, I_GU = 16 * 16, I_DN = 8 * 32;
        constexpr int N_IN = 2 * I_IN, N_OUT = 2 * I_SQ, N_KV = I_KV, N_Q = 2 * I_SQ, N_O = 2 * I_SQ, N_G = 64 * I_GU, N_U = 64 * I_GU, N_D = 64 * I_DN;
        constexpr int NITEMS = N_IN + N_OUT + N_KV + N_Q + N_O + N_G + N_U + N_D;
        struct Blk { const float* W; int ldw, k0, n0; unsigned char* WT; int ldt, drow0; };
        auto decode = [&](int it) -> Blk { Blk B; int r = it;
            if (r < N_IN) { const int l = r / I_IN, q = r % I_IN, kb = q / 96, nb = q % 96; B = Blk{a.in[I_AWIN] + (size_t)l * DM * A_IN, A_IN, 64 * kb, 32 * nb, (unsigned char*)(ws + WS_WIN) + (size_t)l * A_PROJ * DM, DM, 32 * nb}; return B; } r -= N_IN;
            if (r < N_OUT) { const int l = r / I_SQ, q = r % I_SQ, kb = q / 32, nb = q % 32; B = Blk{a.in[I_AWOUT] + (size_t)l * DM * DM, DM, 64 * kb, 32 * nb, (unsigned char*)(ws + WS_WOUT) + (size_t)l * DM * DM, DM, 32 * nb}; return B; } r -= N_OUT;
            if (r < N_KV) { const int kb = r / 64, nb = r % 64; B = Blk{a.in[I_WKV], KV_OUT, 64 * kb, 32 * nb, (unsigned char*)(ws + WS_WKV), DM, 32 * nb}; return B; } r -= N_KV;
            if (r < N_Q) { const int l = r / I_SQ, q = r % I_SQ, kb = q / 32, nb = q % 32; B = Blk{a.in[I_BWQ] + (size_t)l * DM * DM, DM, 64 * kb, 32 * nb, (unsigned char*)(ws + WS_WQ) + (size_t)l * DM * DM, DM, 32 * nb}; return B; } r -= N_Q;
            if (r < N_O) { const int l = r / I_SQ, q = r % I_SQ, kb = q / 32, nb = q % 32; B = Blk{a.in[I_BWO] + (size_t)l * DM * DM, DM, 64 * kb, 32 * nb, (unsigned char*)(ws + WS_WO) + (size_t)l * DM * DM, DM, 32 * nb}; return B; } r -= N_O;
            if (r < N_G + N_U) { const int up = r >= N_G; if (up) r -= N_G; const int le = r / I_GU, q = r % I_GU, kb = q / 16, nb = q % 16; const int n0 = 32 * nb;
                B = Blk{a.in[up ? I_WU : I_WG] + (size_t)le * DM * DE, DE, 64 * kb, n0, (unsigned char*)(ws + WS_BT1) + (size_t)le * 1024 * DM, DM, (n0 >> 7) * 256 + up * 128 + (n0 & 127)}; return B; } r -= N_G + N_U;
            { const int le = r / I_DN, q = r % I_DN, kb = q / 32, nb = q % 32; B = Blk{a.in[I_WD] + (size_t)le * DE * DM, DM, 64 * kb, 32 * nb, (unsigned char*)(ws + WS_BT2) + (size_t)le * DM * DE, DE, 32 * nb}; return B; } };
        const int lane = plane;
        float tv[32];
        if (gw < NITEMS) { const Blk B = decode(gw);
#pragma unroll
            for (int i = 0; i < 32; ++i) tv[i] = ((const GAS float*)B.W)[(size_t)(B.k0 + 2 * i + (lane >> 5)) * B.ldw + B.n0 + (lane & 31)]; }
        for (int it = gw; it < NITEMS; it += NGW) {
            const Blk B = decode(it);
#pragma unroll
            for (int i = 0; i < 32; ++i) scr[(2 * i + (lane >> 5)) * 33 + (lane & 31)] = tv[i] * 32.0f;
            if (it + NGW < NITEMS) { const Blk Bn = decode(it + NGW);
#pragma unroll
                for (int i = 0; i < 32; ++i) tv[i] = ((const GAS float*)Bn.W)[(size_t)(Bn.k0 + 2 * i + (lane >> 5)) * Bn.ldw + Bn.n0 + (lane & 31)]; }
            LDS_WAIT(); asm volatile("" ::: "memory");
            const int c = lane & 7;
#pragma unroll
            for (int j = 0; j < 4; ++j) { const int n = (lane >> 3) + 8 * j; const LAS float* s = scr + (8 * c) * 33 + n;
                int w0 = 0, w1 = 0;
                w0 = cvt8(s[0 * 33], s[1 * 33], w0, false); w0 = cvt8(s[2 * 33], s[3 * 33], w0, true);
                w1 = cvt8(s[4 * 33], s[5 * 33], w1, false); w1 = cvt8(s[6 * 33], s[7 * 33], w1, true);
                v2u o; o.x = (unsigned)w0; o.y = (unsigned)w1;
                *(GAS v2u*)(B.WT + (size_t)(B.drow0 + n) * B.ldt + B.k0 + 8 * c) = o; }
            LDS_WAIT(); asm volatile("" ::: "memory");
        }
    }
}

__device__ __forceinline__ float log_sigmoidf_(float x) { return fminf(x, 0.f) - log1pf(__expf(-fabsf(x))); }
template <bool ROUTER>
__device__ __forceinline__ void norm_phase(Frame& F, const void* xv, int xbf, const float* gamma, const float* shift, const float* scale, int mstride, bf16* out,
                                           int mode, const float* W16, int ldw, const float* bias16, float* G16, float2* wts, int* perm, gu32* gcnt) {
    LAS float* wT = (LAS float*)(F.lds);
    LAS int* hist = (LAS int*)(F.lds + 65536);
    LAS int* sbase = hist + 32;
    LAS int* tinfo = hist + 64;
    LAS float* slog = (LAS float*)(F.lds + 65536 + 2048);
    int tid_ = HW_TID(F.wave); asm volatile("" : "+v"(tid_)); int bid_ = blockIdx.x; asm volatile("" : "+s"(bid_)); const int bid = bid_; const int tid = tid_, lane = tid & 63, wave = __builtin_amdgcn_readfirstlane(tid >> 6);
    if (mode != 0) { for (int i = tid; i < DM * 16; i += 512) { const int d = i >> 4, e = i & 15; wT[e * DM + d] = W16[(size_t)d * ldw + e]; } }
    if (tid < 32) hist[tid] = 0;
    __syncthreads();
    for (int chunk = bid; chunk < NT / 256; chunk += F.G) {
        const int b = chunk >> 4;
        f32x4 ga[4], sb[4];
#pragma unroll
        for (int j = 0; j < 4; ++j) { const int col = 4 * lane + 256 * j; const f32x4 g = *(const f32x4*)(gamma + col), sc = *(const f32x4*)(scale + (size_t)b * mstride + col); sb[j] = *(const f32x4*)(shift + (size_t)b * mstride + col);
            ga[j] = g * (sc + 1.0f); }
#pragma clang loop unroll(disable)
        for (int i = 0; i < 32; ++i) {
            const int row = chunk * 256 + wave * 32 + i;
            f32x4 v[4]; float s = 0.f;
            if (xbf) { const GAS v2u* xr = (const GAS v2u*)((const bf16*)xv + (size_t)row * DM) + lane;
#pragma unroll
                for (int j = 0; j < 4; ++j) { const v2u t = xr[64 * j]; v[j] = (f32x4){bf2f(t.x & 0xffffu), bf2f(t.x >> 16), bf2f(t.y & 0xffffu), bf2f(t.y >> 16)}; } }
            else { const GAS f32x4* xr = (const GAS f32x4*)((const float*)xv + (size_t)row * DM) + lane;
#pragma unroll
                for (int j = 0; j < 4; ++j) v[j] = xr[64 * j]; }
#pragma unroll
            for (int j = 0; j < 4; ++j) s += (v[j].x * v[j].x + v[j].y * v[j].y) + (v[j].z * v[j].z + v[j].w * v[j].w);
            const float r = 1.0f / sqrtf(wave_sum(s) * (1.0f / DM) + EPS);
            GAS v2u* o8 = (GAS v2u*)(out + (size_t)row * DM) + lane;
#pragma unroll
            for (int j = 0; j < 4; ++j) { v[j] = v[j] * r * ga[j] + sb[j];
                if (ROUTER ? MOE1_F8 : PROJ_F8) { int w8 = 0; w8 = cvt8(v[j].x, v[j].y, w8, false); w8 = cvt8(v[j].z, v[j].w, w8, true); ((GAS unsigned*)((unsigned char*)out + (size_t)row * DM))[lane + 64 * j] = (unsigned)w8; }
                else { v2u w; w.x = pk2(v[j].x, v[j].y); w.y = pk2(v[j].z, v[j].w); o8[64 * j] = w; } }
            if (mode == 0) continue;
            float p[16];
#pragma unroll
            for (int e = 0; e < 16; ++e) { float a = 0.f;
#pragma unroll
                for (int j = 0; j < 4; ++j) { const f32x4 w = *(const LAS f32x4*)(wT + e * DM + 4 * lane + 256 * j); a += (v[j].x * w.x + v[j].y * w.y) + (v[j].z * w.z + v[j].w * w.w); }
                p[e] = a; }
#pragma unroll
            for (int k = 0; k < 8; ++k) { const bool hi = lane & 32; const float mine = hi ? p[k + 8] : p[k], send = hi ? p[k] : p[k + 8]; p[k] = mine + __shfl_xor(send, 32); }
#pragma unroll
            for (int k = 0; k < 4; ++k) { const bool hi = lane & 16; const float mine = hi ? p[k + 4] : p[k], send = hi ? p[k] : p[k + 4]; p[k] = mine + __shfl_xor(send, 16); }
#pragma unroll
            for (int k = 0; k < 2; ++k) { const bool hi = lane & 8; const float mine = hi ? p[k + 2] : p[k], send = hi ? p[k] : p[k + 2]; p[k] = mine + __shfl_xor(send, 8); }
            { const bool hi = lane & 4; const float mine = hi ? p[1] : p[0], send = hi ? p[0] : p[1]; p[0] = mine + __shfl_xor(send, 4); }
            p[0] += __shfl_xor(p[0], 2); p[0] += __shfl_xor(p[0], 1);
            if ((lane & 3) == 0) slog[(wave * 32 + i) * 16 + ((lane >> 2) & 15)] = p[0];
        }
        if (mode != 0) {
            if (!ROUTER) {
#pragma clang loop unroll(disable)
                for (int k = 0; k < 8; ++k) { const int idx = lane + 64 * k, e = idx & 15; float g = slog[wave * 512 + idx] + bias16[e];
                    if (mode == 1) { g = 15.0f * tanhf(g * (1.0f / 15.0f)); if (e >= 8) g = log_sigmoidf_(g); } else g = log_sigmoidf_(g);
                    G16[(size_t)(chunk * 256 + wave * 32) * 16 + idx] = g; }
            } else if (lane < 32) {
                const int row = chunk * 256 + wave * 32 + lane;
                float aff[16], sel[16];
#pragma unroll
                for (int q4 = 0; q4 < 4; ++q4) { const f32x4 lg = *(const LAS f32x4*)(slog + (wave * 32 + lane) * 16 + 4 * q4);
#pragma unroll
                    for (int q = 0; q < 4; ++q) { aff[4 * q4 + q] = 1.0f / (1.0f + __expf(-lg[q])); sel[4 * q4 + q] = aff[4 * q4 + q] + bias16[4 * q4 + q]; } }
                float gs[4];
#pragma unroll
                for (int g = 0; g < 4; ++g) { const float s0 = sel[4 * g], s1 = sel[4 * g + 1], s2 = sel[4 * g + 2], s3 = sel[4 * g + 3];
                    const float a = fmaxf(s0, s1), bb = fminf(s0, s1), c = fmaxf(s2, s3), d = fminf(s2, s3);
                    gs[g] = fmaxf(a, c) + fmaxf(fminf(a, c), fmaxf(bb, d)); }
                int grp = 0; float best = gs[0];
#pragma unroll
                for (int g = 1; g < 4; ++g) if (gs[g] > best) { best = gs[g]; grp = g; }
                float sg[4], ag[4];
#pragma unroll
                for (int q = 0; q < 4; ++q) { sg[q] = grp == 0 ? sel[q] : grp == 1 ? sel[4 + q] : grp == 2 ? sel[8 + q] : sel[12 + q]; ag[q] = grp == 0 ? aff[q] : grp == 1 ? aff[4 + q] : grp == 2 ? aff[8 + q] : aff[12 + q]; }
                int i1 = 0; float b1 = sg[0];
#pragma unroll
                for (int q = 1; q < 4; ++q) if (sg[q] > b1) { b1 = sg[q]; i1 = q; }
                int i2 = -1; float b2 = 0.f;
#pragma unroll
                for (int q = 0; q < 4; ++q) if (q != i1 && (i2 < 0 || sg[q] > b2)) { b2 = sg[q]; i2 = q; }
                const int ea = i1 < i2 ? i1 : i2, eb = i1 < i2 ? i2 : i1;
                const float wa = ea == 0 ? ag[0] : ea == 1 ? ag[1] : ag[2], wb = eb == 1 ? ag[1] : eb == 2 ? ag[2] : ag[3];
                const float inv = 1.0f / (wa + wb);
                const int pid = ea == 0 ? eb - 1 : ea == 1 ? eb + 1 : 5;
                const int cls = grp * 6 + pid;
                wts[row] = make_float2(wa * inv, wb * inv); const int rk = __hip_atomic_fetch_add(&hist[cls], 1, __ATOMIC_RELAXED, __HIP_MEMORY_SCOPE_WORKGROUP); tinfo[wave * 32 + lane] = cls | (rk << 8);
            }
        }
        if (ROUTER) {
            __syncthreads();
            if (tid < NCLS) { const int n = hist[tid]; sbase[tid] = n ? (int)__hip_atomic_fetch_add(gcnt + tid, (unsigned)n, RLX_AGENT) : 0; }
            __syncthreads();
            if (tid < 256) { const int ti = tinfo[tid], cls = ti & 255, rk = ti >> 8; perm[(size_t)cls * CLS_CAP + sbase[cls] + rk] = chunk * 256 + tid; }
            __syncthreads();
            if (tid < 32) hist[tid] = 0;
            __syncthreads();
        }
    }
    __syncthreads();
}
template <bool ROUTER>
__device__ __forceinline__ void normT_phase(Frame& F, const void* xv, int xbf, const float* gamma, const float* shift, const float* scale, int mstride, bf16* out,
                                            int mode, const float* W16, int ldw, const float* bias16, float* G16, float2* wts, int* perm, gu32* gcnt) {
    constexpr bool OUT8 = ROUTER ? MOE1_F8 : PROJ_F8;
    constexpr int WP = 1032;
    LAS float* sG = (LAS float*)(F.lds);
    LAS float* sS = sG + 1024;
    LAS bf16* sWh = (LAS bf16*)(F.lds + 8192);
    LAS bf16* sWl = sWh + 16 * WP;
    LAS float* slog = (LAS float*)(F.lds + 8192 + 2 * 16 * WP * 2);
    LAS int* hist = (LAS int*)(slog + 8 * 32 * 16);
    LAS int* sbase = hist + 32;
    LAS int* tinfo = hist + 64;
    LAS v2u* tw = (LAS v2u*)(tinfo + 256);
    int tid_ = HW_TID(F.wave); asm volatile("" : "+v"(tid_)); int bid_ = blockIdx.x; asm volatile("" : "+s"(bid_)); const int bid = bid_;
    const int tid = tid_, lane = tid & 63, wave = __builtin_amdgcn_readfirstlane(tid >> 6), r = lane & 15, g = lane >> 4;
    if (mode != 0) {
        float wv[32];
#pragma unroll
        for (int k = 0; k < 32; ++k) { const int i = tid + 512 * k; wv[k] = ((const GAS float*)W16)[(size_t)(i >> 4) * ldw + (i & 15)]; }
#pragma unroll
        for (int k = 0; k < 32; ++k) { const int i = tid + 512 * k, d = i >> 4, e = i & 15; const float w = wv[k]; const unsigned hi = f2bf(w); sWh[e * WP + d] = (bf16)hi; sWl[e * WP + d] = (bf16)f2bf(w - bf2f(hi)); } }
    if (tid < 32) hist[tid] = 0;
    int cur_b = -1;
    for (int chunk = bid; chunk < NT / 256; chunk += F.G) {
        const int b = chunk >> 4;
        if (b != cur_b) { cur_b = b; __syncthreads();
            { const GAS float* const gamma_ = (const GAS float*)gamma; const GAS float* const scale_ = (const GAS float*)scale; const GAS float* const shift_ = (const GAS float*)shift;
              const float g0 = gamma_[tid], g1 = gamma_[tid + 512], c0 = scale_[(size_t)b * mstride + tid], c1 = scale_[(size_t)b * mstride + tid + 512], h0 = shift_[(size_t)b * mstride + tid], h1 = shift_[(size_t)b * mstride + tid + 512];
              sG[tid] = g0 * (1.0f + c0); sG[tid + 512] = g1 * (1.0f + c1); sS[tid] = h0; sS[tid + 512] = h1; } }
        __syncthreads();
#pragma clang loop unroll(disable)
        for (int tt = 0; tt < 2; ++tt) {
            const int row = chunk * 256 + wave * 32 + 16 * tt + r;
            v4u xp[16][2]; float ss = 0.f;
            if (xbf) { const GAS v4u* xr = (const GAS v4u*)((const bf16*)xv + (size_t)row * DM + 16 * g);
#pragma unroll
                for (int kp = 0; kp < 16; ++kp) { xp[kp][0] = xr[8 * kp]; xp[kp][1] = xr[8 * kp + 1]; } }
            else { const GAS f32x4* xr = (const GAS f32x4*)((const float*)xv + (size_t)row * DM + 16 * g);
#pragma unroll
                for (int kp = 0; kp < 16; ++kp) { const f32x4 a = xr[16 * kp], b2 = xr[16 * kp + 1], c = xr[16 * kp + 2], d = xr[16 * kp + 3];
                    xp[kp][0] = (v4u){pk2(a.x, a.y), pk2(a.z, a.w), pk2(b2.x, b2.y), pk2(b2.z, b2.w)}; xp[kp][1] = (v4u){pk2(c.x, c.y), pk2(c.z, c.w), pk2(d.x, d.y), pk2(d.z, d.w)};
                    if (kp & 1) asm volatile("" ::: "memory"); } }
#pragma unroll
            for (int kp = 0; kp < 16; ++kp)
#pragma unroll
                for (int q = 0; q < 2; ++q)
#pragma unroll
                    for (int j = 0; j < 4; ++j) { const float lo = bf2f(xp[kp][q][j] & 0xffffu), hi = bf2f(xp[kp][q][j] >> 16); ss += lo * lo + hi * hi; }
            ss += __shfl_xor(ss, 16); ss += __shfl_xor(ss, 32);
            const float rr = 1.0f / sqrtf(ss * (1.0f / DM) + EPS);
#pragma unroll
            for (int kp = 0; kp < 16; ++kp) { asm volatile("" : "+v"(xp[kp][0]), "+v"(xp[kp][1])); }
            f32x4 acc = (f32x4){0.f, 0.f, 0.f, 0.f};
#pragma unroll
            for (int kp = 0; kp < 16; ++kp) {
                asm volatile("" ::: "memory");
                const int c0 = 64 * kp + 16 * g;
                bf16x8 ahi[2], alo[2];
#pragma unroll
                for (int q = 0; q < 2; ++q) { const f32x4 g0 = *(const LAS f32x4*)(sG + c0 + 8 * q), g1 = *(const LAS f32x4*)(sG + c0 + 8 * q + 4), s0 = *(const LAS f32x4*)(sS + c0 + 8 * q), s1 = *(const LAS f32x4*)(sS + c0 + 8 * q + 4);
                    float h[8];
#pragma unroll
                    for (int j = 0; j < 4; ++j) { const float lo = bf2f(xp[kp][q][j] & 0xffffu), hi = bf2f(xp[kp][q][j] >> 16);
                        const float gg0 = j < 2 ? g0[2 * j] : g1[2 * j - 4], gg1 = j < 2 ? g0[2 * j + 1] : g1[2 * j - 3], sh0 = j < 2 ? s0[2 * j] : s1[2 * j - 4], sh1 = j < 2 ? s0[2 * j + 1] : s1[2 * j - 3];
                        h[2 * j] = lo * rr * gg0 + sh0; h[2 * j + 1] = hi * rr * gg1 + sh1; }
                    v4u hp;
#pragma unroll
                    for (int j = 0; j < 4; ++j) hp[j] = pk2(h[2 * j], h[2 * j + 1]);
                    ahi[q] = __builtin_bit_cast(bf16x8, hp);
                    if (ROUTER && RSPLIT) { v4u lp;
#pragma unroll
                        for (int j = 0; j < 4; ++j) lp[j] = pk2(h[2 * j] - bf2f(hp[j] & 0xffffu), h[2 * j + 1] - bf2f(hp[j] >> 16));
                        alo[q] = __builtin_bit_cast(bf16x8, lp); }
                    if (OUT8) { int w0 = 0, w1 = 0;
                        w0 = cvt8(h[0], h[1], w0, false); w0 = cvt8(h[2], h[3], w0, true);
                        w1 = cvt8(h[4], h[5], w1, false); w1 = cvt8(h[6], h[7], w1, true);
                        v2u o; o.x = (unsigned)w0; o.y = (unsigned)w1; *(GAS v2u*)((unsigned char*)out + (size_t)row * DM + c0 + 8 * q) = o; }
                    else *(GAS v4u*)(out + (size_t)row * DM + c0 + 8 * q) = hp;
                }
                if (mode != 0) {
#pragma unroll
                    for (int q = 0; q < 2; ++q) { const bf16x8 bh = *(const LAS bf16x8*)(sWh + r * WP + c0 + 8 * q), bl = *(const LAS bf16x8*)(sWl + r * WP + c0 + 8 * q);
                        acc = __builtin_amdgcn_mfma_f32_16x16x32_bf16(ahi[q], bh, acc, 0, 0, 0); if (ROUTER && RSPLIT) { acc = __builtin_amdgcn_mfma_f32_16x16x32_bf16(alo[q], bh, acc, 0, 0, 0); acc = __builtin_amdgcn_mfma_f32_16x16x32_bf16(ahi[q], bl, acc, 0, 0, 0); } } }
            }
            if (mode != 0) {
                const int e = r;
                if (!ROUTER) { const float be = bias16[e];
#pragma unroll
                    for (int i = 0; i < 4; ++i) { float gv = acc[i] + be;
                        if (mode == 1) { gv = 15.0f * tanhf(gv * (1.0f / 15.0f)); if (e >= 8) gv = log_sigmoidf_(gv); } else gv = log_sigmoidf_(gv);
                        ((GAS float*)G16)[(size_t)(chunk * 256 + wave * 32 + 16 * tt + 4 * g + i) * 16 + e] = gv; } }
                else {
#pragma unroll
                    for (int i = 0; i < 4; ++i) slog[(wave * 32 + 16 * tt + 4 * g + i) * 16 + e] = acc[i]; }
            }
        }
        if (ROUTER) {
            if (lane < 32) {
                const int row = chunk * 256 + wave * 32 + lane;
                float aff[16], sel[16];
#pragma unroll
                for (int q4 = 0; q4 < 4; ++q4) { const f32x4 lg = *(const LAS f32x4*)(slog + (wave * 32 + lane) * 16 + 4 * q4);
#pragma unroll
                    for (int q = 0; q < 4; ++q) { aff[4 * q4 + q] = 1.0f / (1.0f + __expf(-lg[q])); sel[4 * q4 + q] = aff[4 * q4 + q] + bias16[4 * q4 + q]; } }
                float gs[4];
#pragma unroll
                for (int gq = 0; gq < 4; ++gq) { const float s0 = sel[4 * gq], s1 = sel[4 * gq + 1], s2 = sel[4 * gq + 2], s3 = sel[4 * gq + 3];
                    const float a = fmaxf(s0, s1), bb = fminf(s0, s1), c = fmaxf(s2, s3), d = fminf(s2, s3);
                    gs[gq] = fmaxf(a, c) + fmaxf(fminf(a, c), fmaxf(bb, d)); }
                int grp = 0; float best = gs[0];
#pragma unroll
                for (int gq = 1; gq < 4; ++gq) if (gs[gq] > best) { best = gs[gq]; grp = gq; }
                float sg[4], ag[4];
#pragma unroll
                for (int q = 0; q < 4; ++q) { sg[q] = grp == 0 ? sel[q] : grp == 1 ? sel[4 + q] : grp == 2 ? sel[8 + q] : sel[12 + q]; ag[q] = grp == 0 ? aff[q] : grp == 1 ? aff[4 + q] : grp == 2 ? aff[8 + q] : aff[12 + q]; }
                int i1 = 0; float b1 = sg[0];
#pragma unroll
                for (int q = 1; q < 4; ++q) if (sg[q] > b1) { b1 = sg[q]; i1 = q; }
                int i2 = -1; float b2 = 0.f;
#pragma unroll
                for (int q = 0; q < 4; ++q) if (q != i1 && (i2 < 0 || sg[q] > b2)) { b2 = sg[q]; i2 = q; }
                const int ea = i1 < i2 ? i1 : i2, eb = i1 < i2 ? i2 : i1;
                const float wa = ea == 0 ? ag[0] : ea == 1 ? ag[1] : ag[2], wb = eb == 1 ? ag[1] : eb == 2 ? ag[2] : ag[3];
                const float inv = 1.0f / (wa + wb);
                const int pid = ea == 0 ? eb - 1 : ea == 1 ? eb + 1 : 5;
                const int cls = grp * 6 + pid;
                const int rk = __hip_atomic_fetch_add(&hist[cls], 1, __ATOMIC_RELAXED, __HIP_MEMORY_SCOPE_WORKGROUP); tinfo[wave * 32 + lane] = cls | (rk << 8); tw[wave * 32 + lane] = (v2u){__builtin_bit_cast(unsigned, wa * inv), __builtin_bit_cast(unsigned, wb * inv)}; (void)row;
            }
            __syncthreads();
            if (tid < NCLS) { const int n = hist[tid]; sbase[tid] = n ? (int)__hip_atomic_fetch_add(gcnt + tid, (unsigned)n, RLX_AGENT) : 0; }
            __syncthreads();
            if (tid < 256) { const int ti = tinfo[tid], cls = ti & 255, rk = ti >> 8; const v2u w2 = tw[tid]; const size_t pi = (size_t)cls * CLS_CAP + sbase[cls] + rk; ((GAS int*)perm)[pi] = chunk * 256 + tid;
                ((GAS v4u*)wts)[pi] = (v4u){(unsigned)(chunk * 256 + tid), w2.x, w2.y, 0u}; }
            __syncthreads();
            if (tid < 32) hist[tid] = 0;
        }
    }
    __syncthreads();
}
__device__ __forceinline__ void final_norm_phase(Frame& F, const bf16* xb, float* out, const float* gamma, const float* shift, const float* scale, int mstride) {
    int tid_ = HW_TID(F.wave); asm volatile("" : "+v"(tid_)); int bid_ = blockIdx.x; asm volatile("" : "+s"(bid_)); const int bid = bid_; const int lane = tid_ & 63, wave = __builtin_amdgcn_readfirstlane(tid_ >> 6);
    for (int chunk = bid; chunk < NT / 256; chunk += F.G) {
        const int b = chunk >> 4;
        f32x4 ga[4], sb[4];
#pragma unroll
        for (int j = 0; j < 4; ++j) { const int col = 4 * lane + 256 * j; const f32x4 g = *(const f32x4*)(gamma + col), sc = *(const f32x4*)(scale + (size_t)b * mstride + col); sb[j] = *(const f32x4*)(shift + (size_t)b * mstride + col);
            ga[j] = g * (sc + 1.0f); }
        const int row0 = chunk * 256 + wave * 32;
        v2u tn[4];
#pragma unroll
        for (int j = 0; j < 4; ++j) tn[j] = ((const GAS v2u*)(xb + (size_t)row0 * DM) + lane)[64 * j];
#pragma clang loop unroll(disable)
        for (int i = 0; i < 32; ++i) {
            const int row = row0 + i;
            v2u t[4];
#pragma unroll
            for (int j = 0; j < 4; ++j) t[j] = tn[j];
            if (i + 1 < 32) {
#pragma unroll
                for (int j = 0; j < 4; ++j) tn[j] = ((const GAS v2u*)(xb + (size_t)(row + 1) * DM) + lane)[64 * j]; }
            GAS f32x4* orow = (GAS f32x4*)(out + (size_t)row * DM) + lane;
            f32x4 v[4]; float s = 0.f;
#pragma unroll
            for (int j = 0; j < 4; ++j) { v[j] = (f32x4){bf2f(t[j].x & 0xffffu), bf2f(t[j].x >> 16), bf2f(t[j].y & 0xffffu), bf2f(t[j].y >> 16)}; s += (v[j].x * v[j].x + v[j].y * v[j].y) + (v[j].z * v[j].z + v[j].w * v[j].w); }
            const float r = 1.0f / sqrtf(wave_sum(s) * (1.0f / DM) + EPS);
#pragma unroll
            for (int j = 0; j < 4; ++j) orow[64 * j] = v[j] * r * ga[j] + sb[j];
        }
    }
}

__device__ __forceinline__ void fcum_phase(Frame& F, const float* logf, float* FB) {
    LAS float* wtot = (LAS float*)(F.lds);
    int tid_ = HW_TID(F.wave); asm volatile("" : "+v"(tid_)); int bid_ = blockIdx.x; asm volatile("" : "+s"(bid_)); const int bid = bid_; const int tid = tid_, lane = tid & 63, wave = __builtin_amdgcn_readfirstlane(tid >> 6);
    for (int chain = bid; chain < NB * 16; chain += F.G) {
        const int b = chain >> 4, hh = chain & 15;
        float v[8]; float run = 0.f;
#pragma unroll
        for (int j = 0; j < 8; ++j) { run += ((const GAS float*)logf)[((size_t)b * SEQ + tid * 8 + j) * 16 + hh]; v[j] = run; }
        float inc = run;
#pragma unroll
        for (int o = 1; o < 64; o <<= 1) { const float t = __shfl_up(inc, o); if (lane >= o) inc += t; }
        if (lane == 63) wtot[wave] = inc;
        __syncthreads();
        float base = inc - run;
        for (int w = 0; w < wave; ++w) base += wtot[w];
#pragma unroll
        for (int j = 0; j < 8; ++j) ((GAS float*)FB)[(size_t)chain * SEQ + tid * 8 + j] = -(base + v[j]) * 1.4426950408889634f;
        __syncthreads();
    }
}

__device__ __forceinline__ float wave_scan_add(float v, int lane) {
#pragma unroll
    for (int o = 1; o < 64; o <<= 1) { const float t = __shfl_up(v, o); if (lane >= o) v += t; }
    return v;
}
__device__ __forceinline__ float wave_scan_max(float v, int lane) {
#pragma unroll
    for (int o = 1; o < 64; o <<= 1) { const float t = __shfl_up(v, o); if (lane >= o) v = fmaxf(v, t); }
    return v;
}
__device__ __forceinline__ void cell_phase(Frame& F, const bf16* PROJ, const float* G16, const float* mhn, bf16* HS) {
    constexpr int PST = 72;
    LAS bf16* sQ = (LAS bf16*)(F.lds);
    LAS bf16* sK = sQ + 64 * PST;
    LAS bf16* sKT = sK + 64 * PST;
    LAS bf16* sW = sKT + 64 * PST;
    LAS bf16* sVT = sW + 64 * PST;
    LAS bf16* sCT = sVT + 128 * PST;
    LAS float* fz = (LAS float*)(sCT + 128 * PST);
    LAS float* sU = fz, *sM = fz + 64, *sA = fz + 128, *sEm = fz + 192, *sWk = fz + 256, *sInv = fz + 320, *sN = fz + 384, *sScal = fz + 448, *sSS = fz + 512;
    int tid_ = HW_TID(F.wave); asm volatile("" : "+v"(tid_)); int bid_ = blockIdx.x; asm volatile("" : "+s"(bid_)); const int bid = bid_;
    const int tid = tid_, lane = tid & 63, w = __builtin_amdgcn_readfirstlane(tid >> 6), fr = lane & 15, fq = lane >> 4;
    for (int chain = bid; chain < NB * 8; chain += F.G) {
        const int b = chain >> 3, hh = chain & 7;
        f32x4 accC[4];
#pragma unroll
        for (int ni = 0; ni < 4; ++ni) accC[ni] = (f32x4){0.f, 0.f, 0.f, 0.f};
        for (int i = tid; i < 128 * PST; i += 512) sCT[i] = 0;
        if (tid < 64) sN[tid] = 0.f;
        float m_prev = 0.f;
        __syncthreads();
        for (int c = 0; c < SEQ / 64; ++c) {
            const size_t t0 = (size_t)b * SEQ + 64 * c;
            const int row = tid >> 3, seg = tid & 7;
            const bf16* pr = PROJ + (t0 + row) * A_PROJ + hh * 64 + seg * 8;
            const v4u qv = *(const GAS v4u*)pr, kv = *(const GAS v4u*)(pr + 512);
            const bf16* pv = PROJ + (t0 + row) * A_PROJ + 1024 + hh * 128 + seg * 8;
            const v4u v0 = *(const GAS v4u*)pv, v1 = *(const GAS v4u*)(pv + 64);
            float ig = 0.f, lf = 0.f;
            if (tid < 64) { ig = G16[(t0 + tid) * 16 + hh]; lf = G16[(t0 + tid) * 16 + 8 + hh]; }
            *(LAS v4u*)(sQ + row * PST + seg * 8) = qv;
            *(LAS v4u*)(sK + row * PST + seg * 8) = kv;
#pragma unroll
            for (int j = 0; j < 4; ++j) { sVT[(seg * 8 + 2 * j) * PST + row] = (bf16)(v0[j] & 0xffffu); sVT[(seg * 8 + 2 * j + 1) * PST + row] = (bf16)(v0[j] >> 16);
                sVT[(64 + seg * 8 + 2 * j) * PST + row] = (bf16)(v1[j] & 0xffffu); sVT[(64 + seg * 8 + 2 * j + 1) * PST + row] = (bf16)(v1[j] >> 16); }
            if (w == 0) {
                const float bc = wave_scan_add(lf, lane), u = ig - bc, pm = wave_scan_max(u, lane), M = fmaxf(m_prev, pm);
                const float M63 = __shfl(M, 63), bl = __shfl(bc, 63);
                sU[lane] = u; sM[lane] = M; sA[lane] = __expf(m_prev - M); sEm[lane] = __expf(-(bc + M)); sWk[lane] = __expf(u - M63);
                if (lane == 0) { sScal[0] = __expf(m_prev - M63); sScal[1] = bl + M63; }
            }
            __syncthreads();
            { const float wk = sWk[row];
#pragma unroll
              for (int j = 0; j < 4; ++j) { sKT[(seg * 8 + 2 * j) * PST + row] = (bf16)f2bf(bf2f(kv[j] & 0xffffu) * wk); sKT[(seg * 8 + 2 * j + 1) * PST + row] = (bf16)f2bf(bf2f(kv[j] >> 16) * wk); } }
            { const int mi = w >> 1;
#pragma unroll
              for (int nn = 0; nn < 2; ++nn) { const int ni = (w & 1) * 2 + nn; f32x4 acc = (f32x4){0.f, 0.f, 0.f, 0.f};
#pragma unroll
                for (int ks = 0; ks < 2; ++ks) { const bf16x8 av = *(const LAS bf16x8*)(sQ + (16 * mi + fr) * PST + 32 * ks + 8 * fq), bv = *(const LAS bf16x8*)(sK + (16 * ni + fr) * PST + 32 * ks + 8 * fq);
                    acc = __builtin_amdgcn_mfma_f32_16x16x32_bf16(av, bv, acc, 0, 0, 0); }
                const int s = 16 * ni + fr; const float us = sU[s];
#pragma unroll
                for (int i = 0; i < 4; ++i) { const int t = 16 * mi + 4 * fq + i; const float wv = (s <= t) ? __expf(us - sM[t]) * acc[i] : 0.f; sW[t * PST + s] = (bf16)f2bf(wv); } } }
            __syncthreads();
            { const int t = tid >> 3, part = tid & 7; float d1 = 0.f, qn = 0.f;
#pragma unroll
              for (int j = 0; j < 8; ++j) { d1 += bf2f(sW[t * PST + part * 8 + j]); qn += bf2f(sQ[t * PST + part * 8 + j]) * sN[part * 8 + j]; }
              d1 += __shfl_xor(d1, 1); d1 += __shfl_xor(d1, 2); d1 += __shfl_xor(d1, 4); qn += __shfl_xor(qn, 1); qn += __shfl_xor(qn, 2); qn += __shfl_xor(qn, 4);
              const float den = d1 + sA[t] * qn; if (part == 0) sInv[t] = 1.0f / fmaxf(fabsf(den), sEm[t]); }
            f32x4 acc[4];
#pragma unroll
            for (int mi = 0; mi < 4; ++mi) acc[mi] = (f32x4){0.f, 0.f, 0.f, 0.f};
#pragma unroll
            for (int ks = 0; ks < 2; ++ks) { const bf16x8 bq = *(const LAS bf16x8*)(sCT + (16 * w + fr) * PST + 32 * ks + 8 * fq);
#pragma unroll
                for (int mi = 0; mi < 4; ++mi) { const bf16x8 av = *(const LAS bf16x8*)(sQ + (16 * mi + fr) * PST + 32 * ks + 8 * fq); acc[mi] = __builtin_amdgcn_mfma_f32_16x16x32_bf16(av, bq, acc[mi], 0, 0, 0); } }
#pragma unroll
            for (int mi = 0; mi < 4; ++mi)
#pragma unroll
                for (int i = 0; i < 4; ++i) acc[mi][i] *= sA[16 * mi + 4 * fq + i];
#pragma unroll
            for (int ks = 0; ks < 2; ++ks) { const bf16x8 bv = *(const LAS bf16x8*)(sVT + (16 * w + fr) * PST + 32 * ks + 8 * fq);
#pragma unroll
                for (int mi = 0; mi < 4; ++mi) { const bf16x8 av = *(const LAS bf16x8*)(sW + (16 * mi + fr) * PST + 32 * ks + 8 * fq); acc[mi] = __builtin_amdgcn_mfma_f32_16x16x32_bf16(av, bv, acc[mi], 0, 0, 0); } }
            __syncthreads();
#pragma unroll
            for (int mi = 0; mi < 4; ++mi)
#pragma unroll
                for (int i = 0; i < 4; ++i) { const int t = 16 * mi + 4 * fq + i; const float hv = acc[mi][i] * sInv[t]; acc[mi][i] = hv; float sq = hv * hv;
                    sq += __shfl_xor(sq, 1); sq += __shfl_xor(sq, 2); sq += __shfl_xor(sq, 4); sq += __shfl_xor(sq, 8); if (fr == 0) sSS[w * 64 + t] = sq; }
            __syncthreads();
            { const int col = hh * 128 + 16 * w + fr; const float mh = mhn[col];
#pragma unroll
              for (int mi = 0; mi < 4; ++mi)
#pragma unroll
                for (int i = 0; i < 4; ++i) { const int t = 16 * mi + 4 * fq + i; float tot = 0.f;
#pragma unroll
                    for (int ww = 0; ww < 8; ++ww) tot += sSS[ww * 64 + t];
                    const float rn = 1.0f / sqrtf(tot * (1.0f / 128.0f) + EPS);
                    const float og = bf2f(PROJ[(t0 + t) * A_PROJ + 2048 + col]);
                    HS[(t0 + t) * DM + col] = (bf16)f2bf(acc[mi][i] * rn * mh * og); } }
            { const float decay = sScal[0];
#pragma unroll
              for (int ni = 0; ni < 4; ++ni) accC[ni] = accC[ni] * decay;
#pragma unroll
              for (int ks = 0; ks < 2; ++ks) { const bf16x8 av = *(const LAS bf16x8*)(sVT + (16 * w + fr) * PST + 32 * ks + 8 * fq);
#pragma unroll
                for (int ni = 0; ni < 4; ++ni) { const bf16x8 bv = *(const LAS bf16x8*)(sKT + (16 * ni + fr) * PST + 32 * ks + 8 * fq); accC[ni] = __builtin_amdgcn_mfma_f32_16x16x32_bf16(av, bv, accC[ni], 0, 0, 0); } }
#pragma unroll
              for (int ni = 0; ni < 4; ++ni)
#pragma unroll
                for (int i = 0; i < 4; ++i) sCT[(16 * w + 4 * fq + i) * PST + 16 * ni + fr] = (bf16)f2bf(accC[ni][i]);
              const int d = tid >> 3, part = tid & 7; float sk = 0.f;
#pragma unroll
              for (int j = 0; j < 8; ++j) sk += bf2f(sKT[d * PST + part * 8 + j]);
              sk += __shfl_xor(sk, 1); sk += __shfl_xor(sk, 2); sk += __shfl_xor(sk, 4);
              if (part == 0) sN[d] = decay * sN[d] + sk;
              m_prev = sScal[1]; }
            __syncthreads();
        }
    }
}

typedef short v4i16_t __attribute__((ext_vector_type(4)));
__device__ __forceinline__ unsigned img_off(unsigned row, unsigned ch) { return 256u * row + 16u * (ch ^ (((row & 3u) << 2) | ((row >> 2) & 3u))); }
__device__ __forceinline__ bf16x8 tr_frag(const LAS unsigned char* img, int lane, int c, int rbase, int rstep) {
    const int q = (lane & 15) >> 2, p = lane & 3;
    const v4i16_t lo = __builtin_amdgcn_ds_read_tr16_b64_v4i16((LAS v4i16_t*)(img + img_off(rbase + q, 2 * c + (p >> 1)) + 8 * (p & 1)));
    const v4i16_t hi = __builtin_amdgcn_ds_read_tr16_b64_v4i16((LAS v4i16_t*)(img + img_off(rbase + rstep + q, 2 * c + (p >> 1)) + 8 * (p & 1)));
    return (bf16x8){lo[0], lo[1], lo[2], lo[3], hi[0], hi[1], hi[2], hi[3]};
}
__device__ __forceinline__ void cellA_phase(Frame& F, const bf16* PROJ, const float* G16, bf16* CTS, float* NS, float* MS, float* SCN) {
    LAS unsigned char* img0 = F.lds;
    LAS float* sU = (LAS float*)(F.lds + 32768);
    LAS float* sPM = sU + 4096;
    LAS float* sBL = sPM + 64;
    int tid_ = HW_TID(F.wave); asm volatile("" : "+v"(tid_)); int bid_ = blockIdx.x; asm volatile("" : "+s"(bid_)); const int bid = bid_;
    const int tid = tid_, lane = tid & 63, w = __builtin_amdgcn_readfirstlane(tid >> 6), fr = lane & 15, fq = lane >> 4;
    const int vt = w & 3, dh = w >> 2, row = tid >> 3, seg = tid & 7;
    bf16x8 ones;
#pragma unroll
    for (int j = 0; j < 8; ++j) ones[j] = (short)0x3F80;
    for (int chain = bid; chain < NB * 16; chain += F.G) {
        const int bh = chain >> 1, vh = chain & 1, b = bh >> 3, hh = bh & 7;
        float igs[8], lfs[8];
#pragma unroll
        for (int k = 0; k < 8; ++k) { const float* pg = G16 + ((size_t)b * SEQ + 64 * (w + 8 * k) + lane) * 16 + hh; igs[k] = ((const GAS float*)pg)[0]; lfs[k] = ((const GAS float*)pg)[8]; }
#pragma unroll
        for (int k = 0; k < 8; ++k) { const int c = w + 8 * k; const float ig = igs[k], lf = lfs[k];
            const float bc = wave_scan_add(lf, lane), u = ig - bc, pm = wave_scan_max(u, lane); sU[c * 64 + lane] = u; if (lane == 63) { sPM[c] = pm; sBL[c] = bc; }
            if (vh == 0) { GAS float* sv = (GAS float*)SCN + ((size_t)(bh * 64 + c) * 3) * 64 + lane; sv[0] = u; sv[64] = pm; sv[128] = bc; } }
        f32x4 accC[2], accN[2];
#pragma unroll
        for (int mt = 0; mt < 2; ++mt) { accC[mt] = (f32x4){0.f, 0.f, 0.f, 0.f}; accN[mt] = (f32x4){0.f, 0.f, 0.f, 0.f}; }
        float m_prev = 0.f;
        const bf16* pk = PROJ + ((size_t)b * SEQ + row) * A_PROJ + 512 + hh * 64 + seg * 8;
        const bf16* pv = PROJ + ((size_t)b * SEQ + row) * A_PROJ + 1024 + hh * 128 + vh * 64 + seg * 8;
        v4u kv = *(const GAS v4u*)pk, vv = *(const GAS v4u*)pv;
        pk += (size_t)64 * A_PROJ; pv += (size_t)64 * A_PROJ;
        v4u kv2 = *(const GAS v4u*)pk, vv2 = *(const GAS v4u*)pv;
        __syncthreads();
        for (int c = 0; c < SEQ / 64; ++c) {
            LAS unsigned char* img = img0 + (c & 1) * 16384;
            const float M63 = fmaxf(m_prev, sPM[c]), decay = __expf(m_prev - M63), m_new = sBL[c] + M63, wkr = __expf(sU[c * 64 + row] - M63);
            { bf16* cs = CTS + ((size_t)(bh * 64 + c) * 128 + vh * 64 + 16 * vt + fr) * 64 + 32 * dh + 4 * fq;
#pragma unroll
              for (int mt = 0; mt < 2; ++mt) { v2u o; o.x = pk2(accC[mt][0], accC[mt][1]); o.y = pk2(accC[mt][2], accC[mt][3]); *(GAS v2u*)(cs + 16 * mt) = o; }
              if (vh == 0 && vt == 0 && fr == 0) { *(GAS f32x4*)(NS + (size_t)(bh * 64 + c) * 64 + 32 * dh + 4 * fq) = accN[0]; *(GAS f32x4*)(NS + (size_t)(bh * 64 + c) * 64 + 32 * dh + 16 + 4 * fq) = accN[1]; }
              if (vh == 0 && tid == 0) ((GAS float*)MS)[bh * 64 + c] = m_prev; }
            { v4u ks;
#pragma unroll
              for (int j = 0; j < 4; ++j) ks[j] = pk2(bf2f(kv[j] & 0xffffu) * wkr, bf2f(kv[j] >> 16) * wkr);
              *(LAS v4u*)(img + img_off(row, seg)) = ks; *(LAS v4u*)(img + img_off(row, 8 + seg)) = vv; }
            kv = kv2; vv = vv2;
            if (c + 2 < SEQ / 64) { pk += (size_t)64 * A_PROJ; pv += (size_t)64 * A_PROJ; kv2 = *(const GAS v4u*)pk; vv2 = *(const GAS v4u*)pv; }
            __syncthreads();
#pragma unroll
            for (int mt = 0; mt < 2; ++mt) { accC[mt] = accC[mt] * decay; accN[mt] = accN[mt] * decay; }
#pragma unroll
            for (int ks = 0; ks < 2; ++ks) { const bf16x8 bv = tr_frag(img, lane, 4 + vt, 32 * ks + 8 * fq, 4);
#pragma unroll
                for (int mt = 0; mt < 2; ++mt) { const bf16x8 av = tr_frag(img, lane, 2 * dh + mt, 32 * ks + 8 * fq, 4);
                    accC[mt] = __builtin_amdgcn_mfma_f32_16x16x32_bf16(av, bv, accC[mt], 0, 0, 0); accN[mt] = __builtin_amdgcn_mfma_f32_16x16x32_bf16(av, ones, accN[mt], 0, 0, 0); } }
            m_prev = m_new;
        }
        __syncthreads();
    }
}
struct CellOps { bf16x8 oq[2], ok[4][2]; float u, pm, bc, m_c; };
#define CELL_LOAD_OPS(D, rb_, hh_, mi_) do { const size_t t0_ = (size_t)(rb_) * 64; const int bh_ = ((rb_) >> 6) * 8 + (hh_), c_ = (rb_) & 63; \
    _Pragma("unroll") for (int ks = 0; ks < 2; ++ks) D.oq[ks] = *(const GAS bf16x8*)(PROJ + (t0_ + 16 * (mi_) + fr) * A_PROJ + (hh_) * 64 + 32 * ks + 8 * fq); \
    _Pragma("unroll") for (int si = 0; si < 4; ++si) if (si <= (mi_)) { _Pragma("unroll") for (int ks = 0; ks < 2; ++ks) D.ok[si][ks] = *(const GAS bf16x8*)(PROJ + (t0_ + 16 * si + fr) * A_PROJ + 512 + (hh_) * 64 + 32 * ks + 8 * fq); } \
    { const GAS float* sv_ = (const GAS float*)SCN + ((size_t)(bh_ * 64 + c_) * 3) * 64 + lane; D.u = sv_[0]; D.pm = sv_[64]; D.bc = sv_[128]; } \
    D.m_c = ((const GAS float*)MS)[bh_ * 64 + c_]; } while (0)
__device__ __forceinline__ void cellB_phase(Frame& F, const bf16* PROJ, const float* G16, const float* mhn, const bf16* CTS, const float* NS, const float* MS, const float* SCN, bf16* HS, int local) {
    constexpr int OP = 136;
    LAS unsigned char* vimg0 = F.lds;
    LAS bf16* stg0 = (LAS bf16*)(F.lds + 65536);
    int tid_ = HW_TID(F.wave); asm volatile("" : "+v"(tid_)); int bid_ = blockIdx.x; asm volatile("" : "+s"(bid_)); const int bid = bid_;
    const int tid = tid_, lane = tid & 63, w = __builtin_amdgcn_readfirstlane(tid >> 6), fr = lane & 15, fq = lane >> 4;
    const int hs = w >> 2, wj = w & 3;
    LAS bf16* stg = stg0 + w * (16 * OP + 32);
    for (int rb = local ? 4 * bid : bid, rbe = local ? 4 * bid + 4 : NT / 64; rb < rbe; rb += local ? 1 : F.G) {
        const int b = rb >> 6, c = rb & 63; const size_t t0 = (size_t)rb * 64;
#pragma clang loop unroll(disable)
        for (int it = 0; it < 2; ++it) {
            __syncthreads();
#pragma unroll
            for (int ps = 0; ps < 2; ++ps) { const int hv = 4 * it + 2 * hs + ps;
#pragma unroll
                for (int k = 0; k < 4; ++k) { const int q = 4 * wj + k, row = 4 * q + (lane >> 4), pc = lane & 15, ch = pc ^ (((row & 3) << 2) | ((row >> 2) & 3));
                    __builtin_amdgcn_global_load_lds((const unsigned*)(PROJ + (t0 + row) * A_PROJ + 1024 + hv * 128 + ch * 8), (LAS unsigned*)(vimg0 + (2 * hs + ps) * 16384 + q * 1024), 16, 0, 0); } }
            CellOps nxt; CELL_LOAD_OPS(nxt, rb, 4 * it + 2 * hs, wj);
            asm volatile("s_waitcnt vmcnt(0)" ::: "memory"); __syncthreads();
#pragma clang loop unroll(disable)
            for (int ps = 0; ps < 2; ++ps) {
                const int hh = 4 * it + 2 * hs + ps, bh = b * 8 + hh, mi = ps ? 3 - wj : wj;
                const LAS unsigned char* vimg = vimg0 + (2 * hs + ps) * 16384;
#define qf nxt.oq
#define kf nxt.ok
            const float u = nxt.u, pm = nxt.pm, bc = nxt.bc, m_c = nxt.m_c;
            f32x4 nv[2][2];
            { const float* np = NS + (size_t)(bh * 64 + c) * 64;
#pragma unroll
              for (int ks = 0; ks < 2; ++ks) { nv[ks][0] = *(const GAS f32x4*)(np + 32 * ks + 8 * fq); nv[ks][1] = *(const GAS f32x4*)(np + 32 * ks + 8 * fq + 4); } }
            const bf16* ctp = CTS + ((size_t)(bh * 64 + c) * 128 + fr) * 64 + 8 * fq;
            bf16x8 ctf[4][2];
#pragma unroll
            for (int cv = 0; cv < 4; ++cv)
#pragma unroll
                for (int ks = 0; ks < 2; ++ks) ctf[cv][ks] = *(const GAS bf16x8*)(ctp + (size_t)cv * 16 * 64 + 32 * ks);
            asm volatile("" ::: "memory");
            const float M = fmaxf(m_c, pm), av = __expf(m_c - M), em = __expf(-(bc + M));
            const int tme = 16 * mi + fr;
            const float Mt = __shfl(M, tme), at = __shfl(av, tme), et = __shfl(em, tme);
            bf16x8 wf[2]; float d1 = 0.f;
#pragma unroll
            for (int si = 0; si < 4; ++si) {
                unsigned w01 = 0u, w23 = 0u;
                if (si <= mi) { f32x4 acc = (f32x4){0.f, 0.f, 0.f, 0.f};
#pragma unroll
                    for (int ks = 0; ks < 2; ++ks) acc = __builtin_amdgcn_mfma_f32_16x16x32_bf16(kf[si][ks], qf[ks], acc, 0, 0, 0);
                    float wv[4];
#pragma unroll
                    for (int i = 0; i < 4; ++i) { const int s = 16 * si + 4 * fq + i; const float us = __shfl(u, s); wv[i] = (s <= tme) ? __expf(us - Mt) * acc[i] : 0.f; }
                    w01 = pk2(wv[0], wv[1]); w23 = pk2(wv[2], wv[3]);
                    d1 += (bf2f(w01 & 0xffffu) + bf2f(w01 >> 16)) + (bf2f(w23 & 0xffffu) + bf2f(w23 >> 16)); }
                wf[si >> 1][(si & 1) * 4 + 0] = (short)(w01 & 0xffffu); wf[si >> 1][(si & 1) * 4 + 1] = (short)(w01 >> 16); wf[si >> 1][(si & 1) * 4 + 2] = (short)(w23 & 0xffffu); wf[si >> 1][(si & 1) * 4 + 3] = (short)(w23 >> 16);
            }
            d1 += __shfl_xor(d1, 16); d1 += __shfl_xor(d1, 32);
            float qn = 0.f;
#pragma unroll
            for (int ks = 0; ks < 2; ++ks)
#pragma unroll
                for (int j = 0; j < 8; ++j) qn += bf2f((unsigned)(unsigned short)qf[ks][j]) * nv[ks][j >> 2][j & 3];
            qn += __shfl_xor(qn, 16); qn += __shfl_xor(qn, 32);
            const float inv = 1.0f / fmaxf(fabsf(d1 + at * qn), et);
            asm volatile("" ::: "memory");
            v4u og[2][2];
#pragma unroll
            for (int hlf = 0; hlf < 2; ++hlf) { const bf16* po = PROJ + (t0 + 16 * mi + (lane >> 3) + 8 * hlf) * A_PROJ + 2048 + hh * 128 + (lane & 7) * 16; og[hlf][0] = *(const GAS v4u*)po; og[hlf][1] = *(const GAS v4u*)(po + 8); }
            asm volatile("" ::: "memory");
            float a_i[4], inv_i[4];
#pragma unroll
            for (int i = 0; i < 4; ++i) { a_i[i] = __shfl(at, 4 * fq + i); inv_i[i] = __shfl(inv, 4 * fq + i); }
            float ssq[4] = {0.f, 0.f, 0.f, 0.f};
#pragma unroll
            for (int cv = 0; cv < 8; ++cv) { f32x4 a = (f32x4){0.f, 0.f, 0.f, 0.f};
#pragma unroll
                for (int ks = 0; ks < 2; ++ks) a = __builtin_amdgcn_mfma_f32_16x16x32_bf16(qf[ks], ctf[cv & 3][ks], a, 0, 0, 0);
                if (cv < 4) {
#pragma unroll
                    for (int ks = 0; ks < 2; ++ks) ctf[cv & 3][ks] = *(const GAS bf16x8*)(ctp + (size_t)(cv + 4) * 16 * 64 + 32 * ks); }
#pragma unroll
                for (int i = 0; i < 4; ++i) a[i] *= a_i[i];
#pragma unroll
                for (int ks = 0; ks < 2; ++ks) if (2 * ks <= mi) { const bf16x8 vf = tr_frag(vimg, lane, cv, 32 * ks + 4 * fq, 16); a = __builtin_amdgcn_mfma_f32_16x16x32_bf16(wf[ks], vf, a, 0, 0, 0); }
#pragma unroll
                for (int i = 0; i < 4; ++i) { a[i] *= inv_i[i]; ssq[i] += a[i] * a[i]; stg[(4 * fq + i) * OP + 16 * cv + fr] = (bf16)f2bf(a[i]); } }
            float rn[4];
#pragma unroll
            for (int i = 0; i < 4; ++i) { float s = ssq[i]; s += __shfl_xor(s, 1); s += __shfl_xor(s, 2); s += __shfl_xor(s, 4); s += __shfl_xor(s, 8); rn[i] = 1.0f / sqrtf(s * (1.0f / 128.0f) + EPS); }
            { LAS float* srn = (LAS float*)(stg + 16 * OP);
#pragma unroll
              for (int i = 0; i < 4; ++i) if (fr == 0) srn[4 * fq + i] = rn[i]; }
            LDS_WAIT(); asm volatile("" ::: "memory");
            f32x4 mhq[4];
#pragma unroll
            for (int q = 0; q < 4; ++q) mhq[q] = ((const GAS f32x4*)(mhn + hh * 128 + (lane & 7) * 16))[q];
#pragma unroll
            for (int hlf = 0; hlf < 2; ++hlf) { const int r = (lane >> 3) + 8 * hlf, sg = lane & 7;
                const v4u h0 = *(const LAS v4u*)(stg + r * OP + sg * 16), h1 = *(const LAS v4u*)(stg + r * OP + sg * 16 + 8);
                const v4u g0 = og[hlf][0], g1 = og[hlf][1]; v4u o0, o1; const float rnr = ((const LAS float*)(stg + 16 * OP))[r];
#pragma unroll
                for (int j = 0; j < 4; ++j) { const f32x4 m0 = mhq[j >> 1], m1 = mhq[2 + (j >> 1)]; const int e = (j & 1) * 2;
                    o0[j] = pk2(bf2f(h0[j] & 0xffffu) * rnr * m0[e] * bf2f(g0[j] & 0xffffu), bf2f(h0[j] >> 16) * rnr * m0[e + 1] * bf2f(g0[j] >> 16));
                    o1[j] = pk2(bf2f(h1[j] & 0xffffu) * rnr * m1[e] * bf2f(g1[j] & 0xffffu), bf2f(h1[j] >> 16) * rnr * m1[e + 1] * bf2f(g1[j] >> 16)); }
                if (OUT_F8) { v4u o8;
#pragma unroll
                    for (int j = 0; j < 2; ++j) { int w0 = 0, w1 = 0;
                        w0 = cvt8(bf2f(o0[2 * j] & 0xffffu), bf2f(o0[2 * j] >> 16), w0, false); w0 = cvt8(bf2f(o0[2 * j + 1] & 0xffffu), bf2f(o0[2 * j + 1] >> 16), w0, true);
                        w1 = cvt8(bf2f(o1[2 * j] & 0xffffu), bf2f(o1[2 * j] >> 16), w1, false); w1 = cvt8(bf2f(o1[2 * j + 1] & 0xffffu), bf2f(o1[2 * j + 1] >> 16), w1, true);
                        o8[j] = (unsigned)w0; o8[2 + j] = (unsigned)w1; }
                    *(GAS v4u*)((unsigned char*)HS + (t0 + 16 * mi + r) * DM + hh * 128 + sg * 16) = o8; }
                else { bf16* ho = HS + (t0 + 16 * mi + r) * DM + hh * 128 + sg * 16;
                    *(GAS v4u*)ho = o0; *(GAS v4u*)(ho + 8) = o1; } }
            LDS_WAIT(); asm volatile("" ::: "memory");
            if (ps == 0) CELL_LOAD_OPS(nxt, rb, hh + 1, 3 - wj);
            }
#undef qf
#undef kf
        }
    }
    __syncthreads();
}

struct DenseProb {
    const bf16* A; int lda; const bf16* Bt; int ldb; int K; int esz, scale_w, scale_a; pg8::StaticOrder S;
    int local, lw;
    __device__ __forceinline__ bool next(int i, pg8::Unit& u) const { if (local) { if (i >= S.nN) return false; u.pm = lw; u.pn = i; u.cls = 0; u.lb = 0; u.hf = 0; u.r0 = 0; return true; } return S.next(i, u); }
    __device__ __forceinline__ const char* a_base() const { return (const char*)A; }
    __device__ __forceinline__ void a_off(const pg8::Unit& u, int R0, int C0, unsigned (&o)[2][2]) const {
#pragma unroll
        for (int h = 0; h < 2; ++h)
#pragma unroll
            for (int i = 0; i < 2; ++i) o[h][i] = (unsigned)((u.pm * 256 + h * 128 + R0 + 64 * i) * lda) * esz + (unsigned)C0 * 2u; }
    __device__ __forceinline__ const char* b_tile(const pg8::Unit& u, int tt) const { return (const char*)Bt + (size_t)u.pn * 256 * ldb * esz + (size_t)tt * 128; }
};
struct ClassTab { const LAS int* blkstart; const LAS int* ncls; };
__device__ __forceinline__ void class_of(const ClassTab& T, pg8::Unit& u) { const int c = T.blkstart[64 + u.pm]; u.cls = c; u.lb = u.pm - T.blkstart[c]; }
__device__ __forceinline__ void pair_of(int cls, int& ea, int& eb) { const int g = cls / 6, p = cls % 6; const int a = p < 3 ? 0 : p < 5 ? 1 : 2, b = p < 3 ? p + 1 : p < 5 ? p - 1 : 3; ea = g * 4 + a; eb = g * 4 + b; }
struct Moe1Prob {
    const bf16* A; int ldb; int K; int esz, scale_w, scale_a; int dense_dbg; const bf16* Bt1l; const int* perm; ClassTab T; pg8::StaticOrder S;
    __device__ __forceinline__ bool next(int i, pg8::Unit& u) const { if (!S.next(i, u)) return false; class_of(T, u); return true; }
    __device__ __forceinline__ const char* a_base() const { return (const char*)A; }
    __device__ __forceinline__ void a_off(const pg8::Unit& u, int R0, int C0, unsigned (&o)[2][2]) const {
        const int n = T.ncls[u.cls];
#pragma unroll
        for (int h = 0; h < 2; ++h)
#pragma unroll
            for (int i = 0; i < 2; ++i) { int pos = u.lb * 256 + h * 128 + R0 + 64 * i; pos = pos < n ? pos : n - 1; int tok = ((const GAS int*)perm)[(size_t)u.cls * CLS_CAP + pos]; if (dense_dbg) tok = u.pm * 256 + h * 128 + R0 + 64 * i; o[h][i] = (unsigned)(tok * DM) * esz + (unsigned)C0 * 2u; } }
    __device__ __forceinline__ const char* b_tile(const pg8::Unit& u, int tt) const { int ea, eb; pair_of(u.cls, ea, eb); const int e = u.pn < 4 ? ea : eb;
        return (const char*)Bt1l + ((size_t)e * 1024 + (size_t)(u.pn & 3) * 256) * DM * esz + (size_t)tt * 128; }
};
struct Moe2Prob {
    const bf16* A; int ldb; int K; int esz, scale_w, scale_a; int halfmode; const bf16* Bt2l; ClassTab T; pg8::StaticOrder S;
    __device__ __forceinline__ bool next(int i, pg8::Unit& u) const {
        const int R = S.nwg / S.G, rem = S.nwg - R * S.G;
        if (2 * rem > S.G) { if (halfmode || !S.next(i, u)) return false; class_of(T, u); return true; }
        if (!halfmode) { if (i >= R || !S.next(i, u)) return false; class_of(T, u); return true; }
        if (i > 0 || S.c >= 2 * rem) return false;
        if (!S.next_L((long)R * S.G + (S.c >> 1), u)) return false;
        u.hf = 1; u.r0 = 128 * (S.c & 1); class_of(T, u); return true; }
    __device__ __forceinline__ const char* a_base() const { return (const char*)A; }
    __device__ __forceinline__ void a_off(const pg8::Unit& u, int R0, int C0, unsigned (&o)[2][2]) const {
#pragma unroll
        for (int h = 0; h < 2; ++h)
#pragma unroll
            for (int i = 0; i < 2; ++i) o[h][i] = (unsigned)((u.pm * 256 + h * 128 + R0 + 64 * i) * DM) * esz + (unsigned)C0 * 2u; }
    __device__ __forceinline__ const char* b_tile(const pg8::Unit& u, int tt) const { int ea, eb; pair_of(u.cls, ea, eb); const int half = (esz == 2) ? 8 : 4; const int e = tt < half ? ea : eb;
        return (const char*)Bt2l + ((size_t)e * 1024 + (size_t)u.pn * 256 + u.r0) * DE * esz + (size_t)(tt & (half - 1)) * 128; }
};

struct EpiProj {
    static constexpr bool PERM = true;
    bf16* O; int ldc; int split_cols; size_t split_stride; int nscale; float scale; int sig_from;
    __device__ __forceinline__ void operator()(const pg8::f32x4 (&acc)[2][2][4][2], const pg8::Unit& u, int wr, int wc, int fr, int fq) const {
        const int row0 = u.pm * 256 + wr * 64 + fr; int colt = u.pn * 256; bf16* base = O;
        if (split_cols) { const int t = colt / split_cols; base += (size_t)t * split_stride; colt -= t * split_cols; }
        const float sc = u.pn < nscale ? scale : 1.0f; const bool sg = u.pn >= sig_from;
        const int col0 = colt + wc * 32 + 8 * fq;
#pragma unroll
        for (int ai = 0; ai < 2; ++ai)
#pragma unroll
            for (int m = 0; m < 4; ++m) { bf16* rowp = base + (size_t)(row0 + ai * 128 + m * 16) * ldc + col0;
#pragma unroll
                for (int bj = 0; bj < 2; ++bj) { pg8::f32x4 v0 = acc[ai][bj][m][0] * sc, v1 = acc[ai][bj][m][1] * sc;
                    if (sg) {
#pragma unroll
                        for (int j = 0; j < 4; ++j) { v0[j] = pg8::sigmoidf_(v0[j]); v1[j] = pg8::sigmoidf_(v1[j]); } }
                    pg8::u32x4 w; w.x = pg8::cvt_pk_bf16(v0[0], v0[1]); w.y = pg8::cvt_pk_bf16(v0[2], v0[3]); w.z = pg8::cvt_pk_bf16(v1[0], v1[1]); w.w = pg8::cvt_pk_bf16(v1[2], v1[3]);
                    *(GAS pg8::u32x4*)(rowp + bj * 128) = w; } }
    }
};
#ifndef ERES_RB
#define ERES_RB 4
#endif
#ifndef ERES_RF
#define ERES_RF 2
#endif
struct EpiRes {
    static constexpr bool PERM = true;
    const void* base; int base_bf; bf16* out; const float* gate; int gstride;
    __device__ __forceinline__ void operator()(const pg8::f32x4 (&acc)[2][2][4][2], const pg8::Unit& u, int wr, int wc, int fr, int fq) const {
        const int row0 = u.pm * 256 + wr * 64 + fr, col0 = u.pn * 256 + wc * 32 + 8 * fq;
        const float* gp = gate + (size_t)(u.pm >> 4) * gstride + col0;
        pg8::f32x4 gv[2][2];
#pragma unroll
        for (int bj = 0; bj < 2; ++bj)
#pragma unroll
            for (int n = 0; n < 2; ++n) gv[bj][n] = *(const GAS pg8::f32x4*)(gp + bj * 128 + n * 4);
        if (base_bf) {
            constexpr int RB = ERES_RB;
#pragma unroll
            for (int g = 0; g < 8 / RB; ++g) {
                pg8::u32x4 t[RB][2];
#pragma unroll
                for (int q = 0; q < RB; ++q) { const int r = g * RB + q, ai = r >> 2, m = r & 3; const unsigned off = ((unsigned)(row0 + ai * 128 + m * 16) * DM + (unsigned)col0) * 2u;
#pragma unroll
                    for (int bj = 0; bj < 2; ++bj) t[q][bj] = *(const GAS pg8::u32x4*)((const GAS char*)base + off + bj * 256); }
#pragma unroll
                for (int q = 0; q < RB; ++q) { const int r = g * RB + q, ai = r >> 2, m = r & 3; const unsigned off = ((unsigned)(row0 + ai * 128 + m * 16) * DM + (unsigned)col0) * 2u;
#pragma unroll
                    for (int bj = 0; bj < 2; ++bj) { const pg8::u32x4 tt = t[q][bj];
                        const pg8::f32x4 b0 = (pg8::f32x4){bf2f(tt.x & 0xffffu), bf2f(tt.x >> 16), bf2f(tt.y & 0xffffu), bf2f(tt.y >> 16)}, b1 = (pg8::f32x4){bf2f(tt.z & 0xffffu), bf2f(tt.z >> 16), bf2f(tt.w & 0xffffu), bf2f(tt.w >> 16)};
                        const pg8::f32x4 v0 = b0 + gv[bj][0] * acc[ai][bj][m][0], v1 = b1 + gv[bj][1] * acc[ai][bj][m][1];
                        pg8::u32x4 w; w.x = pg8::cvt_pk_bf16(v0[0], v0[1]); w.y = pg8::cvt_pk_bf16(v0[2], v0[3]); w.z = pg8::cvt_pk_bf16(v1[0], v1[1]); w.w = pg8::cvt_pk_bf16(v1[2], v1[3]);
                        *(GAS pg8::u32x4*)((GAS char*)out + off + bj * 256) = w; } } }
        } else {
            constexpr int RF = ERES_RF;
#pragma unroll
            for (int g = 0; g < 8 / RF; ++g) {
                pg8::f32x4 f0[RF][2], f1[RF][2];
#pragma unroll
                for (int q = 0; q < RF; ++q) { const int r = g * RF + q, ai = r >> 2, m = r & 3; const size_t off = (size_t)(row0 + ai * 128 + m * 16) * DM + col0;
#pragma unroll
                    for (int bj = 0; bj < 2; ++bj) { f0[q][bj] = *(const GAS pg8::f32x4*)((const float*)base + off + bj * 128); f1[q][bj] = *(const GAS pg8::f32x4*)((const float*)base + off + bj * 128 + 4); } }
#pragma unroll
                for (int q = 0; q < RF; ++q) { const int r = g * RF + q, ai = r >> 2, m = r & 3; const size_t off = (size_t)(row0 + ai * 128 + m * 16) * DM + col0;
#pragma unroll
                    for (int bj = 0; bj < 2; ++bj) {
                        const pg8::f32x4 v0 = f0[q][bj] + gv[bj][0] * acc[ai][bj][m][0], v1 = f1[q][bj] + gv[bj][1] * acc[ai][bj][m][1];
                        pg8::u32x4 w; w.x = pg8::cvt_pk_bf16(v0[0], v0[1]); w.y = pg8::cvt_pk_bf16(v0[2], v0[3]); w.z = pg8::cvt_pk_bf16(v1[0], v1[1]); w.w = pg8::cvt_pk_bf16(v1[2], v1[3]);
                        *(GAS pg8::u32x4*)(out + off + bj * 128) = w; } } }
        }
    }
};
#ifndef MOE2_HALF_FIRST
#define MOE2_HALF_FIRST 1
#endif
#ifndef REP_MOE2
#define REP_MOE2 1
#endif
#ifndef REP_MOE1
#define REP_MOE1 1
#endif
#ifndef ESC_RB
#define ESC_RB 2
#endif
struct EpiResScatter {
    static constexpr bool PERM = true;
    unsigned char* wsb; unsigned xoff; const bf16* gate16; int gstride; const int* perm; ClassTab T; int skip = 0;
    __device__ __forceinline__ void operator()(const pg8::f32x4 (&acc)[2][2][4][2], const pg8::Unit& u, int wr, int wc, int fr, int fq) const {
#if REP_MOE2 > 1
        if (skip == 1) return;
#endif
        const int n = T.ncls[u.cls]; const int col0 = u.pn * 256 + u.r0 + wc * 32 + 8 * fq;
        int tok[2][4];
#pragma unroll
        for (int ai = 0; ai < 2; ++ai)
#pragma unroll
            for (int m = 0; m < 4; ++m) { int pos = u.lb * 256 + ai * 128 + wr * 64 + m * 16 + fr; pos = pos < n ? pos : n - 1; tok[ai][m] = ((const GAS int*)perm)[(size_t)u.cls * CLS_CAP + pos];
#if REP_MOE2 > 1
                if (skip == 2) tok[ai][m] = (u.pm * 256 + ai * 128 + wr * 64 + m * 16 + fr) & 65535;
#endif
            }
        const GAS char* const xb = (const GAS char*)wsb;
#pragma unroll
        for (int g_ = 0; g_ < 8 / ESC_RB; ++g_) {
            pg8::u32x4 xv[ESC_RB][2], gw[ESC_RB][2];
#pragma unroll
            for (int q = 0; q < ESC_RB; ++q) { const int r_ = g_ * ESC_RB + q, ai = r_ >> 2, m = r_ & 3; const int tk = tok[ai][m];
                const GAS char* xp = xb + (xoff + ((unsigned)tk * DM + (unsigned)col0) * 2u); const GAS char* gp = (const GAS char*)gate16 + ((unsigned)(tk >> 12) * (unsigned)gstride + (unsigned)col0) * 2u;
#pragma unroll
                for (int bj = 0; bj < 2; ++bj) { if (bj == 1 && u.hf) continue; xv[q][bj] = *(const GAS pg8::u32x4*)(xp + bj * 256); gw[q][bj] = *(const GAS pg8::u32x4*)(gp + bj * 256); } }
#pragma unroll
            for (int q = 0; q < ESC_RB; ++q) { const int r_ = g_ * ESC_RB + q, ai = r_ >> 2, m = r_ & 3; const int lr = ai * 128 + wr * 64 + m * 16 + fr; const int pos = u.lb * 256 + lr;
                const unsigned so = (pos < n) ? xoff + ((unsigned)tok[ai][m] * DM + (unsigned)col0) * 2u : (unsigned)WS_DUMP + ((unsigned)lr * DM + (unsigned)col0) * 2u;
                GAS char* sp = (GAS char*)wsb + so;
#pragma unroll
                for (int bj = 0; bj < 2; ++bj) { if (bj == 1 && u.hf) continue; const pg8::u32x4 t = xv[q][bj], g = gw[q][bj];
                    const pg8::f32x4 b0 = (pg8::f32x4){bf2f(t.x & 0xffffu), bf2f(t.x >> 16), bf2f(t.y & 0xffffu), bf2f(t.y >> 16)}, b1 = (pg8::f32x4){bf2f(t.z & 0xffffu), bf2f(t.z >> 16), bf2f(t.w & 0xffffu), bf2f(t.w >> 16)};
                    const pg8::f32x4 g0 = (pg8::f32x4){bf2f(g.x & 0xffffu), bf2f(g.x >> 16), bf2f(g.y & 0xffffu), bf2f(g.y >> 16)}, g1 = (pg8::f32x4){bf2f(g.z & 0xffffu), bf2f(g.z >> 16), bf2f(g.w & 0xffffu), bf2f(g.w >> 16)};
                    const pg8::f32x4 v0 = b0 + g0 * acc[ai][bj][m][0], v1 = b1 + g1 * acc[ai][bj][m][1];
                    pg8::u32x4 w; w.x = pg8::cvt_pk_bf16(v0[0], v0[1]); w.y = pg8::cvt_pk_bf16(v0[2], v0[3]); w.z = pg8::cvt_pk_bf16(v1[0], v1[1]); w.w = pg8::cvt_pk_bf16(v1[2], v1[3]);
                    *(GAS pg8::u32x4*)(sp + bj * 256) = w; } } }
    }
};
struct EpiAct {
    static constexpr bool PERM = true;
    bf16* act; const int* perm; const float2* wts; ClassTab T; int skip = 0;
    __device__ __forceinline__ void operator()(const pg8::f32x4 (&acc)[2][2][4][2], const pg8::Unit& u, int wr, int wc, int fr, int fq) const {
#if REP_MOE1 > 1
        if (skip) return;
#endif
        const int n = T.ncls[u.cls]; const int second = u.pn >> 2; const int col0 = second * 512 + (u.pn & 3) * 128 + wc * 32 + 8 * fq;
        float wtv[2][4];
#pragma unroll
        for (int ai = 0; ai < 2; ++ai)
#pragma unroll
            for (int m = 0; m < 4; ++m) { int pos = u.lb * 256 + ai * 128 + wr * 64 + m * 16 + fr; pos = pos < n ? pos : n - 1;
                const pg8::u32x2 pe = *(const GAS pg8::u32x2*)((const unsigned*)wts + ((size_t)u.cls * CLS_CAP + pos) * 4 + 1); wtv[ai][m] = __builtin_bit_cast(float, second ? pe.y : pe.x); }
#pragma unroll
        for (int ai = 0; ai < 2; ++ai)
#pragma unroll
            for (int m = 0; m < 4; ++m) { const int lr = ai * 128 + wr * 64 + m * 16 + fr; const float wt = wtv[ai][m];
                pg8::f32x4 g0 = acc[ai][0][m][0], g1 = acc[ai][0][m][1]; const pg8::f32x4 u0 = acc[ai][1][m][0], u1 = acc[ai][1][m][1];
#pragma unroll
                for (int j = 0; j < 4; ++j) { g0[j] = g0[j] * pg8::sigmoidf_(g0[j]) * u0[j] * wt; g1[j] = g1[j] * pg8::sigmoidf_(g1[j]) * u1[j] * wt; }
                if (MOE2_F8) { int w0 = 0, w1 = 0;
                    w0 = cvt8(g0[0] * 4.f, g0[1] * 4.f, w0, false); w0 = cvt8(g0[2] * 4.f, g0[3] * 4.f, w0, true);
                    w1 = cvt8(g1[0] * 4.f, g1[1] * 4.f, w1, false); w1 = cvt8(g1[2] * 4.f, g1[3] * 4.f, w1, true);
                    pg8::u32x2 w; w.x = (unsigned)w0; w.y = (unsigned)w1; *(GAS pg8::u32x2*)((unsigned char*)act + (size_t)(u.pm * 256 + lr) * DM + col0) = w; }
                else { pg8::u32x4 w; w.x = pg8::cvt_pk_bf16(g0[0], g0[1]); w.y = pg8::cvt_pk_bf16(g0[2], g0[3]); w.z = pg8::cvt_pk_bf16(g1[0], g1[1]); w.w = pg8::cvt_pk_bf16(g1[2], g1[3]);
                    *(GAS pg8::u32x4*)(act + (size_t)(u.pm * 256 + lr) * DM + col0) = w; } }
    }
};
__device__ __forceinline__ void build_class_tab(Frame& F, gu32* gcnt) {
    LAS int* blkstart = (LAS int*)(F.lds + TAB_OFF); LAS int* ncls = blkstart + 32;
    const int t = HW_TID(F.wave);
    if (t < NCLS) ncls[t] = (int)__hip_atomic_load(gcnt + t, RLX_AGENT);
    __syncthreads();
    if (t == 0) { int run = 0; for (int c = 0; c < NCLS; ++c) { blkstart[c] = run; run += (ncls[c] + 255) >> 8; } blkstart[NCLS] = run; }
    __syncthreads();
    if (t < blkstart[NCLS]) { int c = 0; while (c < NCLS - 1 && t >= blkstart[c + 1]) ++c; blkstart[64 + t] = c; }
    __syncthreads();
}

__global__ void __launch_bounds__(NWAVES * 64, 2) mk_fwd(Args args) {
    extern __shared__ __attribute__((aligned(16))) unsigned char lds[];
    Frame F;
    F.lds = (LAS unsigned char*)lds;
    F.MISC = (volatile LAS unsigned*)(F.lds + MISC_OFF);
    F.wave = __builtin_amdgcn_readfirstlane((int)threadIdx.x >> 6);
    F.G = gridDim.x; { const int bx = blockIdx.x; F.vcu = (F.G % 8 == 0) ? (bx % 8) * (F.G / 8) + bx / 8 : bx; F.cid = bx; }
    unsigned char* ws = args.ws;
    F.ctl = (gu32*)(ws + WS_CTL);
    for (int u = HW_TID(F.wave); u < (LDS_BYTES - LDSCTL_OFF) / 4; u += NWAVES * 64) ((LAS unsigned*)(F.lds + LDSCTL_OFF))[u] = 0u;
    __syncthreads();
    const int lo = args.ph_lo, hi = args.ph_hi;
    const bool multi = (hi - lo) > 1;
    XcdBarrier bar; bar.bar = (unsigned*)(F.ctl + CW_BAR); bar.x = 0; bar.st = nullptr; bar.w0 = F.wave;
    if (multi) bar = xcd_barrier_post((unsigned*)(F.ctl + CW_BAR), F.MISC + 8, F.wave);
    if (multi && HW_TID(F.wave) == 0) { const unsigned xcc = xb_xcc_id(); F.MISC[20] = xcc; F.MISC[21] = __hip_atomic_fetch_add(F.ctl + CW_XCCT + 64 * xcc, 1u, RLX_AGENT); }
    int ph = 0;
#define REPEAT(N) _Pragma("clang loop unroll(disable)") for (int rep_ = 0; rep_ < (N); ++rep_)
#ifndef REP_NORM1
#define REP_NORM1 1
#endif
#ifndef REP_PROJ
#define REP_PROJ 1
#endif
#ifndef REP_CELL
#define REP_CELL 1
#endif
#ifndef REP_CELLB
#define REP_CELLB 1
#endif
#ifndef REP_ATTN_NOFB
#define REP_ATTN_NOFB 0
#endif
#ifndef REP_ATTN
#define REP_ATTN 1
#endif
#ifndef REP_MOE1_DENSE
#define REP_MOE1_DENSE 0
#endif
#ifndef REP_MOE1
#define REP_MOE1 1
#endif
#ifndef REP_MOE2
#define REP_MOE2 1
#endif
#ifndef REP_MOE2_SKIP
#define REP_MOE2_SKIP 0
#endif
#ifndef REP_MOE1_SKIP
#define REP_MOE1_SKIP 0
#endif
#ifndef REP_NORM2N
#define REP_NORM2N 0
#endif
#ifdef PROBE_TYPE
    const bool pr_me = (blockIdx.x == 0 && HW_TID(F.wave) == 0);
#define PH_BEGIN(run, ty) const bool run = (lo <= ph && ph < hi); ++ph; const bool pr_on = pr_me && ((ty) == PROBE_TYPE); if (pr_on) { const unsigned long long t_ = __builtin_amdgcn_s_memrealtime(); F.MISC[16] = (unsigned)t_; F.MISC[17] = (unsigned)(t_ >> 32); }
#define PH_END(run) do { if (run && ph < hi) xcd_barrier(bar); if (pr_on) { const unsigned long long t0_ = ((unsigned long long)F.MISC[17] << 32) | F.MISC[16], a_ = (((unsigned long long)F.MISC[19] << 32) | F.MISC[18]) + (__builtin_amdgcn_s_memrealtime() - t0_); F.MISC[18] = (unsigned)a_; F.MISC[19] = (unsigned)(a_ >> 32); } } while (0)
#else
#define PH_BEGIN(run, ty) const bool run = (lo <= ph && ph < hi); ++ph;
#define PH_END(run) do { if (run && ph < hi) xcd_barrier(bar); } while (0)
#endif
    const bool chain = FUSE_LOCAL && (F.G == NT / 256);
#define PH_END_CHAIN(run) do { if (chain) { if (run && ph < hi) { asm volatile("s_waitcnt vmcnt(0)" ::: "memory"); __syncthreads(); } } else PH_END(run); } while (0)

    bf16* const X = (bf16*)(args.ws + WS_XB);

    { PH_BEGIN(run, 0) if (run) {
#ifndef DIS_P0
 p0_prologue(F, args);
#endif
 } PH_END(run); }

    if (multi && lo == 0 && F.G == 256) {
        unsigned cj[8];
#pragma unroll
        for (int j = 0; j < 8; ++j) cj[j] = __hip_atomic_load(F.ctl + CW_XCCT + 64 * j, RLX_AGENT);
        bool ok = true;
#pragma unroll
        for (int j = 0; j < 8; ++j) ok = ok & (cj[j] == 32u);
        if (ok) { const int xcc = (int)F.MISC[20], idx = (int)F.MISC[21]; F.vcu = __builtin_amdgcn_readfirstlane(xcc * 32 + idx); F.cid = __builtin_amdgcn_readfirstlane(idx * 8 + xcc); }
    }
    for (int step = 0; step < 5; ++step) {
        unsigned char* ws = args.ws; asm volatile("" : "+s"(ws));
        float* const MODS = (float*)(ws + WS_MODS);
        bf16* const HB = (bf16*)(ws + WS_HB);
        bf16* const BIG = (bf16*)(ws + WS_BIG);
        bf16* const ACT = (bf16*)(ws + WS_ACT);
        float* const G16 = (float*)(ws + WS_G16);
        float* const FB = (float*)(ws + WS_FB);
        float2* const WTS = (float2*)(ws + WS_PW);
        int* const PERM = (int*)(ws + WS_PERM);
        bf16* const Kb = BIG; bf16* const Vb = BIG + (size_t)NT * DM; bf16* const Qb = BIG + (size_t)2 * NT * DM;
        const int kind = step < 2 ? 0 : step == 2 ? 1 : 2;
        const int L = step < 2 ? step : step == 2 ? 2 : step - 1;
        const void* xin = (L == 0) ? (const void*)args.in[I_X] : (const void*)X; const int xin_bf = (L != 0);
        const float* mods = MODS + (size_t)L * NB * 6144;
        { PH_BEGIN(run, 1) if (run) {
#ifndef DIS_NORM1
            const float* gam = kind == 1 ? args.in[I_KVNORM] : args.in[I_NMIX] + L * DM;
            const float* shf = kind == 1 ? (const float*)(ws + WS_KVMOD) : mods; const float* scl = shf + 1024; const int mstr = kind == 1 ? 2048 : 6144;
            const int nmode = kind == 0 ? 1 : kind == 1 ? 2 : 0;
            const float* w16 = kind == 0 ? args.in[I_AWIN] + (size_t)L * DM * A_IN + A_PROJ : args.in[I_WKV] + 2048; const int ldw16 = kind == 0 ? A_IN : KV_OUT;
            const float* b16 = kind == 0 ? args.in[I_ABG] + L * 16 : args.in[I_BFG];
            REPEAT(REP_NORM1) normT_phase<false>(F, xin, xin_bf, gam, shf, scl, mstr, HB, nmode, w16, ldw16, b16, G16, nullptr, nullptr, nullptr);
#endif
          } if (kind == 1) PH_END(run); else PH_END_CHAIN(run); }
        { PH_BEGIN(run, 2) if (run) {
#ifndef DIS_PROJ
            if (kind == 1) fcum_phase(F, G16, FB);
            DenseProb P; P.A = HB; P.lda = DM; P.ldb = DM; P.K = DM; P.esz = PROJ_F8 ? 1 : 2; P.scale_w = 0x7a7a7a7a; P.scale_a = 0x7f7f7f7f;
            constexpr int WE = PROJ_F8 ? 1 : 2;
            EpiProj E; E.split_cols = 0; E.split_stride = 0; E.nscale = 0; E.scale = 1.f; E.sig_from = 1 << 30;
            if (kind == 0) { P.Bt = (const bf16*)(ws + WS_WIN + (size_t)L * A_PROJ * DM * WE); P.S.init(NT / 256, A_PROJ / 256, F.G, F.cid); E.O = BIG; E.ldc = A_PROJ; E.nscale = 2; E.scale = 0.125f; E.sig_from = 8; }
            else if (kind == 1) { P.Bt = (const bf16*)(ws + WS_WKV); P.S.init(NT / 256, 8, F.G, F.cid); E.O = Kb; E.ldc = DM; E.split_cols = 1024; E.split_stride = (size_t)NT * DM; }
            else { P.Bt = (const bf16*)(ws + WS_WQ + (size_t)(L - 2) * DM * DM * WE); P.S.init(NT / 256, 4, F.G, F.cid); E.O = Qb; E.ldc = DM; E.nscale = 4; E.scale = attn_body::C2; }
            P.local = chain ? 1 : 0; P.lw = (int)blockIdx.x;
            REPEAT(REP_PROJ) pg8::gemm_phase<EpiProj, DenseProb, true, PROJ_F8>(F.lds + RING_OFF, F.wave, P, E);
#endif
          } PH_END(run); }
        if (kind == 1) continue;
        bf16* const CTS = ACT; float* const NS = (float*)(ws + WS_ACT + (size_t)128 * MiB); float* const MS = NS + (size_t)NB * 8 * 64 * 64; float* const SCN = MS + NB * 8 * 64;
        if (kind == 0) { PH_BEGIN(run, 3) if (run) {
#ifndef DIS_CELL
            REPEAT(REP_CELL) cellA_phase(F, BIG, G16, CTS, NS, MS, SCN);
#endif
          } PH_END(run); }
        { PH_BEGIN(run, (kind == 0 ? 4 : 10)) if (run) {
#ifndef DIS_CELL
            if (kind == 0) REPEAT(REP_CELLB) cellB_phase(F, BIG, G16, args.in[I_AMH] + L * DM, CTS, NS, MS, SCN, HB, chain ? 1 : 0);
#endif
#ifndef DIS_ATTN
            if (kind == 2) REPEAT(REP_ATTN) { const attn_body::AttnTensors AT{(const attn_body::bf16*)Qb, (const attn_body::bf16*)Kb, (const attn_body::bf16*)Vb, (attn_body::bf16*)(rep_ + 1 < REP_ATTN ? ACT : (OUT_F8 ? HB : Qb)), FB};
                   if (rep_ + 1 < REP_ATTN) attn_body::attn_phase<60, (REP_ATTN_NOFB != 0)>((char*)lds + RING_OFF, AT, F.vcu, F.G, F.wave); else attn_body::attn_phase<60>((char*)lds + RING_OFF, AT, F.vcu, F.G, F.wave); }
#endif
          } if (kind == 0) PH_END_CHAIN(run); else PH_END(run); }
        { PH_BEGIN(run, 5) if (run) {
#ifndef DIS_OUT
            DenseProb P; P.A = (kind == 0 || OUT_F8) ? HB : Qb; P.lda = DM; P.ldb = DM; P.K = DM; P.esz = OUT_F8 ? 1 : 2; P.scale_w = 0x7a7a7a7a; P.scale_a = 0x7f7f7f7f;
            P.Bt = kind == 0 ? (const bf16*)(ws + WS_WOUT + (size_t)L * DM * DM * (OUT_F8 ? 1 : 2)) : (const bf16*)(ws + WS_WO + (size_t)(L - 2) * DM * DM * (OUT_F8 ? 1 : 2));
            P.S.init(NT / 256, 4, F.G, F.cid); P.local = chain ? 1 : 0; P.lw = (int)blockIdx.x;
            EpiRes E; E.base = xin; E.base_bf = xin_bf; E.out = X; E.gate = mods + 2048; E.gstride = 6144;
            pg8::gemm_phase<EpiRes, DenseProb, true, OUT_F8>(F.lds + RING_OFF, F.wave, P, E);
#endif
          } PH_END_CHAIN(run); }
        gu32* const gcnt = (gu32*)(ws + WS_CTL) + CW_CNT + L * 32;
        { PH_BEGIN(run, 6) if (run) {
#ifndef DIS_NORM2
            REPEAT(REP_NORM2N) norm_phase<false>(F, X, 1, args.in[I_NFFN] + L * DM, mods + 3072, mods + 4096, 6144, ACT, 0, nullptr, 0, nullptr, nullptr, nullptr, nullptr, nullptr);
            normT_phase<true>(F, X, 1, args.in[I_NFFN] + L * DM, mods + 3072, mods + 4096, 6144, HB, 3, args.in[I_WR], 16, args.in[I_RB], nullptr, WTS, PERM, gcnt);
#endif
          } PH_END(run); }
        const ClassTab CT{(const LAS int*)(F.lds + TAB_OFF), (const LAS int*)(F.lds + TAB_OFF) + 32};
        { PH_BEGIN(run, 7) if (run) {
#ifndef DIS_MOE1
            build_class_tab(F, gcnt);
            Moe1Prob P; P.A = HB; P.ldb = DM; P.K = DM; P.esz = MOE1_F8 ? 1 : 2; P.scale_w = 0x7a7a7a7a; P.scale_a = 0x7f7f7f7f;
            P.Bt1l = (const bf16*)(ws + WS_BT1 + (size_t)L * 16 * 1024 * DM * (MOE1_F8 ? 1 : 2)); P.perm = PERM; P.T = CT;
            P.S.init(CT.blkstart[NCLS], 8, F.G, F.cid);
            EpiAct E; E.act = ACT; E.perm = PERM; E.wts = WTS; E.T = CT;
            REPEAT(REP_MOE1) { P.dense_dbg = (rep_ + 1 < REP_MOE1) ? REP_MOE1_DENSE : 0; E.skip = (rep_ + 1 < REP_MOE1) ? REP_MOE1_SKIP : 0; pg8::gemm_phase<EpiAct, Moe1Prob, true, MOE1_F8>(F.lds + RING_OFF, F.wave, P, E); }
#endif
          } PH_END(run); }
        { PH_BEGIN(run, 8) if (run) {
#ifndef DIS_MOE2
            build_class_tab(F, gcnt);
            Moe2Prob P; P.A = ACT; P.ldb = DE; P.K = DM; P.esz = MOE2_F8 ? 1 : 2; P.scale_w = 0x7a7a7a7a; P.scale_a = 0x7d7d7d7d; P.Bt2l = (const bf16*)(ws + WS_BT2 + (size_t)L * 16 * DM * DE * (MOE2_F8 ? 1 : 2)); P.T = CT;
            P.S.init(CT.blkstart[NCLS], 4, F.G, F.cid);
            EpiResScatter E; E.wsb = ws; E.xoff = (unsigned)WS_XB; E.gate16 = (const bf16*)(ws + WS_MODS16) + (size_t)L * NB * 6144 + 5120; E.gstride = 6144; E.perm = PERM; E.T = CT;
            REPEAT(REP_MOE2) {
#if REP_MOE2 > 1
            E.xoff = (rep_ + 1 < REP_MOE2) ? (unsigned)(WS_BIG + (size_t)2 * NT * DM * 2) : (unsigned)WS_XB; E.skip = (rep_ + 1 < REP_MOE2) ? REP_MOE2_SKIP : 0;
#endif
#if MOE2_HALF_FIRST
            P.halfmode = 1; pg8::gemm_phase<EpiResScatter, Moe2Prob, true, MOE2_F8, true>(F.lds + RING_OFF, F.wave, P, E);
            P.halfmode = 0; pg8::gemm_phase<EpiResScatter, Moe2Prob, true, MOE2_F8>(F.lds + RING_OFF, F.wave, P, E); }
#else
            P.halfmode = 0; pg8::gemm_phase<EpiResScatter, Moe2Prob, true, MOE2_F8>(F.lds + RING_OFF, F.wave, P, E);
            P.halfmode = 1; pg8::gemm_phase<EpiResScatter, Moe2Prob, true, MOE2_F8, true>(F.lds + RING_OFF, F.wave, P, E); }
#endif
#endif
          } PH_END(run); }
    }
    { PH_BEGIN(run, 9) if (run) {
#ifndef DIS_FINAL
 final_norm_phase(F, X, args.out, args.in[I_NFIN], (const float*)(args.ws + WS_FIN), (const float*)(args.ws + WS_FIN) + 1024, 2048);
#endif
 } }
#ifdef PROBE_TYPE
    if (pr_me) { const unsigned long long t = __builtin_amdgcn_s_memrealtime(); const unsigned long long pr_acc = ((unsigned long long)F.MISC[19] << 32) | F.MISC[18]; while (__builtin_amdgcn_s_memrealtime() - t < 2 * pr_acc) __builtin_amdgcn_s_sleep(8); }
#endif
#undef PH_BEGIN
#undef PH_END
}
constexpr int N_PHASES = 1 + 2 * 8 + 2 + 2 * 7 + 1;

#ifndef MK_SPLIT
#define MK_SPLIT 0
#endif
extern "C" void kernel_launch(void* const* d_in, const int* in_sizes, int n_in, void* d_out, int out_size, void* d_ws, size_t ws_size, hipStream_t stream) {
    static int grid = 0;
    if (grid == 0) {
        if (n_in != 25 || in_sizes[0] != NT * DM || out_size != NT * DM || ws_size < WS_END) { fprintf(stderr, "kernel_launch: unexpected shapes (n_in %d, in0 %d, out %d, ws %zu); nothing launched\n", n_in, n_in > 0 ? in_sizes[0] : -1, out_size, ws_size); grid = -1; return; }
        int dev = 0, cus = 0, per_cu = 0;
        if (hipGetDevice(&dev) != hipSuccess || hipDeviceGetAttribute(&cus, hipDeviceAttributeMultiprocessorCount, dev) != hipSuccess) { grid = -1; return; }
        if (hipFuncSetAttribute((const void*)mk_fwd, hipFuncAttributeMaxDynamicSharedMemorySize, LDS_BYTES) != hipSuccess) { fprintf(stderr, "kernel_launch: hipFuncSetAttribute failed\n"); grid = -1; return; }
        if (hipOccupancyMaxActiveBlocksPerMultiprocessor(&per_cu, (const void*)mk_fwd, NWAVES * 64, LDS_BYTES) != hipSuccess || per_cu < 1) { fprintf(stderr, "kernel_launch: occupancy query reports %d workgroups per CU\n", per_cu); }
        (void)hipGetLastError();
        grid = cus;
    }
    if (grid < 0) return;
    if (hipMemsetAsync((char*)d_ws + WS_CTL, 0, CTL_ZERO_BYTES, stream) != hipSuccess) return;
    Args a{};
    for (int i = 0; i < 25; ++i) a.in[i] = (const float*)d_in[i];
    a.out = (float*)d_out; a.ws = (unsigned char*)d_ws;
#if MK_SPLIT
    for (int p = 0; p < N_PHASES; ++p) { a.ph_lo = p; a.ph_hi = p + 1; hipLaunchKernelGGL(mk_fwd, dim3(grid), dim3(NWAVES * 64), LDS_BYTES, stream, a); }
#else
    a.ph_lo = 0; a.ph_hi = N_PHASES;
    hipLaunchKernelGGL(mk_fwd, dim3(grid), dim3(NWAVES * 64), LDS_BYTES, stream, a);
#endif
}
```
